# Optimizing an MI355X kernel written in HIP

```python
import jax, jax.numpy as jnp
from jax import lax
import numpy as np

D_MODEL = 1024
BATCH = 4
SEQ = 8192
DEPTH = 1

HEAD_DIM = 64
MOBA_HEADS = 8
NSA_HEADS = 8
NSA_KV_HEADS = 2
NSA_GROUP = NSA_HEADS // NSA_KV_HEADS
MIX_WIDTH = (MOBA_HEADS + NSA_HEADS) * HEAD_DIM
MOBA_BLOCK = 256
MOBA_TOPK = 3
NSA_CMP_LEN = 32
NSA_CMP_STRIDE = 16
NSA_SLC_BLOCK = 64
NSA_SLC_TOPN = 16
NSA_WINDOW = 512
NSA_BRANCHES = 3
N_EXPERTS = 32
TOP_K = 4
D_FF = D_MODEL
SWIGLU_LIMIT = 7.0
SWIGLU_ALPHA = 1.702
MOE_ROW_BLOCK = 256
Q_BLOCK = 64
RMS_EPS = 1e-5
NEG_BIG = -1e30
NSA_GATE_COLS = NSA_BRANCHES * NSA_HEADS
IN_COLS = 3 * MOBA_HEADS * HEAD_DIM + NSA_HEADS * HEAD_DIM + 2 * NSA_BRANCHES * NSA_KV_HEADS * HEAD_DIM + NSA_GATE_COLS

kernel_name = 'hybrid_moba_nsa_moe_alibi'


def rmsnorm(x, g):
    xf = x.astype(jnp.float32)
    y = xf * lax.rsqrt(jnp.mean(xf * xf, axis=-1, keepdims=True) + RMS_EPS)
    return (y * g.astype(jnp.float32)).astype(x.dtype)


def masked_softmax(logits, mask):
    z = jnp.where(mask, logits, NEG_BIG)
    z = z - jnp.max(z, axis=-1, keepdims=True)
    p = jnp.where(mask, jnp.exp(z), 0.0)
    return p / jnp.maximum(jnp.sum(p, axis=-1, keepdims=True), 1e-30)


def alibi_slopes():
    n = MOBA_HEADS + NSA_HEADS
    s = jnp.exp2(-8.0 * jnp.arange(1, n + 1, dtype=jnp.float32) / n)
    return s[0::2], s[1::2]


def moba_attention(q, k, v, slopes):
    B, S, H, hd = q.shape
    nb = -(-S // MOBA_BLOCK)
    pad = nb * MOBA_BLOCK - S
    padw = ((0, 0), (0, pad), (0, 0), (0, 0))
    kb = jnp.pad(k, padw).reshape(B, nb, MOBA_BLOCK, H, hd).transpose(0, 3, 1, 2, 4)
    vb = jnp.pad(v, padw).reshape(B, nb, MOBA_BLOCK, H, hd).transpose(0, 3, 1, 2, 4)
    kmean = jnp.mean(kb.astype(jnp.float32), axis=3)
    qh = q.transpose(0, 2, 1, 3) * (hd ** -0.5)
    topk = min(MOBA_TOPK, nb)
    nsel = topk * MOBA_BLOCK
    bi = jnp.arange(B)[:, None, None, None]
    hi = jnp.arange(H)[None, :, None, None]
    sl = slopes[None, :, None, None]
    offs = jnp.arange(MOBA_BLOCK)

    def chunk(c):
        t0 = c * Q_BLOCK
        qc = lax.dynamic_slice_in_dim(qh, t0, Q_BLOCK, axis=2)
        t = t0 + jnp.arange(Q_BLOCK)
        cur = t // MOBA_BLOCK
        gate = jnp.einsum('bhcd,bhnd->bhcn', qc.astype(jnp.float32), kmean)
        past = jnp.arange(nb)[None, :] < cur[:, None]
        _, idx = lax.top_k(jnp.where(past, gate, -jnp.inf), topk)
        ksel = kb[bi, hi, idx]
        vsel = vb[bi, hi, idx]
        pos_sel = idx[..., None] * MOBA_BLOCK + offs
        dist_sel = (t[None, None, :, None, None] - pos_sel).astype(jnp.float32)
        s_sel = jnp.einsum('bhcd,bhcnjd->bhcnj', qc, ksel, preferred_element_type=jnp.float32) - sl[..., None] * dist_sel
        mask_sel = jnp.broadcast_to((jnp.arange(topk)[None, :] < cur[:, None])[None, None, :, :, None], s_sel.shape)
        cb = t0 // MOBA_BLOCK
        kown = lax.dynamic_index_in_dim(kb, cb, axis=2, keepdims=False)
        vown = lax.dynamic_index_in_dim(vb, cb, axis=2, keepdims=False)
        pos_own = cb * MOBA_BLOCK + offs
        dist_own = (t[:, None] - pos_own[None, :]).astype(jnp.float32)
        s_own = jnp.einsum('bhcd,bhjd->bhcj', qc, kown, preferred_element_type=jnp.float32) - sl * dist_own
        mask_own = jnp.broadcast_to((dist_own >= 0)[None, None], s_own.shape)
        logits = jnp.concatenate([s_sel.reshape(B, H, Q_BLOCK, nsel), s_own], axis=-1)
        mask = jnp.concatenate([mask_sel.reshape(B, H, Q_BLOCK, nsel), mask_own], axis=-1)
        p = masked_softmax(logits, mask).astype(v.dtype)
        out = jnp.einsum('bhcm,bhcmd->bhcd', p[..., :nsel], vsel.reshape(B, H, Q_BLOCK, nsel, hd))
        return out + jnp.einsum('bhcj,bhjd->bhcd', p[..., nsel:], vown)

    outs = lax.map(chunk, jnp.arange(S // Q_BLOCK))
    return outs.transpose(1, 0, 3, 2, 4).reshape(B, S, H * hd)


def compress_blocks(kv, pe, w1, w2):
    B, S, G, hd = kv.shape
    n_cmp = (S - NSA_CMP_LEN) // NSA_CMP_STRIDE + 1
    idx = jnp.arange(n_cmp)[:, None] * NSA_CMP_STRIDE + jnp.arange(NSA_CMP_LEN)[None, :]
    blk = kv[:, idx] + pe[None, None, :, None, :]
    flat = blk.transpose(0, 1, 3, 2, 4).reshape(B, n_cmp, G, NSA_CMP_LEN * hd)
    return jax.nn.gelu(flat @ w1) @ w2


def nsa_attention(q, kc, vc, ks, vs, kw, vw, gate_logits, pe_k, pe_v, w1_k, w2_k, w1_v, w2_v, slopes):
    B, S, Hq, hd = q.shape
    G, Hg = NSA_KV_HEADS, NSA_GROUP
    dt = q.dtype
    n_cmp = (S - NSA_CMP_LEN) // NSA_CMP_STRIDE + 1
    n_slc = S // NSA_SLC_BLOCK
    topn = min(NSA_SLC_TOPN, n_slc)
    W = NSA_WINDOW
    kcmp = compress_blocks(kc, pe_k, w1_k, w2_k)
    vcmp = compress_blocks(vc, pe_v, w1_v, w2_v)
    cmp_pos = jnp.arange(n_cmp) * NSA_CMP_STRIDE + NSA_CMP_LEN - 1
    cu, su = NSA_CMP_LEN // NSA_CMP_STRIDE, NSA_SLC_BLOCK // NSA_CMP_STRIDE
    ii = jnp.arange(n_cmp)[:, None]
    jj = jnp.arange(n_slc)[None, :]
    overlap = jnp.clip(jnp.minimum(ii + cu, (jj + 1) * su) - jnp.maximum(ii, jj * su), 0, None).astype(jnp.float32)
    qh = q.reshape(B, S, G, Hg, hd).transpose(0, 2, 3, 1, 4) * (hd ** -0.5)
    ksb = ks.reshape(B, n_slc, NSA_SLC_BLOCK, G, hd).transpose(0, 3, 1, 2, 4)
    vsb = vs.reshape(B, n_slc, NSA_SLC_BLOCK, G, hd).transpose(0, 3, 1, 2, 4)
    padw = ((0, 0), (W, 0), (0, 0), (0, 0))
    kwp = jnp.pad(kw, padw).transpose(0, 2, 1, 3)
    vwp = jnp.pad(vw, padw).transpose(0, 2, 1, 3)
    gates = jax.nn.sigmoid(gate_logits.astype(jnp.float32)).reshape(B, S, G, Hg, NSA_BRANCHES).transpose(0, 2, 3, 1, 4)
    sl = slopes.reshape(G, Hg)[None, :, :, None, None]
    bi = jnp.arange(B)[:, None, None, None]
    gi = jnp.arange(G)[None, :, None, None]
    soffs = jnp.arange(NSA_SLC_BLOCK)
    nwin = Q_BLOCK + W - 1
    nsel = topn * NSA_SLC_BLOCK

    def chunk(c):
        t0 = c * Q_BLOCK
        qc = lax.dynamic_slice_in_dim(qh, t0, Q_BLOCK, axis=3)
        t = t0 + jnp.arange(Q_BLOCK)
        dist_c = (t[:, None] - cmp_pos[None, :]).astype(jnp.float32)
        s_c = jnp.einsum('bghcd,bngd->bghcn', qc, kcmp, preferred_element_type=jnp.float32)
        p_c = masked_softmax(s_c - sl * dist_c, dist_c >= 0)
        o_c = jnp.einsum('bghcn,bngd->bghcd', p_c.astype(dt), vcmp)
        imp = jnp.einsum('bghcn,nj->bgcj', p_c, overlap)
        cur = t // NSA_SLC_BLOCK
        jr = jnp.arange(n_slc)[None, :]
        forced = (jr == 0) | (jr == cur[:, None]) | (jr == cur[:, None] - 1)
        allowed = jr <= cur[:, None]
        score = jnp.where(allowed, jnp.where(forced, jnp.inf, imp), -jnp.inf)
        _, sidx = lax.top_k(score, topn)
        ksel = ksb[bi, gi, sidx]
        vsel = vsb[bi, gi, sidx]
        pos_s = sidx[..., None] * NSA_SLC_BLOCK + soffs
        dist_s = (t[None, None, :, None, None] - pos_s).astype(jnp.float32)[:, :, None]
        s_s = jnp.einsum('bghcd,bgcnjd->bghcnj', qc, ksel, preferred_element_type=jnp.float32) - sl[..., None] * dist_s
        p_s = masked_softmax(s_s.reshape(B, G, Hg, Q_BLOCK, nsel), (dist_s >= 0).reshape(B, G, 1, Q_BLOCK, nsel))
        o_s = jnp.einsum('bghcm,bgcmd->bghcd', p_s.astype(dt), vsel.reshape(B, G, Q_BLOCK, nsel, hd))
        kwin = lax.dynamic_slice_in_dim(kwp, t0 + 1, nwin, axis=2)
        vwin = lax.dynamic_slice_in_dim(vwp, t0 + 1, nwin, axis=2)
        pos_w = t0 - W + 1 + jnp.arange(nwin)
        dist_w = t[:, None] - pos_w[None, :]
        mask_w = (dist_w >= 0) & (dist_w < W) & (pos_w[None, :] >= 0)
        s_w = jnp.einsum('bghcd,bgjd->bghcj', qc, kwin, preferred_element_type=jnp.float32)
        p_w = masked_softmax(s_w - sl * dist_w.astype(jnp.float32), mask_w)
        o_w = jnp.einsum('bghcj,bgjd->bghcd', p_w.astype(dt), vwin)
        g = lax.dynamic_slice_in_dim(gates, t0, Q_BLOCK, axis=3).astype(dt)
        return g[..., 0:1] * o_c + g[..., 1:2] * o_s + g[..., 2:3] * o_w

    outs = lax.map(chunk, jnp.arange(S // Q_BLOCK))
    return outs.transpose(1, 0, 4, 2, 3, 5).reshape(B, S, Hq * hd)


def clamped_swiglu(h):
    g = jnp.minimum(h[..., 0::2], SWIGLU_LIMIT)
    u = jnp.clip(h[..., 1::2], -SWIGLU_LIMIT, SWIGLU_LIMIT)
    return g * jax.nn.sigmoid(SWIGLU_ALPHA * g) * (u + 1.0)


def moe_ffn(h, w_router, b_router, w_up, b_up, w_down, b_down):
    B, S, D = h.shape
    N = B * S
    NK = N * TOP_K
    ht = h.reshape(N, D)
    logits = (ht @ w_router + b_router).astype(jnp.float32)
    top_val, top_idx = lax.top_k(logits, TOP_K)
    wts = jax.nn.softmax(top_val, axis=-1)
    flat_e = top_idx.reshape(NK)
    flat_tok = jnp.repeat(jnp.arange(N, dtype=jnp.int32), TOP_K)
    order = jnp.argsort(flat_e, stable=True)
    se, stok, sw = flat_e[order], flat_tok[order], wts.reshape(NK)[order]
    counts = jnp.bincount(flat_e, length=N_EXPERTS)
    starts = jnp.cumsum(counts) - counts
    padded = (counts + MOE_ROW_BLOCK - 1) // MOE_ROW_BLOCK * MOE_ROW_BLOCK
    pends = jnp.cumsum(padded)
    pstarts = pends - padded
    dest = pstarts[se] + jnp.arange(NK) - starts[se]
    n_blk = (NK + N_EXPERTS * MOE_ROW_BLOCK + MOE_ROW_BLOCK - 1) // MOE_ROW_BLOCK
    P = n_blk * MOE_ROW_BLOCK
    row_tok = jnp.full((P,), N, jnp.int32).at[dest].set(stok)
    xrows = jnp.concatenate([ht, jnp.zeros((1, D), ht.dtype)], axis=0)[row_tok].reshape(n_blk, MOE_ROW_BLOCK, D)
    blk_e = jnp.minimum(jnp.searchsorted(pends, jnp.arange(n_blk) * MOE_ROW_BLOCK, side='right'), N_EXPERTS - 1)

    def expert_block(args):
        xb, e = args
        a = clamped_swiglu(xb @ w_up[e] + b_up[e])
        return a @ w_down[e] + b_down[e]

    yrows = lax.map(expert_block, (xrows, blk_e)).reshape(P, D)
    contrib = yrows[dest] * sw[:, None].astype(yrows.dtype)
    return jax.ops.segment_sum(contrib, stok, num_segments=N).reshape(B, S, D)


def setup_inputs(seed: int = 0) -> dict:
    key = jax.random.key(seed)
    k = jax.random.split(key, 20)
    hd, L = HEAD_DIM, NSA_CMP_LEN

    def nrm(kk, shape, scale):
        return jax.random.normal(kk, shape, jnp.float32) * scale

    return {
        'x': nrm(k[0], (BATCH, SEQ, D_MODEL), 1.0),
        'attn_norm_g': 1.0 + nrm(k[1], (DEPTH, D_MODEL), 0.02),
        'w_in': nrm(k[2], (DEPTH, D_MODEL, IN_COLS), D_MODEL ** -0.5),
        'cmp_pe_k': nrm(k[3], (DEPTH, L, hd), 0.1),
        'cmp_pe_v': nrm(k[4], (DEPTH, L, hd), 0.1),
        'cmp_w1_k': nrm(k[5], (DEPTH, L * hd, hd), (L * hd) ** -0.5),
        'cmp_w2_k': nrm(k[6], (DEPTH, hd, hd), hd ** -0.5),
        'cmp_w1_v': nrm(k[7], (DEPTH, L * hd, hd), (L * hd) ** -0.5),
        'cmp_w2_v': nrm(k[8], (DEPTH, hd, hd), hd ** -0.5),
        'w_out': nrm(k[9], (DEPTH, MIX_WIDTH, D_MODEL), MIX_WIDTH ** -0.5),
        'ffn_norm_g': 1.0 + nrm(k[10], (DEPTH, D_MODEL), 0.02),
        'w_router': nrm(k[11], (DEPTH, D_MODEL, N_EXPERTS), D_MODEL ** -0.5),
        'b_router': nrm(k[12], (DEPTH, N_EXPERTS), 0.01),
        'w_up': nrm(k[13], (DEPTH, N_EXPERTS, D_MODEL, 2 * D_FF), D_MODEL ** -0.5),
        'b_up': nrm(k[14], (DEPTH, N_EXPERTS, 2 * D_FF), 0.01),
        'w_down': nrm(k[15], (DEPTH, N_EXPERTS, D_FF, D_MODEL), D_FF ** -0.5),
        'b_down': nrm(k[16], (DEPTH, N_EXPERTS, D_MODEL), 0.01),
        'final_norm_g': 1.0 + nrm(k[17], (D_MODEL,), 0.02),
    }


def reference(x, attn_norm_g, w_in, cmp_pe_k, cmp_pe_v, cmp_w1_k, cmp_w2_k, cmp_w1_v, cmp_w2_v, w_out, ffn_norm_g, w_router, b_router, w_up, b_up, w_down, b_down, final_norm_g):
    B, S, _ = x.shape
    moba_sl, nsa_sl = alibi_slopes()
    sizes = [MOBA_HEADS * HEAD_DIM] * 3 + [NSA_HEADS * HEAD_DIM] + [NSA_KV_HEADS * HEAD_DIM] * (2 * NSA_BRANCHES) + [NSA_GATE_COLS]
    cuts = [int(c) for c in np.cumsum(sizes)[:-1]]

    def heads(t, n):
        return t.reshape(B, S, n, HEAD_DIM)

    for l in range(DEPTH):
        xn = rmsnorm(x, attn_norm_g[l])
        mq, mk, mv, nq, kc, vc, ks, vs, kw, vw, ng = jnp.split(xn @ w_in[l], cuts, axis=-1)
        o_moba = moba_attention(heads(mq, MOBA_HEADS), heads(mk, MOBA_HEADS), heads(mv, MOBA_HEADS), moba_sl)
        o_nsa = nsa_attention(heads(nq, NSA_HEADS), heads(kc, NSA_KV_HEADS), heads(vc, NSA_KV_HEADS),
                              heads(ks, NSA_KV_HEADS), heads(vs, NSA_KV_HEADS), heads(kw, NSA_KV_HEADS),
                              heads(vw, NSA_KV_HEADS), ng, cmp_pe_k[l], cmp_pe_v[l], cmp_w1_k[l],
                              cmp_w2_k[l], cmp_w1_v[l], cmp_w2_v[l], nsa_sl)
        x = x + jnp.concatenate([o_moba, o_nsa], axis=-1) @ w_out[l]
        x = x + moe_ffn(rmsnorm(x, ffn_norm_g[l]), w_router[l], b_router[l], w_up[l], b_up[l], w_down[l], b_down[l])
    return rmsnorm(x, final_norm_g)
```

```cpp
#include <hip/hip_runtime.h>
#include <hip/hip_cooperative_groups.h>
#include <cstdio>
#include <cstdint>
namespace cg = cooperative_groups;

constexpr int NB = 4, SEQ = 8192, DM = 1024, NTOK = NB * SEQ;
constexpr int INC = 2840;
constexpr int C_MQ = 0, C_MK = 512, C_MV = 1024, C_NQ = 1536, C_KC = 2048, C_VC = 2176, C_KS = 2304, C_VS = 2432,
              C_KW = 2560, C_VW = 2688, C_NG = 2816;
constexpr int NCMP = 511, NCMPP = 512;
constexpr int NE = 32, TOPK = 4, NK = NTOK * TOPK;
constexpr int DFF2 = 2048;

constexpr size_t OFF_XN   = 0;
constexpr size_t OFF_BIG  = OFF_XN + (size_t)NTOK * DM;
constexpr size_t OFF_MIX  = OFF_BIG + (size_t)NK * DM;
constexpr size_t OFF_KMEAN = OFF_MIX + (size_t)NTOK * DM;
constexpr size_t OFF_KCMP = OFF_KMEAN + 65536;
constexpr size_t OFF_VCMP = OFF_KCMP + 262144;
constexpr size_t OFF_SELE = OFF_VCMP + 262144;
constexpr size_t OFF_SELW = OFF_SELE + NK;
constexpr size_t OFF_RTOK = OFF_SELW + NK;
constexpr size_t OFF_RW   = OFF_RTOK + NK;
constexpr size_t OFF_CNT  = OFF_RW + NK;
constexpr size_t WS_FLOATS = OFF_CNT + 64;

struct Params {
    const float *x, *attn_g, *w_in, *pe_k, *pe_v, *w1k, *w2k, *w1v, *w2v, *w_out, *ffn_g, *w_router, *b_router,
        *w_up, *b_up, *w_down, *b_down, *final_g;
    float* out;
    float* ws;
    int ph_lo, ph_hi;
};

__device__ __forceinline__ float wave_sum(float v) {
#pragma unroll
    for (int o = 32; o > 0; o >>= 1) v += __shfl_xor(v, o);
    return v;
}
__device__ __forceinline__ float wave_max(float v) {
#pragma unroll
    for (int o = 32; o > 0; o >>= 1) v = fmaxf(v, __shfl_xor(v, o));
    return v;
}
__device__ __forceinline__ int wave_min_i(int v) {
#pragma unroll
    for (int o = 32; o > 0; o >>= 1) v = min(v, __shfl_xor(v, o));
    return v;
}
__device__ __forceinline__ float dot4(float4 a, float4 b) { return a.x * b.x + a.y * b.y + a.z * b.z + a.w * b.w; }

__device__ __forceinline__ float dot64(const float* qs, const float* krow) {
    const float4* k4 = (const float4*)krow;
    const float4* q4 = (const float4*)qs;
    float s = 0.f;
#pragma unroll
    for (int i = 0; i < 16; ++i) s += dot4(q4[i], k4[i]);
    return s;
}

template <class Epi>
__device__ __forceinline__ void gemm_tile(float* lds, const float* aptr, int K, const float* Bm, int ldb, int ncols,
                                          int col0, Epi epi) {
    float* As = lds;
    float* Bs = lds + 16 * 68;
    const int tid = threadIdx.x, tx = tid & 15, ty = tid >> 4;
    const int ar = tid >> 2, akq = (tid & 3) * 4;
    const int bk = tid >> 4, bc = (tid & 15) * 4;
    const bool bvalid = (col0 + bc) < ncols;
    float acc[4][4];
#pragma unroll
    for (int i = 0; i < 4; ++i)
#pragma unroll
        for (int j = 0; j < 4; ++j) acc[i][j] = 0.f;
    for (int k0 = 0; k0 < K; k0 += 16) {
        float4 a = make_float4(0.f, 0.f, 0.f, 0.f), b = make_float4(0.f, 0.f, 0.f, 0.f);
        if (aptr) a = *(const float4*)(aptr + k0 + akq);
        if (bvalid) b = *(const float4*)(Bm + (size_t)(k0 + bk) * ldb + col0 + bc);
        __syncthreads();
        As[(akq + 0) * 68 + ar] = a.x;
        As[(akq + 1) * 68 + ar] = a.y;
        As[(akq + 2) * 68 + ar] = a.z;
        As[(akq + 3) * 68 + ar] = a.w;
        *(float4*)(Bs + bk * 68 + bc) = b;
        __syncthreads();
#pragma unroll
        for (int kk = 0; kk < 16; ++kk) {
            const float4 av = *(const float4*)(As + kk * 68 + ty * 4);
            const float4 bv = *(const float4*)(Bs + kk * 68 + tx * 4);
            const float aa[4] = {av.x, av.y, av.z, av.w};
            const float bb[4] = {bv.x, bv.y, bv.z, bv.w};
#pragma unroll
            for (int i = 0; i < 4; ++i)
#pragma unroll
                for (int j = 0; j < 4; ++j) acc[i][j] += aa[i] * bb[j];
        }
    }
    if (bvalid) {
#pragma unroll
        for (int i = 0; i < 4; ++i) epi(ty * 4 + i, col0 + tx * 4, make_float4(acc[i][0], acc[i][1], acc[i][2], acc[i][3]));
    }
}

__device__ __forceinline__ void ph_norm1(const Params& p) {
    const int lane = threadIdx.x & 63, w = threadIdx.x >> 6;
    if (blockIdx.x == 0 && threadIdx.x < 64) ((int*)(p.ws + OFF_CNT))[threadIdx.x] = 0;
    float* xn = p.ws + OFF_XN;
    for (int row = blockIdx.x * 4 + w; row < NTOK; row += gridDim.x * 4) {
        const float4* xr = (const float4*)(p.x + (size_t)row * DM);
        float4 v[4];
        float ss = 0.f;
#pragma unroll
        for (int j = 0; j < 4; ++j) { v[j] = xr[lane + 64 * j]; ss += dot4(v[j], v[j]); }
        ss = wave_sum(ss);
        const float r = 1.0f / sqrtf(ss * (1.0f / DM) + 1e-5f);
        const float4* g4 = (const float4*)p.attn_g;
        float4* o = (float4*)(xn + (size_t)row * DM);
#pragma unroll
        for (int j = 0; j < 4; ++j) {
            const float4 g = g4[lane + 64 * j];
            o[lane + 64 * j] = make_float4(v[j].x * r * g.x, v[j].y * r * g.y, v[j].z * r * g.z, v[j].w * r * g.w);
        }
    }
}

__device__ __forceinline__ void ph_proj(const Params& p, float* lds) {
    const float* xn = p.ws + OFF_XN;
    float* proj = p.ws + OFF_BIG;
    constexpr int NT = (INC + 63) / 64;
    for (int it = blockIdx.x; it < (NTOK / 64) * NT; it += gridDim.x) {
        const int m = it / NT, n = it % NT;
        const float* aptr = xn + (size_t)(m * 64 + (threadIdx.x >> 2)) * DM;
        gemm_tile(lds, aptr, DM, p.w_in, INC, INC, n * 64, [&](int rl, int c, float4 v) {
            *(float4*)(proj + (size_t)(m * 64 + rl) * INC + c) = v;
        });
    }
}

__device__ __forceinline__ float gelu_tanh(float x) {
    return 0.5f * x * (1.0f + tanhf(0.7978845608028654f * (x + 0.044715f * x * x * x)));
}

__device__ __forceinline__ void ph_pre_attn(const Params& p, float* lds) {
    const int tid = threadIdx.x, lane = tid & 63, w = tid >> 6;
    const float* proj = p.ws + OFF_BIG;
    float* kmean = p.ws + OFF_KMEAN;
    for (int it = blockIdx.x * 4 + w; it < NB * 32 * 8; it += gridDim.x * 4) {
        const int h = it & 7, n = (it >> 3) & 31, b = it >> 8;
        const float* base = proj + (size_t)(b * SEQ + n * 256) * INC + C_MK + h * 64 + lane;
        float s = 0.f;
        for (int j = 0; j < 256; ++j) s += base[(size_t)j * INC];
        kmean[((b * 8 + h) * 32 + n) * 64 + lane] = s * (1.0f / 256.0f);
    }
    float* flat = lds;
    float* red = lds + 2048;
    float* h1 = lds + 2048 + 256;
    for (int it = blockIdx.x; it < 2 * NB * NCMP * 2; it += gridDim.x) {
        const int g = it & 1;
        const int i = (it >> 1) % NCMP;
        const int b = ((it >> 1) / NCMP) % NB;
        const int kv = (it >> 1) / (NCMP * NB);
        const float* pe = kv ? p.pe_v : p.pe_k;
        const float* w1 = kv ? p.w1v : p.w1k;
        const float* w2 = kv ? p.w2v : p.w2k;
        float* dst = p.ws + (kv ? OFF_VCMP : OFF_KCMP);
        const int col = (kv ? C_VC : C_KC) + g * 64;
        __syncthreads();
        for (int e = tid; e < 2048; e += 256) {
            const int l = e >> 6, d = e & 63;
            flat[e] = proj[(size_t)(b * SEQ + i * 16 + l) * INC + col + d] + pe[l * 64 + d];
        }
        __syncthreads();
        {
            const int c = tid & 63, part = tid >> 6;
            float s = 0.f;
            for (int f = part * 512; f < part * 512 + 512; ++f) s += flat[f] * w1[f * 64 + c];
            red[part * 64 + c] = s;
        }
        __syncthreads();
        if (tid < 64) h1[tid] = gelu_tanh(red[tid] + red[64 + tid] + red[128 + tid] + red[192 + tid]);
        __syncthreads();
        if (tid < 64) {
            float o = 0.f;
            for (int cc = 0; cc < 64; ++cc) o += h1[cc] * w2[cc * 64 + tid];
            dst[(size_t)((b * 2 + g) * NCMPP + i) * 64 + tid] = o;
        }
    }
}

__device__ __forceinline__ void ph_attn(const Params& p, float* lds) {
    const int tid = threadIdx.x, lane = tid & 63, w = tid >> 6;
    const float* proj = p.ws + OFF_BIG;
    const float* kmean = p.ws + OFF_KMEAN;
    const float* kcmp = p.ws + OFF_KCMP;
    const float* vcmp = p.ws + OFF_VCMP;
    float* mix = p.ws + OFF_MIX;
    float* q_s = lds + w * 64;
    float* pc = lds + 256;
    float* imp = lds + 2304;
    int* sel = (int*)(lds + 2432);
    float* p_s = lds + 2464 + w * 1024;

    for (int it = blockIdx.x; it < NTOK * 2; it += gridDim.x) {
        const int tok = it >> 1, hg = it & 1;
        const int b = tok / SEQ, t = tok % SEQ;
        const int h = hg * 4 + w;
        const int cur = t >> 8;
        const float slope = exp2f(-((float)h + 0.5f));
        __syncthreads();
        q_s[lane] = proj[(size_t)tok * INC + C_MQ + h * 64 + lane] * 0.125f;
        __syncthreads();
        float gv = -INFINITY;
        if (lane < cur) gv = dot64(q_s, kmean + (size_t)((b * 8 + h) * 32 + lane) * 64);
        const int nsel = cur < 3 ? cur : 3;
        int blk[4];
#pragma unroll
        for (int s = 0; s < 3; ++s) {
            blk[s] = 0;
            if (s < nsel) {
                const float m = wave_max(gv);
                const unsigned long long bal = __ballot(gv == m);
                const int idx = __ffsll((long long)bal) - 1;
                blk[s] = idx;
                if (lane == idx) gv = -INFINITY;
            }
        }
        float sc[16];
        float mx = -INFINITY;
#pragma unroll
        for (int s = 0; s < 4; ++s) {
            const int bb = (s < nsel) ? blk[s] : cur;
#pragma unroll
            for (int r = 0; r < 4; ++r) {
                const int j = lane + 64 * r;
                const int pos = bb * 256 + j;
                float v = -INFINITY;
                if (s <= nsel && pos <= t) {
                    v = dot64(q_s, proj + (size_t)(b * SEQ + pos) * INC + C_MK + h * 64) - slope * (float)(t - pos);
                }
                sc[s * 4 + r] = v;
                mx = fmaxf(mx, v);
            }
        }
        mx = wave_max(mx);
        float sum = 0.f;
#pragma unroll
        for (int s = 0; s < 4; ++s)
#pragma unroll
            for (int r = 0; r < 4; ++r) {
                const float e = (sc[s * 4 + r] == -INFINITY) ? 0.f : __expf(sc[s * 4 + r] - mx);
                sum += e;
                p_s[s * 256 + lane + 64 * r] = e;
            }
        sum = wave_sum(sum);
        __syncthreads();
        float o = 0.f;
        for (int s = 0; s <= nsel; ++s) {
            const int bb = (s < nsel) ? (s == 0 ? blk[0] : (s == 1 ? blk[1] : blk[2])) : cur;
            const int nk = (s < nsel) ? 256 : (t - cur * 256 + 1);
            const float* vb = proj + (size_t)(b * SEQ + bb * 256) * INC + C_MV + h * 64 + lane;
            for (int j = 0; j < nk; ++j) o += p_s[s * 256 + j] * vb[(size_t)j * INC];
        }
        mix[(size_t)tok * DM + h * 64 + lane] = o / sum;
    }

    for (int it = blockIdx.x; it < NTOK * 2; it += gridDim.x) {
        const int tok = it >> 1, g = it & 1;
        const int b = tok / SEQ, t = tok % SEQ;
        const int hq = g * 4 + w;
        const float slope = exp2f(-(float)(hq + 1));
        __syncthreads();
        q_s[lane] = proj[(size_t)tok * INC + C_NQ + hq * 64 + lane] * 0.125f;
        __syncthreads();
        const int nv = (t >= 31) ? ((t - 31) / 16 + 1) : 0;
        float oc = 0.f;
        {
            float sc[8];
            float mx = -INFINITY;
#pragma unroll
            for (int r = 0; r < 8; ++r) {
                const int i = lane + 64 * r;
                float v = -INFINITY;
                if (i < nv) v = dot64(q_s, kcmp + (size_t)((b * 2 + g) * NCMPP + i) * 64) - slope * (float)(t - (16 * i + 31));
                sc[r] = v;
                mx = fmaxf(mx, v);
            }
            mx = wave_max(mx);
            float sum = 0.f;
#pragma unroll
            for (int r = 0; r < 8; ++r) {
                sc[r] = (sc[r] == -INFINITY) ? 0.f : __expf(sc[r] - mx);
                sum += sc[r];
            }
            sum = wave_sum(sum);
            const float inv = (nv > 0) ? 1.0f / sum : 0.f;
#pragma unroll
            for (int r = 0; r < 8; ++r) pc[w * 512 + lane + 64 * r] = sc[r] * inv;
            __syncthreads();
            const float* vb = vcmp + (size_t)((b * 2 + g) * NCMPP) * 64 + lane;
            for (int i = 0; i < nv; ++i) oc += pc[w * 512 + i] * vb[(size_t)i * 64];
        }
        const int cur = t >> 6;
        if (tid < 128) {
            const int j = tid;
            float s = 0.f;
#pragma unroll
            for (int hh = 0; hh < 4; ++hh) {
                const float* pp = pc + hh * 512;
                float a = 2.0f * (pp[4 * j] + pp[4 * j + 1] + pp[4 * j + 2]) + pp[4 * j + 3];
                if (j > 0) a += pp[4 * j - 1];
                s += a;
            }
            imp[j] = s;
        }
        __syncthreads();
        if (w == 0) {
            if (cur < 16) {
                if (lane < 16) sel[lane] = lane;
                if (lane == 0) sel[16] = cur + 1;
            } else {
                float va = (lane >= 1 && lane <= cur - 2) ? imp[lane] : -1.0f;
                float vb = (lane + 64 <= cur - 2) ? imp[lane + 64] : -1.0f;
                if (lane == 0) { sel[0] = 0; sel[1] = cur - 1; sel[2] = cur; sel[16] = 16; }
                for (int s = 0; s < 13; ++s) {
                    const float m = wave_max(fmaxf(va, vb));
                    const int cand = (va == m) ? lane : ((vb == m) ? lane + 64 : 9999);
                    const int mj = wave_min_i(cand);
                    if (lane == 0) sel[3 + s] = mj;
                    if (mj == lane) va = -2.0f;
                    if (mj == lane + 64) vb = -2.0f;
                }
            }
        }
        __syncthreads();
        const int nsb = sel[16];
        float os = 0.f;
        {
            float sc[16];
            float mx = -INFINITY;
#pragma unroll
            for (int sb = 0; sb < 16; ++sb) {
                float v = -INFINITY;
                if (sb < nsb) {
                    const int pos = sel[sb] * 64 + lane;
                    if (pos <= t) v = dot64(q_s, proj + (size_t)(b * SEQ + pos) * INC + C_KS + g * 64) - slope * (float)(t - pos);
                }
                sc[sb] = v;
                mx = fmaxf(mx, v);
            }
            mx = wave_max(mx);
            float sum = 0.f;
#pragma unroll
            for (int sb = 0; sb < 16; ++sb) {
                const float e = (sc[sb] == -INFINITY) ? 0.f : __expf(sc[sb] - mx);
                sum += e;
                p_s[sb * 64 + lane] = e;
            }
            sum = wave_sum(sum);
            __syncthreads();
            for (int sb = 0; sb < nsb; ++sb) {
                const int p0 = sel[sb] * 64;
                int nk = t - p0 + 1;
                nk = nk > 64 ? 64 : nk;
                const float* vb = proj + (size_t)(b * SEQ + p0) * INC + C_VS + g * 64 + lane;
                for (int j = 0; j < nk; ++j) os += p_s[sb * 64 + j] * vb[(size_t)j * INC];
            }
            os /= sum;
        }
        __syncthreads();
        float ow = 0.f;
        {
            float sc[8];
            float mx = -INFINITY;
#pragma unroll
            for (int r = 0; r < 8; ++r) {
                const int pos = t - 511 + lane + 64 * r;
                float v = -INFINITY;
                if (pos >= 0) v = dot64(q_s, proj + (size_t)(b * SEQ + pos) * INC + C_KW + g * 64) - slope * (float)(t - pos);
                sc[r] = v;
                mx = fmaxf(mx, v);
            }
            mx = wave_max(mx);
            float sum = 0.f;
#pragma unroll
            for (int r = 0; r < 8; ++r) {
                const float e = (sc[r] == -INFINITY) ? 0.f : __expf(sc[r] - mx);
                sum += e;
                p_s[lane + 64 * r] = e;
            }
            sum = wave_sum(sum);
            __syncthreads();
            const int j0 = (t >= 511) ? 0 : (511 - t);
            const float* vb = proj + (size_t)(b * SEQ) * INC + C_VW + g * 64 + lane;
            for (int j = j0; j < 512; ++j) ow += p_s[j] * vb[(size_t)(t - 511 + j) * INC];
            ow /= sum;
        }
        const float* gl = proj + (size_t)tok * INC + C_NG + hq * 3;
        const float g0 = 1.0f / (1.0f + __expf(-gl[0])), g1 = 1.0f / (1.0f + __expf(-gl[1])), g2 = 1.0f / (1.0f + __expf(-gl[2]));
        mix[(size_t)tok * DM + 512 + hq * 64 + lane] = g0 * oc + g1 * os + g2 * ow;
    }
}

__device__ __forceinline__ void ph_outproj(const Params& p, float* lds) {
    const float* mix = p.ws + OFF_MIX;
    for (int it = blockIdx.x; it < (NTOK / 64) * 16; it += gridDim.x) {
        const int m = it >> 4, n = it & 15;
        const float* aptr = mix + (size_t)(m * 64 + (threadIdx.x >> 2)) * DM;
        gemm_tile(lds, aptr, DM, p.w_out, DM, DM, n * 64, [&](int rl, int c, float4 v) {
            const size_t o = (size_t)(m * 64 + rl) * DM + c;
            const float4 xv = *(const float4*)(p.x + o);
            *(float4*)(p.out + o) = make_float4(xv.x + v.x, xv.y + v.y, xv.z + v.z, xv.w + v.w);
        });
    }
}

__device__ __forceinline__ void ph_router(const Params& p) {
    const int lane = threadIdx.x & 63, w = threadIdx.x >> 6;
    float* hb = p.ws + OFF_XN;
    int* sele = (int*)(p.ws + OFF_SELE);
    float* selw = p.ws + OFF_SELW;
    int* cnt = (int*)(p.ws + OFF_CNT);
    for (int row = blockIdx.x * 4 + w; row < NTOK; row += gridDim.x * 4) {
        const float4* xr = (const float4*)(p.out + (size_t)row * DM);
        float4 v[4];
        float ss = 0.f;
#pragma unroll
        for (int j = 0; j < 4; ++j) { v[j] = xr[lane + 64 * j]; ss += dot4(v[j], v[j]); }
        ss = wave_sum(ss);
        const float r = 1.0f / sqrtf(ss * (1.0f / DM) + 1e-5f);
        const float4* g4 = (const float4*)p.ffn_g;
        float4* o = (float4*)(hb + (size_t)row * DM);
#pragma unroll
        for (int j = 0; j < 4; ++j) {
            const float4 g = g4[lane + 64 * j];
            v[j] = make_float4(v[j].x * r * g.x, v[j].y * r * g.y, v[j].z * r * g.z, v[j].w * r * g.w);
            o[lane + 64 * j] = v[j];
        }
        float lg[32];
#pragma unroll
        for (int e = 0; e < 32; ++e) lg[e] = 0.f;
#pragma unroll
        for (int j = 0; j < 4; ++j) {
            const float hv[4] = {v[j].x, v[j].y, v[j].z, v[j].w};
#pragma unroll
            for (int c = 0; c < 4; ++c) {
                const int k = (lane + 64 * j) * 4 + c;
                const float4* wr = (const float4*)(p.w_router + (size_t)k * 32);
#pragma unroll
                for (int e4 = 0; e4 < 8; ++e4) {
                    const float4 wv = wr[e4];
                    lg[e4 * 4 + 0] += hv[c] * wv.x;
                    lg[e4 * 4 + 1] += hv[c] * wv.y;
                    lg[e4 * 4 + 2] += hv[c] * wv.z;
                    lg[e4 * 4 + 3] += hv[c] * wv.w;
                }
            }
        }
#pragma unroll
        for (int e = 0; e < 32; ++e) lg[e] = wave_sum(lg[e]) + p.b_router[e];
        float tv[4];
        int ti[4];
#pragma unroll
        for (int s = 0; s < 4; ++s) {
            float best = -INFINITY;
            int bi = 0;
#pragma unroll
            for (int e = 0; e < 32; ++e)
                if (lg[e] > best) { best = lg[e]; bi = e; }
            tv[s] = best;
            ti[s] = bi;
#pragma unroll
            for (int e = 0; e < 32; ++e)
                if (e == bi) lg[e] = -INFINITY;
        }
        const float e1 = __expf(tv[1] - tv[0]), e2 = __expf(tv[2] - tv[0]), e3 = __expf(tv[3] - tv[0]);
        const float inv = 1.0f / (1.0f + e1 + e2 + e3);
        if (lane == 0) {
            sele[row * 4 + 0] = ti[0]; sele[row * 4 + 1] = ti[1]; sele[row * 4 + 2] = ti[2]; sele[row * 4 + 3] = ti[3];
            selw[row * 4 + 0] = inv; selw[row * 4 + 1] = e1 * inv; selw[row * 4 + 2] = e2 * inv; selw[row * 4 + 3] = e3 * inv;
            atomicAdd(&cnt[ti[0]], 1); atomicAdd(&cnt[ti[1]], 1); atomicAdd(&cnt[ti[2]], 1); atomicAdd(&cnt[ti[3]], 1);
        }
    }
}

__device__ __forceinline__ void ph_fill(const Params& p, float* lds) {
    int* off = (int*)lds;
    const int* cnt = (const int*)(p.ws + OFF_CNT);
    int* cursor = (int*)(p.ws + OFF_CNT) + 32;
    const int* sele = (const int*)(p.ws + OFF_SELE);
    const float* selw = p.ws + OFF_SELW;
    int* rtok = (int*)(p.ws + OFF_RTOK);
    float* rw = p.ws + OFF_RW;
    __syncthreads();
    if (threadIdx.x == 0) {
        int a = 0;
        for (int e = 0; e < NE; ++e) { off[e] = a; a += cnt[e]; }
    }
    __syncthreads();
    for (int i = blockIdx.x * 256 + threadIdx.x; i < NK; i += gridDim.x * 256) {
        const int e = sele[i];
        const int pos = off[e] + atomicAdd(&cursor[e], 1);
        rtok[pos] = i >> 2;
        rw[pos] = selw[i];
    }
}

__device__ __forceinline__ void build_tiles(const Params& p, int* tb) {
    const int* cnt = (const int*)(p.ws + OFF_CNT);
    __syncthreads();
    if (threadIdx.x == 0) {
        int a = 0, t = 0;
        for (int e = 0; e < NE; ++e) { tb[e] = a; tb[40 + e] = t; a += cnt[e]; t += (cnt[e] + 63) >> 6; }
        tb[32] = a; tb[40 + 32] = t;
    }
    __syncthreads();
}
__device__ __forceinline__ float swiglu(float g, float u) {
    g = fminf(g, 7.0f);
    u = fminf(fmaxf(u, -7.0f), 7.0f);
    return g * (1.0f / (1.0f + __expf(-1.702f * g))) * (u + 1.0f);
}

__device__ __forceinline__ void ph_up(const Params& p, float* lds) {
    int* tb = (int*)(lds + 2 * 16 * 68);
    build_tiles(p, tb);
    const int T = tb[40 + 32];
    const float* hb = p.ws + OFF_XN;
    float* act = p.ws + OFF_BIG;
    const int* rtok = (const int*)(p.ws + OFF_RTOK);
    for (int it = blockIdx.x; it < T * 32; it += gridDim.x) {
        const int vt = it >> 5, ct = it & 31;
        int e = 0;
        while (tb[40 + e + 1] <= vt) ++e;
        const int lt = vt - tb[40 + e];
        const int rowbase = tb[e] + lt * 64;
        const int nrows = min(64, tb[e + 1] - rowbase);
        const int ar = threadIdx.x >> 2;
        const float* aptr = (ar < nrows) ? hb + (size_t)rtok[rowbase + ar] * DM : nullptr;
        const float* bias = p.b_up + (size_t)e * DFF2;
        gemm_tile(lds, aptr, DM, p.w_up + (size_t)e * DM * DFF2, DFF2, DFF2, ct * 64, [&](int rl, int c, float4 v) {
            if (rl < nrows) {
                const float4 bv = *(const float4*)(bias + c);
                const float a0 = swiglu(v.x + bv.x, v.y + bv.y), a1 = swiglu(v.z + bv.z, v.w + bv.w);
                *(float2*)(act + (size_t)(rowbase + rl) * DM + (c >> 1)) = make_float2(a0, a1);
            }
        });
    }
}

__device__ __forceinline__ void ph_down(const Params& p, float* lds) {
    int* tb = (int*)(lds + 2 * 16 * 68);
    build_tiles(p, tb);
    const int T = tb[40 + 32];
    const float* act = p.ws + OFF_BIG;
    const int* rtok = (const int*)(p.ws + OFF_RTOK);
    const float* rw = p.ws + OFF_RW;
    for (int it = blockIdx.x; it < T * 16; it += gridDim.x) {
        const int vt = it >> 4, ct = it & 15;
        int e = 0;
        while (tb[40 + e + 1] <= vt) ++e;
        const int lt = vt - tb[40 + e];
        const int rowbase = tb[e] + lt * 64;
        const int nrows = min(64, tb[e + 1] - rowbase);
        const int ar = threadIdx.x >> 2;
        const float* aptr = (ar < nrows) ? act + (size_t)(rowbase + ar) * DM : nullptr;
        const float* bias = p.b_down + (size_t)e * DM;
        gemm_tile(lds, aptr, DM, p.w_down + (size_t)e * DM * DM, DM, DM, ct * 64, [&](int rl, int c, float4 v) {
            if (rl < nrows) {
                const int tok = rtok[rowbase + rl];
                const float wgt = rw[rowbase + rl];
                const float4 bv = *(const float4*)(bias + c);
                float* o = p.out + (size_t)tok * DM + c;
                unsafeAtomicAdd(o + 0, wgt * (v.x + bv.x));
                unsafeAtomicAdd(o + 1, wgt * (v.y + bv.y));
                unsafeAtomicAdd(o + 2, wgt * (v.z + bv.z));
                unsafeAtomicAdd(o + 3, wgt * (v.w + bv.w));
            }
        });
    }
}

__device__ __forceinline__ void ph_final(const Params& p) {
    const int lane = threadIdx.x & 63, w = threadIdx.x >> 6;
    for (int row = blockIdx.x * 4 + w; row < NTOK; row += gridDim.x * 4) {
        float4* xr = (float4*)(p.out + (size_t)row * DM);
        float4 v[4];
        float ss = 0.f;
#pragma unroll
        for (int j = 0; j < 4; ++j) { v[j] = xr[lane + 64 * j]; ss += dot4(v[j], v[j]); }
        ss = wave_sum(ss);
        const float r = 1.0f / sqrtf(ss * (1.0f / DM) + 1e-5f);
        const float4* g4 = (const float4*)p.final_g;
#pragma unroll
        for (int j = 0; j < 4; ++j) {
            const float4 g = g4[lane + 64 * j];
            xr[lane + 64 * j] = make_float4(v[j].x * r * g.x, v[j].y * r * g.y, v[j].z * r * g.z, v[j].w * r * g.w);
        }
    }
}

constexpr int NPHASE = 10;
constexpr int LDS_FLOATS = 2464 + 4096;

__global__ void __launch_bounds__(256) fwd_kernel(Params p) {
    __shared__ __attribute__((aligned(16))) float lds[LDS_FLOATS];
    cg::grid_group grid = cg::this_grid();
    for (int ph = p.ph_lo; ph < p.ph_hi; ++ph) {
        switch (ph) {
            case 0: ph_norm1(p); break;
            case 1: ph_proj(p, lds); break;
            case 2: ph_pre_attn(p, lds); break;
            case 3: ph_attn(p, lds); break;
            case 4: ph_outproj(p, lds); break;
            case 5: ph_router(p); break;
            case 6: ph_fill(p, lds); break;
            case 7: ph_up(p, lds); break;
            case 8: ph_down(p, lds); break;
            case 9: ph_final(p); break;
        }
        if (ph + 1 < p.ph_hi) grid.sync();
    }
}

#ifndef MULTI_LAUNCH
#define MULTI_LAUNCH 0
#endif

extern "C" void kernel_launch(void* const* d_in, const int* in_sizes, int n_in, void* d_out, int out_size, void* d_ws,
                              size_t ws_size, hipStream_t stream) {
    static int grid_blocks = 0;
    if (!grid_blocks) {
        int dev = 0, cus = 0, per_cu = 0;
        hipGetDevice(&dev);
        hipDeviceGetAttribute(&cus, hipDeviceAttributeMultiprocessorCount, dev);
        hipOccupancyMaxActiveBlocksPerMultiprocessor(&per_cu, fwd_kernel, 256, 0);
        if (per_cu < 1) per_cu = 1;
        if (per_cu > 2) per_cu = 2;
        grid_blocks = cus * per_cu;
        if (ws_size < WS_FLOATS * sizeof(float))
            fprintf(stderr, "kernel_launch: workspace too small: %zu < %zu\n", ws_size, WS_FLOATS * sizeof(float));
    }
    Params p{};
    p.x = (const float*)d_in[0];
    p.attn_g = (const float*)d_in[1];
    p.w_in = (const float*)d_in[2];
    p.pe_k = (const float*)d_in[3];
    p.pe_v = (const float*)d_in[4];
    p.w1k = (const float*)d_in[5];
    p.w2k = (const float*)d_in[6];
    p.w1v = (const float*)d_in[7];
    p.w2v = (const float*)d_in[8];
    p.w_out = (const float*)d_in[9];
    p.ffn_g = (const float*)d_in[10];
    p.w_router = (const float*)d_in[11];
    p.b_router = (const float*)d_in[12];
    p.w_up = (const float*)d_in[13];
    p.b_up = (const float*)d_in[14];
    p.w_down = (const float*)d_in[15];
    p.b_down = (const float*)d_in[16];
    p.final_g = (const float*)d_in[17];
    p.out = (float*)d_out;
    p.ws = (float*)d_ws;
#if MULTI_LAUNCH
    for (int ph = 0; ph < NPHASE; ++ph) {
        p.ph_lo = ph;
        p.ph_hi = ph + 1;
        hipLaunchKernelGGL(fwd_kernel, dim3(grid_blocks), dim3(256), 0, stream, p);
    }
#else
    p.ph_lo = 0;
    p.ph_hi = NPHASE;
    void* args[] = {&p};
    hipError_t e = hipLaunchCooperativeKernel((void*)fwd_kernel, dim3(grid_blocks), dim3(256), args, 0, stream);
    if (e != hipSuccess) fprintf(stderr, "cooperative launch failed: %s (grid %d)\n", hipGetErrorString(e), grid_blocks);
#endif
}
```

```cpp
#include <hip/hip_runtime.h>
#include <hip/hip_cooperative_groups.h>
#include <cstdio>
#include <cstdint>
namespace cg = cooperative_groups;

constexpr int NB = 4, SEQ = 8192, DM = 1024, NTOK = NB * SEQ;
constexpr int INC = 2840;
constexpr int NCMP = 511, NCMPP = 512;
constexpr int NE = 32, TOPK = 4, NK = NTOK * TOPK;
constexpr int DFF2 = 2048;
constexpr int NIN_PAD = 3072;
constexpr int PMAX = 139264;
constexpr float LOG2E = 1.4426950408889634f;
constexpr float QSCALE = 0.125f * LOG2E;
constexpr int HG_MQ = 0, HG_MK = 8, HG_MV = 16, HG_NQ = 24, HG_KC = 32, HG_VC = 34, HG_KS = 36, HG_VS = 38, HG_KW = 40,
              HG_VW = 42, NHG = 44;

constexpr size_t WS_BTUP  = 0;
constexpr size_t WS_BTDN  = WS_BTUP + (size_t)NE * DFF2 * DM * 2;
constexpr size_t WS_BTOUT = WS_BTDN + (size_t)NE * DM * DM * 2;
constexpr size_t WS_BTIN  = WS_BTOUT + (size_t)DM * DM * 2;
constexpr size_t WS_XN    = WS_BTIN + (size_t)NIN_PAD * DM * 2;
constexpr size_t WS_H     = WS_XN;
constexpr size_t WS_PT    = WS_XN + (size_t)NTOK * DM * 2;
constexpr size_t WS_GATES = WS_PT + (size_t)NHG * NTOK * 64 * 2;
constexpr size_t WS_KMEAN = WS_GATES + (size_t)NTOK * 24 * 4;
constexpr size_t WS_KCMP  = WS_KMEAN + 65536 * 4;
constexpr size_t WS_VCMP  = WS_KCMP + 262144 * 2;
constexpr size_t WS_MIXB  = WS_VCMP + 262144 * 2;
constexpr size_t WS_ACT   = WS_PT;
constexpr size_t WS_Y     = WS_ACT + (size_t)PMAX * DM * 2;
static_assert(WS_MIXB + (size_t)NTOK * DM * 2 <= WS_Y, "act overlay");
constexpr size_t WS_SELE  = WS_Y + (size_t)PMAX * DM * 2;
constexpr size_t WS_SELW  = WS_SELE + (size_t)NK * 4;
constexpr size_t WS_SELR  = WS_SELW + (size_t)NK * 4;
constexpr size_t WS_SELP  = WS_SELR + (size_t)NK * 4;
constexpr size_t WS_BCNT  = WS_SELP + (size_t)NK * 4;
constexpr size_t WS_GCNT  = WS_BCNT + 256 * 32 * 4;
constexpr size_t WS_RTOK  = WS_GCNT + 256;
constexpr size_t WS_RW    = WS_RTOK + (size_t)PMAX * 4;
constexpr size_t WS_C1    = WS_RW + (size_t)PMAX * 4;
constexpr size_t WS_W1T   = WS_C1 + 512;
constexpr size_t WS_W2T   = WS_W1T + 2 * 64 * 2048 * 2;
constexpr size_t WS_OMIX  = WS_W2T + 2 * 64 * 64 * 2;
constexpr size_t WS_OKCMP = WS_OMIX + (size_t)NTOK * DM * 4;
constexpr size_t WS_OVCMP = WS_OKCMP + 262144 * 4;
constexpr size_t WS_END   = WS_OVCMP + 262144 * 4;

struct Params {
    const float *x, *attn_g, *w_in, *pe_k, *pe_v, *w1k, *w2k, *w1v, *w2v, *w_out, *ffn_g, *w_router, *b_router,
        *w_up, *b_up, *w_down, *b_down, *final_g;
    float* out;
    float* ws;
    int ph_lo, ph_hi;
};

typedef unsigned short bf16_t;
typedef short bf16x8 __attribute__((ext_vector_type(8)));
typedef float f32x4 __attribute__((ext_vector_type(4)));
typedef float f32x16 __attribute__((ext_vector_type(16)));
typedef unsigned u32x4 __attribute__((ext_vector_type(4)));
typedef unsigned u32x2 __attribute__((ext_vector_type(2)));

__device__ __forceinline__ unsigned pk_bf16(float lo, float hi) {
    unsigned r;
    asm("v_cvt_pk_bf16_f32 %0, %1, %2" : "=v"(r) : "v"(lo), "v"(hi));
    return r;
}
__device__ __forceinline__ float bf_lo(unsigned u) { return __uint_as_float(u << 16); }
__device__ __forceinline__ float bf_hi(unsigned u) { return __uint_as_float(u & 0xffff0000u); }
__device__ __forceinline__ float bf2f(bf16_t b) { return __uint_as_float((unsigned)b << 16); }

__device__ __forceinline__ float wave_sum(float v) {
#pragma unroll
    for (int o = 32; o > 0; o >>= 1) v += __shfl_xor(v, o);
    return v;
}
__device__ __forceinline__ float wave_max(float v) {
#pragma unroll
    for (int o = 32; o > 0; o >>= 1) v = fmaxf(v, __shfl_xor(v, o));
    return v;
}
__device__ __forceinline__ int wave_min_i(int v) {
#pragma unroll
    for (int o = 32; o > 0; o >>= 1) v = min(v, __shfl_xor(v, o));
    return v;
}
__device__ __forceinline__ float dot4(float4 a, float4 b) { return a.x * b.x + a.y * b.y + a.z * b.z + a.w * b.w; }

__device__ __forceinline__ float gelu_tanh(float x) {
    return 0.5f * x * (1.0f + tanhf(0.7978845608028654f * (x + 0.044715f * x * x * x)));
}
__device__ __forceinline__ float swiglu(float g, float u) {
    g = fminf(g, 7.0f);
    u = fminf(fmaxf(u, -7.0f), 7.0f);
    return g * (1.0f / (1.0f + __expf(-1.702f * g))) * (u + 1.0f);
}

__device__ __forceinline__ float dot64f(const float* qs, const float* krow) {
    const float4* k4 = (const float4*)krow;
    const float4* q4 = (const float4*)qs;
    float s = 0.f;
#pragma unroll
    for (int i = 0; i < 16; ++i) s += dot4(q4[i], k4[i]);
    return s;
}
__device__ __forceinline__ float dot64b(const float* qs, const bf16_t* krow) {
    const u32x4* k4 = (const u32x4*)krow;
    float s = 0.f;
#pragma unroll
    for (int i = 0; i < 8; ++i) {
        const u32x4 kv = k4[i];
        const float* q = qs + i * 8;
        s += q[0] * bf_lo(kv.x) + q[1] * bf_hi(kv.x) + q[2] * bf_lo(kv.y) + q[3] * bf_hi(kv.y) + q[4] * bf_lo(kv.z) +
             q[5] * bf_hi(kv.z) + q[6] * bf_lo(kv.w) + q[7] * bf_hi(kv.w);
    }
    return s;
}
__device__ __forceinline__ const bf16_t* pt_row(const bf16_t* pt, int hg, int tok) { return pt + ((size_t)hg * NTOK + tok) * 64; }

__device__ __forceinline__ void ph_pre_attn(const Params& p, float* lds) {
    const int tid = threadIdx.x;
    unsigned char* wsb = (unsigned char*)p.ws;
    const bf16_t* pt = (const bf16_t*)(wsb + WS_PT);
    float* flat = lds;
    float* red = lds + 2048;
    float* h1 = lds + 2048 + 256;
    for (int it = blockIdx.x; it < 2 * NB * NCMP * 2; it += gridDim.x) {
        const int g = it & 1;
        const int i = (it >> 1) % NCMP;
        const int b = ((it >> 1) / NCMP) % NB;
        const int kv = (it >> 1) / (NCMP * NB);
        const float* pe = kv ? p.pe_v : p.pe_k;
        const float* w1 = kv ? p.w1v : p.w1k;
        const float* w2 = kv ? p.w2v : p.w2k;
        float* dst = (float*)(wsb + (kv ? WS_OVCMP : WS_OKCMP));
        const int hg = (kv ? HG_VC : HG_KC) + g;
        __syncthreads();
        for (int e = tid; e < 2048; e += 256) {
            const int l = e >> 6, d = e & 63;
            flat[e] = bf2f(pt_row(pt, hg, b * SEQ + i * 16 + l)[d]) + pe[l * 64 + d];
        }
        __syncthreads();
        {
            const int c = tid & 63, part = tid >> 6;
            float s = 0.f;
            for (int f = part * 512; f < part * 512 + 512; ++f) s += flat[f] * w1[f * 64 + c];
            red[part * 64 + c] = s;
        }
        __syncthreads();
        if (tid < 64) h1[tid] = gelu_tanh(red[tid] + red[64 + tid] + red[128 + tid] + red[192 + tid]);
        __syncthreads();
        if (tid < 64) {
            float o = 0.f;
            for (int cc = 0; cc < 64; ++cc) o += h1[cc] * w2[cc * 64 + tid];
            dst[(size_t)((b * 2 + g) * NCMPP + i) * 64 + tid] = o;
        }
    }
}

template <bool DO_MOBA, bool DO_NSA>
__device__ __forceinline__ void ph_attn(const Params& p, float* lds) {
    const int tid = threadIdx.x, lane = tid & 63, w = tid >> 6;
    unsigned char* wsb = (unsigned char*)p.ws;
    const bf16_t* pt = (const bf16_t*)(wsb + WS_PT);
    const float* gates = (const float*)(wsb + WS_GATES);
    const float* kmean = (const float*)(wsb + WS_KMEAN);
    const float* kcmp = (const float*)(wsb + WS_OKCMP);
    const float* vcmp = (const float*)(wsb + WS_OVCMP);
    float* mix = (float*)(wsb + WS_OMIX);
    bf16_t* mixb = (bf16_t*)(wsb + WS_MIXB);
    float* q_s = lds + w * 64;
    float* pc = lds + 256;
    float* imp = lds + 2304;
    int* sel = (int*)(lds + 2432);
    float* p_s = lds + 2464 + w * 1024;

    if (DO_MOBA)
    for (int it = blockIdx.x; it < NTOK * 2; it += gridDim.x) {
        const int tok = it >> 1, hg = it & 1;
        const int b = tok / SEQ, t = tok % SEQ;
        const int h = hg * 4 + w;
        const int cur = t >> 8;
        const float slope = exp2f(-((float)h + 0.5f));
        __syncthreads();
        q_s[lane] = bf2f(pt_row(pt, HG_MQ + h, tok)[lane]) * (1.0f / LOG2E);
        __syncthreads();
        float gv = -INFINITY;
        if (lane < cur) gv = dot64f(q_s, kmean + (size_t)((b * 8 + h) * 32 + lane) * 64);
        const int nsel = cur < 3 ? cur : 3;
        int blk[4];
#pragma unroll
        for (int s = 0; s < 3; ++s) {
            blk[s] = 0;
            if (s < nsel) {
                const float m = wave_max(gv);
                const unsigned long long bal = __ballot(gv == m);
                const int idx = __ffsll((long long)bal) - 1;
                blk[s] = idx;
                if (lane == idx) gv = -INFINITY;
            }
        }
        float sc[16];
        float mx = -INFINITY;
#pragma unroll
        for (int s = 0; s < 4; ++s) {
            const int bb = (s < nsel) ? blk[s] : cur;
#pragma unroll
            for (int r = 0; r < 4; ++r) {
                const int j = lane + 64 * r;
                const int pos = bb * 256 + j;
                float v = -INFINITY;
                if (s <= nsel && pos <= t) v = dot64b(q_s, pt_row(pt, HG_MK + h, b * SEQ + pos)) - slope * (float)(t - pos);
                sc[s * 4 + r] = v;
                mx = fmaxf(mx, v);
            }
        }
        mx = wave_max(mx);
        float sum = 0.f;
#pragma unroll
        for (int s = 0; s < 4; ++s)
#pragma unroll
            for (int r = 0; r < 4; ++r) {
                const float e = (sc[s * 4 + r] == -INFINITY) ? 0.f : __expf(sc[s * 4 + r] - mx);
                sum += e;
                p_s[s * 256 + lane + 64 * r] = e;
            }
        sum = wave_sum(sum);
        __syncthreads();
        float o = 0.f;
        for (int s = 0; s <= nsel; ++s) {
            const int bb = (s < nsel) ? (s == 0 ? blk[0] : (s == 1 ? blk[1] : blk[2])) : cur;
            const int nk = (s < nsel) ? 256 : (t - cur * 256 + 1);
            const bf16_t* vb = pt_row(pt, HG_MV + h, b * SEQ + bb * 256) + lane;
            for (int j = 0; j < nk; ++j) o += p_s[s * 256 + j] * bf2f(vb[(size_t)j * 64]);
        }
        o /= sum;
        mix[(size_t)tok * DM + h * 64 + lane] = o;
        mixb[(size_t)tok * DM + h * 64 + lane] = (bf16_t)(pk_bf16(o, 0.f) & 0xffffu);
    }

    if (DO_NSA)
    for (int it = blockIdx.x; it < NTOK * 2; it += gridDim.x) {
        const int tok = it >> 1, g = it & 1;
        const int b = tok / SEQ, t = tok % SEQ;
        const int hq = g * 4 + w;
        const float slope = exp2f(-(float)(hq + 1));
        __syncthreads();
        q_s[lane] = bf2f(pt_row(pt, HG_NQ + hq, tok)[lane]) * (1.0f / LOG2E);
        __syncthreads();
        const int nv = (t >= 31) ? ((t - 31) / 16 + 1) : 0;
        float oc = 0.f;
        {
            float sc[8];
            float mx = -INFINITY;
#pragma unroll
            for (int r = 0; r < 8; ++r) {
                const int i = lane + 64 * r;
                float v = -INFINITY;
                if (i < nv) v = dot64f(q_s, kcmp + (size_t)((b * 2 + g) * NCMPP + i) * 64) - slope * (float)(t - (16 * i + 31));
                sc[r] = v;
                mx = fmaxf(mx, v);
            }
            mx = wave_max(mx);
            float sum = 0.f;
#pragma unroll
            for (int r = 0; r < 8; ++r) {
                sc[r] = (sc[r] == -INFINITY) ? 0.f : __expf(sc[r] - mx);
                sum += sc[r];
            }
            sum = wave_sum(sum);
            const float inv = (nv > 0) ? 1.0f / sum : 0.f;
#pragma unroll
            for (int r = 0; r < 8; ++r) pc[w * 512 + lane + 64 * r] = sc[r] * inv;
            __syncthreads();
            const float* vb = vcmp + (size_t)((b * 2 + g) * NCMPP) * 64 + lane;
            for (int i = 0; i < nv; ++i) oc += pc[w * 512 + i] * vb[(size_t)i * 64];
        }
        const int cur = t >> 6;
        if (tid < 128) {
            const int j = tid;
            float s = 0.f;
#pragma unroll
            for (int hh = 0; hh < 4; ++hh) {
                const float* pp = pc + hh * 512;
                float a = 2.0f * (pp[4 * j] + pp[4 * j + 1] + pp[4 * j + 2]) + pp[4 * j + 3];
                if (j > 0) a += pp[4 * j - 1];
                s += a;
            }
            imp[j] = s;
        }
        __syncthreads();
        if (w == 0) {
            if (cur < 16) {
                if (lane < 16) sel[lane] = lane;
                if (lane == 0) sel[16] = cur + 1;
            } else {
                float va = (lane >= 1 && lane <= cur - 2) ? imp[lane] : -1.0f;
                float vb = (lane + 64 <= cur - 2) ? imp[lane + 64] : -1.0f;
                if (lane == 0) { sel[0] = 0; sel[1] = cur - 1; sel[2] = cur; sel[16] = 16; }
                for (int s = 0; s < 13; ++s) {
                    const float m = wave_max(fmaxf(va, vb));
                    const int cand = (va == m) ? lane : ((vb == m) ? lane + 64 : 9999);
                    const int mj = wave_min_i(cand);
                    if (lane == 0) sel[3 + s] = mj;
                    if (mj == lane) va = -2.0f;
                    if (mj == lane + 64) vb = -2.0f;
                }
            }
        }
        __syncthreads();
        const int nsb = sel[16];
        float os = 0.f;
        {
            float sc[16];
            float mx = -INFINITY;
#pragma unroll
            for (int sb = 0; sb < 16; ++sb) {
                float v = -INFINITY;
                if (sb < nsb) {
                    const int pos = sel[sb] * 64 + lane;
                    if (pos <= t) v = dot64b(q_s, pt_row(pt, HG_KS + g, b * SEQ + pos)) - slope * (float)(t - pos);
                }
                sc[sb] = v;
                mx = fmaxf(mx, v);
            }
            mx = wave_max(mx);
            float sum = 0.f;
#pragma unroll
            for (int sb = 0; sb < 16; ++sb) {
                const float e = (sc[sb] == -INFINITY) ? 0.f : __expf(sc[sb] - mx);
                sum += e;
                p_s[sb * 64 + lane] = e;
            }
            sum = wave_sum(sum);
            __syncthreads();
            for (int sb = 0; sb < nsb; ++sb) {
                const int p0 = sel[sb] * 64;
                int nk = t - p0 + 1;
                nk = nk > 64 ? 64 : nk;
                const bf16_t* vb = pt_row(pt, HG_VS + g, b * SEQ + p0) + lane;
                for (int j = 0; j < nk; ++j) os += p_s[sb * 64 + j] * bf2f(vb[(size_t)j * 64]);
            }
            os /= sum;
        }
        __syncthreads();
        float ow = 0.f;
        {
            float sc[8];
            float mx = -INFINITY;
#pragma unroll
            for (int r = 0; r < 8; ++r) {
                const int pos = t - 511 + lane + 64 * r;
                float v = -INFINITY;
                if (pos >= 0) v = dot64b(q_s, pt_row(pt, HG_KW + g, b * SEQ + pos)) - slope * (float)(t - pos);
                sc[r] = v;
                mx = fmaxf(mx, v);
            }
            mx = wave_max(mx);
            float sum = 0.f;
#pragma unroll
            for (int r = 0; r < 8; ++r) {
                const float e = (sc[r] == -INFINITY) ? 0.f : __expf(sc[r] - mx);
                sum += e;
                p_s[lane + 64 * r] = e;
            }
            sum = wave_sum(sum);
            __syncthreads();
            const int j0 = (t >= 511) ? 0 : (511 - t);
            const bf16_t* vb = pt_row(pt, HG_VW + g, b * SEQ) + lane;
            for (int j = j0; j < 512; ++j) ow += p_s[j] * bf2f(vb[(size_t)(t - 511 + j) * 64]);
            ow /= sum;
        }
        const float* gl = gates + (size_t)tok * 24 + hq * 3;
        const float o = gl[0] * oc + gl[1] * os + gl[2] * ow;
        mix[(size_t)tok * DM + 512 + hq * 64 + lane] = o;
        mixb[(size_t)tok * DM + 512 + hq * 64 + lane] = (bf16_t)(pk_bf16(o, 0.f) & 0xffffu);
    }
}

template <class Epi>
__device__ __forceinline__ void gemm_tile(float* lds, const float* aptr, int K, const float* Bm, int ldb, int ncols,
                                          int col0, Epi epi) {
    float* As = lds;
    float* Bs = lds + 16 * 68;
    const int tid = threadIdx.x, tx = tid & 15, ty = tid >> 4;
    const int ar = tid >> 2, akq = (tid & 3) * 4;
    const int bk = tid >> 4, bc = (tid & 15) * 4;
    const bool bvalid = (col0 + bc) < ncols;
    float acc[4][4];
#pragma unroll
    for (int i = 0; i < 4; ++i)
#pragma unroll
        for (int j = 0; j < 4; ++j) acc[i][j] = 0.f;
    for (int k0 = 0; k0 < K; k0 += 16) {
        float4 a = make_float4(0.f, 0.f, 0.f, 0.f), b = make_float4(0.f, 0.f, 0.f, 0.f);
        if (aptr) a = *(const float4*)(aptr + k0 + akq);
        if (bvalid) b = *(const float4*)(Bm + (size_t)(k0 + bk) * ldb + col0 + bc);
        __syncthreads();
        As[(akq + 0) * 68 + ar] = a.x;
        As[(akq + 1) * 68 + ar] = a.y;
        As[(akq + 2) * 68 + ar] = a.z;
        As[(akq + 3) * 68 + ar] = a.w;
        *(float4*)(Bs + bk * 68 + bc) = b;
        __syncthreads();
#pragma unroll
        for (int kk = 0; kk < 16; ++kk) {
            const float4 av = *(const float4*)(As + kk * 68 + ty * 4);
            const float4 bv = *(const float4*)(Bs + kk * 68 + tx * 4);
            const float aa[4] = {av.x, av.y, av.z, av.w};
            const float bb[4] = {bv.x, bv.y, bv.z, bv.w};
#pragma unroll
            for (int i = 0; i < 4; ++i)
#pragma unroll
                for (int j = 0; j < 4; ++j) acc[i][j] += aa[i] * bb[j];
        }
    }
    if (bvalid) {
#pragma unroll
        for (int i = 0; i < 4; ++i) epi(ty * 4 + i, col0 + tx * 4, make_float4(acc[i][0], acc[i][1], acc[i][2], acc[i][3]));
    }
}

__device__ __forceinline__ void ph_outproj(const Params& p, float* lds) {
    const float* mix = (const float*)((unsigned char*)p.ws + WS_OMIX);
    for (int it = blockIdx.x; it < (NTOK / 64) * 16; it += gridDim.x) {
        const int m = it >> 4, n = it & 15;
        const float* aptr = mix + (size_t)(m * 64 + (threadIdx.x >> 2)) * DM;
        gemm_tile(lds, aptr, DM, p.w_out, DM, DM, n * 64, [&](int rl, int c, float4 v) {
            const size_t o = (size_t)(m * 64 + rl) * DM + c;
            const float4 xv = *(const float4*)(p.x + o);
            *(float4*)(p.out + o) = make_float4(xv.x + v.x, xv.y + v.y, xv.z + v.z, xv.w + v.w);
        });
    }
}

constexpr int OLDS_FLOATS = 2464 + 4096;
__global__ void __launch_bounds__(256) oracle_kernel(Params p) {
    __shared__ __attribute__((aligned(16))) float lds[OLDS_FLOATS];
    cg::grid_group grid = cg::this_grid();
    const int lo = p.ph_lo, hi = p.ph_hi;
    if (lo <= 0 && 0 < hi) ph_pre_attn(p, lds);
    if (lo <= 0 && 1 < hi) grid.sync();
    if (lo <= 1 && 1 < hi) ph_attn<true, true>(p, lds);
    if (lo <= 1 && 2 < hi) grid.sync();
    if (lo <= 2 && 2 < hi) ph_outproj(p, lds);
}

constexpr int G_BM = 256, G_BK = 64, G_HALF = 128, G_HT = G_HALF * G_BK;
constexpr int GEMM_LDS_BYTES = 8 * G_HT * 2;
constexpr int FAST_LDS_BYTES = 155648;
__device__ __forceinline__ int lds_byte(int r, int c) {
    const int st = (r >> 4) * 2 + (c >> 5), rr = r & 15, cc = c & 31, ob = rr * 64 + cc * 2;
    return st * 1024 + (ob ^ (((ob >> 9) & 1) << 5));
}
__device__ __forceinline__ void stage_rc(int b, int& R, int& C) {
    const int st = b / 1024, sb = b % 1024, swz = sb ^ (((sb >> 9) & 1) << 5);
    R = (st >> 1) * 16 + swz / 64;
    C = (st & 1) * 32 + (swz % 64) / 2;
}

#define LAS __attribute__((address_space(3)))
template <class ARow>
__device__ __forceinline__ void gemm256_tile(LAS unsigned char* lds, const char* __restrict__ Abase, ARow arow,
                                             const char* __restrict__ Bbase, int K, f32x4 (&acc)[2][2][4][2]) {
    constexpr int HTB = G_HT * 2;
#define SA(b, h) (((b) * 2 + (h)) * HTB)
#define SB(b, h) ((4 + (b) * 2 + (h)) * HTB)
#define STAGE_A(b, h, kt)                                                                                              \
    do {                                                                                                               \
        _Pragma("unroll") for (int _i = 0; _i < 2; ++_i) __builtin_amdgcn_global_load_lds(                              \
            (const unsigned*)(Abase + (size_t)(kt) * (G_BK * 2) + voffA[h][_i]),                                       \
            (LAS unsigned*)(lds + SA(b, h) + ldsw + _i * 8192), 16, 0, 0);                                              \
    } while (0)
#define STAGE_B(b, h, kt)                                                                                              \
    do {                                                                                                               \
        _Pragma("unroll") for (int _i = 0; _i < 2; ++_i) __builtin_amdgcn_global_load_lds(                              \
            (const unsigned*)(Bbase + (size_t)(h) * hstep + (size_t)(kt) * (G_BK * 2) + voffB[_i]),                    \
            (LAS unsigned*)(lds + SB(b, h) + ldsw + _i * 8192), 16, 0, 0);                                              \
    } while (0)
#define LDA(dst, b, h)                                                                                                 \
    do {                                                                                                               \
        _Pragma("unroll") for (int m = 0; m < 4; ++m) _Pragma("unroll") for (int k = 0; k < 2; ++k) dst[m][k] =         \
            *(const LAS bf16x8*)(lds + SA(b, h) + aoff + m * 2048 + k * 1024);                                          \
    } while (0)
#define LDB(dst, b, h)                                                                                                 \
    do {                                                                                                               \
        _Pragma("unroll") for (int n = 0; n < 2; ++n) _Pragma("unroll") for (int k = 0; k < 2; ++k) dst[n][k] =         \
            *(const LAS bf16x8*)(lds + SB(b, h) + boff + n * 2048 + k * 1024);                                          \
    } while (0)
#define MMA(ai, bj, Af, Bf)                                                                                            \
    do {                                                                                                               \
        __builtin_amdgcn_s_setprio(1);                                                                                 \
        _Pragma("unroll") for (int m = 0; m < 4; ++m) _Pragma("unroll") for (int n = 0; n < 2; ++n)                     \
            _Pragma("unroll") for (int k = 0; k < 2; ++k) acc[ai][bj][m][n] =                                           \
                __builtin_amdgcn_mfma_f32_16x16x32_bf16(Bf[n][k], Af[m][k], acc[ai][bj][m][n], 0, 0, 0);               \
        __builtin_amdgcn_s_setprio(0);                                                                                 \
    } while (0)
#define WAIT_V(n) asm volatile("s_waitcnt vmcnt(" #n ")" ::: "memory")
#define WAIT_L(n) asm volatile("s_waitcnt lgkmcnt(" #n ")" ::: "memory")
#define BAR __builtin_amdgcn_s_barrier()
#define SCHED __builtin_amdgcn_sched_barrier(0)
    const int tid = threadIdx.x, wid = __builtin_amdgcn_readfirstlane(tid >> 6), lane = tid & 63, wr = wid >> 2, wc = wid & 3,
              fr = lane & 15, fq = lane >> 4;
    unsigned voffA[2][2], voffB[2];
#pragma unroll
    for (int i = 0; i < 2; ++i) {
        int R, C;
        stage_rc(tid * 16 + i * 8192, R, C);
        voffB[i] = (unsigned)(R * K + C) * 2u;
#pragma unroll
        for (int h = 0; h < 2; ++h) voffA[h][i] = (unsigned)arow(h * G_HALF + R) + (unsigned)C * 2u;
    }
    const size_t hstep = (size_t)G_HALF * K * 2;
    const unsigned ldsw = (unsigned)wid * 1024u;
    const int aoff = lds_byte(wr * 64 + fr, fq * 8), boff = lds_byte(wc * 32 + fr, fq * 8);
#pragma unroll
    for (int ai = 0; ai < 2; ++ai)
#pragma unroll
        for (int bj = 0; bj < 2; ++bj)
#pragma unroll
            for (int m = 0; m < 4; ++m)
#pragma unroll
                for (int n = 0; n < 2; ++n) acc[ai][bj][m][n] = (f32x4){0.f, 0.f, 0.f, 0.f};
    bf16x8 At[4][2], B0[2][2], B1[2][2];
    const int nt = K / G_BK;
    STAGE_B(0, 0, 0); STAGE_A(0, 0, 0);
    STAGE_B(0, 1, 0); STAGE_A(0, 1, 0);
    if (wr == 1) BAR;
    WAIT_V(4); BAR;
    STAGE_B(1, 0, 1); STAGE_A(1, 0, 1); STAGE_B(1, 1, 1);
    WAIT_V(6); BAR;
    for (int t = 0; t < nt - 2; t += 2) {
        LDB(B0, 0, 0); SCHED; LDA(At, 0, 0); STAGE_A(1, 1, t + 1);
        WAIT_L(8); BAR; WAIT_L(0); MMA(0, 0, At, B0); BAR; SCHED;
        LDB(B1, 0, 1); STAGE_B(0, 0, t + 2);
        BAR; WAIT_L(0); MMA(0, 1, At, B1); BAR;
        LDA(At, 0, 1); STAGE_A(0, 0, t + 2);
        BAR; WAIT_L(0); MMA(1, 0, At, B0); BAR; SCHED;
        STAGE_B(0, 1, t + 2);
        WAIT_V(6); BAR; MMA(1, 1, At, B1); BAR;
        LDB(B0, 1, 0); SCHED; LDA(At, 1, 0); STAGE_A(0, 1, t + 2);
        WAIT_L(8); BAR; WAIT_L(0); MMA(0, 0, At, B0); BAR; SCHED;
        LDB(B1, 1, 1); STAGE_B(1, 0, t + 3);
        BAR; WAIT_L(0); MMA(0, 1, At, B1); BAR;
        LDA(At, 1, 1); STAGE_A(1, 0, t + 3);
        BAR; WAIT_L(0); MMA(1, 0, At, B0); BAR; SCHED;
        STAGE_B(1, 1, t + 3);
        WAIT_V(6); BAR; MMA(1, 1, At, B1); BAR;
    }
    {
        LDB(B0, 0, 0); LDA(At, 0, 0); STAGE_A(1, 1, nt - 1);
        BAR; WAIT_L(0); MMA(0, 0, At, B0); BAR;
        LDB(B1, 0, 1); BAR; WAIT_L(0); MMA(0, 1, At, B1); BAR;
        LDA(At, 0, 1); WAIT_V(4); BAR; WAIT_L(0); MMA(1, 0, At, B0); MMA(1, 1, At, B1); BAR;
    }
    {
        LDB(B0, 1, 0); LDA(At, 1, 0); WAIT_V(2); BAR; WAIT_L(0); MMA(0, 0, At, B0); BAR;
        LDB(B1, 1, 1); WAIT_V(0); BAR; WAIT_L(0); MMA(0, 1, At, B1); BAR;
        LDA(At, 1, 1); BAR; WAIT_L(0); MMA(1, 0, At, B0); MMA(1, 1, At, B1); BAR;
    }
    if (wr == 0) BAR;
#undef SA
#undef SB
#undef STAGE_A
#undef STAGE_B
#undef LDA
#undef LDB
#undef MMA
}

template <class ORow>
__device__ __forceinline__ void convert_item(float* T, const float* __restrict__ W, int K, int ncols, int ldw,
                                             bf16_t* __restrict__ WT, ORow orow, int k0, int n0) {
    const int tid = threadIdx.x;
    __syncthreads();
#pragma unroll
    for (int i = 0; i < 2; ++i) {
        const int idx = tid + i * 512, kr = idx >> 4, c4 = idx & 15;
        float4 v = make_float4(0.f, 0.f, 0.f, 0.f);
        if (n0 + c4 * 4 < ncols) v = *(const float4*)(W + (size_t)(k0 + kr) * ldw + n0 + c4 * 4);
        T[(c4 * 4 + 0) * 65 + kr] = v.x;
        T[(c4 * 4 + 1) * 65 + kr] = v.y;
        T[(c4 * 4 + 2) * 65 + kr] = v.z;
        T[(c4 * 4 + 3) * 65 + kr] = v.w;
    }
    __syncthreads();
    const int n = tid >> 3, c = tid & 7;
    const float* sp = T + n * 65 + c * 8;
    u32x4 o;
    o.x = pk_bf16(sp[0], sp[1]);
    o.y = pk_bf16(sp[2], sp[3]);
    o.z = pk_bf16(sp[4], sp[5]);
    o.w = pk_bf16(sp[6], sp[7]);
    const int r = orow(n0 + n);
    *(u32x4*)(WT + (size_t)r * K + k0 + c * 8) = o;
}

__device__ __forceinline__ void f_prologue(const Params& p, unsigned char* shm) {
    const int tid = threadIdx.x, lane = tid & 63, w = tid >> 6;
    unsigned char* wsb = (unsigned char*)p.ws;
    bf16_t* xn = (bf16_t*)(wsb + WS_XN);
    {
        float4* km = (float4*)(wsb + WS_KMEAN);
        for (int i = blockIdx.x * 512 + tid; i < 16384; i += gridDim.x * 512) km[i] = make_float4(0.f, 0.f, 0.f, 0.f);
    }
    for (int row = blockIdx.x * 8 + w; row < NTOK; row += gridDim.x * 8) {
        const float4* xr = (const float4*)(p.x + (size_t)row * DM);
        float4 v[4];
        float ss = 0.f;
#pragma unroll
        for (int j = 0; j < 4; ++j) { v[j] = xr[lane + 64 * j]; ss += dot4(v[j], v[j]); }
        ss = wave_sum(ss);
        const float r = 1.0f / sqrtf(ss * (1.0f / DM) + 1e-5f);
        const float4* g4 = (const float4*)p.attn_g;
        u32x2* o = (u32x2*)(xn + (size_t)row * DM);
#pragma unroll
        for (int j = 0; j < 4; ++j) {
            const float4 g = g4[lane + 64 * j];
            u32x2 ov;
            ov.x = pk_bf16(v[j].x * r * g.x, v[j].y * r * g.y);
            ov.y = pk_bf16(v[j].z * r * g.z, v[j].w * r * g.w);
            o[lane + 64 * j] = ov;
        }
    }
    float* T = (float*)shm;
    bf16_t* btin = (bf16_t*)(wsb + WS_BTIN);
    for (int it = blockIdx.x; it < 16 * 48; it += gridDim.x)
        convert_item(T, p.w_in, DM, INC, INC, btin, [](int c) { return c; }, (it / 48) * 64, (it % 48) * 64);
    bf16_t* btout = (bf16_t*)(wsb + WS_BTOUT);
    for (int it = blockIdx.x; it < 16 * 16; it += gridDim.x)
        convert_item(T, p.w_out, DM, DM, DM, btout, [](int c) { return c; }, (it >> 4) * 64, (it & 15) * 64);
    bf16_t* btup = (bf16_t*)(wsb + WS_BTUP);
    for (int it = blockIdx.x; it < NE * 16 * 32; it += gridDim.x) {
        const int e = it >> 9, r = it & 511;
        convert_item(T, p.w_up + (size_t)e * DM * DFF2, DM, DFF2, DFF2, btup + (size_t)e * DFF2 * DM,
                     [](int c) { const int a = c >> 1, n = c & 1; return (a >> 4) * 32 + n * 16 + (a & 15); }, (r >> 5) * 64, (r & 31) * 64);
    }
    bf16_t* btdn = (bf16_t*)(wsb + WS_BTDN);
    for (int it = blockIdx.x; it < NE * 16 * 16; it += gridDim.x) {
        const int e = it >> 8, r = it & 255;
        convert_item(T, p.w_down + (size_t)e * DM * DM, DM, DM, DM, btdn + (size_t)e * DM * DM, [](int c) { return c; },
                     (r >> 4) * 64, (r & 15) * 64);
    }
    __syncthreads();
}

__device__ __forceinline__ void f_inproj(const Params& p, unsigned char* shm) {
    unsigned char* wsb = (unsigned char*)p.ws;
    const bf16_t* xn = (const bf16_t*)(wsb + WS_XN);
    const bf16_t* btin = (const bf16_t*)(wsb + WS_BTIN);
    bf16_t* pt = (bf16_t*)(wsb + WS_PT);
    float* gates = (float*)(wsb + WS_GATES);
    float* kmean = (float*)(wsb + WS_KMEAN);
    const int tid = threadIdx.x, wid = __builtin_amdgcn_readfirstlane(tid >> 6), lane = tid & 63, wr = wid >> 2, wc = wid & 3;
    constexpr int NTN = NIN_PAD / 256;
    for (int it = blockIdx.x; it < (NTOK / 256) * NTN; it += gridDim.x) {
        const int pm = it / NTN, pn = it % NTN;
        f32x4 acc[2][2][4][2];
        gemm256_tile((LAS unsigned char*)shm, (const char*)xn, [&](int r) { return (pm * 256 + r) * (DM * 2); },
                     (const char*)(btin + (size_t)pn * 256 * DM), DM, acc);
        int le = lane;
        asm volatile("" : "+v"(le));
        const int er = le & 15, eq = le >> 4;
        if (pn < 11) {
#pragma unroll
            for (int bj = 0; bj < 2; ++bj) {
                const int hg = pn * 4 + bj * 2 + (wc >> 1);
                const float sc = (hg < 8 || (hg >= 24 && hg < 32)) ? QSCALE : 1.0f;
                bf16_t* base = pt + ((size_t)hg * NTOK + pm * 256 + wr * 64) * 64 + (wc & 1) * 32;
#pragma unroll
                for (int ai = 0; ai < 2; ++ai)
#pragma unroll
                    for (int m = 0; m < 4; ++m)
#pragma unroll
                        for (int n = 0; n < 2; ++n) {
                            const f32x4 a = acc[ai][bj][m][n];
                            u32x2 ov;
                            ov.x = pk_bf16(a[0] * sc, a[1] * sc);
                            ov.y = pk_bf16(a[2] * sc, a[3] * sc);
                            *(u32x2*)(base + (size_t)(ai * 128 + m * 16 + er) * 64 + n * 16 + eq * 4) = ov;
                        }
                if (hg >= HG_MK && hg < HG_MK + 8) {
                    const int b = (pm * 256) / SEQ, nblk = ((pm * 256) % SEQ) >> 8, h = hg - HG_MK;
                    float* kb = kmean + (size_t)((b * 8 + h) * 32 + nblk) * 64 + (wc & 1) * 32;
#pragma unroll
                    for (int n = 0; n < 2; ++n) {
                        f32x4 s = acc[0][bj][0][n];
#pragma unroll
                        for (int m = 1; m < 4; ++m) s += acc[0][bj][m][n];
#pragma unroll
                        for (int m = 0; m < 4; ++m) s += acc[1][bj][m][n];
#pragma unroll
                        for (int o = 1; o < 16; o <<= 1) {
                            s[0] += __shfl_xor(s[0], o);
                            s[1] += __shfl_xor(s[1], o);
                            s[2] += __shfl_xor(s[2], o);
                            s[3] += __shfl_xor(s[3], o);
                        }
                        if (er == 0) {
                            float* d = kb + n * 16 + eq * 4;
                            unsafeAtomicAdd(d + 0, s[0]);
                            unsafeAtomicAdd(d + 1, s[1]);
                            unsafeAtomicAdd(d + 2, s[2]);
                            unsafeAtomicAdd(d + 3, s[3]);
                        }
                    }
                }
            }
        } else if (wc == 0) {
#pragma unroll
            for (int n = 0; n < 2; ++n) {
                const int gc = n * 16 + eq * 4;
                if (gc < 24) {
#pragma unroll
                    for (int ai = 0; ai < 2; ++ai)
#pragma unroll
                        for (int m = 0; m < 4; ++m) {
                            const f32x4 a = acc[ai][0][m][n];
                            const int row = pm * 256 + ai * 128 + wr * 64 + m * 16 + er;
                            f32x4 sg;
                            sg[0] = 1.0f / (1.0f + __expf(-a[0]));
                            sg[1] = 1.0f / (1.0f + __expf(-a[1]));
                            sg[2] = 1.0f / (1.0f + __expf(-a[2]));
                            sg[3] = 1.0f / (1.0f + __expf(-a[3]));
                            *(f32x4*)(gates + (size_t)row * 24 + gc) = sg;
                        }
                }
            }
        }
    }
    __syncthreads();
}

__device__ __forceinline__ void f_outproj(const Params& p, unsigned char* shm) {
    unsigned char* wsb = (unsigned char*)p.ws;
    const bf16_t* mixb = (const bf16_t*)(wsb + WS_MIXB);
    const bf16_t* btout = (const bf16_t*)(wsb + WS_BTOUT);
    const int tid = threadIdx.x, wid = __builtin_amdgcn_readfirstlane(tid >> 6), lane = tid & 63, wr = wid >> 2, wc = wid & 3;
    for (int it = blockIdx.x; it < (NTOK / 256) * 4; it += gridDim.x) {
        const int pm = it >> 2, pn = it & 3;
        f32x4 acc[2][2][4][2];
        gemm256_tile((LAS unsigned char*)shm, (const char*)mixb, [&](int r) { return (pm * 256 + r) * (DM * 2); },
                     (const char*)(btout + (size_t)pn * 256 * DM), DM, acc);
        int le = lane;
        asm volatile("" : "+v"(le));
        const int er = le & 15, eq = le >> 4;
#pragma unroll
        for (int ai = 0; ai < 2; ++ai)
#pragma unroll
            for (int m = 0; m < 4; ++m) {
                const size_t rowoff = (size_t)(pm * 256 + ai * 128 + wr * 64 + m * 16 + er) * DM;
#pragma unroll
                for (int bj = 0; bj < 2; ++bj)
#pragma unroll
                    for (int n = 0; n < 2; ++n) {
                        const size_t o = rowoff + pn * 256 + bj * 128 + wc * 32 + n * 16 + eq * 4;
                        const f32x4 xv = *(const f32x4*)(p.x + o);
                        *(f32x4*)(p.out + o) = xv + acc[ai][bj][m][n];
                    }
            }
    }
    __syncthreads();
}

__device__ __forceinline__ void f_router(const Params& p, unsigned char* shm) {
    const int tid = threadIdx.x, lane = tid & 63, w = tid >> 6;
    unsigned char* wsb = (unsigned char*)p.ws;
    float* Wl = (float*)shm;
    int* hist = (int*)(shm + 147456);
    bf16_t* hb = (bf16_t*)(wsb + WS_H);
    int* sele = (int*)(wsb + WS_SELE);
    float* selw = (float*)(wsb + WS_SELW);
    int* selr = (int*)(wsb + WS_SELR);
    int* bcnt = (int*)(wsb + WS_BCNT);
    __syncthreads();
    for (int idx = tid; idx < 8192; idx += 512) {
        const int k = idx >> 3, e4 = idx & 7;
        const float4 v = ((const float4*)p.w_router)[idx];
        const int rho = ((k >> 8) * 4 + (k & 3)) * 64 + ((k >> 2) & 63);
        *(float4*)(Wl + rho * 36 + e4 * 4) = v;
    }
    for (int c = blockIdx.x; c < NTOK / 128; c += gridDim.x) {
        __syncthreads();
        if (tid < 32) hist[tid] = 0;
        __syncthreads();
        for (int rr = 0; rr < 16; ++rr) {
            const int row = c * 128 + w * 16 + rr;
            const float4* xr = (const float4*)(p.out + (size_t)row * DM);
            float4 v[4];
            float ss = 0.f;
#pragma unroll
            for (int j = 0; j < 4; ++j) { v[j] = xr[lane + 64 * j]; ss += dot4(v[j], v[j]); }
            ss = wave_sum(ss);
            const float r = 1.0f / sqrtf(ss * (1.0f / DM) + 1e-5f);
            const float4* g4 = (const float4*)p.ffn_g;
            u32x2* o = (u32x2*)(hb + (size_t)row * DM);
#pragma unroll
            for (int j = 0; j < 4; ++j) {
                const float4 g = g4[lane + 64 * j];
                v[j] = make_float4(v[j].x * r * g.x, v[j].y * r * g.y, v[j].z * r * g.z, v[j].w * r * g.w);
                u32x2 ov;
                ov.x = pk_bf16(v[j].x, v[j].y);
                ov.y = pk_bf16(v[j].z, v[j].w);
                o[lane + 64 * j] = ov;
            }
            float lg[32];
#pragma unroll
            for (int e = 0; e < 32; ++e) lg[e] = 0.f;
#pragma unroll
            for (int j = 0; j < 4; ++j) {
                const float hv[4] = {v[j].x, v[j].y, v[j].z, v[j].w};
#pragma unroll
                for (int cc = 0; cc < 4; ++cc) {
                    const float4* wr = (const float4*)(Wl + ((j * 4 + cc) * 64 + lane) * 36);
#pragma unroll
                    for (int e4 = 0; e4 < 8; ++e4) {
                        const float4 wv = wr[e4];
                        lg[e4 * 4 + 0] += hv[cc] * wv.x;
                        lg[e4 * 4 + 1] += hv[cc] * wv.y;
                        lg[e4 * 4 + 2] += hv[cc] * wv.z;
                        lg[e4 * 4 + 3] += hv[cc] * wv.w;
                    }
                }
            }
#pragma unroll
            for (int e = 0; e < 32; ++e) lg[e] = wave_sum(lg[e]) + p.b_router[e];
            float tv[4];
            int ti[4];
#pragma unroll
            for (int s = 0; s < 4; ++s) {
                float best = -INFINITY;
                int bi = 0;
#pragma unroll
                for (int e = 0; e < 32; ++e)
                    if (lg[e] > best) { best = lg[e]; bi = e; }
                tv[s] = best;
                ti[s] = bi;
#pragma unroll
                for (int e = 0; e < 32; ++e)
                    if (e == bi) lg[e] = -INFINITY;
            }
            const float e1 = __expf(tv[1] - tv[0]), e2 = __expf(tv[2] - tv[0]), e3 = __expf(tv[3] - tv[0]);
            const float inv = 1.0f / (1.0f + e1 + e2 + e3);
            if (lane == 0) {
                const float wv[4] = {inv, e1 * inv, e2 * inv, e3 * inv};
#pragma unroll
                for (int s = 0; s < 4; ++s) {
                    sele[row * 4 + s] = ti[s];
                    selw[row * 4 + s] = wv[s];
                    selr[row * 4 + s] = atomicAdd(&hist[ti[s]], 1);
                }
            }
        }
        __syncthreads();
        if (tid < 32) bcnt[c * 32 + tid] = hist[tid];
    }
    __syncthreads();
}

__device__ __forceinline__ void f_fill(const Params& p, unsigned char* shm) {
    const int tid = threadIdx.x;
    unsigned char* wsb = (unsigned char*)p.ws;
    const int* sele = (const int*)(wsb + WS_SELE);
    const float* selw = (const float*)(wsb + WS_SELW);
    const int* selr = (const int*)(wsb + WS_SELR);
    int* selp = (int*)(wsb + WS_SELP);
    const int* bcnt = (const int*)(wsb + WS_BCNT);
    int* gcnt = (int*)(wsb + WS_GCNT);
    int* rtok = (int*)(wsb + WS_RTOK);
    float* rw = (float*)(wsb + WS_RW);
    int* pa = (int*)shm;
    int* pb = pa + 512;
    int* tot = pb + 512;
    int* base = tot + 32;
    int* pstart = base + 32;
    for (int c = blockIdx.x; c < NTOK / 128; c += gridDim.x) {
        __syncthreads();
        {
            const int e = tid & 31, part = tid >> 5;
            int sa = 0, sb = 0;
            for (int cc = part * 16; cc < part * 16 + 16; ++cc) {
                const int v = bcnt[cc * 32 + e];
                sa += v;
                sb += (cc < c) ? v : 0;
            }
            pa[part * 32 + e] = sa;
            pb[part * 32 + e] = sb;
        }
        __syncthreads();
        if (tid < 32) {
            int sa = 0, sb = 0;
            for (int q = 0; q < 16; ++q) { sa += pa[q * 32 + tid]; sb += pb[q * 32 + tid]; }
            tot[tid] = sa;
            base[tid] = sb;
        }
        __syncthreads();
        if (tid == 0) {
            int a = 0;
            for (int e = 0; e < NE; ++e) { pstart[e] = a; a += ((tot[e] + 255) >> 8) << 8; }
            pstart[NE] = a;
        }
        __syncthreads();
        {
            const int i = c * 512 + tid;
            const int e = sele[i];
            const int pos = pstart[e] + base[e] + selr[i];
            rtok[pos] = i >> 2;
            rw[pos] = selw[i];
            selp[i] = pos;
        }
        if (c == 0) {
            if (tid < 32) gcnt[tid] = tot[tid];
            for (int e = 0; e < NE; ++e) {
                const int r0 = pstart[e] + tot[e], r1 = pstart[e + 1];
                for (int r = r0 + tid; r < r1; r += 512) { rtok[r] = 0; rw[r] = 0.f; }
            }
        }
    }
    __syncthreads();
}

__device__ __forceinline__ void f_build_tiles(const Params& p, int* tb) {
    const int* gcnt = (const int*)((unsigned char*)p.ws + WS_GCNT);
    __syncthreads();
    if (threadIdx.x == 0) {
        int a = 0, t = 0;
        for (int e = 0; e < NE; ++e) {
            tb[e] = a;
            tb[40 + e] = t;
            const int nt = (gcnt[e] + 255) >> 8;
            a += nt << 8;
            t += nt;
        }
        tb[32] = a;
        tb[40 + 32] = t;
    }
    __syncthreads();
}

__device__ __forceinline__ void f_up(const Params& p, unsigned char* shm) {
    unsigned char* wsb = (unsigned char*)p.ws;
    int* tb = (int*)(shm + GEMM_LDS_BYTES);
    f_build_tiles(p, tb);
    const int T = tb[40 + 32];
    const bf16_t* hb = (const bf16_t*)(wsb + WS_H);
    const bf16_t* btup = (const bf16_t*)(wsb + WS_BTUP);
    bf16_t* act = (bf16_t*)(wsb + WS_ACT);
    const int* rtok = (const int*)(wsb + WS_RTOK);
    const int tid = threadIdx.x, wid = __builtin_amdgcn_readfirstlane(tid >> 6), lane = tid & 63, wr = wid >> 2, wc = wid & 3;
    for (int it = blockIdx.x; it < T * 8; it += gridDim.x) {
        const int vt = it >> 3, pn = it & 7;
        int e = 0;
        while (tb[40 + e + 1] <= vt) ++e;
        const int rowbase = tb[e] + (vt - tb[40 + e]) * 256;
        f32x4 acc[2][2][4][2];
        gemm256_tile((LAS unsigned char*)shm, (const char*)hb, [&](int r) { return rtok[rowbase + r] * (DM * 2); },
                     (const char*)(btup + ((size_t)e * DFF2 + pn * 256) * DM), DM, acc);
        int le = lane;
        asm volatile("" : "+v"(le));
        const int er = le & 15, eq = le >> 4;
        const float* bias = p.b_up + (size_t)e * DFF2;
#pragma unroll
        for (int bj = 0; bj < 2; ++bj) {
            const int a0 = (pn * 8 + bj * 4 + wc) * 16 + eq * 4;
            const float4 blo = *(const float4*)(bias + 2 * a0), bhi = *(const float4*)(bias + 2 * a0 + 4);
#pragma unroll
            for (int ai = 0; ai < 2; ++ai)
#pragma unroll
                for (int m = 0; m < 4; ++m) {
                    const int row = rowbase + ai * 128 + wr * 64 + m * 16 + er;
                    const f32x4 g = acc[ai][bj][m][0], u = acc[ai][bj][m][1];
                    u32x2 ov;
                    ov.x = pk_bf16(swiglu(g[0] + blo.x, u[0] + blo.y), swiglu(g[1] + blo.z, u[1] + blo.w));
                    ov.y = pk_bf16(swiglu(g[2] + bhi.x, u[2] + bhi.y), swiglu(g[3] + bhi.z, u[3] + bhi.w));
                    *(u32x2*)(act + (size_t)row * DM + a0) = ov;
                }
        }
    }
    __syncthreads();
}

__device__ __forceinline__ void f_down(const Params& p, unsigned char* shm) {
    unsigned char* wsb = (unsigned char*)p.ws;
    int* tb = (int*)(shm + GEMM_LDS_BYTES);
    f_build_tiles(p, tb);
    const int T = tb[40 + 32];
    const bf16_t* act = (const bf16_t*)(wsb + WS_ACT);
    const bf16_t* btdn = (const bf16_t*)(wsb + WS_BTDN);
    bf16_t* yb = (bf16_t*)(wsb + WS_Y);
    const float* rw = (const float*)(wsb + WS_RW);
    const int tid = threadIdx.x, wid = __builtin_amdgcn_readfirstlane(tid >> 6), lane = tid & 63, wr = wid >> 2, wc = wid & 3;
    for (int it = blockIdx.x; it < T * 4; it += gridDim.x) {
        const int vt = it >> 2, pn = it & 3;
        int e = 0;
        while (tb[40 + e + 1] <= vt) ++e;
        const int rowbase = tb[e] + (vt - tb[40 + e]) * 256;
        f32x4 acc[2][2][4][2];
        gemm256_tile((LAS unsigned char*)shm, (const char*)(act + (size_t)rowbase * DM), [&](int r) { return r * (DM * 2); },
                     (const char*)(btdn + ((size_t)e * DM + pn * 256) * DM), DM, acc);
        int le = lane;
        asm volatile("" : "+v"(le));
        const int er = le & 15, eq = le >> 4;
        const float* bias = p.b_down + (size_t)e * DM;
#pragma unroll
        for (int ai = 0; ai < 2; ++ai)
#pragma unroll
            for (int m = 0; m < 4; ++m) {
                const int row = rowbase + ai * 128 + wr * 64 + m * 16 + er;
                const float wgt = rw[row];
#pragma unroll
                for (int bj = 0; bj < 2; ++bj)
#pragma unroll
                    for (int n = 0; n < 2; ++n) {
                        const int col = pn * 256 + bj * 128 + wc * 32 + n * 16 + eq * 4;
                        const float4 bv = *(const float4*)(bias + col);
                        const f32x4 a = acc[ai][bj][m][n];
                        u32x2 ov;
                        ov.x = pk_bf16((a[0] + bv.x) * wgt, (a[1] + bv.y) * wgt);
                        ov.y = pk_bf16((a[2] + bv.z) * wgt, (a[3] + bv.w) * wgt);
                        *(u32x2*)(yb + (size_t)row * DM + col) = ov;
                    }
            }
    }
    __syncthreads();
}


__device__ __forceinline__ void f_final(const Params& p) {
    const int lane = threadIdx.x & 63, w = threadIdx.x >> 6;
    unsigned char* wsb = (unsigned char*)p.ws;
    const bf16_t* yb = (const bf16_t*)(wsb + WS_Y);
    const int* selp = (const int*)(wsb + WS_SELP);
    for (int row = blockIdx.x * 8 + w; row < NTOK; row += gridDim.x * 8) {
        float4* xr = (float4*)(p.out + (size_t)row * DM);
        float4 v[4];
#pragma unroll
        for (int j = 0; j < 4; ++j) v[j] = xr[lane + 64 * j];
#pragma unroll
        for (int k = 0; k < 4; ++k) {
            const u32x2* yr = (const u32x2*)(yb + (size_t)selp[row * 4 + k] * DM);
#pragma unroll
            for (int j = 0; j < 4; ++j) {
                const u32x2 yv = yr[lane + 64 * j];
                v[j].x += bf_lo(yv.x);
                v[j].y += bf_hi(yv.x);
                v[j].z += bf_lo(yv.y);
                v[j].w += bf_hi(yv.y);
            }
        }
        float ss = 0.f;
#pragma unroll
        for (int j = 0; j < 4; ++j) ss += dot4(v[j], v[j]);
        ss = wave_sum(ss);
        const float r = 1.0f / sqrtf(ss * (1.0f / DM) + 1e-5f);
        const float4* g4 = (const float4*)p.final_g;
#pragma unroll
        for (int j = 0; j < 4; ++j) {
            const float4 g = g4[lane + 64 * j];
            xr[lane + 64 * j] = make_float4(v[j].x * r * g.x, v[j].y * r * g.y, v[j].z * r * g.z, v[j].w * r * g.w);
        }
    }
}

constexpr int NFPHASE = 8;
__global__ void __launch_bounds__(512) fast_kernel(Params p) {
    extern __shared__ __attribute__((aligned(16))) unsigned char shm[];
    cg::grid_group grid = cg::this_grid();
    const int lo = p.ph_lo, hi = p.ph_hi;
#define F_IN(k) (lo <= (k) && (k) < hi)
#define F_SYNC(k) do { if (F_IN(k) && F_IN((k) + 1)) grid.sync(); } while (0)
    if (F_IN(0)) f_prologue(p, shm);
    F_SYNC(0);
    if (F_IN(1)) f_inproj(p, shm);
    F_SYNC(1);
    if (F_IN(2)) f_outproj(p, shm);
    F_SYNC(2);
    if (F_IN(3)) f_router(p, shm);
    F_SYNC(3);
    if (F_IN(4)) f_fill(p, shm);
    F_SYNC(4);
    if (F_IN(5)) f_up(p, shm);
    F_SYNC(5);
    if (F_IN(6)) f_down(p, shm);
    F_SYNC(6);
    if (F_IN(7)) f_final(p);
}

#ifndef FAST_OUTPROJ
#define FAST_OUTPROJ 1
#endif

extern "C" void kernel_launch(void* const* d_in, const int* in_sizes, int n_in, void* d_out, int out_size, void* d_ws,
                              size_t ws_size, hipStream_t stream) {
    static int ogrid = 0;
    if (!ogrid) {
        int dev = 0, cus = 0, per_cu = 0;
        (void)hipGetDevice(&dev);
        (void)hipDeviceGetAttribute(&cus, hipDeviceAttributeMultiprocessorCount, dev);
        (void)hipOccupancyMaxActiveBlocksPerMultiprocessor(&per_cu, oracle_kernel, 256, 0);
        if (per_cu < 1) per_cu = 1;
        if (per_cu > 2) per_cu = 2;
        ogrid = cus * per_cu;
        (void)hipFuncSetAttribute((const void*)fast_kernel, hipFuncAttributeMaxDynamicSharedMemorySize, FAST_LDS_BYTES);
        if (ws_size < WS_END) fprintf(stderr, "kernel_launch: workspace too small: %zu < %zu\n", ws_size, (size_t)WS_END);
    }
    Params p{};
    p.x = (const float*)d_in[0];
    p.attn_g = (const float*)d_in[1];
    p.w_in = (const float*)d_in[2];
    p.pe_k = (const float*)d_in[3];
    p.pe_v = (const float*)d_in[4];
    p.w1k = (const float*)d_in[5];
    p.w2k = (const float*)d_in[6];
    p.w1v = (const float*)d_in[7];
    p.w2v = (const float*)d_in[8];
    p.w_out = (const float*)d_in[9];
    p.ffn_g = (const float*)d_in[10];
    p.w_router = (const float*)d_in[11];
    p.b_router = (const float*)d_in[12];
    p.w_up = (const float*)d_in[13];
    p.b_up = (const float*)d_in[14];
    p.w_down = (const float*)d_in[15];
    p.b_down = (const float*)d_in[16];
    p.final_g = (const float*)d_in[17];
    p.out = (float*)d_out;
    p.ws = (float*)d_ws;
    auto fast = [&](int lo, int hi) {
        for (int ph = lo; ph < hi; ++ph) {
            p.ph_lo = ph;
            p.ph_hi = ph + 1;
            hipLaunchKernelGGL(fast_kernel, dim3(256), dim3(512), FAST_LDS_BYTES, stream, p);
        }
    };
    auto oracle = [&](int lo, int hi) {
        p.ph_lo = lo;
        p.ph_hi = hi;
        void* args[] = {&p};
        hipError_t e = hipLaunchCooperativeKernel((void*)oracle_kernel, dim3(ogrid), dim3(256), args, 0, stream);
        if (e != hipSuccess) fprintf(stderr, "cooperative launch failed: %s (grid %d)\n", hipGetErrorString(e), ogrid);
    };
    fast(0, 2);
#if FAST_OUTPROJ
    oracle(0, 2);
    fast(2, NFPHASE);
#else
    oracle(0, 3);
    fast(3, NFPHASE);
#endif
}
```

```cpp
#include <hip/hip_runtime.h>
#include <hip/hip_cooperative_groups.h>
#include <cstdio>
#include <cstdint>
namespace cg = cooperative_groups;

constexpr int NB = 4, SEQ = 8192, DM = 1024, NTOK = NB * SEQ;
constexpr int INC = 2840;
constexpr int NCMP = 511, NCMPP = 512;
constexpr int NE = 32, TOPK = 4, NK = NTOK * TOPK;
constexpr int DFF2 = 2048;
constexpr int NIN_PAD = 3072;
constexpr int PMAX = 139264;
constexpr float LOG2E = 1.4426950408889634f;
constexpr float QSCALE = 0.125f * LOG2E;
constexpr int HG_MQ = 0, HG_MK = 8, HG_MV = 16, HG_NQ = 24, HG_KC = 32, HG_VC = 34, HG_KS = 36, HG_VS = 38, HG_KW = 40,
              HG_VW = 42, NHG = 44;

constexpr size_t WS_BTUP  = 0;
constexpr size_t WS_BTDN  = WS_BTUP + (size_t)NE * DFF2 * DM * 2;
constexpr size_t WS_BTOUT = WS_BTDN + (size_t)NE * DM * DM * 2;
constexpr size_t WS_BTIN  = WS_BTOUT + (size_t)DM * DM * 2;
constexpr size_t WS_XN    = WS_BTIN + (size_t)NIN_PAD * DM * 2;
constexpr size_t WS_H     = WS_XN;
constexpr size_t WS_PT    = WS_XN + (size_t)NTOK * DM * 2;
constexpr size_t WS_GATES = WS_PT + (size_t)NHG * NTOK * 64 * 2;
constexpr size_t WS_KMEAN = WS_GATES + (size_t)NTOK * 24 * 4;
constexpr size_t WS_KCMP  = WS_KMEAN + 65536 * 4;
constexpr size_t WS_VCMP  = WS_KCMP + 262144 * 2;
constexpr size_t WS_MIXB  = WS_VCMP + 262144 * 2;
constexpr size_t WS_ACT   = WS_PT;
constexpr size_t WS_Y     = WS_ACT + (size_t)PMAX * DM * 2;
static_assert(WS_MIXB + (size_t)NTOK * DM * 2 <= WS_Y, "act overlay");
constexpr size_t WS_SELE  = WS_Y + (size_t)PMAX * DM * 2;
constexpr size_t WS_SELW  = WS_SELE + (size_t)NK * 4;
constexpr size_t WS_SELR  = WS_SELW + (size_t)NK * 4;
constexpr size_t WS_SELP  = WS_SELR + (size_t)NK * 4;
constexpr size_t WS_BCNT  = WS_SELP + (size_t)NK * 4;
constexpr size_t WS_GCNT  = WS_BCNT + 256 * 32 * 4;
constexpr size_t WS_RTOK  = WS_GCNT + 256;
constexpr size_t WS_RW    = WS_RTOK + (size_t)PMAX * 4;
constexpr size_t WS_C1    = WS_RW + (size_t)PMAX * 4;
constexpr size_t WS_W1T   = WS_C1 + 512;
constexpr size_t WS_W2T   = WS_W1T + 2 * 64 * 2048 * 2;
constexpr size_t WS_OMIX  = WS_W2T + 2 * 64 * 64 * 2;
constexpr size_t WS_OKCMP = WS_OMIX + (size_t)NTOK * DM * 4;
constexpr size_t WS_OVCMP = WS_OKCMP + 262144 * 4;
constexpr size_t WS_END   = WS_OVCMP + 262144 * 4;

struct Params {
    const float *x, *attn_g, *w_in, *pe_k, *pe_v, *w1k, *w2k, *w1v, *w2v, *w_out, *ffn_g, *w_router, *b_router,
        *w_up, *b_up, *w_down, *b_down, *final_g;
    float* out;
    float* ws;
    int ph_lo, ph_hi;
};

typedef unsigned short bf16_t;
typedef short bf16x8 __attribute__((ext_vector_type(8)));
typedef float f32x4 __attribute__((ext_vector_type(4)));
typedef float f32x16 __attribute__((ext_vector_type(16)));
typedef unsigned u32x4 __attribute__((ext_vector_type(4)));
typedef unsigned u32x2 __attribute__((ext_vector_type(2)));

typedef float f32x2 __attribute__((ext_vector_type(2)));
typedef __bf16 bf16x2v __attribute__((ext_vector_type(2)));
__device__ __forceinline__ unsigned pk_bf16(float lo, float hi) {
    const f32x2 f = {lo, hi};
    return __builtin_bit_cast(unsigned, __builtin_convertvector(f, bf16x2v));
}
__device__ __forceinline__ float bf_lo(unsigned u) { return __uint_as_float(u << 16); }
__device__ __forceinline__ float bf_hi(unsigned u) { return __uint_as_float(u & 0xffff0000u); }
__device__ __forceinline__ float bf2f(bf16_t b) { return __uint_as_float((unsigned)b << 16); }

__device__ __forceinline__ float wave_sum(float v) {
#pragma unroll
    for (int o = 32; o > 0; o >>= 1) v += __shfl_xor(v, o);
    return v;
}
__device__ __forceinline__ float wave_max(float v) {
#pragma unroll
    for (int o = 32; o > 0; o >>= 1) v = fmaxf(v, __shfl_xor(v, o));
    return v;
}
__device__ __forceinline__ int wave_min_i(int v) {
#pragma unroll
    for (int o = 32; o > 0; o >>= 1) v = min(v, __shfl_xor(v, o));
    return v;
}
__device__ __forceinline__ float dot4(float4 a, float4 b) { return a.x * b.x + a.y * b.y + a.z * b.z + a.w * b.w; }

__device__ __forceinline__ float gelu_tanh(float x) {
    return 0.5f * x * (1.0f + tanhf(0.7978845608028654f * (x + 0.044715f * x * x * x)));
}
__device__ __forceinline__ float swiglu(float g, float u) {
    g = fminf(g, 7.0f);
    u = fminf(fmaxf(u, -7.0f), 7.0f);
    return g * (1.0f / (1.0f + __expf(-1.702f * g))) * (u + 1.0f);
}


constexpr int G_BM = 256, G_BK = 64, G_HALF = 128, G_HT = G_HALF * G_BK;
constexpr int GEMM_LDS_BYTES = 8 * G_HT * 2;
constexpr int FAST_LDS_BYTES = 155648;
__device__ __forceinline__ int lds_byte(int r, int c) {
    const int st = (r >> 4) * 2 + (c >> 5), rr = r & 15, cc = c & 31, ob = rr * 64 + cc * 2;
    return st * 1024 + (ob ^ (((ob >> 9) & 1) << 5));
}
__device__ __forceinline__ void stage_rc(int b, int& R, int& C) {
    const int st = b / 1024, sb = b % 1024, swz = sb ^ (((sb >> 9) & 1) << 5);
    R = (st >> 1) * 16 + swz / 64;
    C = (st & 1) * 32 + (swz % 64) / 2;
}

#define LAS __attribute__((address_space(3)))
template <class ARow>
__device__ __forceinline__ void gemm256_tile(LAS unsigned char* lds, const char* __restrict__ Abase, ARow arow,
                                             const char* __restrict__ Bbase, int K, f32x4 (&acc)[2][2][4][2]) {
    constexpr int HTB = G_HT * 2;
#define SA(b, h) (((b) * 2 + (h)) * HTB)
#define SB(b, h) ((4 + (b) * 2 + (h)) * HTB)
#define STAGE_A(b, h, kt)                                                                                              \
    do {                                                                                                               \
        _Pragma("unroll") for (int _i = 0; _i < 2; ++_i) __builtin_amdgcn_global_load_lds(                              \
            (const unsigned*)(Abase + (size_t)(kt) * (G_BK * 2) + voffA[h][_i]),                                       \
            (LAS unsigned*)(lds + SA(b, h) + ldsw + _i * 8192), 16, 0, 0);                                              \
    } while (0)
#define STAGE_B(b, h, kt)                                                                                              \
    do {                                                                                                               \
        _Pragma("unroll") for (int _i = 0; _i < 2; ++_i) __builtin_amdgcn_global_load_lds(                              \
            (const unsigned*)(Bbase + (size_t)(h) * hstep + (size_t)(kt) * (G_BK * 2) + voffB[_i]),                    \
            (LAS unsigned*)(lds + SB(b, h) + ldsw + _i * 8192), 16, 0, 0);                                              \
    } while (0)
#define LDA(dst, b, h)                                                                                                 \
    do {                                                                                                               \
        _Pragma("unroll") for (int m = 0; m < 4; ++m) _Pragma("unroll") for (int k = 0; k < 2; ++k) dst[m][k] =         \
            *(const LAS bf16x8*)(lds + SA(b, h) + aoff + m * 2048 + k * 1024);                                          \
    } while (0)
#define LDB(dst, b, h)                                                                                                 \
    do {                                                                                                               \
        _Pragma("unroll") for (int n = 0; n < 2; ++n) _Pragma("unroll") for (int k = 0; k < 2; ++k) dst[n][k] =         \
            *(const LAS bf16x8*)(lds + SB(b, h) + boff + n * 2048 + k * 1024);                                          \
    } while (0)
#define MMA(ai, bj, Af, Bf)                                                                                            \
    do {                                                                                                               \
        __builtin_amdgcn_s_setprio(1);                                                                                 \
        _Pragma("unroll") for (int m = 0; m < 4; ++m) _Pragma("unroll") for (int n = 0; n < 2; ++n)                     \
            _Pragma("unroll") for (int k = 0; k < 2; ++k) acc[ai][bj][m][n] =                                           \
                __builtin_amdgcn_mfma_f32_16x16x32_bf16(Bf[n][k], Af[m][k], acc[ai][bj][m][n], 0, 0, 0);               \
        __builtin_amdgcn_s_setprio(0);                                                                                 \
    } while (0)
#define WAIT_V(n) asm volatile("s_waitcnt vmcnt(" #n ")" ::: "memory")
#define WAIT_L(n) asm volatile("s_waitcnt lgkmcnt(" #n ")" ::: "memory")
#define BAR __builtin_amdgcn_s_barrier()
#define SCHED __builtin_amdgcn_sched_barrier(0)
    const int tid = threadIdx.x, wid = __builtin_amdgcn_readfirstlane(tid >> 6), lane = tid & 63, wr = wid >> 2, wc = wid & 3,
              fr = lane & 15, fq = lane >> 4;
    unsigned voffA[2][2], voffB[2];
#pragma unroll
    for (int i = 0; i < 2; ++i) {
        int R, C;
        stage_rc(tid * 16 + i * 8192, R, C);
        voffB[i] = (unsigned)(R * K + C) * 2u;
#pragma unroll
        for (int h = 0; h < 2; ++h) voffA[h][i] = (unsigned)arow(h * G_HALF + R) + (unsigned)C * 2u;
    }
    const size_t hstep = (size_t)G_HALF * K * 2;
    const unsigned ldsw = (unsigned)wid * 1024u;
    const int aoff = lds_byte(wr * 64 + fr, fq * 8), boff = lds_byte(wc * 32 + fr, fq * 8);
#pragma unroll
    for (int ai = 0; ai < 2; ++ai)
#pragma unroll
        for (int bj = 0; bj < 2; ++bj)
#pragma unroll
            for (int m = 0; m < 4; ++m)
#pragma unroll
                for (int n = 0; n < 2; ++n) acc[ai][bj][m][n] = (f32x4){0.f, 0.f, 0.f, 0.f};
    bf16x8 At[4][2], B0[2][2], B1[2][2];
    const int nt = K / G_BK;
    STAGE_B(0, 0, 0); STAGE_A(0, 0, 0);
    STAGE_B(0, 1, 0); STAGE_A(0, 1, 0);
    if (wr == 1) BAR;
    WAIT_V(4); BAR;
    STAGE_B(1, 0, 1); STAGE_A(1, 0, 1); STAGE_B(1, 1, 1);
    WAIT_V(6); BAR;
    for (int t = 0; t < nt - 2; t += 2) {
        LDB(B0, 0, 0); SCHED; LDA(At, 0, 0); STAGE_A(1, 1, t + 1);
        WAIT_L(8); BAR; WAIT_L(0); MMA(0, 0, At, B0); BAR; SCHED;
        LDB(B1, 0, 1); STAGE_B(0, 0, t + 2);
        BAR; WAIT_L(0); MMA(0, 1, At, B1); BAR;
        LDA(At, 0, 1); STAGE_A(0, 0, t + 2);
        BAR; WAIT_L(0); MMA(1, 0, At, B0); BAR; SCHED;
        STAGE_B(0, 1, t + 2);
        WAIT_V(6); BAR; MMA(1, 1, At, B1); BAR;
        LDB(B0, 1, 0); SCHED; LDA(At, 1, 0); STAGE_A(0, 1, t + 2);
        WAIT_L(8); BAR; WAIT_L(0); MMA(0, 0, At, B0); BAR; SCHED;
        LDB(B1, 1, 1); STAGE_B(1, 0, t + 3);
        BAR; WAIT_L(0); MMA(0, 1, At, B1); BAR;
        LDA(At, 1, 1); STAGE_A(1, 0, t + 3);
        BAR; WAIT_L(0); MMA(1, 0, At, B0); BAR; SCHED;
        STAGE_B(1, 1, t + 3);
        WAIT_V(6); BAR; MMA(1, 1, At, B1); BAR;
    }
    {
        LDB(B0, 0, 0); LDA(At, 0, 0); STAGE_A(1, 1, nt - 1);
        BAR; WAIT_L(0); MMA(0, 0, At, B0); BAR;
        LDB(B1, 0, 1); BAR; WAIT_L(0); MMA(0, 1, At, B1); BAR;
        LDA(At, 0, 1); WAIT_V(4); BAR; WAIT_L(0); MMA(1, 0, At, B0); MMA(1, 1, At, B1); BAR;
    }
    {
        LDB(B0, 1, 0); LDA(At, 1, 0); WAIT_V(2); BAR; WAIT_L(0); MMA(0, 0, At, B0); BAR;
        LDB(B1, 1, 1); WAIT_V(0); BAR; WAIT_L(0); MMA(0, 1, At, B1); BAR;
        LDA(At, 1, 1); BAR; WAIT_L(0); MMA(1, 0, At, B0); MMA(1, 1, At, B1); BAR;
    }
    if (wr == 0) BAR;
#undef SA
#undef SB
#undef STAGE_A
#undef STAGE_B
#undef LDA
#undef LDB
#undef MMA
}

template <class ORow>
__device__ __forceinline__ void convert_item(float* T, const float* __restrict__ W, int K, int ncols, int ldw,
                                             bf16_t* __restrict__ WT, ORow orow, int k0, int n0) {
    const int tid = threadIdx.x;
    __syncthreads();
#pragma unroll
    for (int i = 0; i < 2; ++i) {
        const int idx = tid + i * 512, kr = idx >> 4, c4 = idx & 15;
        float4 v = make_float4(0.f, 0.f, 0.f, 0.f);
        if (n0 + c4 * 4 < ncols) v = *(const float4*)(W + (size_t)(k0 + kr) * ldw + n0 + c4 * 4);
        T[(c4 * 4 + 0) * 65 + kr] = v.x;
        T[(c4 * 4 + 1) * 65 + kr] = v.y;
        T[(c4 * 4 + 2) * 65 + kr] = v.z;
        T[(c4 * 4 + 3) * 65 + kr] = v.w;
    }
    __syncthreads();
    const int n = tid >> 3, c = tid & 7;
    const float* sp = T + n * 65 + c * 8;
    u32x4 o;
    o.x = pk_bf16(sp[0], sp[1]);
    o.y = pk_bf16(sp[2], sp[3]);
    o.z = pk_bf16(sp[4], sp[5]);
    o.w = pk_bf16(sp[6], sp[7]);
    const int r = orow(n0 + n);
    *(u32x4*)(WT + (size_t)r * K + k0 + c * 8) = o;
}

constexpr int AT_KP = 144, AT_VP = 136, AT_KB = 64 * AT_KP, AT_VB = 64 * AT_VP, AT_BUF = AT_KB + AT_VB;
constexpr int AT_IMPA = 36864, AT_IMPB = AT_IMPA + 32768, AT_SELB = AT_IMPB + 32768, AT_KMS = AT_IMPA;
#define MFMA32(a, b, c) __builtin_amdgcn_mfma_f32_32x32x16_bf16(a, b, c, 0, 0, 0)
#define CREG(reg) (((reg) & 3) + 8 * ((reg) >> 2))

struct AtStage { u32x4 k, v; };
__device__ __forceinline__ void at_load(AtStage& st, const bf16_t* __restrict__ Kg, const bf16_t* __restrict__ Vg, bool with_v, unsigned koff, unsigned voff) {
    st.k = *(const u32x4*)((const char*)Kg + koff);
    if (with_v) st.v = *(const u32x4*)((const char*)Vg + voff);
}
__device__ __forceinline__ void at_store(const AtStage& st, LAS unsigned char* buf, bool with_v) {
    const int tid = threadIdx.x;
    *(LAS u32x4*)(buf + (tid >> 3) * AT_KP + (tid & 7) * 16) = st.k;
    if (with_v) {
        LAS unsigned short* vt = (LAS unsigned short*)(buf + AT_KB + (tid >> 6) * 8 * AT_VP + (tid & 63) * 2);
        vt[0 * (AT_VP / 2)] = (unsigned short)(st.v.x & 0xffffu);
        vt[1 * (AT_VP / 2)] = (unsigned short)(st.v.x >> 16);
        vt[2 * (AT_VP / 2)] = (unsigned short)(st.v.y & 0xffffu);
        vt[3 * (AT_VP / 2)] = (unsigned short)(st.v.y >> 16);
        vt[4 * (AT_VP / 2)] = (unsigned short)(st.v.z & 0xffffu);
        vt[5 * (AT_VP / 2)] = (unsigned short)(st.v.z >> 16);
        vt[6 * (AT_VP / 2)] = (unsigned short)(st.v.w & 0xffffu);
        vt[7 * (AT_VP / 2)] = (unsigned short)(st.v.w >> 16);
    }
}
__device__ __forceinline__ void at_scores(LAS const unsigned char* buf, const bf16x8 (&qf)[4], const f32x16& ramp, float base0, float base1,
                                          f32x16& s0, f32x16& s1) {
    const int lane = threadIdx.x & 63, r = lane & 31, h = lane >> 5;
    LAS const unsigned char* kb = buf + r * AT_KP + h * 16;
    s0 = ramp + base0;
    s1 = ramp + base1;
#pragma unroll
    for (int kk = 0; kk < 4; ++kk) {
        const bf16x8 k0 = *(LAS const bf16x8*)(kb + kk * 32);
        const bf16x8 k1 = *(LAS const bf16x8*)(kb + 32 * AT_KP + kk * 32);
        s0 = MFMA32(k0, qf[kk], s0);
        s1 = MFMA32(k1, qf[kk], s1);
    }
}
__device__ __forceinline__ bf16x8 at_pack8(const f32x16& P, int s2) {
    u32x4 w;
    if (s2 == 0) { w.x = pk_bf16(P[0], P[1]); w.y = pk_bf16(P[2], P[3]); w.z = pk_bf16(P[4], P[5]); w.w = pk_bf16(P[6], P[7]); }
    else         { w.x = pk_bf16(P[8], P[9]); w.y = pk_bf16(P[10], P[11]); w.z = pk_bf16(P[12], P[13]); w.w = pk_bf16(P[14], P[15]); }
    return __builtin_bit_cast(bf16x8, w);
}
__device__ __forceinline__ void at_pv(LAS const unsigned char* buf, const f32x16& p0, const f32x16& p1, f32x16& o0, f32x16& o1) {
    const int lane = threadIdx.x & 63, r = lane & 31, h = lane >> 5;
    LAS const unsigned char* vb = buf + AT_KB + r * AT_VP + h * 8;
#pragma unroll
    for (int half = 0; half < 2; ++half) {
#pragma unroll
        for (int s2 = 0; s2 < 2; ++s2) {
            const bf16x8 pf = at_pack8(half ? p1 : p0, s2);
            const int ko = (32 * half + 16 * s2) * 2;
            const u32x2 a0 = *(LAS const u32x2*)(vb + ko), a1 = *(LAS const u32x2*)(vb + ko + 16);
            const u32x2 b0 = *(LAS const u32x2*)(vb + 32 * AT_VP + ko), b1 = *(LAS const u32x2*)(vb + 32 * AT_VP + ko + 16);
            const u32x4 va = {a0.x, a0.y, a1.x, a1.y}, vbb = {b0.x, b0.y, b1.x, b1.y};
            o0 = MFMA32(__builtin_bit_cast(bf16x8, va), pf, o0);
            o1 = MFMA32(__builtin_bit_cast(bf16x8, vbb), pf, o1);
        }
    }
}
__device__ __forceinline__ float at_rowmax(const f32x16& s0, const f32x16& s1) {
    float m = fmaxf(s0[0], s1[0]);
#pragma unroll
    for (int i = 1; i < 16; ++i) m = fmaxf(m, fmaxf(s0[i], s1[i]));
    return fmaxf(m, __shfl_xor(m, 32));
}
#define AT_MASK_LE(S0, S1, lim)  do { _Pragma("unroll") for (int i_ = 0; i_ < 16; ++i_) { if (CREG(i_) > (lim)) S0[i_] = -INFINITY; if (CREG(i_) + 32 > (lim)) S1[i_] = -INFINITY; } } while (0)
#define AT_MASK_GE(S0, S1, lo)   do { _Pragma("unroll") for (int i_ = 0; i_ < 16; ++i_) { if (CREG(i_) < (lo)) S0[i_] = -INFINITY; if (CREG(i_) + 32 < (lo)) S1[i_] = -INFINITY; } } while (0)
__device__ __forceinline__ float at_exp(f32x16& s0, f32x16& s1, float mref) {
    float l = 0.f;
#pragma unroll
    for (int i = 0; i < 16; ++i) {
        s0[i] = __builtin_amdgcn_exp2f(s0[i] - mref);
        s1[i] = __builtin_amdgcn_exp2f(s1[i] - mref);
        l += s0[i] + s1[i];
    }
    return l;
}

#define AT_PASS_BEGIN(Kg, Vg, WITHV, NTILE, ROW)                                                                       \
    {                                                                                                                  \
        AtStage st_;                                                                                                   \
        const int nt_ = (NTILE);                                                                                       \
        unsigned koff_ = (threadIdx.x >> 3) * 128 + (threadIdx.x & 7) * 16, voff_ = (threadIdx.x & 63) * 128 + (threadIdx.x >> 6) * 16; \
        asm volatile("" : "+v"(koff_), "+v"(voff_));     \
        __syncthreads();                                                                                               \
        at_load(st_, (Kg) + (size_t)(ROW(0)) * 64, (Vg) + (size_t)(ROW(0)) * 64, WITHV, koff_, voff_);                 \
        at_store(st_, lds, WITHV);                                                                                     \
        __syncthreads();                                                                                               \
        for (int i = 0; i < nt_; ++i) {                                                                                \
            LAS unsigned char* buf = lds + (i & 1) * AT_BUF;                                                           \
            LAS unsigned char* nxt_ = lds + ((i + 1) & 1) * AT_BUF;                                                    \
            const bool more_ = (i + 1 < nt_);                                                                          \
            if (more_) at_load(st_, (Kg) + (size_t)(ROW(i + 1)) * 64, (Vg) + (size_t)(ROW(i + 1)) * 64, WITHV, koff_, voff_); \
            do {
#define AT_PASS_END(WITHV)                                                                                             \
            } while (0);                                                                                               \
            if (more_) at_store(st_, nxt_, WITHV);                                                                     \
            __syncthreads();                                                                                           \
        }                                                                                                              \
    }

__device__ __forceinline__ void nsa_item(const Params& p, unsigned char* shm, int b, int g, int c) {
    LAS unsigned char* lds = (LAS unsigned char*)shm;
    unsigned char* wsb = (unsigned char*)p.ws;
    const bf16_t* pt = (const bf16_t*)(wsb + WS_PT);
    const int tid = threadIdx.x, lane = tid & 63, w = __builtin_amdgcn_readfirstlane(tid >> 6), r = lane & 31, h = lane >> 5;
    const int tokl = 8 * w + (r >> 2), head = r & 3, hq = 4 * g + head, t = 64 * c + tokl, tok = b * SEQ + t;
    const float sl2 = exp2f(-(float)(hq + 1)) * LOG2E;
    f32x16 ramp;
#pragma unroll
    for (int i = 0; i < 16; ++i) ramp[i] = sl2 * (float)(CREG(i) + 4 * h);
    bf16x8 qf[4];
    {
        const bf16_t* qrow = pt + ((size_t)(HG_NQ + hq) * NTOK + tok) * 64 + 8 * h;
#pragma unroll
        for (int kk = 0; kk < 4; ++kk) qf[kk] = *(const bf16x8*)(qrow + 16 * kk);
    }
    const float* gl = (const float*)(wsb + WS_GATES) + (size_t)tok * 24 + hq * 3;
    const float g0 = gl[0], g1 = gl[1], g2 = gl[2];
    f32x16 R0, R1;
#pragma unroll
    for (int i = 0; i < 16; ++i) { R0[i] = 0.f; R1[i] = 0.f; }
    LAS float* impA = (LAS float*)(lds + AT_IMPA);
    LAS float* impB = (LAS float*)(lds + AT_IMPB);
    LAS unsigned* selb = (LAS unsigned*)(lds + AT_SELB);

    {
        const bf16_t* Kc = (const bf16_t*)(wsb + WS_KCMP) + (size_t)(b * 2 + g) * NCMPP * 64;
        const bf16_t* Vc = (const bf16_t*)(wsb + WS_VCMP) + (size_t)(b * 2 + g) * NCMPP * 64;
        const int ntile = (4 * c + 3 + 63) >> 6;
        const int imax = (t >= 31) ? ((t - 31) >> 4) : -1;
        f32x16 ramp16;
#pragma unroll
        for (int i = 0; i < 16; ++i) ramp16[i] = ramp[i] * 16.0f;
        float m = -INFINITY, l = 0.f;
#define ROW_(_i) (64 * (_i))
        AT_PASS_BEGIN(Kc, Vc, false, ntile, ROW_)
            f32x16 s0, s1;
            const float base0 = sl2 * (float)(16 * 64 * i + 31 - 64 * c), base1 = base0 + sl2 * 512.0f;
            at_scores(buf, qf, ramp16, base0, base1, s0, s1);
            const int lim = imax - 64 * i - 4 * h;
            AT_MASK_LE(s0, s1, lim);
            const float tm = at_rowmax(s0, s1);
            const float mn = fmaxf(m, tm);
            if (mn > -INFINITY) {
                l *= __builtin_amdgcn_exp2f(m - mn);
                l += at_exp(s0, s1, mn);
                m = mn;
            }
        AT_PASS_END(false)
        l += __shfl_xor(l, 32);
        const float inv = (l > 0.f) ? 1.0f / l : 0.f;
        const float mfin = (m > -INFINITY) ? m : 0.f;
        f32x16 o0, o1;
#pragma unroll
        for (int i = 0; i < 16; ++i) { o0[i] = 0.f; o1[i] = 0.f; }
        AT_PASS_BEGIN(Kc, Vc, true, ntile, ROW_)
            f32x16 s0, s1;
            const float base0 = sl2 * (float)(16 * 64 * i + 31 - 64 * c), base1 = base0 + sl2 * 512.0f;
            at_scores(buf, qf, ramp16, base0, base1, s0, s1);
            const int lim = imax - 64 * i - 4 * h;
            AT_MASK_LE(s0, s1, lim);
            (void)at_exp(s0, s1, mfin);
#pragma unroll
            for (int q = 0; q < 16; ++q) { s0[q] *= inv; s1[q] *= inv; }
#pragma unroll
            for (int hf = 0; hf < 2; ++hf)
#pragma unroll
                for (int u = 0; u < 4; ++u) {
                    const f32x16& P = hf ? s1 : s0;
                    float A = 2.0f * (P[4 * u] + P[4 * u + 1] + P[4 * u + 2]) + P[4 * u + 3], Bv = P[4 * u + 3];
                    A += __shfl_xor(A, 1); A += __shfl_xor(A, 2);
                    Bv += __shfl_xor(Bv, 1); Bv += __shfl_xor(Bv, 2);
                    const int j = 16 * i + 8 * hf + 2 * u + h;
                    if (head == 0) impA[tokl * 128 + j] = A;
                    if (head == 1) impB[tokl * 128 + j] = Bv;
                }
            at_pv(buf, s0, s1, o0, o1);
        AT_PASS_END(true)
#undef ROW_
#pragma unroll
        for (int i = 0; i < 16; ++i) { R0[i] = g0 * o0[i]; R1[i] = g0 * o1[i]; }
    }

    unsigned sw0, sw1, sw2, sw3;
    {
        __syncthreads();
        for (int tk = 0; tk < 8; ++tk) {
            const int tl = 8 * w + tk;
            unsigned long long ba, bb;
            if (c < 16) {
                ba = (1ull << (c + 1)) - 1ull;
                bb = 0ull;
            } else {
                const int jA = lane, jB = lane + 64;
                float vA = (jA >= 1 && jA <= c - 2) ? impA[tl * 128 + jA] + impB[tl * 128 + jA - 1] : -1.0f;
                float vB = (jB <= c - 2) ? impA[tl * 128 + jB] + impB[tl * 128 + jB - 1] : -1.0f;
                bool sA = (jA == 0) || (jA == c - 1) || (jA == c), sB = (jB == c - 1) || (jB == c);
                for (int s = 0; s < 13; ++s) {
                    const float mx = wave_max(fmaxf(vA, vB));
                    const int cand = (vA == mx) ? jA : ((vB == mx) ? jB : 9999);
                    const int mj = wave_min_i(cand);
                    if (mj == jA) { sA = true; vA = -2.0f; }
                    if (mj == jB) { sB = true; vB = -2.0f; }
                }
                ba = __ballot(sA);
                bb = __ballot(sB);
            }
            if (lane == 0) {
                selb[tl * 4 + 0] = (unsigned)ba;
                selb[tl * 4 + 1] = (unsigned)(ba >> 32);
                selb[tl * 4 + 2] = (unsigned)bb;
                selb[tl * 4 + 3] = (unsigned)(bb >> 32);
            }
        }
        __syncthreads();
        sw0 = selb[tokl * 4 + 0];
        sw1 = selb[tokl * 4 + 1];
        sw2 = selb[tokl * 4 + 2];
        sw3 = selb[tokl * 4 + 3];
    }

    {
        const bf16_t* Ks = pt + ((size_t)(HG_KS + g) * NTOK + (size_t)b * SEQ) * 64;
        const bf16_t* Vs = pt + ((size_t)(HG_VS + g) * NTOK + (size_t)b * SEQ) * 64;
        f32x16 o0, o1;
#pragma unroll
        for (int i = 0; i < 16; ++i) { o0[i] = 0.f; o1[i] = 0.f; }
        float mref = 0.f, l = 0.f;
#define ROW_(_i) (64 * (c - (_i)))
        AT_PASS_BEGIN(Ks, Vs, true, c + 1, ROW_)
            const int j = c - i;
            const unsigned wsel = (j < 32) ? sw0 : (j < 64) ? sw1 : (j < 96) ? sw2 : sw3;
            const bool rowsel = (i == 0) || ((wsel >> (j & 31)) & 1u);
            if (__ballot(rowsel) == 0ull) break;
            f32x16 s0, s1;
            const float base0 = sl2 * (float)(-64 * i), base1 = base0 + sl2 * 32.0f;
            at_scores(buf, qf, ramp, base0, base1, s0, s1);
            if (i == 0) {
                const int lim = tokl - 4 * h;
                AT_MASK_LE(s0, s1, lim);
                mref = at_rowmax(s0, s1);
            }
            float ls = at_exp(s0, s1, mref);
            if (!rowsel) {
                ls = 0.f;
#pragma unroll
                for (int q = 0; q < 16; ++q) { s0[q] = 0.f; s1[q] = 0.f; }
            }
            l += ls;
            at_pv(buf, s0, s1, o0, o1);
        AT_PASS_END(true)
        l += __shfl_xor(l, 32);
        const float sc = g1 / l;
#pragma unroll
        for (int i = 0; i < 16; ++i) { R0[i] += sc * o0[i]; R1[i] += sc * o1[i]; }
    }

    {
        const bf16_t* Kw = pt + ((size_t)(HG_KW + g) * NTOK + (size_t)b * SEQ) * 64;
        const bf16_t* Vw = pt + ((size_t)(HG_VW + g) * NTOK + (size_t)b * SEQ) * 64;
        f32x16 o0, o1;
#pragma unroll
        for (int i = 0; i < 16; ++i) { o0[i] = 0.f; o1[i] = 0.f; }
        float mref = 0.f, l = 0.f;
        const int ntile = (c >= 8) ? 9 : (c + 1);
        AT_PASS_BEGIN(Kw, Vw, true, ntile, ROW_)
            f32x16 s0, s1;
            const float base0 = sl2 * (float)(-64 * i), base1 = base0 + sl2 * 32.0f;
            at_scores(buf, qf, ramp, base0, base1, s0, s1);
            if (i == 0) {
                const int lim = tokl - 4 * h;
                AT_MASK_LE(s0, s1, lim);
                mref = at_rowmax(s0, s1);
            }
            if (i == 8) {
                const int lo = tokl + 1 - 4 * h;
                AT_MASK_GE(s0, s1, lo);
            }
            l += at_exp(s0, s1, mref);
            at_pv(buf, s0, s1, o0, o1);
        AT_PASS_END(true)
#undef ROW_
        l += __shfl_xor(l, 32);
        const float sc = g2 / l;
#pragma unroll
        for (int i = 0; i < 16; ++i) { R0[i] += sc * o0[i]; R1[i] += sc * o1[i]; }
    }

    {
        bf16_t* orow = (bf16_t*)(wsb + WS_MIXB) + (size_t)tok * DM + 512 + hq * 64 + 4 * h;
#pragma unroll
        for (int u = 0; u < 4; ++u) {
            u32x2 a, bq;
            a.x = pk_bf16(R0[4 * u], R0[4 * u + 1]);
            a.y = pk_bf16(R0[4 * u + 2], R0[4 * u + 3]);
            bq.x = pk_bf16(R1[4 * u], R1[4 * u + 1]);
            bq.y = pk_bf16(R1[4 * u + 2], R1[4 * u + 3]);
            *(u32x2*)(orow + 8 * u) = a;
            *(u32x2*)(orow + 32 + 8 * u) = bq;
        }
    }
}

__device__ __forceinline__ void moba_item(const Params& p, unsigned char* shm, int b, int hh, int cb) {
    LAS unsigned char* lds = (LAS unsigned char*)shm;
    unsigned char* wsb = (unsigned char*)p.ws;
    const bf16_t* pt = (const bf16_t*)(wsb + WS_PT);
    const int tid = threadIdx.x, lane = tid & 63, w = __builtin_amdgcn_readfirstlane(tid >> 6), r = lane & 31, h = lane >> 5;
    const int tloc = 32 * w + r, t = 256 * cb + tloc, tok = b * SEQ + t;
    const float sl2 = exp2f(-((float)hh + 0.5f)) * LOG2E;
    f32x16 ramp;
#pragma unroll
    for (int i = 0; i < 16; ++i) ramp[i] = sl2 * (float)(CREG(i) + 4 * h);
    bf16x8 qf[4];
    {
        const bf16_t* qrow = pt + ((size_t)(HG_MQ + hh) * NTOK + tok) * 64 + 8 * h;
#pragma unroll
        for (int kk = 0; kk < 4; ++kk) qf[kk] = *(const bf16x8*)(qrow + 16 * kk);
    }
    unsigned selmask = 0u;
    {
        LAS float* kms = (LAS float*)(lds + AT_KMS);
        __syncthreads();
        {
            const f32x4 v = ((const f32x4*)((const float*)(wsb + WS_KMEAN) + (size_t)(b * 8 + hh) * 2048))[tid];
            *(LAS f32x4*)(kms + tid * 4) = v;
        }
        __syncthreads();
        float qv[32];
#pragma unroll
        for (int kk = 0; kk < 4; ++kk) {
            const u32x4 qq = __builtin_bit_cast(u32x4, qf[kk]);
            qv[kk * 8 + 0] = bf_lo(qq.x); qv[kk * 8 + 1] = bf_hi(qq.x);
            qv[kk * 8 + 2] = bf_lo(qq.y); qv[kk * 8 + 3] = bf_hi(qq.y);
            qv[kk * 8 + 4] = bf_lo(qq.z); qv[kk * 8 + 5] = bf_hi(qq.z);
            qv[kk * 8 + 6] = bf_lo(qq.w); qv[kk * 8 + 7] = bf_hi(qq.w);
        }
        float b0 = -INFINITY, b1 = -INFINITY, b2 = -INFINITY;
        int i0 = 0, i1 = 0, i2 = 0;
        for (int n = 0; n < cb; ++n) {
            float s = 0.f;
#pragma unroll
            for (int kk = 0; kk < 4; ++kk) {
                const f32x4 ka = *(LAS const f32x4*)(kms + n * 64 + 16 * kk + 8 * h), kb = *(LAS const f32x4*)(kms + n * 64 + 16 * kk + 8 * h + 4);
                s += qv[kk * 8 + 0] * ka[0] + qv[kk * 8 + 1] * ka[1] + qv[kk * 8 + 2] * ka[2] + qv[kk * 8 + 3] * ka[3];
                s += qv[kk * 8 + 4] * kb[0] + qv[kk * 8 + 5] * kb[1] + qv[kk * 8 + 6] * kb[2] + qv[kk * 8 + 7] * kb[3];
            }
            s += __shfl_xor(s, 32);
            if (s > b0) { b2 = b1; i2 = i1; b1 = b0; i1 = i0; b0 = s; i0 = n; }
            else if (s > b1) { b2 = b1; i2 = i1; b1 = s; i1 = n; }
            else if (s > b2) { b2 = s; i2 = n; }
        }
        if (cb >= 1) selmask |= 1u << i0;
        if (cb >= 2) selmask |= 1u << i1;
        if (cb >= 3) selmask |= 1u << i2;
    }
    const bf16_t* Km = pt + ((size_t)(HG_MK + hh) * NTOK + (size_t)b * SEQ) * 64;
    const bf16_t* Vm = pt + ((size_t)(HG_MV + hh) * NTOK + (size_t)b * SEQ) * 64;
    f32x16 o0, o1;
#pragma unroll
    for (int i = 0; i < 16; ++i) { o0[i] = 0.f; o1[i] = 0.f; }
    float mref = 0.f, l = 0.f;
    const int wt = w >> 1;
#define ROW_(_i) (256 * (cb - ((_i) >> 2)) + 64 * (3 - ((_i) & 3)))
    AT_PASS_BEGIN(Km, Vm, true, 4 * (cb + 1), ROW_)
        const int n = cb - (i >> 2), tt = 3 - (i & 3);
        bool rowsel;
        if (i < 4) { if (tt > wt) break; rowsel = true; }
        else { rowsel = (selmask >> n) & 1u; if (__ballot(rowsel) == 0ull) break; }
        f32x16 s0, s1;
        const float base0 = sl2 * (float)(256 * (n - cb) + 64 * tt), base1 = base0 + sl2 * 32.0f;
        at_scores(buf, qf, ramp, base0, base1, s0, s1);
        if (i < 4 && tt == wt) {
            const int lim = tloc - 64 * tt - 4 * h;
            AT_MASK_LE(s0, s1, lim);
            mref = at_rowmax(s0, s1);
        }
        float ls = at_exp(s0, s1, mref);
        if (!rowsel) {
            ls = 0.f;
#pragma unroll
            for (int q = 0; q < 16; ++q) { s0[q] = 0.f; s1[q] = 0.f; }
        }
        l += ls;
        at_pv(buf, s0, s1, o0, o1);
    AT_PASS_END(true)
#undef ROW_
    l += __shfl_xor(l, 32);
    const float sc = 1.0f / l;
    {
        bf16_t* orow = (bf16_t*)(wsb + WS_MIXB) + (size_t)tok * DM + hh * 64 + 4 * h;
#pragma unroll
        for (int u = 0; u < 4; ++u) {
            u32x2 a, bq;
            a.x = pk_bf16(sc * o0[4 * u], sc * o0[4 * u + 1]);
            a.y = pk_bf16(sc * o0[4 * u + 2], sc * o0[4 * u + 3]);
            bq.x = pk_bf16(sc * o1[4 * u], sc * o1[4 * u + 1]);
            bq.y = pk_bf16(sc * o1[4 * u + 2], sc * o1[4 * u + 3]);
            *(u32x2*)(orow + 8 * u) = a;
            *(u32x2*)(orow + 32 + 8 * u) = bq;
        }
    }
}

template <bool DO_MOBA, bool DO_NSA>
__device__ __forceinline__ void f_attn(const Params& p, unsigned char* shm) {
    const int G = gridDim.x, bx = blockIdx.x;
    for (int s = 0; s * G < 1024; ++s) {
        const int q = s * G + ((s & 1) ? (G - 1 - bx) : bx);
        if (q < 1024) {
            if (DO_NSA) nsa_item(p, shm, (q & 7) >> 1, q & 1, 127 - (q >> 3));
            if (DO_MOBA) moba_item(p, shm, (q & 31) >> 3, q & 7, 31 - (q >> 5));
        }
    }
    __syncthreads();
}

__device__ __forceinline__ void f_prologue(const Params& p, unsigned char* shm) {
    const int tid = threadIdx.x, lane = tid & 63, w = tid >> 6;
    unsigned char* wsb = (unsigned char*)p.ws;
    bf16_t* xn = (bf16_t*)(wsb + WS_XN);
    {
        float4* km = (float4*)(wsb + WS_KMEAN);
        for (int i = blockIdx.x * 512 + tid; i < 16384; i += gridDim.x * 512) km[i] = make_float4(0.f, 0.f, 0.f, 0.f);
    }
    for (int row = blockIdx.x * 8 + w; row < NTOK; row += gridDim.x * 8) {
        const float4* xr = (const float4*)(p.x + (size_t)row * DM);
        float4 v[4];
        float ss = 0.f;
#pragma unroll
        for (int j = 0; j < 4; ++j) { v[j] = xr[lane + 64 * j]; ss += dot4(v[j], v[j]); }
        ss = wave_sum(ss);
        const float r = 1.0f / sqrtf(ss * (1.0f / DM) + 1e-5f);
        const float4* g4 = (const float4*)p.attn_g;
        u32x2* o = (u32x2*)(xn + (size_t)row * DM);
#pragma unroll
        for (int j = 0; j < 4; ++j) {
            const float4 g = g4[lane + 64 * j];
            u32x2 ov;
            ov.x = pk_bf16(v[j].x * r * g.x, v[j].y * r * g.y);
            ov.y = pk_bf16(v[j].z * r * g.z, v[j].w * r * g.w);
            o[lane + 64 * j] = ov;
        }
    }
    float* T = (float*)shm;
    bf16_t* btin = (bf16_t*)(wsb + WS_BTIN);
    for (int it = blockIdx.x; it < 16 * 48; it += gridDim.x)
        convert_item(T, p.w_in, DM, INC, INC, btin, [](int c) { return c; }, (it / 48) * 64, (it % 48) * 64);
    bf16_t* btout = (bf16_t*)(wsb + WS_BTOUT);
    for (int it = blockIdx.x; it < 16 * 16; it += gridDim.x)
        convert_item(T, p.w_out, DM, DM, DM, btout, [](int c) { return c; }, (it >> 4) * 64, (it & 15) * 64);
    bf16_t* btup = (bf16_t*)(wsb + WS_BTUP);
    for (int it = blockIdx.x; it < NE * 16 * 32; it += gridDim.x) {
        const int e = it >> 9, r = it & 511;
        convert_item(T, p.w_up + (size_t)e * DM * DFF2, DM, DFF2, DFF2, btup + (size_t)e * DFF2 * DM,
                     [](int c) { const int a = c >> 1, n = c & 1; return (a >> 4) * 32 + n * 16 + (a & 15); }, (r >> 5) * 64, (r & 31) * 64);
    }
    bf16_t* btdn = (bf16_t*)(wsb + WS_BTDN);
    for (int it = blockIdx.x; it < NE * 16 * 16; it += gridDim.x) {
        const int e = it >> 8, r = it & 255;
        convert_item(T, p.w_down + (size_t)e * DM * DM, DM, DM, DM, btdn + (size_t)e * DM * DM, [](int c) { return c; },
                     (r >> 4) * 64, (r & 15) * 64);
    }
    bf16_t* w1t = (bf16_t*)(wsb + WS_W1T);
    bf16_t* w2t = (bf16_t*)(wsb + WS_W2T);
    for (int it = blockIdx.x; it < 2 * 33; it += gridDim.x) {
        const int kv = it / 33, r = it % 33;
        if (r < 32) convert_item(T, kv ? p.w1v : p.w1k, 2048, 64, 64, w1t + (size_t)kv * 64 * 2048, [](int c) { return c; }, r * 64, 0);
        else        convert_item(T, kv ? p.w2v : p.w2k, 64, 64, 64, w2t + (size_t)kv * 64 * 64, [](int c) { return c; }, 0, 0);
    }
    __syncthreads();
    if (blockIdx.x == gridDim.x - 1) {
        const int o = tid & 127, part = tid >> 7, kv = o >> 6, n = o & 63;
        const float* pe = kv ? p.pe_v : p.pe_k;
        const float* w1 = kv ? p.w1v : p.w1k;
        float s = 0.f;
        for (int ff = part * 512; ff < part * 512 + 512; ++ff) s += pe[ff] * w1[ff * 64 + n];
        T[part * 128 + o] = s;
        __syncthreads();
        if (tid < 128) ((float*)(wsb + WS_C1))[tid] = T[tid] + T[128 + tid] + T[256 + tid] + T[384 + tid];
    }
    __syncthreads();
}

__device__ __forceinline__ void f_cmp(const Params& p, unsigned char* shm) {
    unsigned char* wsb = (unsigned char*)p.ws;
    const bf16_t* pt = (const bf16_t*)(wsb + WS_PT);
    const bf16_t* w1t = (const bf16_t*)(wsb + WS_W1T);
    const bf16_t* w2t = (const bf16_t*)(wsb + WS_W2T);
    const float* c1 = (const float*)(wsb + WS_C1);
    const int tid = threadIdx.x, lane = tid & 63, w = __builtin_amdgcn_readfirstlane(tid >> 6), fr = lane & 15, fq = lane >> 4;
    LAS float* part = (LAS float*)shm;
    LAS unsigned char* h1buf = (LAS unsigned char*)shm + 32768;
    for (int it = blockIdx.x; it < 512; it += gridDim.x) {
        const int rg = it & 31, g = (it >> 5) & 1, b = (it >> 6) & 3, kv = it >> 8;
        const int hg = (kv ? HG_VC : HG_KC) + g;
        const bf16_t* arow = pt + ((size_t)hg * NTOK + (size_t)b * SEQ + 16 * (16 * rg + fr)) * 64 + 8 * fq + 256 * w;
        const bf16_t* brow = w1t + ((size_t)kv * 64 + fr) * 2048 + 8 * fq + 256 * w;
        f32x4 acc[4];
#pragma unroll
        for (int nt = 0; nt < 4; ++nt) acc[nt] = (f32x4){0.f, 0.f, 0.f, 0.f};
#pragma unroll
        for (int kk = 0; kk < 8; ++kk) {
            const bf16x8 a = *(const bf16x8*)(arow + 32 * kk);
#pragma unroll
            for (int nt = 0; nt < 4; ++nt) {
                const bf16x8 bb = *(const bf16x8*)(brow + (size_t)nt * 16 * 2048 + 32 * kk);
                acc[nt] = __builtin_amdgcn_mfma_f32_16x16x32_bf16(a, bb, acc[nt], 0, 0, 0);
            }
        }
        __syncthreads();
#pragma unroll
        for (int nt = 0; nt < 4; ++nt)
#pragma unroll
            for (int reg = 0; reg < 4; ++reg) part[w * 1024 + (4 * fq + reg) * 64 + nt * 16 + fr] = acc[nt][reg];
        __syncthreads();
        {
#pragma unroll
            for (int q = 0; q < 2; ++q) {
                const int o = tid + 512 * q, row = o >> 6, col = o & 63;
                float s = c1[kv * 64 + col];
#pragma unroll
                for (int ww = 0; ww < 8; ++ww) s += part[ww * 1024 + o];
                *(LAS unsigned short*)(h1buf + row * 144 + col * 2) = (unsigned short)(pk_bf16(gelu_tanh(s), 0.f) & 0xffffu);
            }
        }
        __syncthreads();
        if (w == 0) {
            f32x4 acc2[4];
#pragma unroll
            for (int nt = 0; nt < 4; ++nt) acc2[nt] = (f32x4){0.f, 0.f, 0.f, 0.f};
#pragma unroll
            for (int k2 = 0; k2 < 2; ++k2) {
                const bf16x8 a2 = *(LAS const bf16x8*)(h1buf + fr * 144 + (32 * k2 + 8 * fq) * 2);
#pragma unroll
                for (int nt = 0; nt < 4; ++nt) {
                    const bf16x8 b2 = *(const bf16x8*)(w2t + ((size_t)kv * 64 + nt * 16 + fr) * 64 + 32 * k2 + 8 * fq);
                    acc2[nt] = __builtin_amdgcn_mfma_f32_16x16x32_bf16(a2, b2, acc2[nt], 0, 0, 0);
                }
            }
            bf16_t* dst = (bf16_t*)(wsb + (kv ? WS_VCMP : WS_KCMP)) + (size_t)((b * 2 + g) * NCMPP + 16 * rg) * 64;
#pragma unroll
            for (int nt = 0; nt < 4; ++nt)
#pragma unroll
                for (int reg = 0; reg < 4; ++reg)
                    dst[(size_t)(4 * fq + reg) * 64 + nt * 16 + fr] = (bf16_t)(pk_bf16(acc2[nt][reg], 0.f) & 0xffffu);
        }
    }
    __syncthreads();
}

__device__ __forceinline__ void f_inproj(const Params& p, unsigned char* shm) {
    unsigned char* wsb = (unsigned char*)p.ws;
    const bf16_t* xn = (const bf16_t*)(wsb + WS_XN);
    const bf16_t* btin = (const bf16_t*)(wsb + WS_BTIN);
    bf16_t* pt = (bf16_t*)(wsb + WS_PT);
    float* gates = (float*)(wsb + WS_GATES);
    float* kmean = (float*)(wsb + WS_KMEAN);
    const int tid = threadIdx.x, wid = __builtin_amdgcn_readfirstlane(tid >> 6), lane = tid & 63, wr = wid >> 2, wc = wid & 3;
    constexpr int NTN = NIN_PAD / 256;
    for (int it = blockIdx.x; it < (NTOK / 256) * NTN; it += gridDim.x) {
        const int pm = it / NTN, pn = it % NTN;
        f32x4 acc[2][2][4][2];
        gemm256_tile((LAS unsigned char*)shm, (const char*)xn, [&](int r) { return (pm * 256 + r) * (DM * 2); },
                     (const char*)(btin + (size_t)pn * 256 * DM), DM, acc);
        int le = lane;
        asm volatile("" : "+v"(le));
        const int er = le & 15, eq = le >> 4;
        if (pn < 11) {
#pragma unroll
            for (int bj = 0; bj < 2; ++bj) {
                const int hg = pn * 4 + bj * 2 + (wc >> 1);
                const float sc = (hg < 8 || (hg >= 24 && hg < 32)) ? QSCALE : 1.0f;
                bf16_t* base = pt + ((size_t)hg * NTOK + pm * 256 + wr * 64) * 64 + (wc & 1) * 32;
#pragma unroll
                for (int ai = 0; ai < 2; ++ai)
#pragma unroll
                    for (int m = 0; m < 4; ++m)
#pragma unroll
                        for (int n = 0; n < 2; ++n) {
                            const f32x4 a = acc[ai][bj][m][n];
                            u32x2 ov;
                            ov.x = pk_bf16(a[0] * sc, a[1] * sc);
                            ov.y = pk_bf16(a[2] * sc, a[3] * sc);
                            *(u32x2*)(base + (size_t)(ai * 128 + m * 16 + er) * 64 + n * 16 + eq * 4) = ov;
                        }
                if (hg >= HG_MK && hg < HG_MK + 8) {
                    const int b = (pm * 256) / SEQ, nblk = ((pm * 256) % SEQ) >> 8, h = hg - HG_MK;
                    float* kb = kmean + (size_t)((b * 8 + h) * 32 + nblk) * 64 + (wc & 1) * 32;
#pragma unroll
                    for (int n = 0; n < 2; ++n) {
                        f32x4 s = acc[0][bj][0][n];
#pragma unroll
                        for (int m = 1; m < 4; ++m) s += acc[0][bj][m][n];
#pragma unroll
                        for (int m = 0; m < 4; ++m) s += acc[1][bj][m][n];
#pragma unroll
                        for (int o = 1; o < 16; o <<= 1) {
                            s[0] += __shfl_xor(s[0], o);
                            s[1] += __shfl_xor(s[1], o);
                            s[2] += __shfl_xor(s[2], o);
                            s[3] += __shfl_xor(s[3], o);
                        }
                        if (er == 0) {
                            float* d = kb + n * 16 + eq * 4;
                            unsafeAtomicAdd(d + 0, s[0]);
                            unsafeAtomicAdd(d + 1, s[1]);
                            unsafeAtomicAdd(d + 2, s[2]);
                            unsafeAtomicAdd(d + 3, s[3]);
                        }
                    }
                }
            }
        } else if (wc == 0) {
#pragma unroll
            for (int n = 0; n < 2; ++n) {
                const int gc = n * 16 + eq * 4;
                if (gc < 24) {
#pragma unroll
                    for (int ai = 0; ai < 2; ++ai)
#pragma unroll
                        for (int m = 0; m < 4; ++m) {
                            const f32x4 a = acc[ai][0][m][n];
                            const int row = pm * 256 + ai * 128 + wr * 64 + m * 16 + er;
                            f32x4 sg;
                            sg[0] = 1.0f / (1.0f + __expf(-a[0]));
                            sg[1] = 1.0f / (1.0f + __expf(-a[1]));
                            sg[2] = 1.0f / (1.0f + __expf(-a[2]));
                            sg[3] = 1.0f / (1.0f + __expf(-a[3]));
                            *(f32x4*)(gates + (size_t)row * 24 + gc) = sg;
                        }
                }
            }
        }
    }
    __syncthreads();
}

__device__ __forceinline__ void f_outproj(const Params& p, unsigned char* shm) {
    unsigned char* wsb = (unsigned char*)p.ws;
    const bf16_t* mixb = (const bf16_t*)(wsb + WS_MIXB);
    const bf16_t* btout = (const bf16_t*)(wsb + WS_BTOUT);
    const int tid = threadIdx.x, wid = __builtin_amdgcn_readfirstlane(tid >> 6), lane = tid & 63, wr = wid >> 2, wc = wid & 3;
    for (int it = blockIdx.x; it < (NTOK / 256) * 4; it += gridDim.x) {
        const int pm = it >> 2, pn = it & 3;
        f32x4 acc[2][2][4][2];
        gemm256_tile((LAS unsigned char*)shm, (const char*)mixb, [&](int r) { return (pm * 256 + r) * (DM * 2); },
                     (const char*)(btout + (size_t)pn * 256 * DM), DM, acc);
        int le = lane;
        asm volatile("" : "+v"(le));
        const int er = le & 15, eq = le >> 4;
#pragma unroll
        for (int ai = 0; ai < 2; ++ai)
#pragma unroll
            for (int m = 0; m < 4; ++m) {
                const size_t rowoff = (size_t)(pm * 256 + ai * 128 + wr * 64 + m * 16 + er) * DM;
#pragma unroll
                for (int bj = 0; bj < 2; ++bj)
#pragma unroll
                    for (int n = 0; n < 2; ++n) {
                        const size_t o = rowoff + pn * 256 + bj * 128 + wc * 32 + n * 16 + eq * 4;
                        const f32x4 xv = *(const f32x4*)(p.x + o);
                        *(f32x4*)(p.out + o) = xv + acc[ai][bj][m][n];
                    }
            }
    }
    __syncthreads();
}

__device__ __forceinline__ void f_router(const Params& p, unsigned char* shm) {
    const int tid = threadIdx.x, lane = tid & 63, w = tid >> 6;
    unsigned char* wsb = (unsigned char*)p.ws;
    float* Wl = (float*)shm;
    int* hist = (int*)(shm + 147456);
    bf16_t* hb = (bf16_t*)(wsb + WS_H);
    int* sele = (int*)(wsb + WS_SELE);
    float* selw = (float*)(wsb + WS_SELW);
    int* selr = (int*)(wsb + WS_SELR);
    int* bcnt = (int*)(wsb + WS_BCNT);
    __syncthreads();
    for (int idx = tid; idx < 8192; idx += 512) {
        const int k = idx >> 3, e4 = idx & 7;
        const float4 v = ((const float4*)p.w_router)[idx];
        const int rho = ((k >> 8) * 4 + (k & 3)) * 64 + ((k >> 2) & 63);
        *(float4*)(Wl + rho * 36 + e4 * 4) = v;
    }
    for (int c = blockIdx.x; c < NTOK / 128; c += gridDim.x) {
        __syncthreads();
        if (tid < 32) hist[tid] = 0;
        __syncthreads();
        for (int rr = 0; rr < 16; ++rr) {
            const int row = c * 128 + w * 16 + rr;
            const float4* xr = (const float4*)(p.out + (size_t)row * DM);
            float4 v[4];
            float ss = 0.f;
#pragma unroll
            for (int j = 0; j < 4; ++j) { v[j] = xr[lane + 64 * j]; ss += dot4(v[j], v[j]); }
            ss = wave_sum(ss);
            const float r = 1.0f / sqrtf(ss * (1.0f / DM) + 1e-5f);
            const float4* g4 = (const float4*)p.ffn_g;
            u32x2* o = (u32x2*)(hb + (size_t)row * DM);
#pragma unroll
            for (int j = 0; j < 4; ++j) {
                const float4 g = g4[lane + 64 * j];
                v[j] = make_float4(v[j].x * r * g.x, v[j].y * r * g.y, v[j].z * r * g.z, v[j].w * r * g.w);
                u32x2 ov;
                ov.x = pk_bf16(v[j].x, v[j].y);
                ov.y = pk_bf16(v[j].z, v[j].w);
                o[lane + 64 * j] = ov;
            }
            float lg[32];
#pragma unroll
            for (int e = 0; e < 32; ++e) lg[e] = 0.f;
#pragma unroll
            for (int j = 0; j < 4; ++j) {
                const float hv[4] = {v[j].x, v[j].y, v[j].z, v[j].w};
#pragma unroll
                for (int cc = 0; cc < 4; ++cc) {
                    const float4* wr = (const float4*)(Wl + ((j * 4 + cc) * 64 + lane) * 36);
#pragma unroll
                    for (int e4 = 0; e4 < 8; ++e4) {
                        const float4 wv = wr[e4];
                        lg[e4 * 4 + 0] += hv[cc] * wv.x;
                        lg[e4 * 4 + 1] += hv[cc] * wv.y;
                        lg[e4 * 4 + 2] += hv[cc] * wv.z;
                        lg[e4 * 4 + 3] += hv[cc] * wv.w;
                    }
                }
            }
#pragma unroll
            for (int e = 0; e < 32; ++e) lg[e] = wave_sum(lg[e]) + p.b_router[e];
            float tv[4];
            int ti[4];
#pragma unroll
            for (int s = 0; s < 4; ++s) {
                float best = -INFINITY;
                int bi = 0;
#pragma unroll
                for (int e = 0; e < 32; ++e)
                    if (lg[e] > best) { best = lg[e]; bi = e; }
                tv[s] = best;
                ti[s] = bi;
#pragma unroll
                for (int e = 0; e < 32; ++e)
                    if (e == bi) lg[e] = -INFINITY;
            }
            const float e1 = __expf(tv[1] - tv[0]), e2 = __expf(tv[2] - tv[0]), e3 = __expf(tv[3] - tv[0]);
            const float inv = 1.0f / (1.0f + e1 + e2 + e3);
            if (lane == 0) {
                const float wv[4] = {inv, e1 * inv, e2 * inv, e3 * inv};
#pragma unroll
                for (int s = 0; s < 4; ++s) {
                    sele[row * 4 + s] = ti[s];
                    selw[row * 4 + s] = wv[s];
                    selr[row * 4 + s] = atomicAdd(&hist[ti[s]], 1);
                }
            }
        }
        __syncthreads();
        if (tid < 32) bcnt[c * 32 + tid] = hist[tid];
    }
    __syncthreads();
}

__device__ __forceinline__ void f_fill(const Params& p, unsigned char* shm) {
    const int tid = threadIdx.x;
    unsigned char* wsb = (unsigned char*)p.ws;
    const int* sele = (const int*)(wsb + WS_SELE);
    const float* selw = (const float*)(wsb + WS_SELW);
    const int* selr = (const int*)(wsb + WS_SELR);
    int* selp = (int*)(wsb + WS_SELP);
    const int* bcnt = (const int*)(wsb + WS_BCNT);
    int* gcnt = (int*)(wsb + WS_GCNT);
    int* rtok = (int*)(wsb + WS_RTOK);
    float* rw = (float*)(wsb + WS_RW);
    int* pa = (int*)shm;
    int* pb = pa + 512;
    int* tot = pb + 512;
    int* base = tot + 32;
    int* pstart = base + 32;
    for (int c = blockIdx.x; c < NTOK / 128; c += gridDim.x) {
        __syncthreads();
        {
            const int e = tid & 31, part = tid >> 5;
            int sa = 0, sb = 0;
            for (int cc = part * 16; cc < part * 16 + 16; ++cc) {
                const int v = bcnt[cc * 32 + e];
                sa += v;
                sb += (cc < c) ? v : 0;
            }
            pa[part * 32 + e] = sa;
            pb[part * 32 + e] = sb;
        }
        __syncthreads();
        if (tid < 32) {
            int sa = 0, sb = 0;
            for (int q = 0; q < 16; ++q) { sa += pa[q * 32 + tid]; sb += pb[q * 32 + tid]; }
            tot[tid] = sa;
            base[tid] = sb;
        }
        __syncthreads();
        if (tid == 0) {
            int a = 0;
            for (int e = 0; e < NE; ++e) { pstart[e] = a; a += ((tot[e] + 255) >> 8) << 8; }
            pstart[NE] = a;
        }
        __syncthreads();
        {
            const int i = c * 512 + tid;
            const int e = sele[i];
            const int pos = pstart[e] + base[e] + selr[i];
            rtok[pos] = i >> 2;
            rw[pos] = selw[i];
            selp[i] = pos;
        }
        if (c == 0) {
            if (tid < 32) gcnt[tid] = tot[tid];
            for (int e = 0; e < NE; ++e) {
                const int r0 = pstart[e] + tot[e], r1 = pstart[e + 1];
                for (int r = r0 + tid; r < r1; r += 512) { rtok[r] = 0; rw[r] = 0.f; }
            }
        }
    }
    __syncthreads();
}

__device__ __forceinline__ void f_build_tiles(const Params& p, int* tb) {
    const int* gcnt = (const int*)((unsigned char*)p.ws + WS_GCNT);
    __syncthreads();
    if (threadIdx.x == 0) {
        int a = 0, t = 0;
        for (int e = 0; e < NE; ++e) {
            tb[e] = a;
            tb[40 + e] = t;
            const int nt = (gcnt[e] + 255) >> 8;
            a += nt << 8;
            t += nt;
        }
        tb[32] = a;
        tb[40 + 32] = t;
    }
    __syncthreads();
}

__device__ __forceinline__ void f_up(const Params& p, unsigned char* shm) {
    unsigned char* wsb = (unsigned char*)p.ws;
    int* tb = (int*)(shm + GEMM_LDS_BYTES);
    f_build_tiles(p, tb);
    const int T = tb[40 + 32];
    const bf16_t* hb = (const bf16_t*)(wsb + WS_H);
    const bf16_t* btup = (const bf16_t*)(wsb + WS_BTUP);
    bf16_t* act = (bf16_t*)(wsb + WS_ACT);
    const int* rtok = (const int*)(wsb + WS_RTOK);
    const int tid = threadIdx.x, wid = __builtin_amdgcn_readfirstlane(tid >> 6), lane = tid & 63, wr = wid >> 2, wc = wid & 3;
    for (int it = blockIdx.x; it < T * 8; it += gridDim.x) {
        const int vt = it >> 3, pn = it & 7;
        int e = 0;
        while (tb[40 + e + 1] <= vt) ++e;
        const int rowbase = tb[e] + (vt - tb[40 + e]) * 256;
        f32x4 acc[2][2][4][2];
        gemm256_tile((LAS unsigned char*)shm, (const char*)hb, [&](int r) { return rtok[rowbase + r] * (DM * 2); },
                     (const char*)(btup + ((size_t)e * DFF2 + pn * 256) * DM), DM, acc);
        int le = lane;
        asm volatile("" : "+v"(le));
        const int er = le & 15, eq = le >> 4;
        const float* bias = p.b_up + (size_t)e * DFF2;
#pragma unroll
        for (int bj = 0; bj < 2; ++bj) {
            const int a0 = (pn * 8 + bj * 4 + wc) * 16 + eq * 4;
            const float4 blo = *(const float4*)(bias + 2 * a0), bhi = *(const float4*)(bias + 2 * a0 + 4);
#pragma unroll
            for (int ai = 0; ai < 2; ++ai)
#pragma unroll
                for (int m = 0; m < 4; ++m) {
                    const int row = rowbase + ai * 128 + wr * 64 + m * 16 + er;
                    const f32x4 g = acc[ai][bj][m][0], u = acc[ai][bj][m][1];
                    u32x2 ov;
                    ov.x = pk_bf16(swiglu(g[0] + blo.x, u[0] + blo.y), swiglu(g[1] + blo.z, u[1] + blo.w));
                    ov.y = pk_bf16(swiglu(g[2] + bhi.x, u[2] + bhi.y), swiglu(g[3] + bhi.z, u[3] + bhi.w));
                    *(u32x2*)(act + (size_t)row * DM + a0) = ov;
                }
        }
    }
    __syncthreads();
}

__device__ __forceinline__ void f_down(const Params& p, unsigned char* shm) {
    unsigned char* wsb = (unsigned char*)p.ws;
    int* tb = (int*)(shm + GEMM_LDS_BYTES);
    f_build_tiles(p, tb);
    const int T = tb[40 + 32];
    const bf16_t* act = (const bf16_t*)(wsb + WS_ACT);
    const bf16_t* btdn = (const bf16_t*)(wsb + WS_BTDN);
    bf16_t* yb = (bf16_t*)(wsb + WS_Y);
    const float* rw = (const float*)(wsb + WS_RW);
    const int tid = threadIdx.x, wid = __builtin_amdgcn_readfirstlane(tid >> 6), lane = tid & 63, wr = wid >> 2, wc = wid & 3;
    for (int it = blockIdx.x; it < T * 4; it += gridDim.x) {
        const int vt = it >> 2, pn = it & 3;
        int e = 0;
        while (tb[40 + e + 1] <= vt) ++e;
        const int rowbase = tb[e] + (vt - tb[40 + e]) * 256;
        f32x4 acc[2][2][4][2];
        gemm256_tile((LAS unsigned char*)shm, (const char*)(act + (size_t)rowbase * DM), [&](int r) { return r * (DM * 2); },
                     (const char*)(btdn + ((size_t)e * DM + pn * 256) * DM), DM, acc);
        int le = lane;
        asm volatile("" : "+v"(le));
        const int er = le & 15, eq = le >> 4;
        const float* bias = p.b_down + (size_t)e * DM;
#pragma unroll
        for (int ai = 0; ai < 2; ++ai)
#pragma unroll
            for (int m = 0; m < 4; ++m) {
                const int row = rowbase + ai * 128 + wr * 64 + m * 16 + er;
                const float wgt = rw[row];
#pragma unroll
                for (int bj = 0; bj < 2; ++bj)
#pragma unroll
                    for (int n = 0; n < 2; ++n) {
                        const int col = pn * 256 + bj * 128 + wc * 32 + n * 16 + eq * 4;
                        const float4 bv = *(const float4*)(bias + col);
                        const f32x4 a = acc[ai][bj][m][n];
                        u32x2 ov;
                        ov.x = pk_bf16((a[0] + bv.x) * wgt, (a[1] + bv.y) * wgt);
                        ov.y = pk_bf16((a[2] + bv.z) * wgt, (a[3] + bv.w) * wgt);
                        *(u32x2*)(yb + (size_t)row * DM + col) = ov;
                    }
            }
    }
    __syncthreads();
}


__device__ __forceinline__ void f_final(const Params& p) {
    const int lane = threadIdx.x & 63, w = threadIdx.x >> 6;
    unsigned char* wsb = (unsigned char*)p.ws;
    const bf16_t* yb = (const bf16_t*)(wsb + WS_Y);
    const int* selp = (const int*)(wsb + WS_SELP);
    for (int row = blockIdx.x * 8 + w; row < NTOK; row += gridDim.x * 8) {
        float4* xr = (float4*)(p.out + (size_t)row * DM);
        float4 v[4];
#pragma unroll
        for (int j = 0; j < 4; ++j) v[j] = xr[lane + 64 * j];
#pragma unroll
        for (int k = 0; k < 4; ++k) {
            const u32x2* yr = (const u32x2*)(yb + (size_t)selp[row * 4 + k] * DM);
#pragma unroll
            for (int j = 0; j < 4; ++j) {
                const u32x2 yv = yr[lane + 64 * j];
                v[j].x += bf_lo(yv.x);
                v[j].y += bf_hi(yv.x);
                v[j].z += bf_lo(yv.y);
                v[j].w += bf_hi(yv.y);
            }
        }
        float ss = 0.f;
#pragma unroll
        for (int j = 0; j < 4; ++j) ss += dot4(v[j], v[j]);
        ss = wave_sum(ss);
        const float r = 1.0f / sqrtf(ss * (1.0f / DM) + 1e-5f);
        const float4* g4 = (const float4*)p.final_g;
#pragma unroll
        for (int j = 0; j < 4; ++j) {
            const float4 g = g4[lane + 64 * j];
            xr[lane + 64 * j] = make_float4(v[j].x * r * g.x, v[j].y * r * g.y, v[j].z * r * g.z, v[j].w * r * g.w);
        }
    }
}

constexpr int NFPHASE = 10;
__global__ void __launch_bounds__(512) fast_kernel(Params p) {
    extern __shared__ __attribute__((aligned(16))) unsigned char shm[];
    cg::grid_group grid = cg::this_grid();
    const int lo = p.ph_lo, hi = p.ph_hi;
#define F_IN(k) (lo <= (k) && (k) < hi)
#define F_SYNC(k) do { if (F_IN(k) && F_IN((k) + 1)) grid.sync(); } while (0)
    if (F_IN(0)) f_prologue(p, shm);
    F_SYNC(0);
    if (F_IN(1)) f_inproj(p, shm);
    F_SYNC(1);
    if (F_IN(2)) f_cmp(p, shm);
    F_SYNC(2);
    if (F_IN(3)) f_attn<true, true>(p, shm);
    F_SYNC(3);
    if (F_IN(4)) f_outproj(p, shm);
    F_SYNC(4);
    if (F_IN(5)) f_router(p, shm);
    F_SYNC(5);
    if (F_IN(6)) f_fill(p, shm);
    F_SYNC(6);
    if (F_IN(7)) f_up(p, shm);
    F_SYNC(7);
    if (F_IN(8)) f_down(p, shm);
    F_SYNC(8);
    if (F_IN(9)) f_final(p);
}

#ifndef MULTI_LAUNCH
#define MULTI_LAUNCH 0
#endif

extern "C" void kernel_launch(void* const* d_in, const int* in_sizes, int n_in, void* d_out, int out_size, void* d_ws,
                              size_t ws_size, hipStream_t stream) {
    static int grid = 0;
    if (!grid) {
        int dev = 0, cus = 0, per_cu = 0;
        (void)hipGetDevice(&dev);
        (void)hipDeviceGetAttribute(&cus, hipDeviceAttributeMultiprocessorCount, dev);
        (void)hipFuncSetAttribute((const void*)fast_kernel, hipFuncAttributeMaxDynamicSharedMemorySize, FAST_LDS_BYTES);
        (void)hipOccupancyMaxActiveBlocksPerMultiprocessor(&per_cu, fast_kernel, 512, FAST_LDS_BYTES);
        if (per_cu < 1) fprintf(stderr, "kernel_launch: occupancy query reports %d blocks per CU\n", per_cu);
        grid = cus;
        if (ws_size < WS_END) fprintf(stderr, "kernel_launch: workspace too small: %zu < %zu\n", ws_size, (size_t)WS_END);
    }
    Params p{};
    p.x = (const float*)d_in[0];
    p.attn_g = (const float*)d_in[1];
    p.w_in = (const float*)d_in[2];
    p.pe_k = (const float*)d_in[3];
    p.pe_v = (const float*)d_in[4];
    p.w1k = (const float*)d_in[5];
    p.w2k = (const float*)d_in[6];
    p.w1v = (const float*)d_in[7];
    p.w2v = (const float*)d_in[8];
    p.w_out = (const float*)d_in[9];
    p.ffn_g = (const float*)d_in[10];
    p.w_router = (const float*)d_in[11];
    p.b_router = (const float*)d_in[12];
    p.w_up = (const float*)d_in[13];
    p.b_up = (const float*)d_in[14];
    p.w_down = (const float*)d_in[15];
    p.b_down = (const float*)d_in[16];
    p.final_g = (const float*)d_in[17];
    p.out = (float*)d_out;
    p.ws = (float*)d_ws;
#if MULTI_LAUNCH
    for (int ph = 0; ph < NFPHASE; ++ph) {
        p.ph_lo = ph;
        p.ph_hi = ph + 1;
        hipLaunchKernelGGL(fast_kernel, dim3(grid), dim3(512), FAST_LDS_BYTES, stream, p);
    }
#else
    p.ph_lo = 0;
    p.ph_hi = NFPHASE;
    void* args[] = {&p};
    hipError_t e = hipLaunchCooperativeKernel((void*)fast_kernel, dim3(grid), dim3(512), args, FAST_LDS_BYTES, stream);
    if (e != hipSuccess) fprintf(stderr, "cooperative launch failed: %s (grid %d)\n", hipGetErrorString(e), grid);
#endif
}
```

```cpp
#include <hip/hip_runtime.h>
#include <hip/hip_cooperative_groups.h>
#include <cstdio>
#include <cstdint>
namespace cg = cooperative_groups;

constexpr int NB = 4, SEQ = 8192, DM = 1024, NTOK = NB * SEQ;
constexpr int INC = 2840;
constexpr int NCMP = 511, NCMPP = 512;
constexpr int NE = 32, TOPK = 4, NK = NTOK * TOPK;
constexpr int DFF2 = 2048;
constexpr int NIN_PAD = 3072;
constexpr int PMAX = 139264;
constexpr float LOG2E = 1.4426950408889634f;
constexpr float QSCALE = 0.125f * LOG2E;
constexpr int HG_MQ = 0, HG_MK = 8, HG_MV = 16, HG_NQ = 24, HG_KC = 32, HG_VC = 34, HG_KS = 36, HG_VS = 38, HG_KW = 40,
              HG_VW = 42, NHG = 44;

constexpr size_t WS_BTUP  = 0;
constexpr size_t WS_BTDN  = WS_BTUP + (size_t)NE * DFF2 * DM * 2;
constexpr size_t WS_BTOUT = WS_BTDN + (size_t)NE * DM * DM * 2;
constexpr size_t WS_BTIN  = WS_BTOUT + (size_t)DM * DM * 2;
constexpr size_t WS_XN    = WS_BTIN + (size_t)NIN_PAD * DM * 2;
constexpr size_t WS_H     = WS_XN;
constexpr size_t WS_PT    = WS_XN + (size_t)NTOK * DM * 2;
constexpr size_t WS_GATES = WS_PT + (size_t)NHG * NTOK * 64 * 2;
constexpr size_t WS_KMEAN = WS_GATES + (size_t)NTOK * 24 * 4;
constexpr size_t WS_KCMP  = WS_KMEAN + 65536 * 4;
constexpr size_t WS_VCMP  = WS_KCMP + 262144 * 2;
constexpr size_t WS_MIXB  = WS_VCMP + 262144 * 2;
constexpr size_t WS_ACT   = WS_PT;
constexpr size_t WS_Y     = WS_ACT + (size_t)PMAX * DM * 2;
static_assert(WS_MIXB + (size_t)NTOK * DM * 2 <= WS_Y, "act overlay");
constexpr size_t WS_PART  = WS_Y;
constexpr size_t WS_MLIST = WS_PART + (size_t)NTOK * 8 * 544;
constexpr size_t WS_MCNT  = WS_MLIST + (size_t)1024 * 8192 * 2;
static_assert(WS_MCNT + 4096 <= WS_Y + (size_t)PMAX * DM * 2, "MoBA scratch overlays y");
constexpr size_t WS_SELE  = WS_Y + (size_t)PMAX * DM * 2;
constexpr size_t WS_SELW  = WS_SELE + (size_t)NK * 4;
constexpr size_t WS_SELR  = WS_SELW + (size_t)NK * 4;
constexpr size_t WS_SELP  = WS_SELR + (size_t)NK * 4;
constexpr size_t WS_BCNT  = WS_SELP + (size_t)NK * 4;
constexpr size_t WS_GCNT  = WS_BCNT + 256 * 32 * 4;
constexpr size_t WS_RTOK  = WS_GCNT + 256;
constexpr size_t WS_RW    = WS_RTOK + (size_t)PMAX * 4;
constexpr size_t WS_C1    = WS_RW + (size_t)PMAX * 4;
constexpr size_t WS_W1T   = WS_C1 + 512;
constexpr size_t WS_W2T   = WS_W1T + 2 * 64 * 2048 * 2;
constexpr size_t WS_BAR   = WS_W2T + 2 * 64 * 64 * 2;
constexpr size_t WS_END   = WS_BAR + 16384;

struct Params {
    const float *x, *attn_g, *w_in, *pe_k, *pe_v, *w1k, *w2k, *w1v, *w2v, *w_out, *ffn_g, *w_router, *b_router,
        *w_up, *b_up, *w_down, *b_down, *final_g;
    float* out;
    float* ws;
    int ph_lo, ph_hi;
};

typedef unsigned short bf16_t;
typedef short bf16x8 __attribute__((ext_vector_type(8)));
typedef float f32x4 __attribute__((ext_vector_type(4)));
typedef float f32x16 __attribute__((ext_vector_type(16)));
typedef unsigned u32x4 __attribute__((ext_vector_type(4)));
typedef unsigned u32x2 __attribute__((ext_vector_type(2)));

typedef float f32x2 __attribute__((ext_vector_type(2)));
typedef __bf16 bf16x2v __attribute__((ext_vector_type(2)));
__device__ __forceinline__ unsigned pk_bf16(float lo, float hi) {
    const f32x2 f = {lo, hi};
    return __builtin_bit_cast(unsigned, __builtin_convertvector(f, bf16x2v));
}
__device__ __forceinline__ float bf_lo(unsigned u) { return __uint_as_float(u << 16); }
__device__ __forceinline__ float bf_hi(unsigned u) { return __uint_as_float(u & 0xffff0000u); }
__device__ __forceinline__ float bf2f(bf16_t b) { return __uint_as_float((unsigned)b << 16); }

__device__ __forceinline__ float wave_sum(float v) {
#pragma unroll
    for (int o = 32; o > 0; o >>= 1) v += __shfl_xor(v, o);
    return v;
}
__device__ __forceinline__ float wave_max(float v) {
#pragma unroll
    for (int o = 32; o > 0; o >>= 1) v = fmaxf(v, __shfl_xor(v, o));
    return v;
}
__device__ __forceinline__ int wave_min_i(int v) {
#pragma unroll
    for (int o = 32; o > 0; o >>= 1) v = min(v, __shfl_xor(v, o));
    return v;
}
__device__ __forceinline__ float dot4(float4 a, float4 b) { return a.x * b.x + a.y * b.y + a.z * b.z + a.w * b.w; }

__device__ __forceinline__ float gelu_tanh(float x) {
    return 0.5f * x * (1.0f + tanhf(0.7978845608028654f * (x + 0.044715f * x * x * x)));
}
__device__ __forceinline__ float swiglu(float g, float u) {
    g = fminf(g, 7.0f);
    u = fminf(fmaxf(u, -7.0f), 7.0f);
    return g * (1.0f / (1.0f + __expf(-1.702f * g))) * (u + 1.0f);
}


constexpr int G_BM = 256, G_BK = 64, G_HALF = 128, G_HT = G_HALF * G_BK;
constexpr int GEMM_LDS_BYTES = 8 * G_HT * 2;
constexpr int FAST_LDS_BYTES = 155648;
__device__ __forceinline__ int lds_byte(int r, int c) {
    const int st = (r >> 4) * 2 + (c >> 5), rr = r & 15, cc = c & 31, ob = rr * 64 + cc * 2;
    return st * 1024 + (ob ^ (((ob >> 9) & 1) << 5));
}
__device__ __forceinline__ void stage_rc(int b, int& R, int& C) {
    const int st = b / 1024, sb = b % 1024, swz = sb ^ (((sb >> 9) & 1) << 5);
    R = (st >> 1) * 16 + swz / 64;
    C = (st & 1) * 32 + (swz % 64) / 2;
}

#define LAS __attribute__((address_space(3)))
template <class ARow>
__device__ __forceinline__ void gemm256_tile(LAS unsigned char* lds, const char* __restrict__ Abase, ARow arow,
                                             const char* __restrict__ Bbase, int K, f32x4 (&acc)[2][2][4][2]) {
    constexpr int HTB = G_HT * 2;
#define SA(b, h) (((b) * 2 + (h)) * HTB)
#define SB(b, h) ((4 + (b) * 2 + (h)) * HTB)
#define STAGE_A(b, h, kt)                                                                                              \
    do {                                                                                                               \
        _Pragma("unroll") for (int _i = 0; _i < 2; ++_i) __builtin_amdgcn_global_load_lds(                              \
            (const unsigned*)(Abase + (size_t)(kt) * (G_BK * 2) + voffA[h][_i]),                                       \
            (LAS unsigned*)(lds + SA(b, h) + ldsw + _i * 8192), 16, 0, 0);                                              \
    } while (0)
#define STAGE_B(b, h, kt)                                                                                              \
    do {                                                                                                               \
        _Pragma("unroll") for (int _i = 0; _i < 2; ++_i) __builtin_amdgcn_global_load_lds(                              \
            (const unsigned*)(Bbase + (size_t)(h) * hstep + (size_t)(kt) * (G_BK * 2) + voffB[_i]),                    \
            (LAS unsigned*)(lds + SB(b, h) + ldsw + _i * 8192), 16, 0, 0);                                              \
    } while (0)
#define LDA(dst, b, h)                                                                                                 \
    do {                                                                                                               \
        _Pragma("unroll") for (int m = 0; m < 4; ++m) _Pragma("unroll") for (int k = 0; k < 2; ++k) dst[m][k] =         \
            *(const LAS bf16x8*)(lds + SA(b, h) + aoff + m * 2048 + k * 1024);                                          \
    } while (0)
#define LDB(dst, b, h)                                                                                                 \
    do {                                                                                                               \
        _Pragma("unroll") for (int n = 0; n < 2; ++n) _Pragma("unroll") for (int k = 0; k < 2; ++k) dst[n][k] =         \
            *(const LAS bf16x8*)(lds + SB(b, h) + boff + n * 2048 + k * 1024);                                          \
    } while (0)
#define MMA(ai, bj, Af, Bf)                                                                                            \
    do {                                                                                                               \
        __builtin_amdgcn_s_setprio(1);                                                                                 \
        _Pragma("unroll") for (int m = 0; m < 4; ++m) _Pragma("unroll") for (int n = 0; n < 2; ++n)                     \
            _Pragma("unroll") for (int k = 0; k < 2; ++k) acc[ai][bj][m][n] =                                           \
                __builtin_amdgcn_mfma_f32_16x16x32_bf16(Bf[n][k], Af[m][k], acc[ai][bj][m][n], 0, 0, 0);               \
        __builtin_amdgcn_s_setprio(0);                                                                                 \
    } while (0)
#define WAIT_V(n) asm volatile("s_waitcnt vmcnt(" #n ")" ::: "memory")
#define WAIT_L(n) asm volatile("s_waitcnt lgkmcnt(" #n ")" ::: "memory")
#define BAR __builtin_amdgcn_s_barrier()
#define SCHED __builtin_amdgcn_sched_barrier(0)
    const int tid = threadIdx.x, wid = __builtin_amdgcn_readfirstlane(tid >> 6), lane = tid & 63, wr = wid >> 2, wc = wid & 3,
              fr = lane & 15, fq = lane >> 4;
    unsigned voffA[2][2], voffB[2];
#pragma unroll
    for (int i = 0; i < 2; ++i) {
        int R, C;
        stage_rc(tid * 16 + i * 8192, R, C);
        voffB[i] = (unsigned)(R * K + C) * 2u;
#pragma unroll
        for (int h = 0; h < 2; ++h) voffA[h][i] = (unsigned)arow(h * G_HALF + R) + (unsigned)C * 2u;
    }
    const size_t hstep = (size_t)G_HALF * K * 2;
    const unsigned ldsw = (unsigned)wid * 1024u;
    const int aoff = lds_byte(wr * 64 + fr, fq * 8), boff = lds_byte(wc * 32 + fr, fq * 8);
#pragma unroll
    for (int ai = 0; ai < 2; ++ai)
#pragma unroll
        for (int bj = 0; bj < 2; ++bj)
#pragma unroll
            for (int m = 0; m < 4; ++m)
#pragma unroll
                for (int n = 0; n < 2; ++n) acc[ai][bj][m][n] = (f32x4){0.f, 0.f, 0.f, 0.f};
    bf16x8 At[4][2], B0[2][2], B1[2][2];
    const int nt = K / G_BK;
    STAGE_B(0, 0, 0); STAGE_A(0, 0, 0);
    STAGE_B(0, 1, 0); STAGE_A(0, 1, 0);
    if (wr == 1) BAR;
    WAIT_V(4); BAR;
    STAGE_B(1, 0, 1); STAGE_A(1, 0, 1); STAGE_B(1, 1, 1);
    WAIT_V(6); BAR;
    for (int t = 0; t < nt - 2; t += 2) {
        LDB(B0, 0, 0); SCHED; LDA(At, 0, 0); STAGE_A(1, 1, t + 1);
        WAIT_L(8); BAR; WAIT_L(0); MMA(0, 0, At, B0); BAR; SCHED;
        LDB(B1, 0, 1); STAGE_B(0, 0, t + 2);
        BAR; WAIT_L(0); MMA(0, 1, At, B1); BAR;
        LDA(At, 0, 1); STAGE_A(0, 0, t + 2);
        BAR; WAIT_L(0); MMA(1, 0, At, B0); BAR; SCHED;
        STAGE_B(0, 1, t + 2);
        WAIT_V(6); BAR; MMA(1, 1, At, B1); BAR;
        LDB(B0, 1, 0); SCHED; LDA(At, 1, 0); STAGE_A(0, 1, t + 2);
        WAIT_L(8); BAR; WAIT_L(0); MMA(0, 0, At, B0); BAR; SCHED;
        LDB(B1, 1, 1); STAGE_B(1, 0, t + 3);
        BAR; WAIT_L(0); MMA(0, 1, At, B1); BAR;
        LDA(At, 1, 1); STAGE_A(1, 0, t + 3);
        BAR; WAIT_L(0); MMA(1, 0, At, B0); BAR; SCHED;
        STAGE_B(1, 1, t + 3);
        WAIT_V(6); BAR; MMA(1, 1, At, B1); BAR;
    }
    {
        LDB(B0, 0, 0); LDA(At, 0, 0); STAGE_A(1, 1, nt - 1);
        BAR; WAIT_L(0); MMA(0, 0, At, B0); BAR;
        LDB(B1, 0, 1); BAR; WAIT_L(0); MMA(0, 1, At, B1); BAR;
        LDA(At, 0, 1); WAIT_V(4); BAR; WAIT_L(0); MMA(1, 0, At, B0); MMA(1, 1, At, B1); BAR;
    }
    {
        LDB(B0, 1, 0); LDA(At, 1, 0); WAIT_V(2); BAR; WAIT_L(0); MMA(0, 0, At, B0); BAR;
        LDB(B1, 1, 1); WAIT_V(0); BAR; WAIT_L(0); MMA(0, 1, At, B1); BAR;
        LDA(At, 1, 1); BAR; WAIT_L(0); MMA(1, 0, At, B0); MMA(1, 1, At, B1); BAR;
    }
    if (wr == 0) BAR;
#undef SA
#undef SB
#undef STAGE_A
#undef STAGE_B
#undef LDA
#undef LDB
#undef MMA
}

struct GPiece { int R[2], C[2]; };
template <class UnitFn, class Epi>
__device__ __forceinline__ void gemm256_stream(LAS unsigned char* lds, UnitFn unit, Epi epi) {
    constexpr int K = 1024, nt = K / G_BK;
    constexpr int HTB = G_HT * 2;
#define SA(b, h) (((b) * 2 + (h)) * HTB)
#define SB(b, h) ((4 + (b) * 2 + (h)) * HTB)
#define STG(bufoff, gbase, voff)                                                                                       \
    do {                                                                                                               \
        _Pragma("unroll") for (int _i = 0; _i < 2; ++_i) __builtin_amdgcn_global_load_lds(                              \
            (const unsigned*)((gbase) + (voff)[_i]), (LAS unsigned*)(lds + (bufoff) + ldsw + _i * 8192), 16, 0, 0);     \
    } while (0)
#define LDA(dst, b, h)                                                                                                 \
    do {                                                                                                               \
        _Pragma("unroll") for (int m = 0; m < 4; ++m) _Pragma("unroll") for (int k = 0; k < 2; ++k) dst[m][k] =         \
            *(const LAS bf16x8*)(lds + SA(b, h) + aoff + m * 2048 + k * 1024);                                          \
    } while (0)
#define LDB(dst, b, h)                                                                                                 \
    do {                                                                                                               \
        _Pragma("unroll") for (int n = 0; n < 2; ++n) _Pragma("unroll") for (int k = 0; k < 2; ++k) dst[n][k] =         \
            *(const LAS bf16x8*)(lds + SB(b, h) + boff + n * 2048 + k * 1024);                                          \
    } while (0)
#define MMA(ai, bj, Af, Bf)                                                                                            \
    do {                                                                                                               \
        __builtin_amdgcn_s_setprio(1);                                                                                 \
        _Pragma("unroll") for (int m = 0; m < 4; ++m) _Pragma("unroll") for (int n = 0; n < 2; ++n)                     \
            _Pragma("unroll") for (int k = 0; k < 2; ++k) acc[ai][bj][m][n] =                                           \
                __builtin_amdgcn_mfma_f32_16x16x32_bf16(Bf[n][k], Af[m][k], acc[ai][bj][m][n], 0, 0, 0);               \
        __builtin_amdgcn_s_setprio(0);                                                                                 \
    } while (0)
    const int tid = threadIdx.x, wid = __builtin_amdgcn_readfirstlane(tid >> 6), lane = tid & 63, wr = wid >> 2, wc = wid & 3,
              fr = lane & 15, fq = lane >> 4;
    GPiece pc;
    unsigned voffB[2];
#pragma unroll
    for (int i = 0; i < 2; ++i) {
        stage_rc(tid * 16 + i * 8192, pc.R[i], pc.C[i]);
        voffB[i] = (unsigned)(pc.R[i] * K + pc.C[i]) * 2u;
    }
    constexpr size_t hstep = (size_t)G_HALF * K * 2, kstep = G_BK * 2;
    const unsigned ldsw = (unsigned)wid * 1024u;
    const int aoff = lds_byte(wr * 64 + fr, fq * 8), boff = lds_byte(wc * 32 + fr, fq * 8);
    const char *cA, *cB, *nA, *nB;
    unsigned vc[2][2], vn[2][2];
    if (!unit(0, cA, cB, vc, pc)) return;
    f32x4 acc[2][2][4][2];
#pragma unroll
    for (int ai = 0; ai < 2; ++ai)
#pragma unroll
        for (int bj = 0; bj < 2; ++bj)
#pragma unroll
            for (int m = 0; m < 4; ++m)
#pragma unroll
                for (int n = 0; n < 2; ++n) acc[ai][bj][m][n] = (f32x4){0.f, 0.f, 0.f, 0.f};
    bf16x8 At[4][2], B0[2][2], B1[2][2];
    STG(SB(0, 0), cB, voffB); STG(SA(0, 0), cA, vc[0]); STG(SB(0, 1), cB + hstep, voffB); STG(SA(0, 1), cA, vc[1]);
    if (wr == 1) BAR;
    WAIT_V(4); BAR;
    STG(SB(1, 0), cB + kstep, voffB); STG(SA(1, 0), cA + kstep, vc[0]); STG(SB(1, 1), cB + hstep + kstep, voffB);
    WAIT_V(6); BAR;
    for (int ui = 0;; ++ui) {
        const bool has_next = unit(ui + 1, nA, nB, vn, pc);
        if (!has_next) {
            nA = cA; nB = cB;
#pragma unroll
            for (int h = 0; h < 2; ++h)
#pragma unroll
                for (int i = 0; i < 2; ++i) vn[h][i] = vc[h][i];
        }
        for (int t = 0; t < nt; t += 2) {
            const bool last = (t == nt - 2);
            const char* a1 = cA + (size_t)(t + 1) * kstep;
            const char* a2 = last ? nA : cA + (size_t)(t + 2) * kstep;
            const char* b2 = last ? nB : cB + (size_t)(t + 2) * kstep;
            const char* a3 = a2 + kstep;
            const char* b3 = b2 + kstep;
            unsigned v2[2][2];
#pragma unroll
            for (int h = 0; h < 2; ++h)
#pragma unroll
                for (int i = 0; i < 2; ++i) v2[h][i] = last ? vn[h][i] : vc[h][i];
            LDB(B0, 0, 0); SCHED; LDA(At, 0, 0); STG(SA(1, 1), a1, vc[1]);
            WAIT_L(8); BAR; WAIT_L(0); MMA(0, 0, At, B0); BAR; SCHED;
            LDB(B1, 0, 1); STG(SB(0, 0), b2, voffB);
            BAR; WAIT_L(0); MMA(0, 1, At, B1); BAR;
            LDA(At, 0, 1); STG(SA(0, 0), a2, v2[0]);
            BAR; WAIT_L(0); MMA(1, 0, At, B0); BAR; SCHED;
            STG(SB(0, 1), b2 + hstep, voffB);
            WAIT_V(6); BAR; MMA(1, 1, At, B1); BAR;
            LDB(B0, 1, 0); SCHED; LDA(At, 1, 0); STG(SA(0, 1), a2, v2[1]);
            WAIT_L(8); BAR; WAIT_L(0); MMA(0, 0, At, B0); BAR; SCHED;
            LDB(B1, 1, 1); STG(SB(1, 0), b3, voffB);
            BAR; WAIT_L(0); MMA(0, 1, At, B1); BAR;
            LDA(At, 1, 1); STG(SA(1, 0), a3, v2[0]);
            BAR; WAIT_L(0); MMA(1, 0, At, B0); BAR; SCHED;
            STG(SB(1, 1), b3 + hstep, voffB);
            WAIT_V(6); BAR; MMA(1, 1, At, B1); BAR;
        }
        epi(ui, acc);
        if (!has_next) break;
#pragma unroll
        for (int ai = 0; ai < 2; ++ai)
#pragma unroll
            for (int bj = 0; bj < 2; ++bj)
#pragma unroll
                for (int m = 0; m < 4; ++m)
#pragma unroll
                    for (int n = 0; n < 2; ++n) acc[ai][bj][m][n] = (f32x4){0.f, 0.f, 0.f, 0.f};
        cA = nA; cB = nB;
#pragma unroll
        for (int h = 0; h < 2; ++h)
#pragma unroll
            for (int i = 0; i < 2; ++i) vc[h][i] = vn[h][i];
    }
    WAIT_V(0);
    if (wr == 0) BAR;
    BAR;
#undef SA
#undef SB
#undef STG
#undef LDA
#undef LDB
#undef MMA
}

constexpr int CV_T = 64 * 65 + 32;
__device__ __forceinline__ void cv_load(float* T, const float* __restrict__ W, int ncols, int ldw, int k0, int n0) {
    const int tid = threadIdx.x;
#pragma unroll
    for (int i = 0; i < 2; ++i) {
        const int idx = tid + i * 512, kr = idx >> 4, c4 = idx & 15;
        float4 v = make_float4(0.f, 0.f, 0.f, 0.f);
        if (n0 + c4 * 4 < ncols) v = *(const float4*)(W + (size_t)(k0 + kr) * ldw + n0 + c4 * 4);
        T[(c4 * 4 + 0) * 65 + kr] = v.x;
        T[(c4 * 4 + 1) * 65 + kr] = v.y;
        T[(c4 * 4 + 2) * 65 + kr] = v.z;
        T[(c4 * 4 + 3) * 65 + kr] = v.w;
    }
}
template <class ORow>
__device__ __forceinline__ void cv_store(const float* T, int K, bf16_t* __restrict__ WT, ORow orow, int k0, int n0) {
    const int tid = threadIdx.x;
    const int n = tid >> 3, c = tid & 7;
    const float* sp = T + n * 65 + c * 8;
    u32x4 o;
    o.x = pk_bf16(sp[0], sp[1]);
    o.y = pk_bf16(sp[2], sp[3]);
    o.z = pk_bf16(sp[4], sp[5]);
    o.w = pk_bf16(sp[6], sp[7]);
    const int r = orow(n0 + n);
    *(u32x4*)(WT + (size_t)r * K + k0 + c * 8) = o;
}
template <class Item, class ORow>
__device__ __forceinline__ void cv_run(float* T, int nitems, Item item, ORow orow) {
    for (int it0 = blockIdx.x * 4; it0 < nitems; it0 += gridDim.x * 4) {
        __syncthreads();
#pragma unroll
        for (int j = 0; j < 4; ++j)
            if (it0 + j < nitems) {
                const float* W; bf16_t* WT; int K, ncols, ldw, k0, n0;
                item(it0 + j, W, K, ncols, ldw, WT, k0, n0);
                cv_load(T + j * CV_T, W, ncols, ldw, k0, n0);
            }
        __syncthreads();
#pragma unroll
        for (int j = 0; j < 4; ++j)
            if (it0 + j < nitems) {
                const float* W; bf16_t* WT; int K, ncols, ldw, k0, n0;
                item(it0 + j, W, K, ncols, ldw, WT, k0, n0);
                cv_store(T + j * CV_T, K, WT, orow, k0, n0);
            }
    }
}

constexpr int AT_KP = 144, AT_VP = 136, AT_KB = 64 * AT_KP, AT_VB = 64 * AT_VP, AT_BUF = AT_KB + AT_VB;
constexpr int AT_IMPA = 36864, AT_IMPB = AT_IMPA + 32768, AT_SELB = AT_IMPB + 32768, AT_CAND = AT_SELB + 1024, AT_KMS = AT_IMPA;
#define MFMA32(a, b, c) __builtin_amdgcn_mfma_f32_32x32x16_bf16(a, b, c, 0, 0, 0)
#define CREG(reg) (((reg) & 3) + 8 * ((reg) >> 2))

__device__ __forceinline__ float quad_sum(float x) {
    x += __int_as_float(__builtin_amdgcn_mov_dpp(__float_as_int(x), 0xB1, 0xF, 0xF, true));
    x += __int_as_float(__builtin_amdgcn_mov_dpp(__float_as_int(x), 0x4E, 0xF, 0xF, true));
    return x;
}
struct AtStage { u32x4 k, v; };
__device__ __forceinline__ void at_load(AtStage& st, const bf16_t* __restrict__ Kg, const bf16_t* __restrict__ Vg, bool with_v, unsigned koff, unsigned voff) {
    st.k = *(const u32x4*)((const char*)Kg + koff);
    if (with_v) st.v = *(const u32x4*)((const char*)Vg + voff);
}
__device__ __forceinline__ void at_store(const AtStage& st, LAS unsigned char* buf, bool with_v) {
    const int tid = threadIdx.x;
    *(LAS u32x4*)(buf + (tid >> 3) * AT_KP + (tid & 7) * 16) = st.k;
    if (with_v) {
        LAS unsigned short* vt = (LAS unsigned short*)(buf + AT_KB + (tid >> 6) * 8 * AT_VP + (tid & 63) * 2);
        vt[0 * (AT_VP / 2)] = (unsigned short)(st.v.x & 0xffffu);
        vt[1 * (AT_VP / 2)] = (unsigned short)(st.v.x >> 16);
        vt[2 * (AT_VP / 2)] = (unsigned short)(st.v.y & 0xffffu);
        vt[3 * (AT_VP / 2)] = (unsigned short)(st.v.y >> 16);
        vt[4 * (AT_VP / 2)] = (unsigned short)(st.v.z & 0xffffu);
        vt[5 * (AT_VP / 2)] = (unsigned short)(st.v.z >> 16);
        vt[6 * (AT_VP / 2)] = (unsigned short)(st.v.w & 0xffffu);
        vt[7 * (AT_VP / 2)] = (unsigned short)(st.v.w >> 16);
    }
}
__device__ __forceinline__ void at_scores(LAS const unsigned char* buf, const bf16x8 (&qf)[4], float ramp, float base0, float base1,
                                          f32x16& s0, f32x16& s1) {
    const int lane = threadIdx.x & 63, r = lane & 31, h = lane >> 5;
    LAS const unsigned char* kb = buf + r * AT_KP + h * 16;
    {
        const float b0 = fmaf(ramp, (float)(4 * h), base0), b1 = fmaf(ramp, (float)(4 * h), base1);
#pragma unroll
        for (int i = 0; i < 16; ++i) { s0[i] = fmaf(ramp, (float)CREG(i), b0); s1[i] = fmaf(ramp, (float)CREG(i), b1); }
    }
#pragma unroll
    for (int kk = 0; kk < 4; ++kk) {
        const bf16x8 k0 = *(LAS const bf16x8*)(kb + kk * 32);
        const bf16x8 k1 = *(LAS const bf16x8*)(kb + 32 * AT_KP + kk * 32);
        s0 = MFMA32(k0, qf[kk], s0);
        s1 = MFMA32(k1, qf[kk], s1);
    }
}
__device__ __forceinline__ bf16x8 at_pack8(const f32x16& P, int s2) {
    u32x4 w;
    if (s2 == 0) { w.x = pk_bf16(P[0], P[1]); w.y = pk_bf16(P[2], P[3]); w.z = pk_bf16(P[4], P[5]); w.w = pk_bf16(P[6], P[7]); }
    else         { w.x = pk_bf16(P[8], P[9]); w.y = pk_bf16(P[10], P[11]); w.z = pk_bf16(P[12], P[13]); w.w = pk_bf16(P[14], P[15]); }
    return __builtin_bit_cast(bf16x8, w);
}
__device__ __forceinline__ void at_pv(LAS const unsigned char* buf, const f32x16& p0, const f32x16& p1, f32x16& o0, f32x16& o1) {
    const int lane = threadIdx.x & 63, r = lane & 31, h = lane >> 5;
    LAS const unsigned char* vb = buf + AT_KB + r * AT_VP + h * 8;
#pragma unroll
    for (int half = 0; half < 2; ++half) {
#pragma unroll
        for (int s2 = 0; s2 < 2; ++s2) {
            const bf16x8 pf = at_pack8(half ? p1 : p0, s2);
            const int ko = (32 * half + 16 * s2) * 2;
            const u32x2 a0 = *(LAS const u32x2*)(vb + ko), a1 = *(LAS const u32x2*)(vb + ko + 16);
            const u32x2 b0 = *(LAS const u32x2*)(vb + 32 * AT_VP + ko), b1 = *(LAS const u32x2*)(vb + 32 * AT_VP + ko + 16);
            const u32x4 va = {a0.x, a0.y, a1.x, a1.y}, vbb = {b0.x, b0.y, b1.x, b1.y};
            o0 = MFMA32(__builtin_bit_cast(bf16x8, va), pf, o0);
            o1 = MFMA32(__builtin_bit_cast(bf16x8, vbb), pf, o1);
        }
    }
}
__device__ __forceinline__ float at_rowmax(const f32x16& s0, const f32x16& s1) {
    float m = fmaxf(s0[0], s1[0]);
#pragma unroll
    for (int i = 1; i < 16; ++i) m = fmaxf(m, fmaxf(s0[i], s1[i]));
    return fmaxf(m, __shfl_xor(m, 32));
}
#define AT_MASK_LE(S0, S1, lim)  do { _Pragma("unroll") for (int i_ = 0; i_ < 16; ++i_) { if (CREG(i_) > (lim)) S0[i_] = -INFINITY; if (CREG(i_) + 32 > (lim)) S1[i_] = -INFINITY; } } while (0)
#define AT_MASK_GE(S0, S1, lo)   do { _Pragma("unroll") for (int i_ = 0; i_ < 16; ++i_) { if (CREG(i_) < (lo)) S0[i_] = -INFINITY; if (CREG(i_) + 32 < (lo)) S1[i_] = -INFINITY; } } while (0)
__device__ __forceinline__ float at_exp(f32x16& s0, f32x16& s1, float mref) {
    float l = 0.f;
#pragma unroll
    for (int i = 0; i < 16; ++i) {
        s0[i] = __builtin_amdgcn_exp2f(s0[i] - mref);
        s1[i] = __builtin_amdgcn_exp2f(s1[i] - mref);
        l += s0[i] + s1[i];
    }
    return l;
}

#define AT_PIN(x) asm volatile("" : "+v"(x))
__device__ __forceinline__ void at_tile_pipe(LAS const unsigned char* buf, const bf16x8 (&qf)[4], float ramp, float base0, float mrow,
                                             float sl2x32, float& l, f32x16& o0, f32x16& o1) {
    const int lane = threadIdx.x & 63, r = lane & 31, h = lane >> 5;
    LAS const unsigned char* kb = buf + r * AT_KP + h * 16;
    LAS const unsigned char* vb = buf + AT_KB + r * AT_VP + h * 8;
    const float c0 = fmaf(ramp, (float)(4 * h), base0 - mrow), c1 = c0 + sl2x32;
    f32x16 s0, s1;
#pragma unroll
    for (int i = 0; i < 16; ++i) { s0[i] = fmaf(ramp, (float)CREG(i), c0); s1[i] = fmaf(ramp, (float)CREG(i), c1); }
    bf16x8 kf[4];
#pragma unroll
    for (int kk = 0; kk < 4; ++kk) kf[kk] = *(LAS const bf16x8*)(kb + kk * 32);
#pragma unroll
    for (int kk = 0; kk < 4; ++kk) s0 = MFMA32(kf[kk], qf[kk], s0);
#pragma unroll
    for (int kk = 0; kk < 4; ++kk) kf[kk] = *(LAS const bf16x8*)(kb + 32 * AT_KP + kk * 32);
    __builtin_amdgcn_sched_barrier(0);
    u32x2 vf[4][2];
    float ls = 0.f;
#pragma unroll
    for (int kk = 0; kk < 4; ++kk) {
        s1 = MFMA32(kf[kk], qf[kk], s1);
        vf[kk][0] = *(LAS const u32x2*)(vb + (kk & 1) * 32 * AT_VP + (16 * (kk >> 1)) * 2);
        vf[kk][1] = *(LAS const u32x2*)(vb + (kk & 1) * 32 * AT_VP + (16 * (kk >> 1)) * 2 + 16);
#pragma unroll
        for (int q = 0; q < 4; ++q) { s0[4 * kk + q] = __builtin_amdgcn_exp2f(s0[4 * kk + q]); ls += s0[4 * kk + q]; }
        AT_PIN(ls);
        __builtin_amdgcn_sched_barrier(0);
    }
    const bf16x8 pa = at_pack8(s0, 0), pb = at_pack8(s0, 1);
#pragma unroll
    for (int st = 0; st < 4; ++st) {
        const int s2 = st >> 1, dt = st & 1;
        const u32x4 vv = {vf[st][0].x, vf[st][0].y, vf[st][1].x, vf[st][1].y};
        if (dt == 0) o0 = MFMA32(__builtin_bit_cast(bf16x8, vv), s2 ? pb : pa, o0);
        else         o1 = MFMA32(__builtin_bit_cast(bf16x8, vv), s2 ? pb : pa, o1);
        vf[st][0] = *(LAS const u32x2*)(vb + dt * 32 * AT_VP + (32 + 16 * s2) * 2);
        vf[st][1] = *(LAS const u32x2*)(vb + dt * 32 * AT_VP + (32 + 16 * s2) * 2 + 16);
#pragma unroll
        for (int q = 0; q < 4; ++q) { s1[4 * st + q] = __builtin_amdgcn_exp2f(s1[4 * st + q]); ls += s1[4 * st + q]; }
        AT_PIN(ls);
        __builtin_amdgcn_sched_barrier(0);
    }
    const bf16x8 pc = at_pack8(s1, 0), pd = at_pack8(s1, 1);
#pragma unroll
    for (int st = 0; st < 4; ++st) {
        const int s2 = st >> 1, dt = st & 1;
        const u32x4 vv = {vf[st][0].x, vf[st][0].y, vf[st][1].x, vf[st][1].y};
        if (dt == 0) o0 = MFMA32(__builtin_bit_cast(bf16x8, vv), s2 ? pd : pc, o0);
        else         o1 = MFMA32(__builtin_bit_cast(bf16x8, vv), s2 ? pd : pc, o1);
    }
    l += ls;
}

#define AT_PASS(Kg, Vg, WITHV, NTILE, ROW, ...)                                                                        \
    {                                                                                                                  \
        AtStage st0_, st1_;                                                                                            \
        const int nt_ = (NTILE);                                                                                       \
        unsigned koff_ = (threadIdx.x >> 3) * 128 + (threadIdx.x & 7) * 16, voff_ = (threadIdx.x & 63) * 128 + (threadIdx.x >> 6) * 16; \
        asm volatile("" : "+v"(koff_), "+v"(voff_));     \
        __syncthreads();                                                                                               \
        at_load(st0_, (Kg) + (size_t)(ROW(0)) * 64, (Vg) + (size_t)(ROW(0)) * 64, WITHV, koff_, voff_);                 \
        at_store(st0_, lds, WITHV);                                                                                    \
        { const int i1_ = nt_ > 1 ? 1 : 0; at_load(st1_, (Kg) + (size_t)(ROW(i1_)) * 64, (Vg) + (size_t)(ROW(i1_)) * 64, WITHV, koff_, voff_); } \
        __syncthreads();                                                                                               \
        for (int i0_ = 0; i0_ < nt_; i0_ += 2) {                                                                       \
            {                                                                                                          \
                const int i = i0_;                                                                                     \
                LAS unsigned char* buf = lds;                                                                          \
                { const int in_ = (i + 2 < nt_) ? i + 2 : nt_ - 1;     \
                  at_load(st0_, (Kg) + (size_t)(ROW(in_)) * 64, (Vg) + (size_t)(ROW(in_)) * 64, WITHV, koff_, voff_); }        \
                do { __VA_ARGS__ } while (0);                                                                          \
                if (i + 1 < nt_) at_store(st1_, lds + AT_BUF, WITHV);                                                  \
                __syncthreads();                                                                                       \
            }                                                                                                          \
            if (i0_ + 1 < nt_) {                                                                                       \
                const int i = i0_ + 1;                                                                                 \
                LAS unsigned char* buf = lds + AT_BUF;                                                                 \
                { const int in_ = (i + 2 < nt_) ? i + 2 : nt_ - 1;                                                     \
                  at_load(st1_, (Kg) + (size_t)(ROW(in_)) * 64, (Vg) + (size_t)(ROW(in_)) * 64, WITHV, koff_, voff_); }        \
                do { __VA_ARGS__ } while (0);                                                                          \
                if (i + 1 < nt_) at_store(st0_, lds, WITHV);                                                           \
                __syncthreads();                                                                                       \
            }                                                                                                          \
        }                                                                                                              \
    }

__device__ __forceinline__ void nsa_item(const Params& p, unsigned char* shm, int b, int g, int c) {
    LAS unsigned char* lds = (LAS unsigned char*)shm;
    unsigned char* wsb = (unsigned char*)p.ws;
    const bf16_t* pt = (const bf16_t*)(wsb + WS_PT);
    const int tid = threadIdx.x, lane = tid & 63, w = __builtin_amdgcn_readfirstlane(tid >> 6), r = lane & 31, h = lane >> 5;
    const int tokl = 8 * w + (r >> 2), head = r & 3, hq = 4 * g + head, t = 64 * c + tokl, tok = b * SEQ + t;
    const float sl2 = exp2f(-(float)(hq + 1)) * LOG2E;
    const float ramp = sl2;
    bf16x8 qf[4];
    {
        const bf16_t* qrow = pt + ((size_t)(HG_NQ + hq) * NTOK + tok) * 64 + 8 * h;
#pragma unroll
        for (int kk = 0; kk < 4; ++kk) qf[kk] = *(const bf16x8*)(qrow + 16 * kk);
    }
    const float* gl = (const float*)(wsb + WS_GATES);
#define GATE_(br, dst) float dst; { int go_ = tok * 24 + hq * 3 + (br); asm volatile("" : "+v"(go_)); dst = gl[go_]; }
    f32x16 R0, R1;
#pragma unroll
    for (int i = 0; i < 16; ++i) { R0[i] = 0.f; R1[i] = 0.f; }
    LAS float* impA = (LAS float*)(lds + AT_IMPA);
    LAS float* impB = (LAS float*)(lds + AT_IMPB);
    LAS unsigned* selb = (LAS unsigned*)(lds + AT_SELB);

    {
        const bf16_t* Kc = (const bf16_t*)(wsb + WS_KCMP) + (size_t)(b * 2 + g) * NCMPP * 64;
        const bf16_t* Vc = (const bf16_t*)(wsb + WS_VCMP) + (size_t)(b * 2 + g) * NCMPP * 64;
        const int ntile = (4 * c + 3 + 63) >> 6;
        const int imax = (t >= 31) ? ((t - 31) >> 4) : -1;
        const float ramp16 = sl2 * 16.0f;
        float m = -INFINITY, l = 0.f;
#define ROW_(_i) (64 * (_i))
        AT_PASS(Kc, Vc, false, ntile, ROW_,
            f32x16 s0, s1;
            const float base0 = sl2 * (float)(16 * 64 * i + 31 - 64 * c), base1 = base0 + sl2 * 512.0f;
            at_scores(buf, qf, ramp16, base0, base1, s0, s1);
            const int lim = imax - 64 * i - 4 * h;
            AT_MASK_LE(s0, s1, lim);
            const float tm = at_rowmax(s0, s1);
            const float mn = fmaxf(m, tm);
            if (mn > -INFINITY) {
                l *= __builtin_amdgcn_exp2f(m - mn);
                l += at_exp(s0, s1, mn);
                m = mn;
            }
        )
        l += __shfl_xor(l, 32);
        const float inv = (l > 0.f) ? 1.0f / l : 0.f;
        const float mfin = (m > -INFINITY) ? m : 0.f;
        f32x16 o0, o1;
#pragma unroll
        for (int i = 0; i < 16; ++i) { o0[i] = 0.f; o1[i] = 0.f; }
        AT_PASS(Kc, Vc, true, ntile, ROW_,
            f32x16 s0, s1;
            const float base0 = sl2 * (float)(16 * 64 * i + 31 - 64 * c), base1 = base0 + sl2 * 512.0f;
            at_scores(buf, qf, ramp16, base0, base1, s0, s1);
            const int lim = imax - 64 * i - 4 * h;
            AT_MASK_LE(s0, s1, lim);
            (void)at_exp(s0, s1, mfin);
_Pragma("unroll")
            for (int q = 0; q < 16; ++q) { s0[q] *= inv; s1[q] *= inv; }
_Pragma("unroll")
            for (int hf = 0; hf < 2; ++hf)
_Pragma("unroll")
                for (int u = 0; u < 4; ++u) {
                    const f32x16& P = hf ? s1 : s0;
                    float A = 2.0f * (P[4 * u] + P[4 * u + 1] + P[4 * u + 2]) + P[4 * u + 3], Bv = P[4 * u + 3];
                    A = quad_sum(A);
                    Bv = quad_sum(Bv);
                    const int j = 16 * i + 8 * hf + 2 * u + h;
                    if (head == 0) impA[tokl * 128 + j] = A;
                    if (head == 1) impB[tokl * 128 + j] = Bv;
                }
            at_pv(buf, s0, s1, o0, o1);
        )
#undef ROW_
        GATE_(0, g0)
#pragma unroll
        for (int i = 0; i < 16; ++i) { R0[i] = g0 * o0[i]; R1[i] = g0 * o1[i]; }
    }

    unsigned sw0, sw1, sw2, sw3;
    {
        __syncthreads();
        for (int tk = 0; tk < 8; ++tk) {
            const int tl = 8 * w + tk;
            unsigned long long ba, bb;
            if (c < 16) {
                ba = (1ull << (c + 1)) - 1ull;
                bb = 0ull;
            } else {
                const int jA = lane, jB = lane + 64;
                const float vA = (jA >= 1 && jA <= c - 2) ? impA[tl * 128 + jA] + impB[tl * 128 + jA - 1] : -1.0f;
                const float vB = (jB <= c - 2) ? impA[tl * 128 + jB] + impB[tl * 128 + jB - 1] : -1.0f;
                LAS float* cand = (LAS float*)(lds + AT_CAND) + w * 128;
                cand[jA] = vA;
                cand[jB] = vB;
                asm volatile("s_waitcnt lgkmcnt(0)" ::: "memory");
                int rA = 0, rB = 0;
                for (int j4 = 0; j4 < 128; j4 += 4) {
                    const f32x4 cv = *(LAS const f32x4*)(cand + j4);
#pragma unroll
                    for (int q = 0; q < 4; ++q) {
                        const int jj = j4 + q;
                        rA += (cv[q] > vA || (cv[q] == vA && jj < jA)) ? 1 : 0;
                        rB += (cv[q] > vB || (cv[q] == vB && jj < jB)) ? 1 : 0;
                    }
                }
                asm volatile("s_waitcnt lgkmcnt(0)" ::: "memory");
                const bool sA = (jA == 0) || (jA == c - 1) || (jA == c) || (vA >= 0.f && rA < 13);
                const bool sB = (jB == c - 1) || (jB == c) || (vB >= 0.f && rB < 13);
                ba = __ballot(sA);
                bb = __ballot(sB);
            }
            if (lane == 0) {
                selb[tl * 4 + 0] = (unsigned)ba;
                selb[tl * 4 + 1] = (unsigned)(ba >> 32);
                selb[tl * 4 + 2] = (unsigned)bb;
                selb[tl * 4 + 3] = (unsigned)(bb >> 32);
            }
        }
        __syncthreads();
        sw0 = selb[tokl * 4 + 0];
        sw1 = selb[tokl * 4 + 1];
        sw2 = selb[tokl * 4 + 2];
        sw3 = selb[tokl * 4 + 3];
    }

    {
        const bf16_t* Ks = pt + ((size_t)(HG_KS + g) * NTOK + (size_t)b * SEQ) * 64;
        const bf16_t* Vs = pt + ((size_t)(HG_VS + g) * NTOK + (size_t)b * SEQ) * 64;
        f32x16 o0, o1;
#pragma unroll
        for (int i = 0; i < 16; ++i) { o0[i] = 0.f; o1[i] = 0.f; }
        float mref = 0.f, l = 0.f;
#define ROW_(_i) (64 * (c - (_i)))
        AT_PASS(Ks, Vs, true, c + 1, ROW_,
            const int j = c - i;
            const unsigned wsel = (j < 32) ? sw0 : (j < 64) ? sw1 : (j < 96) ? sw2 : sw3;
            const bool rowsel = (i == 0) || ((wsel >> (j & 31)) & 1u);
            if (__ballot(rowsel) == 0ull) break;
            const float base0 = sl2 * (float)(-64 * i);
            if (i == 0) {
                f32x16 s0, s1;
                at_scores(buf, qf, ramp, base0, base0 + sl2 * 32.0f, s0, s1);
                const int lim = tokl - 4 * h;
                AT_MASK_LE(s0, s1, lim);
                mref = at_rowmax(s0, s1);
                l += at_exp(s0, s1, mref);
                at_pv(buf, s0, s1, o0, o1);
            } else {
                at_tile_pipe(buf, qf, ramp, base0, rowsel ? mref : INFINITY, sl2 * 32.0f, l, o0, o1);
            }
        )
        l += __shfl_xor(l, 32);
        GATE_(1, g1)
        const float sc = g1 / l;
#pragma unroll
        for (int i = 0; i < 16; ++i) { R0[i] += sc * o0[i]; R1[i] += sc * o1[i]; }
    }

    {
        const bf16_t* Kw = pt + ((size_t)(HG_KW + g) * NTOK + (size_t)b * SEQ) * 64;
        const bf16_t* Vw = pt + ((size_t)(HG_VW + g) * NTOK + (size_t)b * SEQ) * 64;
        f32x16 o0, o1;
#pragma unroll
        for (int i = 0; i < 16; ++i) { o0[i] = 0.f; o1[i] = 0.f; }
        float mref = 0.f, l = 0.f;
        const int ntile = (c >= 8) ? 9 : (c + 1);
        AT_PASS(Kw, Vw, true, ntile, ROW_,
            const float base0 = sl2 * (float)(-64 * i);
            if (i == 0 || i == 8) {
                f32x16 s0, s1;
                at_scores(buf, qf, ramp, base0, base0 + sl2 * 32.0f, s0, s1);
                if (i == 0) {
                    const int lim = tokl - 4 * h;
                    AT_MASK_LE(s0, s1, lim);
                    mref = at_rowmax(s0, s1);
                } else {
                    const int lo = tokl + 1 - 4 * h;
                    AT_MASK_GE(s0, s1, lo);
                }
                l += at_exp(s0, s1, mref);
                at_pv(buf, s0, s1, o0, o1);
            } else {
                at_tile_pipe(buf, qf, ramp, base0, mref, sl2 * 32.0f, l, o0, o1);
            }
        )
#undef ROW_
        l += __shfl_xor(l, 32);
        GATE_(2, g2)
        const float sc = g2 / l;
#pragma unroll
        for (int i = 0; i < 16; ++i) { R0[i] += sc * o0[i]; R1[i] += sc * o1[i]; }
    }

    {
        bf16_t* orow = (bf16_t*)(wsb + WS_MIXB) + (size_t)tok * DM + 512 + hq * 64 + 4 * h;
#pragma unroll
        for (int u = 0; u < 4; ++u) {
            u32x2 a, bq;
            a.x = pk_bf16(R0[4 * u], R0[4 * u + 1]);
            a.y = pk_bf16(R0[4 * u + 2], R0[4 * u + 3]);
            bq.x = pk_bf16(R1[4 * u], R1[4 * u + 1]);
            bq.y = pk_bf16(R1[4 * u + 2], R1[4 * u + 3]);
            *(u32x2*)(orow + 8 * u) = a;
            *(u32x2*)(orow + 32 + 8 * u) = bq;
        }
    }
}

constexpr int PART_REC = 136, PART_ROW = 4 * PART_REC;
__device__ __forceinline__ unsigned char* part_rec(unsigned char* wsb, int b, int hh, int t, int slot) {
    return wsb + WS_PART + ((size_t)((b * 8 + hh) * SEQ + t)) * PART_ROW + slot * PART_REC;
}
__device__ __forceinline__ void part_store(unsigned char* rec, const f32x16& o0, const f32x16& o1, float l, float m, int h) {
    const float sc = 1.0f / l;
    bf16_t* orow = (bf16_t*)rec + 4 * h;
#pragma unroll
    for (int u = 0; u < 4; ++u) {
        u32x2 a, bq;
        a.x = pk_bf16(sc * o0[4 * u], sc * o0[4 * u + 1]);
        a.y = pk_bf16(sc * o0[4 * u + 2], sc * o0[4 * u + 3]);
        bq.x = pk_bf16(sc * o1[4 * u], sc * o1[4 * u + 1]);
        bq.y = pk_bf16(sc * o1[4 * u + 2], sc * o1[4 * u + 3]);
        *(u32x2*)(orow + 8 * u) = a;
        *(u32x2*)(orow + 32 + 8 * u) = bq;
    }
    if (h == 0) { f32x2 lm = {l, m}; *(f32x2*)(rec + 128) = lm; }
}

__device__ __forceinline__ void moba_gate_item(const Params& p, unsigned char* shm, int b, int hh, int cb) {
    LAS unsigned char* lds = (LAS unsigned char*)shm;
    unsigned char* wsb = (unsigned char*)p.ws;
    const bf16_t* pt = (const bf16_t*)(wsb + WS_PT);
    int tid = threadIdx.x;
    asm volatile("" : "+v"(tid));
    const int lane = tid & 63, w = __builtin_amdgcn_readfirstlane(tid >> 6), r = lane & 31, h = lane >> 5;
    const int tloc = 32 * w + r, t = 256 * cb + tloc, tok = b * SEQ + t;
    LAS float* kms = (LAS float*)(lds + AT_KMS);
    LAS int* lcnt = (LAS int*)(lds + AT_SELB);
    LAS int* lbase = lcnt + 32;
    int* mcnt = (int*)(wsb + WS_MCNT) + (b * 8 + hh) * 32;
    unsigned short* mlist = (unsigned short*)(wsb + WS_MLIST) + (size_t)((b * 8 + hh) * 32) * 8192;
    __syncthreads();
    {
        const f32x4 v = ((const f32x4*)((const float*)(wsb + WS_KMEAN) + (size_t)(b * 8 + hh) * 2048))[tid];
        *(LAS f32x4*)(kms + tid * 4) = v;
    }
    if (tid < 32) lcnt[tid] = 0;
    __syncthreads();
    float qv[32];
    {
        const bf16_t* qrow = pt + ((size_t)(HG_MQ + hh) * NTOK + tok) * 64 + 8 * h;
#pragma unroll
        for (int kk = 0; kk < 4; ++kk) {
            const u32x4 qq = *(const u32x4*)(qrow + 16 * kk);
            qv[kk * 8 + 0] = bf_lo(qq.x); qv[kk * 8 + 1] = bf_hi(qq.x);
            qv[kk * 8 + 2] = bf_lo(qq.y); qv[kk * 8 + 3] = bf_hi(qq.y);
            qv[kk * 8 + 4] = bf_lo(qq.z); qv[kk * 8 + 5] = bf_hi(qq.z);
            qv[kk * 8 + 6] = bf_lo(qq.w); qv[kk * 8 + 7] = bf_hi(qq.w);
        }
    }
    float b0 = -INFINITY, b1 = -INFINITY, b2 = -INFINITY;
    int i0 = 0, i1 = 0, i2 = 0;
    for (int n = 0; n < cb; ++n) {
        float s = 0.f;
#pragma unroll
        for (int kk = 0; kk < 4; ++kk) {
            const f32x4 ka = *(LAS const f32x4*)(kms + n * 64 + 16 * kk + 8 * h), kb = *(LAS const f32x4*)(kms + n * 64 + 16 * kk + 8 * h + 4);
            s += qv[kk * 8 + 0] * ka[0] + qv[kk * 8 + 1] * ka[1] + qv[kk * 8 + 2] * ka[2] + qv[kk * 8 + 3] * ka[3];
            s += qv[kk * 8 + 4] * kb[0] + qv[kk * 8 + 5] * kb[1] + qv[kk * 8 + 6] * kb[2] + qv[kk * 8 + 7] * kb[3];
        }
        s += __shfl_xor(s, 32);
        if (s > b0) { b2 = b1; i2 = i1; b1 = b0; i1 = i0; b0 = s; i0 = n; }
        else if (s > b1) { b2 = b1; i2 = i1; b1 = s; i1 = n; }
        else if (s > b2) { b2 = s; i2 = n; }
    }
    const int nsel = cb < 3 ? cb : 3;
    int n0 = i0, n1 = i1, n2 = i2;
    if (nsel >= 2 && n1 < n0) { const int x = n0; n0 = n1; n1 = x; }
    if (nsel >= 3) {
        if (n2 < n1) { const int x = n1; n1 = n2; n2 = x; }
        if (n1 < n0) { const int x = n0; n0 = n1; n1 = x; }
    }
    int r0 = 0, r1 = 0, r2 = 0;
    if (h == 0) {
        r0 = atomicAdd((int*)(lcnt + n0), 1);
        if (nsel >= 2) r1 = atomicAdd((int*)(lcnt + n1), 1);
        if (nsel >= 3) r2 = atomicAdd((int*)(lcnt + n2), 1);
    }
    __syncthreads();
    if (tid < cb) lbase[tid] = atomicAdd(mcnt + tid, lcnt[tid]);
    __syncthreads();
    if (h == 0) {
        mlist[(size_t)n0 * 8192 + lbase[n0] + r0] = (unsigned short)(t | (0 << 13));
        if (nsel >= 2) mlist[(size_t)n1 * 8192 + lbase[n1] + r1] = (unsigned short)(t | (1 << 13));
        if (nsel >= 3) mlist[(size_t)n2 * 8192 + lbase[n2] + r2] = (unsigned short)(t | (2 << 13));
    }
}

__device__ __forceinline__ void moba_own_item(const Params& p, unsigned char* shm, int b, int hh, int cb) {
    LAS unsigned char* lds = (LAS unsigned char*)shm;
    unsigned char* wsb = (unsigned char*)p.ws;
    const bf16_t* pt = (const bf16_t*)(wsb + WS_PT);
    int tid = threadIdx.x;
    asm volatile("" : "+v"(tid));
    const int lane = tid & 63, w = __builtin_amdgcn_readfirstlane(tid >> 6), r = lane & 31, h = lane >> 5;
    const int tloc = 32 * w + r, t = 256 * cb + tloc, tok = b * SEQ + t;
    const float sl2 = exp2f(-((float)hh + 0.5f)) * LOG2E;
    const float ramp = sl2;
    bf16x8 qf[4];
    {
        const bf16_t* qrow = pt + ((size_t)(HG_MQ + hh) * NTOK + tok) * 64 + 8 * h;
#pragma unroll
        for (int kk = 0; kk < 4; ++kk) qf[kk] = *(const bf16x8*)(qrow + 16 * kk);
    }
    const bf16_t* Km = pt + ((size_t)(HG_MK + hh) * NTOK + (size_t)b * SEQ) * 64;
    const bf16_t* Vm = pt + ((size_t)(HG_MV + hh) * NTOK + (size_t)b * SEQ) * 64;
    f32x16 o0, o1;
#pragma unroll
    for (int i = 0; i < 16; ++i) { o0[i] = 0.f; o1[i] = 0.f; }
    float mref = 0.f, l = 0.f;
    const int wt = w >> 1;
#define ROW_(_i) (256 * cb + 64 * (3 - (_i)))
    AT_PASS(Km, Vm, true, 4, ROW_,
        const int tt = 3 - i;
        if (tt > wt) break;
        const float base0 = sl2 * (float)(64 * tt);
        if (tt == wt) {
            f32x16 s0, s1;
            at_scores(buf, qf, ramp, base0, base0 + sl2 * 32.0f, s0, s1);
            const int lim = tloc - 64 * tt - 4 * h;
            AT_MASK_LE(s0, s1, lim);
            mref = at_rowmax(s0, s1);
            l += at_exp(s0, s1, mref);
            at_pv(buf, s0, s1, o0, o1);
        } else {
            at_tile_pipe(buf, qf, ramp, base0, mref, sl2 * 32.0f, l, o0, o1);
        }
        )
#undef ROW_
    l += __shfl_xor(l, 32);
    part_store(part_rec(wsb, b, hh, t, 3), o0, o1, l, mref - sl2 * (float)tloc, h);
}

__device__ __forceinline__ void moba_gather_item(const Params& p, unsigned char* shm, int b, int hh, int n, int k, int cnt) {
    LAS unsigned char* lds = (LAS unsigned char*)shm;
    unsigned char* wsb = (unsigned char*)p.ws;
    const bf16_t* pt = (const bf16_t*)(wsb + WS_PT);
    int tid = threadIdx.x;
    asm volatile("" : "+v"(tid));
    const int lane = tid & 63, w = __builtin_amdgcn_readfirstlane(tid >> 6), r = lane & 31, h = lane >> 5;
    const unsigned short* mlist = (const unsigned short*)(wsb + WS_MLIST) + (size_t)((b * 8 + hh) * 32 + n) * 8192;
    const int li = 256 * k + 32 * w + r;
    const bool live = li < cnt;
    const unsigned ent = mlist[live ? li : cnt - 1];
    const int t = ent & 8191, slot = ent >> 13, tok = b * SEQ + t;
    const float sl2 = exp2f(-((float)hh + 0.5f)) * LOG2E;
    const float ramp = sl2;
    bf16x8 qf[4];
    {
        const bf16_t* qrow = pt + ((size_t)(HG_MQ + hh) * NTOK + tok) * 64 + 8 * h;
#pragma unroll
        for (int kk = 0; kk < 4; ++kk) qf[kk] = *(const bf16x8*)(qrow + 16 * kk);
    }
    const bf16_t* Km = pt + ((size_t)(HG_MK + hh) * NTOK + (size_t)b * SEQ) * 64;
    const bf16_t* Vm = pt + ((size_t)(HG_MV + hh) * NTOK + (size_t)b * SEQ) * 64;
    f32x16 o0, o1;
#pragma unroll
    for (int i = 0; i < 16; ++i) { o0[i] = 0.f; o1[i] = 0.f; }
    float mref = 0.f, l = 0.f;
    const float tb = sl2 * (float)(256 * n - t);
#define ROW_(_i) (256 * n + 64 * (3 - (_i)))
    AT_PASS(Km, Vm, true, 4, ROW_,
        const int tt = 3 - i;
        const float base0 = tb + sl2 * (float)(64 * tt);
        if (i == 0) {
            f32x16 s0, s1;
            at_scores(buf, qf, ramp, base0, base0 + sl2 * 32.0f, s0, s1);
            mref = at_rowmax(s0, s1);
            l += at_exp(s0, s1, mref);
            at_pv(buf, s0, s1, o0, o1);
        } else {
            at_tile_pipe(buf, qf, ramp, base0, mref, sl2 * 32.0f, l, o0, o1);
        }
        )
#undef ROW_
    l += __shfl_xor(l, 32);
    if (live) part_store(part_rec(wsb, b, hh, t, slot), o0, o1, l, mref, h);
}

__device__ __forceinline__ void f_moba_merge(const Params& p) {
    unsigned char* wsb = (unsigned char*)p.ws;
    const int tid = threadIdx.x;
    bf16_t* mixb = (bf16_t*)(wsb + WS_MIXB);
    for (int idx = blockIdx.x * 512 + tid; idx < NTOK * 8 * 8; idx += gridDim.x * 512) {
        const int dq = idx & 7, rho = idx >> 3;
        const int t = rho & (SEQ - 1), bh = rho >> 13, hh = bh & 7, b = bh >> 3;
        const int cbk = t >> 8, nsel = cbk < 3 ? cbk : 3;
        const unsigned char* row = wsb + WS_PART + (size_t)rho * PART_ROW;
        float lw[4];
        float M = -INFINITY;
        f32x2 lm[4];
#pragma unroll
        for (int s = 0; s < 4; ++s) {
            const bool on = (s == 3) || (s < nsel);
            lm[s] = on ? *(const f32x2*)(row + s * PART_REC + 128) : (f32x2){0.f, -INFINITY};
            M = fmaxf(M, lm[s][1]);
        }
        float W = 0.f;
#pragma unroll
        for (int s = 0; s < 4; ++s) { lw[s] = lm[s][0] * __builtin_amdgcn_exp2f(lm[s][1] - M); W += lw[s]; }
        float acc[8];
#pragma unroll
        for (int q = 0; q < 8; ++q) acc[q] = 0.f;
#pragma unroll
        for (int s = 0; s < 4; ++s) {
            const bool on = (s == 3) || (s < nsel);
            if (on) {
                const u32x4 v = *(const u32x4*)(row + s * PART_REC + dq * 16);
                acc[0] += lw[s] * bf_lo(v.x); acc[1] += lw[s] * bf_hi(v.x);
                acc[2] += lw[s] * bf_lo(v.y); acc[3] += lw[s] * bf_hi(v.y);
                acc[4] += lw[s] * bf_lo(v.z); acc[5] += lw[s] * bf_hi(v.z);
                acc[6] += lw[s] * bf_lo(v.w); acc[7] += lw[s] * bf_hi(v.w);
            }
        }
        const float inv = 1.0f / W;
        u32x4 o;
        o.x = pk_bf16(acc[0] * inv, acc[1] * inv);
        o.y = pk_bf16(acc[2] * inv, acc[3] * inv);
        o.z = pk_bf16(acc[4] * inv, acc[5] * inv);
        o.w = pk_bf16(acc[6] * inv, acc[7] * inv);
        *(u32x4*)(mixb + (size_t)(b * SEQ + t) * DM + hh * 64 + dq * 8) = o;
    }
}

__device__ __forceinline__ void f_moba_gate(const Params& p, unsigned char* shm) {
    for (int q = blockIdx.x; q < 1024; q += gridDim.x) {
        const int cb = q >> 5, bh = q & 31;
        if (cb >= 1) moba_gate_item(p, shm, bh >> 3, bh & 7, cb);
    }
    __syncthreads();
}

__device__ __forceinline__ void f_attn(const Params& p, unsigned char* shm) {
    const int G = gridDim.x, bx = blockIdx.x;
    for (int s = 0; s * G < 1024; ++s) {
        const int q = s * G + ((s & 1) ? (G - 1 - bx) : bx);
        if (q < 1024) nsa_item(p, shm, (q & 7) >> 1, q & 1, 127 - (q >> 3));
    }
    for (int q = bx; q < 1024; q += G) moba_own_item(p, shm, (q & 31) >> 3, q & 7, q >> 5);
    {
        LAS int* pre = (LAS int*)((LAS unsigned char*)shm + AT_IMPA);
        const int* mcnt = (const int*)((unsigned char*)p.ws + WS_MCNT);
        int tid = threadIdx.x;
        asm volatile("" : "+v"(tid));
        __syncthreads();
        {
            LAS int* wtot = pre + 1040;
            const int lane = tid & 63, w = tid >> 6;
            const int v0 = (mcnt[2 * tid] + 255) >> 8, v1 = (mcnt[2 * tid + 1] + 255) >> 8;
            int sc = v0 + v1;
#pragma unroll
            for (int d = 1; d < 64; d <<= 1) { const int u = __shfl_up(sc, d); if (lane >= d) sc += u; }
            if (lane == 63) wtot[w] = sc;
            __syncthreads();
            int woff = 0;
            for (int ww = 0; ww < w; ++ww) woff += wtot[ww];
            const int excl = woff + sc - (v0 + v1);
            pre[2 * tid] = excl;
            pre[2 * tid + 1] = excl + v0;
            if (tid == 511) pre[1024] = excl + v0 + v1;
        }
        __syncthreads();
        const int total = pre[1024];
        for (int it = bx; it < total; it += G) {
            int lo = 0, hi = 1024;
            while (hi - lo > 1) { const int mid = (lo + hi) >> 1; if (pre[mid] <= it) lo = mid; else hi = mid; }
            const int li = lo, k = it - pre[li];
            const int cnt = mcnt[li];
            moba_gather_item(p, shm, li >> 8, (li >> 5) & 7, li & 31, k, cnt);
        }
    }
    __syncthreads();
}

__device__ __forceinline__ void f_prologue(const Params& p, unsigned char* shm) {
    const int tid = threadIdx.x, lane = tid & 63, w = tid >> 6;
    unsigned char* wsb = (unsigned char*)p.ws;
    bf16_t* xn = (bf16_t*)(wsb + WS_XN);
    {
        float4* km = (float4*)(wsb + WS_KMEAN);
        for (int i = blockIdx.x * 512 + tid; i < 16384; i += gridDim.x * 512) km[i] = make_float4(0.f, 0.f, 0.f, 0.f);
        int* mc = (int*)(wsb + WS_MCNT);
        for (int i = blockIdx.x * 512 + tid; i < 1024; i += gridDim.x * 512) mc[i] = 0;
    }
    for (int row = blockIdx.x * 8 + w; row < NTOK; row += gridDim.x * 8) {
        const float4* xr = (const float4*)(p.x + (size_t)row * DM);
        float4 v[4];
        float ss = 0.f;
#pragma unroll
        for (int j = 0; j < 4; ++j) { v[j] = xr[lane + 64 * j]; ss += dot4(v[j], v[j]); }
        ss = wave_sum(ss);
        const float r = 1.0f / sqrtf(ss * (1.0f / DM) + 1e-5f);
        const float4* g4 = (const float4*)p.attn_g;
        u32x2* o = (u32x2*)(xn + (size_t)row * DM);
#pragma unroll
        for (int j = 0; j < 4; ++j) {
            const float4 g = g4[lane + 64 * j];
            u32x2 ov;
            ov.x = pk_bf16(v[j].x * r * g.x, v[j].y * r * g.y);
            ov.y = pk_bf16(v[j].z * r * g.z, v[j].w * r * g.w);
            o[lane + 64 * j] = ov;
        }
    }
    float* T = (float*)shm;
    bf16_t* btin = (bf16_t*)(wsb + WS_BTIN);
    bf16_t* btout = (bf16_t*)(wsb + WS_BTOUT);
    bf16_t* btup = (bf16_t*)(wsb + WS_BTUP);
    bf16_t* btdn = (bf16_t*)(wsb + WS_BTDN);
    bf16_t* w1t = (bf16_t*)(wsb + WS_W1T);
    bf16_t* w2t = (bf16_t*)(wsb + WS_W2T);
    const auto ident = [](int c) { return c; };
    cv_run(T, 16 * 48, [&](int it, const float*& W, int& K, int& ncols, int& ldw, bf16_t*& WT, int& k0, int& n0) {
        W = p.w_in; K = DM; ncols = INC; ldw = INC; WT = btin; k0 = (it / 48) * 64; n0 = (it % 48) * 64; }, ident);
    cv_run(T, 16 * 16, [&](int it, const float*& W, int& K, int& ncols, int& ldw, bf16_t*& WT, int& k0, int& n0) {
        W = p.w_out; K = DM; ncols = DM; ldw = DM; WT = btout; k0 = (it >> 4) * 64; n0 = (it & 15) * 64; }, ident);
    cv_run(T, NE * 16 * 32, [&](int it, const float*& W, int& K, int& ncols, int& ldw, bf16_t*& WT, int& k0, int& n0) {
        const int e = it >> 9, r = it & 511;
        W = p.w_up + (size_t)e * DM * DFF2; K = DM; ncols = DFF2; ldw = DFF2; WT = btup + (size_t)e * DFF2 * DM; k0 = (r >> 5) * 64; n0 = (r & 31) * 64; },
        [](int c) { const int a = c >> 1, n = c & 1; return (a >> 4) * 32 + n * 16 + (a & 15); });
    cv_run(T, NE * 16 * 16, [&](int it, const float*& W, int& K, int& ncols, int& ldw, bf16_t*& WT, int& k0, int& n0) {
        const int e = it >> 8, r = it & 255;
        W = p.w_down + (size_t)e * DM * DM; K = DM; ncols = DM; ldw = DM; WT = btdn + (size_t)e * DM * DM; k0 = (r >> 4) * 64; n0 = (r & 15) * 64; }, ident);
    cv_run(T, 2 * 33, [&](int it, const float*& W, int& K, int& ncols, int& ldw, bf16_t*& WT, int& k0, int& n0) {
        const int kv = it / 33, r = it % 33;
        ncols = 64; ldw = 64; n0 = 0;
        if (r < 32) { W = kv ? p.w1v : p.w1k; K = 2048; WT = w1t + (size_t)kv * 64 * 2048; k0 = r * 64; }
        else        { W = kv ? p.w2v : p.w2k; K = 64;   WT = w2t + (size_t)kv * 64 * 64;   k0 = 0; } }, ident);
    __syncthreads();
    if (blockIdx.x == gridDim.x - 1) {
        const int o = tid & 127, part = tid >> 7, kv = o >> 6, n = o & 63;
        const float* pe = kv ? p.pe_v : p.pe_k;
        const float* w1 = kv ? p.w1v : p.w1k;
        float s = 0.f;
        for (int ff = part * 512; ff < part * 512 + 512; ++ff) s += pe[ff] * w1[ff * 64 + n];
        T[part * 128 + o] = s;
        __syncthreads();
        if (tid < 128) ((float*)(wsb + WS_C1))[tid] = T[tid] + T[128 + tid] + T[256 + tid] + T[384 + tid];
    }
    __syncthreads();
}

__device__ __forceinline__ void f_cmp(const Params& p, unsigned char* shm) {
    unsigned char* wsb = (unsigned char*)p.ws;
    const bf16_t* pt = (const bf16_t*)(wsb + WS_PT);
    const bf16_t* w1t = (const bf16_t*)(wsb + WS_W1T);
    const bf16_t* w2t = (const bf16_t*)(wsb + WS_W2T);
    const float* c1 = (const float*)(wsb + WS_C1);
    const int tid = threadIdx.x, lane = tid & 63, w = __builtin_amdgcn_readfirstlane(tid >> 6), fr = lane & 15, fq = lane >> 4;
    LAS float* part = (LAS float*)shm;
    LAS unsigned char* h1buf = (LAS unsigned char*)shm + 32768;
    for (int it = blockIdx.x; it < 512; it += gridDim.x) {
        const int rg = it & 31, g = (it >> 5) & 1, b = (it >> 6) & 3, kv = it >> 8;
        const int hg = (kv ? HG_VC : HG_KC) + g;
        const bf16_t* arow = pt + ((size_t)hg * NTOK + (size_t)b * SEQ + 16 * (16 * rg + fr)) * 64 + 8 * fq + 256 * w;
        const bf16_t* brow = w1t + ((size_t)kv * 64 + fr) * 2048 + 8 * fq + 256 * w;
        f32x4 acc[4];
#pragma unroll
        for (int nt = 0; nt < 4; ++nt) acc[nt] = (f32x4){0.f, 0.f, 0.f, 0.f};
#pragma unroll
        for (int kk = 0; kk < 8; ++kk) {
            const bf16x8 a = *(const bf16x8*)(arow + 32 * kk);
#pragma unroll
            for (int nt = 0; nt < 4; ++nt) {
                const bf16x8 bb = *(const bf16x8*)(brow + (size_t)nt * 16 * 2048 + 32 * kk);
                acc[nt] = __builtin_amdgcn_mfma_f32_16x16x32_bf16(a, bb, acc[nt], 0, 0, 0);
            }
        }
        __syncthreads();
#pragma unroll
        for (int nt = 0; nt < 4; ++nt)
#pragma unroll
            for (int reg = 0; reg < 4; ++reg) part[w * 1024 + (4 * fq + reg) * 64 + nt * 16 + fr] = acc[nt][reg];
        __syncthreads();
        {
#pragma unroll
            for (int q = 0; q < 2; ++q) {
                const int o = tid + 512 * q, row = o >> 6, col = o & 63;
                float s = c1[kv * 64 + col];
#pragma unroll
                for (int ww = 0; ww < 8; ++ww) s += part[ww * 1024 + o];
                *(LAS unsigned short*)(h1buf + row * 144 + col * 2) = (unsigned short)(pk_bf16(gelu_tanh(s), 0.f) & 0xffffu);
            }
        }
        __syncthreads();
        if (w == 0) {
            f32x4 acc2[4];
#pragma unroll
            for (int nt = 0; nt < 4; ++nt) acc2[nt] = (f32x4){0.f, 0.f, 0.f, 0.f};
#pragma unroll
            for (int k2 = 0; k2 < 2; ++k2) {
                const bf16x8 a2 = *(LAS const bf16x8*)(h1buf + fr * 144 + (32 * k2 + 8 * fq) * 2);
#pragma unroll
                for (int nt = 0; nt < 4; ++nt) {
                    const bf16x8 b2 = *(const bf16x8*)(w2t + ((size_t)kv * 64 + nt * 16 + fr) * 64 + 32 * k2 + 8 * fq);
                    acc2[nt] = __builtin_amdgcn_mfma_f32_16x16x32_bf16(a2, b2, acc2[nt], 0, 0, 0);
                }
            }
            bf16_t* dst = (bf16_t*)(wsb + (kv ? WS_VCMP : WS_KCMP)) + (size_t)((b * 2 + g) * NCMPP + 16 * rg) * 64;
#pragma unroll
            for (int nt = 0; nt < 4; ++nt)
#pragma unroll
                for (int reg = 0; reg < 4; ++reg)
                    dst[(size_t)(4 * fq + reg) * 64 + nt * 16 + fr] = (bf16_t)(pk_bf16(acc2[nt][reg], 0.f) & 0xffffu);
        }
    }
    __syncthreads();
}

__device__ __forceinline__ void f_inproj(const Params& p, unsigned char* shm) {
    unsigned char* wsb = (unsigned char*)p.ws;
    const bf16_t* xn = (const bf16_t*)(wsb + WS_XN);
    const bf16_t* btin = (const bf16_t*)(wsb + WS_BTIN);
    bf16_t* pt = (bf16_t*)(wsb + WS_PT);
    float* gates = (float*)(wsb + WS_GATES);
    float* kmean = (float*)(wsb + WS_KMEAN);
    const int tid = threadIdx.x, wid = __builtin_amdgcn_readfirstlane(tid >> 6), lane = tid & 63, wr = wid >> 2, wc = wid & 3;
    constexpr int NTN = NIN_PAD / 256;
    gemm256_stream((LAS unsigned char*)shm,
        [&](int i, const char*& A, const char*& B, unsigned (&va)[2][2], const GPiece& pc) __attribute__((always_inline)) {
            const int it = blockIdx.x + i * gridDim.x;
            if (it >= (NTOK / 256) * NTN) return false;
            const int pm = it / NTN, pn = it % NTN;
            A = (const char*)xn;
            B = (const char*)(btin + (size_t)pn * 256 * DM);
#pragma unroll
            for (int h = 0; h < 2; ++h)
#pragma unroll
                for (int j = 0; j < 2; ++j) va[h][j] = (unsigned)((pm * 256 + h * 128 + pc.R[j]) * DM + pc.C[j]) * 2u;
            return true;
        },
        [&](int i, f32x4 (&acc)[2][2][4][2]) __attribute__((always_inline)) {
        const int it = blockIdx.x + i * gridDim.x;
        const int pm = it / NTN, pn = it % NTN;
        int le = lane;
        asm volatile("" : "+v"(le));
        const int er = le & 15, eq = le >> 4;
        if (pn < 11) {
#pragma unroll
            for (int bj = 0; bj < 2; ++bj) {
                const int hg = pn * 4 + bj * 2 + (wc >> 1);
                const float sc = (hg < 8 || (hg >= 24 && hg < 32)) ? QSCALE : 1.0f;
                bf16_t* base = pt + ((size_t)hg * NTOK + pm * 256 + wr * 64) * 64 + (wc & 1) * 32;
#pragma unroll
                for (int ai = 0; ai < 2; ++ai)
#pragma unroll
                    for (int m = 0; m < 4; ++m)
#pragma unroll
                        for (int n = 0; n < 2; ++n) {
                            const f32x4 a = acc[ai][bj][m][n];
                            u32x2 ov;
                            ov.x = pk_bf16(a[0] * sc, a[1] * sc);
                            ov.y = pk_bf16(a[2] * sc, a[3] * sc);
                            *(u32x2*)(base + (size_t)(ai * 128 + m * 16 + er) * 64 + n * 16 + eq * 4) = ov;
                        }
                if (hg >= HG_MK && hg < HG_MK + 8) {
                    const int b = (pm * 256) / SEQ, nblk = ((pm * 256) % SEQ) >> 8, h = hg - HG_MK;
                    float* kb = kmean + (size_t)((b * 8 + h) * 32 + nblk) * 64 + (wc & 1) * 32;
#pragma unroll
                    for (int n = 0; n < 2; ++n) {
                        f32x4 s = acc[0][bj][0][n];
#pragma unroll
                        for (int m = 1; m < 4; ++m) s += acc[0][bj][m][n];
#pragma unroll
                        for (int m = 0; m < 4; ++m) s += acc[1][bj][m][n];
#pragma unroll
                        for (int o = 1; o < 16; o <<= 1) {
                            s[0] += __shfl_xor(s[0], o);
                            s[1] += __shfl_xor(s[1], o);
                            s[2] += __shfl_xor(s[2], o);
                            s[3] += __shfl_xor(s[3], o);
                        }
                        if (er == 0) {
                            float* d = kb + n * 16 + eq * 4;
                            unsafeAtomicAdd(d + 0, s[0]);
                            unsafeAtomicAdd(d + 1, s[1]);
                            unsafeAtomicAdd(d + 2, s[2]);
                            unsafeAtomicAdd(d + 3, s[3]);
                        }
                    }
                }
            }
        } else if (wc == 0) {
#pragma unroll
            for (int n = 0; n < 2; ++n) {
                const int gc = n * 16 + eq * 4;
                if (gc < 24) {
#pragma unroll
                    for (int ai = 0; ai < 2; ++ai)
#pragma unroll
                        for (int m = 0; m < 4; ++m) {
                            const f32x4 a = acc[ai][0][m][n];
                            const int row = pm * 256 + ai * 128 + wr * 64 + m * 16 + er;
                            f32x4 sg;
                            sg[0] = 1.0f / (1.0f + __expf(-a[0]));
                            sg[1] = 1.0f / (1.0f + __expf(-a[1]));
                            sg[2] = 1.0f / (1.0f + __expf(-a[2]));
                            sg[3] = 1.0f / (1.0f + __expf(-a[3]));
                            *(f32x4*)(gates + (size_t)row * 24 + gc) = sg;
                        }
                }
            }
        }
    });
    __syncthreads();
}

__device__ __forceinline__ void f_outproj(const Params& p, unsigned char* shm) {
    unsigned char* wsb = (unsigned char*)p.ws;
    const bf16_t* mixb = (const bf16_t*)(wsb + WS_MIXB);
    const bf16_t* btout = (const bf16_t*)(wsb + WS_BTOUT);
    const int tid = threadIdx.x, wid = __builtin_amdgcn_readfirstlane(tid >> 6), lane = tid & 63, wr = wid >> 2, wc = wid & 3;
    gemm256_stream((LAS unsigned char*)shm,
        [&](int i, const char*& A, const char*& B, unsigned (&va)[2][2], const GPiece& pc) __attribute__((always_inline)) {
            const int it = blockIdx.x + i * gridDim.x;
            if (it >= (NTOK / 256) * 4) return false;
            const int pm = it >> 2, pn = it & 3;
            A = (const char*)mixb;
            B = (const char*)(btout + (size_t)pn * 256 * DM);
#pragma unroll
            for (int h = 0; h < 2; ++h)
#pragma unroll
                for (int j = 0; j < 2; ++j) va[h][j] = (unsigned)((pm * 256 + h * 128 + pc.R[j]) * DM + pc.C[j]) * 2u;
            return true;
        },
        [&](int i, f32x4 (&acc)[2][2][4][2]) __attribute__((always_inline)) {
        const int it = blockIdx.x + i * gridDim.x;
        const int pm = it >> 2, pn = it & 3;
        int le = lane;
        asm volatile("" : "+v"(le));
        const int er = le & 15, eq = le >> 4;
#pragma unroll
        for (int ai = 0; ai < 2; ++ai)
#pragma unroll
            for (int m = 0; m < 4; ++m) {
                const size_t rowoff = (size_t)(pm * 256 + ai * 128 + wr * 64 + m * 16 + er) * DM;
#pragma unroll
                for (int bj = 0; bj < 2; ++bj)
#pragma unroll
                    for (int n = 0; n < 2; ++n) {
                        const size_t o = rowoff + pn * 256 + bj * 128 + wc * 32 + n * 16 + eq * 4;
                        const f32x4 xv = *(const f32x4*)(p.x + o);
                        *(f32x4*)(p.out + o) = xv + acc[ai][bj][m][n];
                    }
            }
    });
    __syncthreads();
}

__device__ __forceinline__ float wave_max_fast(float x) {
    x = fmaxf(x, __int_as_float(__builtin_amdgcn_mov_dpp(__float_as_int(x), 0xB1, 0xF, 0xF, true)));
    x = fmaxf(x, __int_as_float(__builtin_amdgcn_mov_dpp(__float_as_int(x), 0x4E, 0xF, 0xF, true)));
    x = fmaxf(x, __int_as_float(__builtin_amdgcn_mov_dpp(__float_as_int(x), 0x141, 0xF, 0xF, true)));
    x = fmaxf(x, __int_as_float(__builtin_amdgcn_mov_dpp(__float_as_int(x), 0x140, 0xF, 0xF, true)));
    x = fmaxf(x, __shfl_xor(x, 16));
    x = fmaxf(x, __shfl_xor(x, 32));
    return x;
}
__device__ __forceinline__ void f_router(const Params& p, unsigned char* shm) {
    const int tid = threadIdx.x, lane = tid & 63, w = tid >> 6;
    unsigned char* wsb = (unsigned char*)p.ws;
    float* Wl = (float*)shm;
    int* hist = (int*)(shm + 147456);
    bf16_t* hb = (bf16_t*)(wsb + WS_H);
    int* sele = (int*)(wsb + WS_SELE);
    float* selw = (float*)(wsb + WS_SELW);
    int* selr = (int*)(wsb + WS_SELR);
    int* bcnt = (int*)(wsb + WS_BCNT);
    __syncthreads();
    for (int idx = tid; idx < 8192; idx += 512) {
        const int k = idx >> 3, e4 = idx & 7;
        const float4 v = ((const float4*)p.w_router)[idx];
        const int rho = ((k >> 8) * 4 + (k & 3)) * 64 + ((k >> 2) & 63);
        *(float4*)(Wl + rho * 36 + e4 * 4) = v;
    }
    const float bias = p.b_router[lane >> 1];
    const float4* g4 = (const float4*)p.ffn_g;
    float4 gv[4];
#pragma unroll
    for (int j = 0; j < 4; ++j) gv[j] = g4[lane + 64 * j];
    for (int c = blockIdx.x; c < NTOK / 128; c += gridDim.x) {
        __syncthreads();
        if (tid < 32) hist[tid] = 0;
        __syncthreads();
        float4 vn[4];
        {
            const float4* xr = (const float4*)(p.out + (size_t)(c * 128 + w * 16) * DM);
#pragma unroll
            for (int j = 0; j < 4; ++j) vn[j] = xr[lane + 64 * j];
        }
        for (int rr = 0; rr < 16; ++rr) {
            const int row = c * 128 + w * 16 + rr;
            float4 v[4];
#pragma unroll
            for (int j = 0; j < 4; ++j) v[j] = vn[j];
            if (rr + 1 < 16) {
                const float4* xr = (const float4*)(p.out + (size_t)(row + 1) * DM);
#pragma unroll
                for (int j = 0; j < 4; ++j) vn[j] = xr[lane + 64 * j];
            }
            float ss = 0.f;
#pragma unroll
            for (int j = 0; j < 4; ++j) ss += dot4(v[j], v[j]);
            ss = wave_sum(ss);
            const float r = 1.0f / sqrtf(ss * (1.0f / DM) + 1e-5f);
            u32x2* o = (u32x2*)(hb + (size_t)row * DM);
#pragma unroll
            for (int j = 0; j < 4; ++j) {
                v[j] = make_float4(v[j].x * r * gv[j].x, v[j].y * r * gv[j].y, v[j].z * r * gv[j].z, v[j].w * r * gv[j].w);
                u32x2 ov;
                ov.x = pk_bf16(v[j].x, v[j].y);
                ov.y = pk_bf16(v[j].z, v[j].w);
                o[lane + 64 * j] = ov;
            }
            float lg[32];
#pragma unroll
            for (int e = 0; e < 32; ++e) lg[e] = 0.f;
#pragma unroll
            for (int j = 0; j < 4; ++j) {
                const float hv[4] = {v[j].x, v[j].y, v[j].z, v[j].w};
#pragma unroll
                for (int cc = 0; cc < 4; ++cc) {
                    const float4* wr = (const float4*)(Wl + ((j * 4 + cc) * 64 + lane) * 36);
#pragma unroll
                    for (int e4 = 0; e4 < 8; ++e4) {
                        const float4 wv = wr[e4];
                        lg[e4 * 4 + 0] += hv[cc] * wv.x;
                        lg[e4 * 4 + 1] += hv[cc] * wv.y;
                        lg[e4 * 4 + 2] += hv[cc] * wv.z;
                        lg[e4 * 4 + 3] += hv[cc] * wv.w;
                    }
                }
            }
#define RS_STEP(N, OFF, BIT)                                                                                           \
            {                                                                                                          \
                const bool up_ = (lane >> (BIT)) & 1;                                                                  \
                _Pragma("unroll") for (int i_ = 0; i_ < (N); ++i_) {                                                     \
                    const float send_ = up_ ? lg[i_] : lg[(N) + i_];                                                   \
                    const float keep_ = up_ ? lg[(N) + i_] : lg[i_];                                                   \
                    lg[i_] = keep_ + __shfl_xor(send_, (OFF));                                                         \
                }                                                                                                      \
            }
            RS_STEP(16, 32, 5)
            RS_STEP(8, 16, 4)
            RS_STEP(4, 8, 3)
            RS_STEP(2, 4, 2)
            RS_STEP(1, 2, 1)
#undef RS_STEP
            float val = lg[0] + __shfl_xor(lg[0], 1) + bias;
            float tv[4];
            int ti[4];
#pragma unroll
            for (int s = 0; s < 4; ++s) {
                const float mx = wave_max_fast(val);
                const unsigned long long bal = __ballot(val == mx);
                const int ln = __ffsll((long long)bal) - 1;
                tv[s] = mx;
                ti[s] = ln >> 1;
                if ((lane >> 1) == (ln >> 1)) val = -INFINITY;
            }
            const float e1 = __expf(tv[1] - tv[0]), e2 = __expf(tv[2] - tv[0]), e3 = __expf(tv[3] - tv[0]);
            const float inv = 1.0f / (1.0f + e1 + e2 + e3);
            if (lane == 0) {
                const float wv[4] = {inv, e1 * inv, e2 * inv, e3 * inv};
#pragma unroll
                for (int s = 0; s < 4; ++s) {
                    sele[row * 4 + s] = ti[s];
                    selw[row * 4 + s] = wv[s];
                    selr[row * 4 + s] = atomicAdd(&hist[ti[s]], 1);
                }
            }
        }
        __syncthreads();
        if (tid < 32) bcnt[c * 32 + tid] = hist[tid];
    }
    __syncthreads();
}

__device__ __forceinline__ void f_fill(const Params& p, unsigned char* shm) {
    const int tid = threadIdx.x;
    unsigned char* wsb = (unsigned char*)p.ws;
    const int* sele = (const int*)(wsb + WS_SELE);
    const float* selw = (const float*)(wsb + WS_SELW);
    const int* selr = (const int*)(wsb + WS_SELR);
    int* selp = (int*)(wsb + WS_SELP);
    const int* bcnt = (const int*)(wsb + WS_BCNT);
    int* gcnt = (int*)(wsb + WS_GCNT);
    int* rtok = (int*)(wsb + WS_RTOK);
    float* rw = (float*)(wsb + WS_RW);
    int* pa = (int*)shm;
    int* pb = pa + 512;
    int* tot = pb + 512;
    int* base = tot + 32;
    int* pstart = base + 32;
    for (int c = blockIdx.x; c < NTOK / 128; c += gridDim.x) {
        __syncthreads();
        {
            const int e = tid & 31, part = tid >> 5;
            int sa = 0, sb = 0;
            for (int cc = part * 16; cc < part * 16 + 16; ++cc) {
                const int v = bcnt[cc * 32 + e];
                sa += v;
                sb += (cc < c) ? v : 0;
            }
            pa[part * 32 + e] = sa;
            pb[part * 32 + e] = sb;
        }
        __syncthreads();
        if (tid < 32) {
            int sa = 0, sb = 0;
            for (int q = 0; q < 16; ++q) { sa += pa[q * 32 + tid]; sb += pb[q * 32 + tid]; }
            tot[tid] = sa;
            base[tid] = sb;
        }
        __syncthreads();
        if (tid == 0) {
            int a = 0;
            for (int e = 0; e < NE; ++e) { pstart[e] = a; a += ((tot[e] + 255) >> 8) << 8; }
            pstart[NE] = a;
        }
        __syncthreads();
        {
            const int i = c * 512 + tid;
            const int e = sele[i];
            const int pos = pstart[e] + base[e] + selr[i];
            rtok[pos] = i >> 2;
            rw[pos] = selw[i];
            selp[i] = pos;
        }
        if (c == 0) {
            if (tid < 32) gcnt[tid] = tot[tid];
            for (int e = 0; e < NE; ++e) {
                const int r0 = pstart[e] + tot[e], r1 = pstart[e + 1];
                for (int r = r0 + tid; r < r1; r += 512) { rtok[r] = 0; rw[r] = 0.f; }
            }
        }
    }
    __syncthreads();
}

__device__ __forceinline__ void f_build_tiles(const Params& p, int* tb) {
    const int* gcnt = (const int*)((unsigned char*)p.ws + WS_GCNT);
    __syncthreads();
    if (threadIdx.x == 0) {
        int a = 0, t = 0;
        for (int e = 0; e < NE; ++e) {
            tb[e] = a;
            tb[40 + e] = t;
            const int nt = (gcnt[e] + 255) >> 8;
            a += nt << 8;
            t += nt;
        }
        tb[32] = a;
        tb[40 + 32] = t;
    }
    __syncthreads();
}

__device__ __forceinline__ void f_up(const Params& p, unsigned char* shm) {
    unsigned char* wsb = (unsigned char*)p.ws;
    int* tb = (int*)(shm + GEMM_LDS_BYTES);
    f_build_tiles(p, tb);
    const int T = tb[40 + 32];
    const bf16_t* hb = (const bf16_t*)(wsb + WS_H);
    const bf16_t* btup = (const bf16_t*)(wsb + WS_BTUP);
    bf16_t* act = (bf16_t*)(wsb + WS_ACT);
    const int* rtok = (const int*)(wsb + WS_RTOK);
    const int tid = threadIdx.x, wid = __builtin_amdgcn_readfirstlane(tid >> 6), lane = tid & 63, wr = wid >> 2, wc = wid & 3;
    gemm256_stream((LAS unsigned char*)shm,
        [&](int i, const char*& A, const char*& B, unsigned (&va)[2][2], const GPiece& pc) __attribute__((always_inline)) {
            const int it = blockIdx.x + i * gridDim.x;
            if (it >= T * 8) return false;
            const int vt = it >> 3, pn = it & 7;
            int e = 0;
            while (tb[40 + e + 1] <= vt) ++e;
            const int rowbase = tb[e] + (vt - tb[40 + e]) * 256;
            A = (const char*)hb;
            B = (const char*)(btup + ((size_t)e * DFF2 + pn * 256) * DM);
#pragma unroll
            for (int h = 0; h < 2; ++h)
#pragma unroll
                for (int j = 0; j < 2; ++j) va[h][j] = (unsigned)(rtok[rowbase + h * 128 + pc.R[j]] * DM + pc.C[j]) * 2u;
            return true;
        },
        [&](int i, f32x4 (&acc)[2][2][4][2]) __attribute__((always_inline)) {
        const int it = blockIdx.x + i * gridDim.x;
        const int vt = it >> 3, pn = it & 7;
        int e = 0;
        while (tb[40 + e + 1] <= vt) ++e;
        const int rowbase = tb[e] + (vt - tb[40 + e]) * 256;
        int le = lane;
        asm volatile("" : "+v"(le));
        const int er = le & 15, eq = le >> 4;
        const float* bias = p.b_up + (size_t)e * DFF2;
#pragma unroll
        for (int bj = 0; bj < 2; ++bj) {
            const int a0 = (pn * 8 + bj * 4 + wc) * 16 + eq * 4;
            const float4 blo = *(const float4*)(bias + 2 * a0), bhi = *(const float4*)(bias + 2 * a0 + 4);
#pragma unroll
            for (int ai = 0; ai < 2; ++ai)
#pragma unroll
                for (int m = 0; m < 4; ++m) {
                    const int row = rowbase + ai * 128 + wr * 64 + m * 16 + er;
                    const f32x4 g = acc[ai][bj][m][0], u = acc[ai][bj][m][1];
                    u32x2 ov;
                    ov.x = pk_bf16(swiglu(g[0] + blo.x, u[0] + blo.y), swiglu(g[1] + blo.z, u[1] + blo.w));
                    ov.y = pk_bf16(swiglu(g[2] + bhi.x, u[2] + bhi.y), swiglu(g[3] + bhi.z, u[3] + bhi.w));
                    *(u32x2*)(act + (size_t)row * DM + a0) = ov;
                }
        }
    });
    __syncthreads();
}

__device__ __forceinline__ void f_down(const Params& p, unsigned char* shm) {
    unsigned char* wsb = (unsigned char*)p.ws;
    int* tb = (int*)(shm + GEMM_LDS_BYTES);
    f_build_tiles(p, tb);
    const int T = tb[40 + 32];
    const bf16_t* act = (const bf16_t*)(wsb + WS_ACT);
    const bf16_t* btdn = (const bf16_t*)(wsb + WS_BTDN);
    bf16_t* yb = (bf16_t*)(wsb + WS_Y);
    const float* rw = (const float*)(wsb + WS_RW);
    const int tid = threadIdx.x, wid = __builtin_amdgcn_readfirstlane(tid >> 6), lane = tid & 63, wr = wid >> 2, wc = wid & 3;
    gemm256_stream((LAS unsigned char*)shm,
        [&](int i, const char*& A, const char*& B, unsigned (&va)[2][2], const GPiece& pc) __attribute__((always_inline)) {
            const int it = blockIdx.x + i * gridDim.x;
            if (it >= T * 4) return false;
            const int vt = it >> 2, pn = it & 3;
            int e = 0;
            while (tb[40 + e + 1] <= vt) ++e;
            const int rowbase = tb[e] + (vt - tb[40 + e]) * 256;
            A = (const char*)(act + (size_t)rowbase * DM);
            B = (const char*)(btdn + ((size_t)e * DM + pn * 256) * DM);
#pragma unroll
            for (int h = 0; h < 2; ++h)
#pragma unroll
                for (int j = 0; j < 2; ++j) va[h][j] = (unsigned)((h * 128 + pc.R[j]) * DM + pc.C[j]) * 2u;
            return true;
        },
        [&](int i, f32x4 (&acc)[2][2][4][2]) __attribute__((always_inline)) {
        const int it = blockIdx.x + i * gridDim.x;
        const int vt = it >> 2, pn = it & 3;
        int e = 0;
        while (tb[40 + e + 1] <= vt) ++e;
        const int rowbase = tb[e] + (vt - tb[40 + e]) * 256;
        int le = lane;
        asm volatile("" : "+v"(le));
        const int er = le & 15, eq = le >> 4;
        const float* bias = p.b_down + (size_t)e * DM;
#pragma unroll
        for (int ai = 0; ai < 2; ++ai)
#pragma unroll
            for (int m = 0; m < 4; ++m) {
                const int row = rowbase + ai * 128 + wr * 64 + m * 16 + er;
                const float wgt = rw[row];
#pragma unroll
                for (int bj = 0; bj < 2; ++bj)
#pragma unroll
                    for (int n = 0; n < 2; ++n) {
                        const int col = pn * 256 + bj * 128 + wc * 32 + n * 16 + eq * 4;
                        const float4 bv = *(const float4*)(bias + col);
                        const f32x4 a = acc[ai][bj][m][n];
                        u32x2 ov;
                        ov.x = pk_bf16((a[0] + bv.x) * wgt, (a[1] + bv.y) * wgt);
                        ov.y = pk_bf16((a[2] + bv.z) * wgt, (a[3] + bv.w) * wgt);
                        *(u32x2*)(yb + (size_t)row * DM + col) = ov;
                    }
            }
    });
    __syncthreads();
}


__device__ __forceinline__ void f_final(const Params& p) {
    const int lane = threadIdx.x & 63, w = threadIdx.x >> 6;
    unsigned char* wsb = (unsigned char*)p.ws;
    const bf16_t* yb = (const bf16_t*)(wsb + WS_Y);
    const int* selp = (const int*)(wsb + WS_SELP);
    const float4* g4 = (const float4*)p.final_g;
    for (int row0 = blockIdx.x * 8 + w; row0 < NTOK / 2; row0 += gridDim.x * 8) {
        float4 v[2][4];
        u32x2 yv[2][4][4];
#pragma unroll
        for (int q = 0; q < 2; ++q) {
            const int row = row0 + q * (NTOK / 2);
            const float4* xr = (const float4*)(p.out + (size_t)row * DM);
            const int4 sp = *(const int4*)(selp + row * 4);
            const int pos[4] = {sp.x, sp.y, sp.z, sp.w};
#pragma unroll
            for (int j = 0; j < 4; ++j) v[q][j] = xr[lane + 64 * j];
#pragma unroll
            for (int k = 0; k < 4; ++k) {
                const u32x2* yr = (const u32x2*)(yb + (size_t)pos[k] * DM);
#pragma unroll
                for (int j = 0; j < 4; ++j) yv[q][k][j] = yr[lane + 64 * j];
            }
        }
#pragma unroll
        for (int q = 0; q < 2; ++q) {
            const int row = row0 + q * (NTOK / 2);
#pragma unroll
            for (int k = 0; k < 4; ++k)
#pragma unroll
                for (int j = 0; j < 4; ++j) {
                    v[q][j].x += bf_lo(yv[q][k][j].x);
                    v[q][j].y += bf_hi(yv[q][k][j].x);
                    v[q][j].z += bf_lo(yv[q][k][j].y);
                    v[q][j].w += bf_hi(yv[q][k][j].y);
                }
            float ss = 0.f;
#pragma unroll
            for (int j = 0; j < 4; ++j) ss += dot4(v[q][j], v[q][j]);
            ss = wave_sum(ss);
            const float r = 1.0f / sqrtf(ss * (1.0f / DM) + 1e-5f);
            float4* xo = (float4*)(p.out + (size_t)row * DM);
#pragma unroll
            for (int j = 0; j < 4; ++j) {
                const float4 g = g4[lane + 64 * j];
                xo[lane + 64 * j] = make_float4(v[q][j].x * r * g.x, v[q][j].y * r * g.y, v[q][j].z * r * g.z, v[q][j].w * r * g.w);
            }
        }
    }
}
#define XB_TMO      128
#define XB_XCNT(j)  (256  + 64 * (j))
#define XB_XSUB(j)  (1280 + 64 * (j))
#define XB_XGEN(j)  (2304 + 64 * (j))
#define XB_TOP      3328
#define XB_TOPGEN   3392
#define XCD_BAR_WORDS 3456
#define XB_SPIN_CAP (1u << 18)

__device__ __forceinline__ unsigned xb_ld(unsigned* p)              { return __hip_atomic_load(p, __ATOMIC_RELAXED, __HIP_MEMORY_SCOPE_AGENT); }
__device__ __forceinline__ unsigned xb_add(unsigned* p, unsigned v) { return __hip_atomic_fetch_add(p, v, __ATOMIC_RELAXED, __HIP_MEMORY_SCOPE_AGENT); }
__device__ __forceinline__ unsigned xb_xcc_id() { return (unsigned)__builtin_amdgcn_s_getreg((3 << 11) | 20) & 0xFu; }
#define XB_SPIN(cond, bar) do { unsigned _sp = 0; while (cond) { __builtin_amdgcn_s_sleep(1); \
    if ((++_sp & 255u) == 0u) { if (xb_ld(&(bar)[XB_TMO])) break; if (_sp > XB_SPIN_CAP) { atomicAdd(&(bar)[XB_TMO], 1u); break; } } } } while (0)

struct XcdBarrier {
    unsigned* bar; unsigned x;
    volatile LAS unsigned* st;
};

__device__ __forceinline__ XcdBarrier xcd_barrier_post(unsigned* bar, volatile LAS unsigned* st) {
    XcdBarrier b; b.bar = bar; b.x = xb_xcc_id(); b.st = st;
    if (threadIdx.x == 0) (void)xb_add(&bar[XB_XCNT(b.x)], 1u);
    return b;
}
__device__ __forceinline__ void xcd_barrier_complete(unsigned* bar, unsigned x, unsigned& nloc, unsigned& nx) {
    const unsigned G = gridDim.x * gridDim.y * gridDim.z;
    unsigned sum, cnt, mine, sp = 0u;
    for (;;) {
        sum = 0u; cnt = 0u; mine = 0u;
#pragma unroll
        for (unsigned j = 0; j < 16; ++j) { const unsigned c = xb_ld(&bar[XB_XCNT(j)]); sum += c; cnt += (c > 0u) ? 1u : 0u; mine = (j == x) ? c : mine; }
        if (sum == G) break;
        __builtin_amdgcn_s_sleep(1);
        if ((++sp & 255u) == 0u) { if (xb_ld(&bar[XB_TMO])) break; if (sp > XB_SPIN_CAP) { atomicAdd(&bar[XB_TMO], 1u); break; } }
    }
    nloc = mine > 0u ? mine : 1u; nx = cnt > 0u ? cnt : 1u;
}

__device__ __forceinline__ void xcd_barrier(const XcdBarrier& b) {
    asm volatile("s_waitcnt vmcnt(0)" ::: "memory");
    __syncthreads();
    if (threadIdx.x == 0) {
        unsigned* bar = b.bar;
        __builtin_amdgcn_s_waitcnt(0);
        unsigned nloc = b.st[0], nx = b.st[1];
        if (nloc == 0u) { xcd_barrier_complete(bar, b.x, nloc, nx); b.st[0] = nloc; b.st[1] = nx; }
        const unsigned old = xb_add(&bar[XB_XSUB(b.x)], 1u);
        const unsigned gen = old / nloc;
        if (old + 1u == (gen + 1u) * nloc) {
            __builtin_amdgcn_fence(__ATOMIC_RELEASE, "agent");
            asm volatile("s_waitcnt vmcnt(0)" ::: "memory");
            const unsigned og = xb_add(&bar[XB_TOP], 1u);
            const unsigned tg = og / nx;
            if (og + 1u == (tg + 1u) * nx) xb_add(&bar[XB_TOPGEN], 1u);
            else XB_SPIN(xb_ld(&bar[XB_TOPGEN]) == tg, bar);
            __builtin_amdgcn_fence(__ATOMIC_ACQUIRE, "agent");
            xb_add(&bar[XB_XGEN(b.x)], 1u);
            asm volatile("s_waitcnt vmcnt(0)" ::: "memory");
        } else {
            XB_SPIN(xb_ld(&bar[XB_XGEN(b.x)]) == gen, bar);
            __builtin_amdgcn_fence(__ATOMIC_ACQUIRE, "agent");
            asm volatile("s_waitcnt vmcnt(0)" ::: "memory");
        }
    }
    __syncthreads();
}


constexpr int NFPHASE = 11;
__global__ void __launch_bounds__(512) fast_kernel(Params p) {
    extern __shared__ __attribute__((aligned(16))) unsigned char shm[];
    cg::grid_group grid = cg::this_grid();
    const int lo = p.ph_lo, hi = p.ph_hi;
    if (lo < -1) grid.sync();
    XcdBarrier bar;
    if (hi - lo > 1) {
        volatile LAS unsigned* st = (volatile LAS unsigned*)((LAS unsigned char*)shm + (FAST_LDS_BYTES - 16));
        if (threadIdx.x < 4) st[threadIdx.x] = 0u;
        __syncthreads();
        bar = xcd_barrier_post((unsigned*)((unsigned char*)p.ws + WS_BAR), st);
    }
#define F_IN(k) (lo <= (k) && (k) < hi)
#define F_SYNC(k) do { if (F_IN(k) && F_IN((k) + 1)) xcd_barrier(bar); } while (0)
    if (F_IN(0)) f_prologue(p, shm);
    F_SYNC(0);
    if (F_IN(1)) f_inproj(p, shm);
    F_SYNC(1);
    if (F_IN(2)) { f_cmp(p, shm); f_moba_gate(p, shm); }
    F_SYNC(2);
    if (F_IN(3)) f_attn(p, shm);
    F_SYNC(3);
    if (F_IN(4)) f_moba_merge(p);
    F_SYNC(4);
    if (F_IN(5)) f_outproj(p, shm);
    F_SYNC(5);
    if (F_IN(6)) f_router(p, shm);
    F_SYNC(6);
    if (F_IN(7)) f_fill(p, shm);
    F_SYNC(7);
    if (F_IN(8)) f_up(p, shm);
    F_SYNC(8);
    if (F_IN(9)) f_down(p, shm);
    F_SYNC(9);
    if (F_IN(10)) f_final(p);
}

#ifndef MULTI_LAUNCH
#define MULTI_LAUNCH 0
#endif

extern "C" void kernel_launch(void* const* d_in, const int* in_sizes, int n_in, void* d_out, int out_size, void* d_ws,
                              size_t ws_size, hipStream_t stream) {
    static int grid = 0;
    if (!grid) {
        int dev = 0, cus = 0, per_cu = 0;
        (void)hipGetDevice(&dev);
        (void)hipDeviceGetAttribute(&cus, hipDeviceAttributeMultiprocessorCount, dev);
        (void)hipFuncSetAttribute((const void*)fast_kernel, hipFuncAttributeMaxDynamicSharedMemorySize, FAST_LDS_BYTES);
        (void)hipOccupancyMaxActiveBlocksPerMultiprocessor(&per_cu, fast_kernel, 512, FAST_LDS_BYTES);
        if (per_cu < 1) fprintf(stderr, "kernel_launch: occupancy query reports %d blocks per CU\n", per_cu);
        grid = cus;
        if (ws_size < WS_END) fprintf(stderr, "kernel_launch: workspace too small: %zu < %zu\n", ws_size, (size_t)WS_END);
    }
    Params p{};
    p.x = (const float*)d_in[0];
    p.attn_g = (const float*)d_in[1];
    p.w_in = (const float*)d_in[2];
    p.pe_k = (const float*)d_in[3];
    p.pe_v = (const float*)d_in[4];
    p.w1k = (const float*)d_in[5];
    p.w2k = (const float*)d_in[6];
    p.w1v = (const float*)d_in[7];
    p.w2v = (const float*)d_in[8];
    p.w_out = (const float*)d_in[9];
    p.ffn_g = (const float*)d_in[10];
    p.w_router = (const float*)d_in[11];
    p.b_router = (const float*)d_in[12];
    p.w_up = (const float*)d_in[13];
    p.b_up = (const float*)d_in[14];
    p.w_down = (const float*)d_in[15];
    p.b_down = (const float*)d_in[16];
    p.final_g = (const float*)d_in[17];
    p.out = (float*)d_out;
    p.ws = (float*)d_ws;
#if MULTI_LAUNCH
#ifndef PROBE_DUP_MASK
#define PROBE_DUP_MASK 0
#endif
    for (int ph = 0; ph < NFPHASE; ++ph) {
        const int reps = ((PROBE_DUP_MASK >> ph) & 1) ? 2 : 1;
        for (int r = 0; r < reps; ++r) {
            p.ph_lo = ph;
            p.ph_hi = ph + 1;
            hipLaunchKernelGGL(fast_kernel, dim3(grid), dim3(512), FAST_LDS_BYTES, stream, p);
        }

    }
#else
    p.ph_lo = 0;
    p.ph_hi = NFPHASE;
    (void)hipMemsetAsync((unsigned char*)d_ws + WS_BAR, 0, 16384, stream);
    void* args[] = {&p};
    hipError_t e = hipLaunchCooperativeKernel((void*)fast_kernel, dim3(grid), dim3(512), args, FAST_LDS_BYTES, stream);
    if (e != hipSuccess) fprintf(stderr, "cooperative launch failed: %s (grid %d)\n", hipGetErrorString(e), grid);
#endif
}
```

```cpp
#include <hip/hip_runtime.h>
#include <hip/hip_cooperative_groups.h>
#include <cstdio>
#include <cstdint>
namespace cg = cooperative_groups;

constexpr int NB = 4, SEQ = 8192, DM = 1024, NTOK = NB * SEQ;
constexpr int INC = 2840;
constexpr int NCMP = 511, NCMPP = 512;
constexpr int NE = 32, TOPK = 4, NK = NTOK * TOPK;
constexpr int DFF2 = 2048;
constexpr int NIN_PAD = 3072;
constexpr int PMAX = 139264;
constexpr float LOG2E = 1.4426950408889634f;
constexpr float QSCALE = 0.125f * LOG2E;
constexpr int HG_MQ = 0, HG_MK = 8, HG_MV = 16, HG_NQ = 24, HG_KC = 32, HG_VC = 34, HG_KS = 36, HG_VS = 38, HG_KW = 40,
              HG_VW = 42, NHG = 44;

constexpr size_t WS_BTUP  = 0;
constexpr size_t WS_BTDN  = WS_BTUP + (size_t)NE * DFF2 * DM * 2;
constexpr size_t WS_BTOUT = WS_BTDN + (size_t)NE * DM * DM * 2;
constexpr size_t WS_BTIN  = WS_BTOUT + (size_t)DM * DM * 2;
constexpr size_t WS_XN    = WS_BTIN + (size_t)NIN_PAD * DM * 2;
constexpr size_t WS_H     = WS_XN;
constexpr size_t WS_PT    = WS_XN + (size_t)NTOK * DM * 2;
constexpr size_t WS_GATES = WS_PT + (size_t)NHG * NTOK * 64 * 2;
constexpr size_t WS_KMEAN = WS_GATES + (size_t)NTOK * 24 * 4;
constexpr size_t WS_KCMP  = WS_KMEAN + 65536 * 4;
constexpr size_t WS_VCMP  = WS_KCMP + 262144 * 2;
constexpr size_t WS_MIXB  = WS_VCMP + 262144 * 2;
constexpr size_t WS_ACT   = WS_PT;
constexpr size_t WS_Y     = WS_ACT + (size_t)PMAX * DM * 2;
static_assert(WS_MIXB + (size_t)NTOK * DM * 2 <= WS_Y, "act overlay");
constexpr size_t WS_PART  = WS_Y;
constexpr size_t WS_MLIST = WS_PART + (size_t)NTOK * 8 * 544;
constexpr size_t WS_MCNT  = WS_MLIST + (size_t)1024 * 8192 * 2;
static_assert(WS_MCNT + 4096 <= WS_Y + (size_t)PMAX * DM * 2, "MoBA scratch overlays y");
constexpr size_t WS_SELE  = WS_Y + (size_t)PMAX * DM * 2;
constexpr size_t WS_SELW  = WS_SELE + (size_t)NK * 4;
constexpr size_t WS_SELR  = WS_SELW + (size_t)NK * 4;
constexpr size_t WS_SELP  = WS_SELR + (size_t)NK * 4;
constexpr size_t WS_BCNT  = WS_SELP + (size_t)NK * 4;
constexpr size_t WS_GCNT  = WS_BCNT + 256 * 32 * 4;
constexpr size_t WS_RTOK  = WS_GCNT + 256;
constexpr size_t WS_RW    = WS_RTOK + (size_t)PMAX * 4;
constexpr size_t WS_C1    = WS_RW + (size_t)PMAX * 4;
constexpr size_t WS_W1T   = WS_C1 + 512;
constexpr size_t WS_W2T   = WS_W1T + 2 * 64 * 2048 * 2;
constexpr size_t WS_BAR   = WS_W2T + 2 * 64 * 64 * 2;
constexpr size_t WS_END   = WS_BAR + 16384;

struct Params {
    const float *x, *attn_g, *w_in, *pe_k, *pe_v, *w1k, *w2k, *w1v, *w2v, *w_out, *ffn_g, *w_router, *b_router,
        *w_up, *b_up, *w_down, *b_down, *final_g;
    float* out;
    float* ws;
    int ph_lo, ph_hi;
};

typedef unsigned short bf16_t;
typedef short bf16x8 __attribute__((ext_vector_type(8)));
typedef float f32x4 __attribute__((ext_vector_type(4)));
typedef float f32x16 __attribute__((ext_vector_type(16)));
typedef unsigned u32x4 __attribute__((ext_vector_type(4)));
typedef unsigned u32x2 __attribute__((ext_vector_type(2)));

typedef float f32x2 __attribute__((ext_vector_type(2)));
typedef __bf16 bf16x2v __attribute__((ext_vector_type(2)));
__device__ __forceinline__ unsigned pk_bf16(float lo, float hi) {
    const f32x2 f = {lo, hi};
    return __builtin_bit_cast(unsigned, __builtin_convertvector(f, bf16x2v));
}
__device__ __forceinline__ float bf_lo(unsigned u) { return __uint_as_float(u << 16); }
__device__ __forceinline__ float bf_hi(unsigned u) { return __uint_as_float(u & 0xffff0000u); }
__device__ __forceinline__ float bf2f(bf16_t b) { return __uint_as_float((unsigned)b << 16); }

__device__ __forceinline__ float wave_sum(float v) {
#pragma unroll
    for (int o = 32; o > 0; o >>= 1) v += __shfl_xor(v, o);
    return v;
}
__device__ __forceinline__ float wave_max(float v) {
#pragma unroll
    for (int o = 32; o > 0; o >>= 1) v = fmaxf(v, __shfl_xor(v, o));
    return v;
}
__device__ __forceinline__ int wave_min_i(int v) {
#pragma unroll
    for (int o = 32; o > 0; o >>= 1) v = min(v, __shfl_xor(v, o));
    return v;
}
__device__ __forceinline__ float dot4(float4 a, float4 b) { return a.x * b.x + a.y * b.y + a.z * b.z + a.w * b.w; }

__device__ __forceinline__ float gelu_tanh(float x) {
    return 0.5f * x * (1.0f + tanhf(0.7978845608028654f * (x + 0.044715f * x * x * x)));
}
__device__ __forceinline__ float swiglu(float g, float u) {
    g = fminf(g, 7.0f);
    u = fminf(fmaxf(u, -7.0f), 7.0f);
    return g * (1.0f / (1.0f + __expf(-1.702f * g))) * (u + 1.0f);
}


constexpr int G_BM = 256, G_BK = 64, G_HALF = 128, G_HT = G_HALF * G_BK;
constexpr int GEMM_LDS_BYTES = 8 * G_HT * 2;
constexpr int FAST_LDS_BYTES = 155648;
__device__ __forceinline__ int lds_byte(int r, int c) {
    const int st = (r >> 4) * 2 + (c >> 5), rr = r & 15, cc = c & 31, ob = rr * 64 + cc * 2;
    return st * 1024 + (ob ^ (((ob >> 9) & 1) << 5));
}
__device__ __forceinline__ void stage_rc(int b, int& R, int& C) {
    const int st = b / 1024, sb = b % 1024, swz = sb ^ (((sb >> 9) & 1) << 5);
    R = (st >> 1) * 16 + swz / 64;
    C = (st & 1) * 32 + (swz % 64) / 2;
}

#define LAS __attribute__((address_space(3)))
template <class ARow>
__device__ __forceinline__ void gemm256_tile(LAS unsigned char* lds, const char* __restrict__ Abase, ARow arow,
                                             const char* __restrict__ Bbase, int K, f32x4 (&acc)[2][2][4][2]) {
    constexpr int HTB = G_HT * 2;
#define SA(b, h) (((b) * 2 + (h)) * HTB)
#define SB(b, h) ((4 + (b) * 2 + (h)) * HTB)
#define STAGE_A(b, h, kt)                                                                                              \
    do {                                                                                                               \
        _Pragma("unroll") for (int _i = 0; _i < 2; ++_i) __builtin_amdgcn_global_load_lds(                              \
            (const unsigned*)(Abase + (size_t)(kt) * (G_BK * 2) + voffA[h][_i]),                                       \
            (LAS unsigned*)(lds + SA(b, h) + ldsw + _i * 8192), 16, 0, 0);                                              \
    } while (0)
#define STAGE_B(b, h, kt)                                                                                              \
    do {                                                                                                               \
        _Pragma("unroll") for (int _i = 0; _i < 2; ++_i) __builtin_amdgcn_global_load_lds(                              \
            (const unsigned*)(Bbase + (size_t)(h) * hstep + (size_t)(kt) * (G_BK * 2) + voffB[_i]),                    \
            (LAS unsigned*)(lds + SB(b, h) + ldsw + _i * 8192), 16, 0, 0);                                              \
    } while (0)
#define LDA(dst, b, h)                                                                                                 \
    do {                                                                                                               \
        _Pragma("unroll") for (int m = 0; m < 4; ++m) _Pragma("unroll") for (int k = 0; k < 2; ++k) dst[m][k] =         \
            *(const LAS bf16x8*)(lds + SA(b, h) + aoff + m * 2048 + k * 1024);                                          \
    } while (0)
#define LDB(dst, b, h)                                                                                                 \
    do {                                                                                                               \
        _Pragma("unroll") for (int n = 0; n < 2; ++n) _Pragma("unroll") for (int k = 0; k < 2; ++k) dst[n][k] =         \
            *(const LAS bf16x8*)(lds + SB(b, h) + boff + n * 2048 + k * 1024);                                          \
    } while (0)
#define MMA(ai, bj, Af, Bf)                                                                                            \
    do {                                                                                                               \
        __builtin_amdgcn_s_setprio(1);                                                                                 \
        _Pragma("unroll") for (int m = 0; m < 4; ++m) _Pragma("unroll") for (int n = 0; n < 2; ++n)                     \
            _Pragma("unroll") for (int k = 0; k < 2; ++k) acc[ai][bj][m][n] =                                           \
                __builtin_amdgcn_mfma_f32_16x16x32_bf16(Bf[n][k], Af[m][k], acc[ai][bj][m][n], 0, 0, 0);               \
        __builtin_amdgcn_s_setprio(0);                                                                                 \
    } while (0)
#define WAIT_V(n) asm volatile("s_waitcnt vmcnt(" #n ")" ::: "memory")
#define WAIT_L(n) asm volatile("s_waitcnt lgkmcnt(" #n ")" ::: "memory")
#define BAR __builtin_amdgcn_s_barrier()
#define SCHED __builtin_amdgcn_sched_barrier(0)
    const int tid = threadIdx.x, wid = __builtin_amdgcn_readfirstlane(tid >> 6), lane = tid & 63, wr = wid >> 2, wc = wid & 3,
              fr = lane & 15, fq = lane >> 4;
    unsigned voffA[2][2], voffB[2];
#pragma unroll
    for (int i = 0; i < 2; ++i) {
        int R, C;
        stage_rc(tid * 16 + i * 8192, R, C);
        voffB[i] = (unsigned)(R * K + C) * 2u;
#pragma unroll
        for (int h = 0; h < 2; ++h) voffA[h][i] = (unsigned)arow(h * G_HALF + R) + (unsigned)C * 2u;
    }
    const size_t hstep = (size_t)G_HALF * K * 2;
    const unsigned ldsw = (unsigned)wid * 1024u;
    const int aoff = lds_byte(wr * 64 + fr, fq * 8), boff = lds_byte(wc * 32 + fr, fq * 8);
#pragma unroll
    for (int ai = 0; ai < 2; ++ai)
#pragma unroll
        for (int bj = 0; bj < 2; ++bj)
#pragma unroll
            for (int m = 0; m < 4; ++m)
#pragma unroll
                for (int n = 0; n < 2; ++n) acc[ai][bj][m][n] = (f32x4){0.f, 0.f, 0.f, 0.f};
    bf16x8 At[4][2], B0[2][2], B1[2][2];
    const int nt = K / G_BK;
    STAGE_B(0, 0, 0); STAGE_A(0, 0, 0);
    STAGE_B(0, 1, 0); STAGE_A(0, 1, 0);
    if (wr == 1) BAR;
    WAIT_V(4); BAR;
    STAGE_B(1, 0, 1); STAGE_A(1, 0, 1); STAGE_B(1, 1, 1);
    WAIT_V(6); BAR;
    for (int t = 0; t < nt - 2; t += 2) {
        LDB(B0, 0, 0); SCHED; LDA(At, 0, 0); STAGE_A(1, 1, t + 1);
        WAIT_L(8); BAR; WAIT_L(0); MMA(0, 0, At, B0); BAR; SCHED;
        LDB(B1, 0, 1); STAGE_B(0, 0, t + 2);
        BAR; WAIT_L(0); MMA(0, 1, At, B1); BAR;
        LDA(At, 0, 1); STAGE_A(0, 0, t + 2);
        BAR; WAIT_L(0); MMA(1, 0, At, B0); BAR; SCHED;
        STAGE_B(0, 1, t + 2);
        WAIT_V(6); BAR; MMA(1, 1, At, B1); BAR;
        LDB(B0, 1, 0); SCHED; LDA(At, 1, 0); STAGE_A(0, 1, t + 2);
        WAIT_L(8); BAR; WAIT_L(0); MMA(0, 0, At, B0); BAR; SCHED;
        LDB(B1, 1, 1); STAGE_B(1, 0, t + 3);
        BAR; WAIT_L(0); MMA(0, 1, At, B1); BAR;
        LDA(At, 1, 1); STAGE_A(1, 0, t + 3);
        BAR; WAIT_L(0); MMA(1, 0, At, B0); BAR; SCHED;
        STAGE_B(1, 1, t + 3);
        WAIT_V(6); BAR; MMA(1, 1, At, B1); BAR;
    }
    {
        LDB(B0, 0, 0); LDA(At, 0, 0); STAGE_A(1, 1, nt - 1);
        BAR; WAIT_L(0); MMA(0, 0, At, B0); BAR;
        LDB(B1, 0, 1); BAR; WAIT_L(0); MMA(0, 1, At, B1); BAR;
        LDA(At, 0, 1); WAIT_V(4); BAR; WAIT_L(0); MMA(1, 0, At, B0); MMA(1, 1, At, B1); BAR;
    }
    {
        LDB(B0, 1, 0); LDA(At, 1, 0); WAIT_V(2); BAR; WAIT_L(0); MMA(0, 0, At, B0); BAR;
        LDB(B1, 1, 1); WAIT_V(0); BAR; WAIT_L(0); MMA(0, 1, At, B1); BAR;
        LDA(At, 1, 1); BAR; WAIT_L(0); MMA(1, 0, At, B0); MMA(1, 1, At, B1); BAR;
    }
    if (wr == 0) BAR;
#undef SA
#undef SB
#undef STAGE_A
#undef STAGE_B
#undef LDA
#undef LDB
#undef MMA
}

struct GPiece { int R[2], C[2]; };
template <bool ALIGN_EPI = true, class UnitFn, class Epi>
__device__ __forceinline__ void gemm256_stream(LAS unsigned char* lds, UnitFn unit, Epi epi) {
    constexpr int K = 1024, nt = K / G_BK;
    constexpr int HTB = G_HT * 2;
#define SA(b, h) (((b) * 2 + (h)) * HTB)
#define SB(b, h) ((4 + (b) * 2 + (h)) * HTB)
#define STG(bufoff, gbase, voff)                                                                                       \
    do {                                                                                                               \
        _Pragma("unroll") for (int _i = 0; _i < 2; ++_i) __builtin_amdgcn_global_load_lds(                              \
            (const unsigned*)((gbase) + (voff)[_i]), (LAS unsigned*)(lds + (bufoff) + ldsw + _i * 8192), 16, 0, 0);     \
    } while (0)
#define LDA(dst, b, h)                                                                                                 \
    do {                                                                                                               \
        _Pragma("unroll") for (int m = 0; m < 4; ++m) _Pragma("unroll") for (int k = 0; k < 2; ++k) dst[m][k] =         \
            *(const LAS bf16x8*)(lds + SA(b, h) + aoff + m * 2048 + k * 1024);                                          \
    } while (0)
#define LDB(dst, b, h)                                                                                                 \
    do {                                                                                                               \
        _Pragma("unroll") for (int n = 0; n < 2; ++n) _Pragma("unroll") for (int k = 0; k < 2; ++k) dst[n][k] =         \
            *(const LAS bf16x8*)(lds + SB(b, h) + boff + n * 2048 + k * 1024);                                          \
    } while (0)
#define MMA(ai, bj, Af, Bf)                                                                                            \
    do {                                                                                                               \
        __builtin_amdgcn_s_setprio(1);                                                                                 \
        _Pragma("unroll") for (int m = 0; m < 4; ++m) _Pragma("unroll") for (int n = 0; n < 2; ++n)                     \
            _Pragma("unroll") for (int k = 0; k < 2; ++k) acc[ai][bj][m][n] =                                           \
                __builtin_amdgcn_mfma_f32_16x16x32_bf16(Bf[n][k], Af[m][k], acc[ai][bj][m][n], 0, 0, 0);               \
        __builtin_amdgcn_s_setprio(0);                                                                                 \
    } while (0)
    const int tid = threadIdx.x, wid = __builtin_amdgcn_readfirstlane(tid >> 6), lane = tid & 63, wr = wid >> 2, wc = wid & 3,
              fr = lane & 15, fq = lane >> 4;
    GPiece pc;
    unsigned voffB[2];
#pragma unroll
    for (int i = 0; i < 2; ++i) {
        stage_rc(tid * 16 + i * 8192, pc.R[i], pc.C[i]);
        const int rho = pc.R[i] & 31, pn_ = rho >> 4, pi_ = rho & 15;
        const int Rb = (pc.R[i] & ~31) + 8 * (pi_ >> 2) + 4 * pn_ + (pi_ & 3);
        voffB[i] = (unsigned)(Rb * K + pc.C[i]) * 2u;
    }
    constexpr size_t hstep = (size_t)G_HALF * K * 2, kstep = G_BK * 2;
    const unsigned ldsw = (unsigned)wid * 1024u;
    const int aoff = lds_byte(wr * 64 + fr, fq * 8), boff = lds_byte(wc * 32 + fr, fq * 8);
    const char *cA, *cB, *nA, *nB;
    unsigned vc[2][2], vn[2][2];
    if (!unit(0, cA, cB, vc, pc)) return;
    f32x4 acc[2][2][4][2];
#pragma unroll
    for (int ai = 0; ai < 2; ++ai)
#pragma unroll
        for (int bj = 0; bj < 2; ++bj)
#pragma unroll
            for (int m = 0; m < 4; ++m)
#pragma unroll
                for (int n = 0; n < 2; ++n) acc[ai][bj][m][n] = (f32x4){0.f, 0.f, 0.f, 0.f};
    bf16x8 At[4][2], B0[2][2], B1[2][2];
    STG(SB(0, 0), cB, voffB); STG(SB(0, 1), cB + hstep, voffB); STG(SA(0, 0), cA, vc[0]); STG(SA(0, 1), cA, vc[1]);
    if (wr == 1) BAR;
    WAIT_V(2); BAR;
    STG(SB(1, 0), cB + kstep, voffB); STG(SA(1, 0), cA + kstep, vc[0]); STG(SB(1, 1), cB + hstep + kstep, voffB);
    WAIT_V(6); BAR;
    for (int ui = 0;; ++ui) {
        const bool has_next = unit(ui + 1, nA, nB, vn, pc);
        if (!has_next) {
            nA = cA; nB = cB;
#pragma unroll
            for (int h = 0; h < 2; ++h)
#pragma unroll
                for (int i = 0; i < 2; ++i) vn[h][i] = vc[h][i];
        }
        for (int t = 0; t < nt; t += 2) {
            const bool last = (t == nt - 2);
            const char* a1 = cA + (size_t)(t + 1) * kstep;
            const char* a2 = last ? nA : cA + (size_t)(t + 2) * kstep;
            const char* b2 = last ? nB : cB + (size_t)(t + 2) * kstep;
            const char* a3 = a2 + kstep;
            const char* b3 = b2 + kstep;
            unsigned v2[2][2];
#pragma unroll
            for (int h = 0; h < 2; ++h)
#pragma unroll
                for (int i = 0; i < 2; ++i) v2[h][i] = last ? vn[h][i] : vc[h][i];
            LDB(B0, 0, 0); LDB(B1, 0, 1); SCHED; LDA(At, 0, 0); STG(SA(1, 1), a1, vc[1]);
            WAIT_V(8); WAIT_L(0); BAR; MMA(0, 0, At, B0); MMA(0, 1, At, B1); BAR; SCHED;
            LDA(At, 0, 1); STG(SB(0, 0), b2, voffB); STG(SB(0, 1), b2 + hstep, voffB); STG(SA(0, 0), a2, v2[0]);
            WAIT_V(8); WAIT_L(0); BAR; MMA(1, 0, At, B0); MMA(1, 1, At, B1); BAR; SCHED;
            LDB(B0, 1, 0); LDB(B1, 1, 1); SCHED; LDA(At, 1, 0); STG(SA(0, 1), a2, v2[1]);
            WAIT_V(8); WAIT_L(0); BAR; MMA(0, 0, At, B0); MMA(0, 1, At, B1); BAR; SCHED;
            LDA(At, 1, 1); STG(SB(1, 0), b3, voffB); STG(SB(1, 1), b3 + hstep, voffB); STG(SA(1, 0), a3, v2[0]);
            WAIT_V(8); WAIT_L(0); BAR; MMA(1, 0, At, B0); MMA(1, 1, At, B1); BAR; SCHED;
        }
        if (ALIGN_EPI) { if (wr == 0) BAR; }
        epi(ui, acc);
        if (!has_next) break;
#pragma unroll
        for (int ai = 0; ai < 2; ++ai)
#pragma unroll
            for (int bj = 0; bj < 2; ++bj)
#pragma unroll
                for (int m = 0; m < 4; ++m)
#pragma unroll
                    for (int n = 0; n < 2; ++n) acc[ai][bj][m][n] = (f32x4){0.f, 0.f, 0.f, 0.f};
        cA = nA; cB = nB;
#pragma unroll
        for (int h = 0; h < 2; ++h)
#pragma unroll
            for (int i = 0; i < 2; ++i) vc[h][i] = vn[h][i];
        if (ALIGN_EPI) { if (wr == 1) BAR; }
    }
    WAIT_V(0);
    if (!ALIGN_EPI) { if (wr == 0) BAR; }
    BAR;
#undef SA
#undef SB
#undef STG
#undef LDA
#undef LDB
#undef MMA
}

__device__ __forceinline__ int xcd_unit(int seq, int total) {
    if (seq >= total) return -1;
    const int q = total >> 3, rem = total & 7, x = seq & 7, off = seq >> 3;
    return (x < rem ? x * (q + 1) : rem * (q + 1) + (x - rem) * q) + off;
}

constexpr int CV_T = 64 * 65 + 32;
struct CvRegs { float4 v[4][2]; };
template <class Item>
__device__ __forceinline__ void cv_fetch(CvRegs& rg, int it0, int nitems, Item item) {
    const int tid = threadIdx.x;
#pragma unroll
    for (int j = 0; j < 4; ++j) {
        const float* W; bf16_t* WT; int K, ncols, ldw, k0, n0;
        const int it = (it0 + j < nitems) ? it0 + j : nitems - 1;
        item(it, W, K, ncols, ldw, WT, k0, n0);
#pragma unroll
        for (int i = 0; i < 2; ++i) {
            const int idx = tid + i * 512, kr = idx >> 4, c4 = idx & 15;
            float4 v = make_float4(0.f, 0.f, 0.f, 0.f);
            if (n0 + c4 * 4 < ncols) v = *(const float4*)(W + (size_t)(k0 + kr) * ldw + n0 + c4 * 4);
            rg.v[j][i] = v;
        }
    }
}
__device__ __forceinline__ void cv_to_lds(float* T, const CvRegs& rg) {
    const int tid = threadIdx.x;
#pragma unroll
    for (int j = 0; j < 4; ++j)
#pragma unroll
        for (int i = 0; i < 2; ++i) {
            const int idx = tid + i * 512, kr = idx >> 4, c4 = idx & 15;
            float* Tj = T + j * CV_T;
            Tj[(c4 * 4 + 0) * 65 + kr] = rg.v[j][i].x;
            Tj[(c4 * 4 + 1) * 65 + kr] = rg.v[j][i].y;
            Tj[(c4 * 4 + 2) * 65 + kr] = rg.v[j][i].z;
            Tj[(c4 * 4 + 3) * 65 + kr] = rg.v[j][i].w;
        }
}
template <class ORow>
__device__ __forceinline__ void cv_store(const float* T, int K, bf16_t* __restrict__ WT, ORow orow, int k0, int n0) {
    const int tid = threadIdx.x;
    const int n = tid >> 3, c = tid & 7;
    const float* sp = T + n * 65 + c * 8;
    u32x4 o;
    o.x = pk_bf16(sp[0], sp[1]);
    o.y = pk_bf16(sp[2], sp[3]);
    o.z = pk_bf16(sp[4], sp[5]);
    o.w = pk_bf16(sp[6], sp[7]);
    const int r = orow(n0 + n);
    *(u32x4*)(WT + (size_t)r * K + k0 + c * 8) = o;
}
template <class Item, class ORow>
__device__ __forceinline__ void cv_run(float* T, int nitems, Item item, ORow orow) {
    const int step = gridDim.x * 4;
    int it0 = blockIdx.x * 4;
    if (it0 >= nitems) return;
    CvRegs cur;
    cv_fetch(cur, it0, nitems, item);
    for (; it0 < nitems; it0 += step) {
        __syncthreads();
        cv_to_lds(T, cur);
        if (it0 + step < nitems) cv_fetch(cur, it0 + step, nitems, item);
        __syncthreads();
#pragma unroll
        for (int j = 0; j < 4; ++j)
            if (it0 + j < nitems) {
                const float* W; bf16_t* WT; int K, ncols, ldw, k0, n0;
                item(it0 + j, W, K, ncols, ldw, WT, k0, n0);
                cv_store(T + j * CV_T, K, WT, orow, k0, n0);
            }
    }
}

constexpr int AT_KP = 144, AT_VP = 136, AT_KB = 64 * AT_KP, AT_VB = 64 * AT_VP, AT_BUF = AT_KB + AT_VB;
constexpr int AT_IMPA = 36864, AT_IMPB = AT_IMPA + 32768, AT_KMS = AT_IMPA;
constexpr int AT_OLDS = 36864, AT_OP = 68;
constexpr int AT_SELB = AT_OLDS + 256 * AT_OP * 4;
constexpr int AT_CAND = AT_SELB + 1024;
constexpr int AT_TOKM = AT_CAND + 4096;
constexpr int AT_MREF = AT_TOKM + 1024;
constexpr int AT_LACC = AT_MREF + 1024;
constexpr int AT_JLIST = AT_LACC + 1024;
constexpr int AT_QS = AT_JLIST + 1024;
static_assert(AT_QS + 256 * 144 <= FAST_LDS_BYTES - 16, "attention LDS map");
__device__ __forceinline__ int nth_set_bit64(unsigned lo, unsigned hi, int n) {
    const int cl = __popc(lo);
    unsigned m = lo;
    int base = 0;
    if (n >= cl) { n -= cl; m = hi; base = 32; }
    int pos = 0;
#pragma unroll
    for (int sh = 16; sh >= 1; sh >>= 1) {
        const int cnt = __popc((m >> pos) & ((1u << sh) - 1u));
        if (n >= cnt) { n -= cnt; pos += sh; }
    }
    return base + pos;
}
#define MFMA32(a, b, c) __builtin_amdgcn_mfma_f32_32x32x16_bf16(a, b, c, 0, 0, 0)
#define CREG(reg) (((reg) & 3) + 8 * ((reg) >> 2))

__device__ __forceinline__ float quad_sum(float x) {
    x += __int_as_float(__builtin_amdgcn_mov_dpp(__float_as_int(x), 0xB1, 0xF, 0xF, true));
    x += __int_as_float(__builtin_amdgcn_mov_dpp(__float_as_int(x), 0x4E, 0xF, 0xF, true));
    return x;
}
struct AtStage { u32x4 k, v; };
__device__ __forceinline__ void at_load(AtStage& st, const bf16_t* __restrict__ Kg, const bf16_t* __restrict__ Vg, bool with_v, unsigned koff, unsigned voff) {
    st.k = *(const u32x4*)((const char*)Kg + koff);
    if (with_v) st.v = *(const u32x4*)((const char*)Vg + voff);
}
__device__ __forceinline__ void at_store(const AtStage& st, LAS unsigned char* buf, bool with_v) {
    const int tid = threadIdx.x;
    *(LAS u32x4*)(buf + (tid >> 3) * AT_KP + (tid & 7) * 16) = st.k;
    if (with_v) {
        LAS unsigned short* vt = (LAS unsigned short*)(buf + AT_KB + (tid >> 6) * 8 * AT_VP + (tid & 63) * 2);
        vt[0 * (AT_VP / 2)] = (unsigned short)(st.v.x & 0xffffu);
        vt[1 * (AT_VP / 2)] = (unsigned short)(st.v.x >> 16);
        vt[2 * (AT_VP / 2)] = (unsigned short)(st.v.y & 0xffffu);
        vt[3 * (AT_VP / 2)] = (unsigned short)(st.v.y >> 16);
        vt[4 * (AT_VP / 2)] = (unsigned short)(st.v.z & 0xffffu);
        vt[5 * (AT_VP / 2)] = (unsigned short)(st.v.z >> 16);
        vt[6 * (AT_VP / 2)] = (unsigned short)(st.v.w & 0xffffu);
        vt[7 * (AT_VP / 2)] = (unsigned short)(st.v.w >> 16);
    }
}
__device__ __forceinline__ void at_scores(LAS const unsigned char* buf, const bf16x8 (&qf)[4], float ramp, float base0, float base1,
                                          f32x16& s0, f32x16& s1) {
    const int lane = threadIdx.x & 63, r = lane & 31, h = lane >> 5;
    LAS const unsigned char* kb = buf + r * AT_KP + h * 16;
    {
        const float b0 = fmaf(ramp, (float)(4 * h), base0), b1 = fmaf(ramp, (float)(4 * h), base1);
#pragma unroll
        for (int i = 0; i < 16; ++i) { s0[i] = fmaf(ramp, (float)CREG(i), b0); s1[i] = fmaf(ramp, (float)CREG(i), b1); }
    }
#pragma unroll
    for (int kk = 0; kk < 4; ++kk) {
        const bf16x8 k0 = *(LAS const bf16x8*)(kb + kk * 32);
        const bf16x8 k1 = *(LAS const bf16x8*)(kb + 32 * AT_KP + kk * 32);
        s0 = MFMA32(k0, qf[kk], s0);
        s1 = MFMA32(k1, qf[kk], s1);
    }
}
__device__ __forceinline__ bf16x8 at_pack8(const f32x16& P, int s2) {
    u32x4 w;
    if (s2 == 0) { w.x = pk_bf16(P[0], P[1]); w.y = pk_bf16(P[2], P[3]); w.z = pk_bf16(P[4], P[5]); w.w = pk_bf16(P[6], P[7]); }
    else         { w.x = pk_bf16(P[8], P[9]); w.y = pk_bf16(P[10], P[11]); w.z = pk_bf16(P[12], P[13]); w.w = pk_bf16(P[14], P[15]); }
    return __builtin_bit_cast(bf16x8, w);
}
__device__ __forceinline__ void at_pv(LAS const unsigned char* buf, const f32x16& p0, const f32x16& p1, f32x16& o0, f32x16& o1) {
    const int lane = threadIdx.x & 63, r = lane & 31, h = lane >> 5;
    LAS const unsigned char* vb = buf + AT_KB + r * AT_VP + h * 8;
#pragma unroll
    for (int half = 0; half < 2; ++half) {
#pragma unroll
        for (int s2 = 0; s2 < 2; ++s2) {
            const bf16x8 pf = at_pack8(half ? p1 : p0, s2);
            const int ko = (32 * half + 16 * s2) * 2;
            const u32x2 a0 = *(LAS const u32x2*)(vb + ko), a1 = *(LAS const u32x2*)(vb + ko + 16);
            const u32x2 b0 = *(LAS const u32x2*)(vb + 32 * AT_VP + ko), b1 = *(LAS const u32x2*)(vb + 32 * AT_VP + ko + 16);
            const u32x4 va = {a0.x, a0.y, a1.x, a1.y}, vbb = {b0.x, b0.y, b1.x, b1.y};
            o0 = MFMA32(__builtin_bit_cast(bf16x8, va), pf, o0);
            o1 = MFMA32(__builtin_bit_cast(bf16x8, vbb), pf, o1);
        }
    }
}
__device__ __forceinline__ float at_rowmax(const f32x16& s0, const f32x16& s1) {
    float m = fmaxf(s0[0], s1[0]);
#pragma unroll
    for (int i = 1; i < 16; ++i) m = fmaxf(m, fmaxf(s0[i], s1[i]));
    return fmaxf(m, __shfl_xor(m, 32));
}
#define AT_MASK_LE(S0, S1, lim)  do { _Pragma("unroll") for (int i_ = 0; i_ < 16; ++i_) { if (CREG(i_) > (lim)) S0[i_] = -INFINITY; if (CREG(i_) + 32 > (lim)) S1[i_] = -INFINITY; } } while (0)
#define AT_MASK_GE(S0, S1, lo)   do { _Pragma("unroll") for (int i_ = 0; i_ < 16; ++i_) { if (CREG(i_) < (lo)) S0[i_] = -INFINITY; if (CREG(i_) + 32 < (lo)) S1[i_] = -INFINITY; } } while (0)
__device__ __forceinline__ float at_exp(f32x16& s0, f32x16& s1, float mref) {
    float l = 0.f;
#pragma unroll
    for (int i = 0; i < 16; ++i) {
        s0[i] = __builtin_amdgcn_exp2f(s0[i] - mref);
        s1[i] = __builtin_amdgcn_exp2f(s1[i] - mref);
        l += s0[i] + s1[i];
    }
    return l;
}

#define AT_PIN(x) asm volatile("" : "+v"(x))
__device__ __forceinline__ void at_tile_pipe(LAS const unsigned char* buf, const bf16x8 (&qf)[4], float ramp, float base0, float mrow,
                                             float sl2x32, float& l, f32x16& o0, f32x16& o1) {
    const int lane = threadIdx.x & 63, r = lane & 31, h = lane >> 5;
    LAS const unsigned char* kb = buf + r * AT_KP + h * 16;
    LAS const unsigned char* vb = buf + AT_KB + r * AT_VP + h * 8;
    const float c0 = fmaf(ramp, (float)(4 * h), base0 - mrow), c1 = c0 + sl2x32;
    f32x16 s0, s1;
#pragma unroll
    for (int i = 0; i < 16; ++i) { s0[i] = fmaf(ramp, (float)CREG(i), c0); s1[i] = fmaf(ramp, (float)CREG(i), c1); }
    bf16x8 kf[4];
#pragma unroll
    for (int kk = 0; kk < 4; ++kk) kf[kk] = *(LAS const bf16x8*)(kb + kk * 32);
#pragma unroll
    for (int kk = 0; kk < 4; ++kk) s0 = MFMA32(kf[kk], qf[kk], s0);
#pragma unroll
    for (int kk = 0; kk < 4; ++kk) kf[kk] = *(LAS const bf16x8*)(kb + 32 * AT_KP + kk * 32);
    __builtin_amdgcn_sched_barrier(0);
    u32x2 vf[4][2];
    float ls = 0.f;
#pragma unroll
    for (int kk = 0; kk < 4; ++kk) {
        s1 = MFMA32(kf[kk], qf[kk], s1);
        vf[kk][0] = *(LAS const u32x2*)(vb + (kk & 1) * 32 * AT_VP + (16 * (kk >> 1)) * 2);
        vf[kk][1] = *(LAS const u32x2*)(vb + (kk & 1) * 32 * AT_VP + (16 * (kk >> 1)) * 2 + 16);
#pragma unroll
        for (int q = 0; q < 4; ++q) { s0[4 * kk + q] = __builtin_amdgcn_exp2f(s0[4 * kk + q]); ls += s0[4 * kk + q]; }
        AT_PIN(ls);
        __builtin_amdgcn_sched_barrier(0);
    }
    const bf16x8 pa = at_pack8(s0, 0), pb = at_pack8(s0, 1);
#pragma unroll
    for (int st = 0; st < 4; ++st) {
        const int s2 = st >> 1, dt = st & 1;
        const u32x4 vv = {vf[st][0].x, vf[st][0].y, vf[st][1].x, vf[st][1].y};
        if (dt == 0) o0 = MFMA32(__builtin_bit_cast(bf16x8, vv), s2 ? pb : pa, o0);
        else         o1 = MFMA32(__builtin_bit_cast(bf16x8, vv), s2 ? pb : pa, o1);
        vf[st][0] = *(LAS const u32x2*)(vb + dt * 32 * AT_VP + (32 + 16 * s2) * 2);
        vf[st][1] = *(LAS const u32x2*)(vb + dt * 32 * AT_VP + (32 + 16 * s2) * 2 + 16);
#pragma unroll
        for (int q = 0; q < 4; ++q) { s1[4 * st + q] = __builtin_amdgcn_exp2f(s1[4 * st + q]); ls += s1[4 * st + q]; }
        AT_PIN(ls);
        __builtin_amdgcn_sched_barrier(0);
    }
    const bf16x8 pc = at_pack8(s1, 0), pd = at_pack8(s1, 1);
#pragma unroll
    for (int st = 0; st < 4; ++st) {
        const int s2 = st >> 1, dt = st & 1;
        const u32x4 vv = {vf[st][0].x, vf[st][0].y, vf[st][1].x, vf[st][1].y};
        if (dt == 0) o0 = MFMA32(__builtin_bit_cast(bf16x8, vv), s2 ? pd : pc, o0);
        else         o1 = MFMA32(__builtin_bit_cast(bf16x8, vv), s2 ? pd : pc, o1);
    }
    l += ls;
}

#define AT_PASS(Kg, Vg, WITHV, NTILE, ROW, ...)                                                                        \
    {                                                                                                                  \
        AtStage st0_, st1_;                                                                                            \
        const int nt_ = (NTILE);                                                                                       \
        unsigned koff_ = (threadIdx.x >> 3) * 128 + (threadIdx.x & 7) * 16, voff_ = (threadIdx.x & 63) * 128 + (threadIdx.x >> 6) * 16; \
        asm volatile("" : "+v"(koff_), "+v"(voff_));     \
        __syncthreads();                                                                                               \
        at_load(st0_, (Kg) + (size_t)(ROW(0)) * 64, (Vg) + (size_t)(ROW(0)) * 64, WITHV, koff_, voff_);                 \
        at_store(st0_, lds, WITHV);                                                                                    \
        { const int i1_ = nt_ > 1 ? 1 : 0; at_load(st1_, (Kg) + (size_t)(ROW(i1_)) * 64, (Vg) + (size_t)(ROW(i1_)) * 64, WITHV, koff_, voff_); } \
        __syncthreads();                                                                                               \
        for (int i0_ = 0; i0_ < nt_; i0_ += 2) {                                                                       \
            {                                                                                                          \
                const int i = i0_;                                                                                     \
                LAS unsigned char* buf = lds;                                                                          \
                { const int in_ = (i + 2 < nt_) ? i + 2 : nt_ - 1;     \
                  at_load(st0_, (Kg) + (size_t)(ROW(in_)) * 64, (Vg) + (size_t)(ROW(in_)) * 64, WITHV, koff_, voff_); }        \
                do { __VA_ARGS__ } while (0);                                                                          \
                if (i + 1 < nt_) at_store(st1_, lds + AT_BUF, WITHV);                                                  \
                __syncthreads();                                                                                       \
            }                                                                                                          \
            if (i0_ + 1 < nt_) {                                                                                       \
                const int i = i0_ + 1;                                                                                 \
                LAS unsigned char* buf = lds + AT_BUF;                                                                 \
                { const int in_ = (i + 2 < nt_) ? i + 2 : nt_ - 1;                                                     \
                  at_load(st1_, (Kg) + (size_t)(ROW(in_)) * 64, (Vg) + (size_t)(ROW(in_)) * 64, WITHV, koff_, voff_); }        \
                do { __VA_ARGS__ } while (0);                                                                          \
                if (i + 1 < nt_) at_store(st0_, lds, WITHV);                                                           \
                __syncthreads();                                                                                       \
            }                                                                                                          \
        }                                                                                                              \
    }

__device__ __forceinline__ void nsa_item(const Params& p, unsigned char* shm, int b, int g, int c) {
    LAS unsigned char* lds = (LAS unsigned char*)shm;
    unsigned char* wsb = (unsigned char*)p.ws;
    const bf16_t* pt = (const bf16_t*)(wsb + WS_PT);
    int tid = threadIdx.x;
    asm volatile("" : "+v"(tid));
    const int lane = tid & 63, w = __builtin_amdgcn_readfirstlane(tid >> 6), r = lane & 31, h = lane >> 5;
    const int tokl = 8 * w + (r >> 2), head = r & 3, hq = 4 * g + head, t = 64 * c + tokl, tok = b * SEQ + t;
    const float sl2 = exp2f(-(float)(hq + 1)) * LOG2E;
    const float ramp = sl2;
    bf16x8 qf[4];
    {
        const bf16_t* qrow = pt + ((size_t)(HG_NQ + hq) * NTOK + tok) * 64 + 8 * h;
#pragma unroll
        for (int kk = 0; kk < 4; ++kk) qf[kk] = *(const bf16x8*)(qrow + 16 * kk);
    }
    const float* gl = (const float*)(wsb + WS_GATES);
#define GATE_(br, dst) float dst; { int go_ = tok * 24 + hq * 3 + (br); asm volatile("" : "+v"(go_)); dst = gl[go_]; }
    f32x16 R0, R1;
#pragma unroll
    for (int i = 0; i < 16; ++i) { R0[i] = 0.f; R1[i] = 0.f; }
    LAS float* impA = (LAS float*)(lds + AT_IMPA);
    LAS float* impB = (LAS float*)(lds + AT_IMPB);
    LAS unsigned* selb = (LAS unsigned*)(lds + AT_SELB);

    {
        const bf16_t* Kc = (const bf16_t*)(wsb + WS_KCMP) + (size_t)(b * 2 + g) * NCMPP * 64;
        const bf16_t* Vc = (const bf16_t*)(wsb + WS_VCMP) + (size_t)(b * 2 + g) * NCMPP * 64;
        const int ntile = (4 * c + 3 + 63) >> 6;
        const int imax = (t >= 31) ? ((t - 31) >> 4) : -1;
        const float ramp16 = sl2 * 16.0f;
        float m = -INFINITY, l = 0.f;
#define ROW_(_i) (64 * (_i))
        AT_PASS(Kc, Vc, false, ntile, ROW_,
            f32x16 s0, s1;
            const float base0 = sl2 * (float)(16 * 64 * i + 31 - 64 * c), base1 = base0 + sl2 * 512.0f;
            at_scores(buf, qf, ramp16, base0, base1, s0, s1);
            const int lim = imax - 64 * i - 4 * h;
            AT_MASK_LE(s0, s1, lim);
            const float tm = at_rowmax(s0, s1);
            const float mn = fmaxf(m, tm);
            if (mn > -INFINITY) {
                l *= __builtin_amdgcn_exp2f(m - mn);
                l += at_exp(s0, s1, mn);
                m = mn;
            }
        )
        l += __shfl_xor(l, 32);
        const float inv = (l > 0.f) ? 1.0f / l : 0.f;
        const float mfin = (m > -INFINITY) ? m : 0.f;
        f32x16 o0, o1;
#pragma unroll
        for (int i = 0; i < 16; ++i) { o0[i] = 0.f; o1[i] = 0.f; }
        AT_PASS(Kc, Vc, true, ntile, ROW_,
            f32x16 s0, s1;
            const float base0 = sl2 * (float)(16 * 64 * i + 31 - 64 * c), base1 = base0 + sl2 * 512.0f;
            at_scores(buf, qf, ramp16, base0, base1, s0, s1);
            const int lim = imax - 64 * i - 4 * h;
            AT_MASK_LE(s0, s1, lim);
            (void)at_exp(s0, s1, mfin);
_Pragma("unroll")
            for (int q = 0; q < 16; ++q) { s0[q] *= inv; s1[q] *= inv; }
_Pragma("unroll")
            for (int hf = 0; hf < 2; ++hf)
_Pragma("unroll")
                for (int u = 0; u < 4; ++u) {
                    const f32x16& P = hf ? s1 : s0;
                    float A = 2.0f * (P[4 * u] + P[4 * u + 1] + P[4 * u + 2]) + P[4 * u + 3], Bv = P[4 * u + 3];
                    A = quad_sum(A);
                    Bv = quad_sum(Bv);
                    const int j = 16 * i + 8 * hf + 2 * u + h;
                    if (head == 0) impA[tokl * 128 + j] = A;
                    if (head == 1) impB[tokl * 128 + j] = Bv;
                }
            at_pv(buf, s0, s1, o0, o1);
        )
#undef ROW_
        GATE_(0, g0)
#pragma unroll
        for (int i = 0; i < 16; ++i) { R0[i] = g0 * o0[i]; R1[i] = g0 * o1[i]; }
    }

    unsigned sw0, sw1, sw2, sw3;
    {
        __syncthreads();
        for (int tk = 0; tk < 8; ++tk) {
            const int tl = 8 * w + tk;
            unsigned long long ba, bb;
            if (c < 16) {
                ba = (1ull << (c + 1)) - 1ull;
                bb = 0ull;
            } else {
                const int jA = lane, jB = lane + 64;
                const float vA = (jA >= 1 && jA <= c - 2) ? impA[tl * 128 + jA] + impB[tl * 128 + jA - 1] : -1.0f;
                const float vB = (jB <= c - 2) ? impA[tl * 128 + jB] + impB[tl * 128 + jB - 1] : -1.0f;
                LAS float* cand = (LAS float*)(lds + AT_CAND) + w * 128;
                cand[jA] = vA;
                cand[jB] = vB;
                asm volatile("s_waitcnt lgkmcnt(0)" ::: "memory");
                int rA = 0, rB = 0;
                for (int j4 = 0; j4 < 128; j4 += 4) {
                    const f32x4 cv = *(LAS const f32x4*)(cand + j4);
#pragma unroll
                    for (int q = 0; q < 4; ++q) {
                        const int jj = j4 + q;
                        rA += (cv[q] > vA || (cv[q] == vA && jj < jA)) ? 1 : 0;
                        rB += (cv[q] > vB || (cv[q] == vB && jj < jB)) ? 1 : 0;
                    }
                }
                asm volatile("s_waitcnt lgkmcnt(0)" ::: "memory");
                const bool sA = (jA == 0) || (jA == c - 1) || (jA == c) || (vA >= 0.f && rA < 13);
                const bool sB = (jB == c - 1) || (jB == c) || (vB >= 0.f && rB < 13);
                ba = __ballot(sA);
                bb = __ballot(sB);
            }
            if (lane == 0) {
                selb[tl * 4 + 0] = (unsigned)ba;
                selb[tl * 4 + 1] = (unsigned)(ba >> 32);
                selb[tl * 4 + 2] = (unsigned)bb;
                selb[tl * 4 + 3] = (unsigned)(bb >> 32);
            }
        }
        __syncthreads();
        sw0 = selb[tokl * 4 + 0];
        sw1 = selb[tokl * 4 + 1];
        sw2 = selb[tokl * 4 + 2];
        sw3 = selb[tokl * 4 + 3];
    }

    {
        const bf16_t* Ks = pt + ((size_t)(HG_KS + g) * NTOK + (size_t)b * SEQ) * 64;
        const bf16_t* Vs = pt + ((size_t)(HG_VS + g) * NTOK + (size_t)b * SEQ) * 64;
        LAS unsigned* tokm = (LAS unsigned*)(lds + AT_TOKM);
        LAS float* olds = (LAS float*)(lds + AT_OLDS);
        LAS float* mrefs = (LAS float*)(lds + AT_MREF);
        LAS float* lacc = (LAS float*)(lds + AT_LACC);
        LAS int* jlist = (LAS int*)(lds + AT_JLIST);
        LAS unsigned char* qs = lds + AT_QS;
        const int myrow = tokl * 4 + head;
        __syncthreads();
#pragma unroll
        for (int kk = 0; kk < 4; ++kk) *(LAS bf16x8*)(qs + myrow * 144 + (16 * kk + 8 * h) * 2) = qf[kk];
        {
            const unsigned wd = selb[lane * 4 + (w >> 1)];
#pragma unroll
            for (int jj = 0; jj < 16; ++jj) {
                const int j = 16 * w + jj;
                const unsigned long long mk = __ballot(((wd >> (j & 31)) & 1u) && j <= c);
                if (lane == 0) { tokm[2 * j] = (unsigned)mk; tokm[2 * j + 1] = (unsigned)(mk >> 32); }
            }
        }
        __syncthreads();
        if (w == 0) {
            const int j1 = c - lane, j2 = c - 64 - lane;
            const bool n1 = j1 >= 0 && (tokm[2 * (j1 < 0 ? 0 : j1)] | tokm[2 * (j1 < 0 ? 0 : j1) + 1]) != 0u;
            const bool n2 = j2 >= 0 && (tokm[2 * (j2 < 0 ? 0 : j2)] | tokm[2 * (j2 < 0 ? 0 : j2) + 1]) != 0u;
            const unsigned long long b1 = __ballot(n1), b2 = __ballot(n2);
            const unsigned long long lt = (1ull << lane) - 1ull;
            const int c1 = __popcll(b1);
            if (n1) jlist[1 + __popcll(b1 & lt)] = j1;
            if (n2) jlist[1 + c1 + __popcll(b2 & lt)] = j2;
            if (lane == 0) jlist[0] = c1 + __popcll(b2);
        }
        __syncthreads();
        const int nj = jlist[0];
#define ROW_(_i) (64 * jlist[1 + (_i)])
        AT_PASS(Ks, Vs, true, nj, ROW_,
            const int j = jlist[1 + i];
            const float base0 = sl2 * (float)(64 * (j - c));
            if (i == 0) {
                f32x16 s0, s1, a0, a1;
                _Pragma("unroll") for (int q = 0; q < 16; ++q) { a0[q] = 0.f; a1[q] = 0.f; }
                at_scores(buf, qf, ramp, base0, base0 + sl2 * 32.0f, s0, s1);
                const int lim = tokl - 4 * h;
                AT_MASK_LE(s0, s1, lim);
                const float mr = at_rowmax(s0, s1);
                const float lp = at_exp(s0, s1, mr);
                at_pv(buf, s0, s1, a0, a1);
                LAS float* orow = olds + myrow * AT_OP + 4 * h;
                _Pragma("unroll") for (int u = 0; u < 4; ++u) {
                    *(LAS f32x4*)(orow + 8 * u) = (f32x4){a0[4 * u], a0[4 * u + 1], a0[4 * u + 2], a0[4 * u + 3]};
                    *(LAS f32x4*)(orow + 32 + 8 * u) = (f32x4){a1[4 * u], a1[4 * u + 1], a1[4 * u + 2], a1[4 * u + 3]};
                }
                const float lt = lp + __shfl_xor(lp, 32);
                if (h == 0) { mrefs[myrow] = mr; lacc[myrow] = lt; }
            } else {
                const unsigned mlo = tokm[2 * j], mhi = tokm[2 * j + 1];
                const int nact = __popc(mlo) + __popc(mhi);
                if (8 * w >= nact) break;
                const int ct = 8 * w + (r >> 2);
                const bool valid = ct < nact;
                const int tau = nth_set_bit64(mlo, mhi, valid ? ct : 0);
                const int row = tau * 4 + head;
                bf16x8 q2[4];
                _Pragma("unroll") for (int kk = 0; kk < 4; ++kk) q2[kk] = *(LAS const bf16x8*)(qs + row * 144 + (16 * kk + 8 * h) * 2);
                const float mrow = valid ? mrefs[row] : INFINITY;
                LAS float* orow = olds + row * AT_OP + 4 * h;
                f32x16 a0, a1;
                _Pragma("unroll") for (int u = 0; u < 4; ++u) {
                    const f32x4 x0 = *(LAS const f32x4*)(orow + 8 * u), x1 = *(LAS const f32x4*)(orow + 32 + 8 * u);
                    a0[4 * u] = x0[0]; a0[4 * u + 1] = x0[1]; a0[4 * u + 2] = x0[2]; a0[4 * u + 3] = x0[3];
                    a1[4 * u] = x1[0]; a1[4 * u + 1] = x1[1]; a1[4 * u + 2] = x1[2]; a1[4 * u + 3] = x1[3];
                }
                float lp = 0.f;
                at_tile_pipe(buf, q2, ramp, base0, mrow, sl2 * 32.0f, lp, a0, a1);
                const float lt = lp + __shfl_xor(lp, 32);
                if (valid) {
                    _Pragma("unroll") for (int u = 0; u < 4; ++u) {
                        *(LAS f32x4*)(orow + 8 * u) = (f32x4){a0[4 * u], a0[4 * u + 1], a0[4 * u + 2], a0[4 * u + 3]};
                        *(LAS f32x4*)(orow + 32 + 8 * u) = (f32x4){a1[4 * u], a1[4 * u + 1], a1[4 * u + 2], a1[4 * u + 3]};
                    }
                    if (h == 0) lacc[row] += lt;
                }
            }
        )
#undef ROW_
        __syncthreads();
        {
            const float l = lacc[myrow];
            GATE_(1, g1)
            const float sc = g1 / l;
            LAS const float* orow = olds + myrow * AT_OP + 4 * h;
#pragma unroll
            for (int u = 0; u < 4; ++u)
#pragma unroll
                for (int q = 0; q < 4; ++q) { R0[4 * u + q] += sc * orow[8 * u + q]; R1[4 * u + q] += sc * orow[32 + 8 * u + q]; }
        }
    }

    {
        const bf16_t* Kw = pt + ((size_t)(HG_KW + g) * NTOK + (size_t)b * SEQ) * 64;
        const bf16_t* Vw = pt + ((size_t)(HG_VW + g) * NTOK + (size_t)b * SEQ) * 64;
        f32x16 o0, o1;
#pragma unroll
        for (int i = 0; i < 16; ++i) { o0[i] = 0.f; o1[i] = 0.f; }
        float mref = 0.f, l = 0.f;
        const int ntile = (c >= 8) ? 9 : (c + 1);
#define ROW_(_i) (64 * (c - (_i)))
        AT_PASS(Kw, Vw, true, ntile, ROW_,
            const float base0 = sl2 * (float)(-64 * i);
            if (i == 0 || i == 8) {
                f32x16 s0, s1;
                at_scores(buf, qf, ramp, base0, base0 + sl2 * 32.0f, s0, s1);
                if (i == 0) {
                    const int lim = tokl - 4 * h;
                    AT_MASK_LE(s0, s1, lim);
                    mref = at_rowmax(s0, s1);
                } else {
                    const int lo = tokl + 1 - 4 * h;
                    AT_MASK_GE(s0, s1, lo);
                }
                l += at_exp(s0, s1, mref);
                at_pv(buf, s0, s1, o0, o1);
            } else {
                at_tile_pipe(buf, qf, ramp, base0, mref, sl2 * 32.0f, l, o0, o1);
            }
        )
#undef ROW_
        l += __shfl_xor(l, 32);
        GATE_(2, g2)
        const float sc = g2 / l;
#pragma unroll
        for (int i = 0; i < 16; ++i) { R0[i] += sc * o0[i]; R1[i] += sc * o1[i]; }
    }

    {
        bf16_t* orow = (bf16_t*)(wsb + WS_MIXB) + (size_t)tok * DM + 512 + hq * 64 + 4 * h;
#pragma unroll
        for (int u = 0; u < 4; ++u) {
            u32x2 a, bq;
            a.x = pk_bf16(R0[4 * u], R0[4 * u + 1]);
            a.y = pk_bf16(R0[4 * u + 2], R0[4 * u + 3]);
            bq.x = pk_bf16(R1[4 * u], R1[4 * u + 1]);
            bq.y = pk_bf16(R1[4 * u + 2], R1[4 * u + 3]);
            *(u32x2*)(orow + 8 * u) = a;
            *(u32x2*)(orow + 32 + 8 * u) = bq;
        }
    }
}

constexpr int PART_REC = 136, PART_ROW = 4 * PART_REC;
__device__ __forceinline__ unsigned char* part_rec(unsigned char* wsb, int b, int hh, int t, int slot) {
    return wsb + WS_PART + ((size_t)((b * 8 + hh) * SEQ + t)) * PART_ROW + slot * PART_REC;
}
__device__ __forceinline__ void part_store(unsigned char* rec, const f32x16& o0, const f32x16& o1, float l, float m, int h) {
    const float sc = 1.0f / l;
    bf16_t* orow = (bf16_t*)rec + 4 * h;
#pragma unroll
    for (int u = 0; u < 4; ++u) {
        u32x2 a, bq;
        a.x = pk_bf16(sc * o0[4 * u], sc * o0[4 * u + 1]);
        a.y = pk_bf16(sc * o0[4 * u + 2], sc * o0[4 * u + 3]);
        bq.x = pk_bf16(sc * o1[4 * u], sc * o1[4 * u + 1]);
        bq.y = pk_bf16(sc * o1[4 * u + 2], sc * o1[4 * u + 3]);
        *(u32x2*)(orow + 8 * u) = a;
        *(u32x2*)(orow + 32 + 8 * u) = bq;
    }
    if (h == 0) { f32x2 lm = {l, m}; *(f32x2*)(rec + 128) = lm; }
}

__device__ __forceinline__ void moba_gate_item(const Params& p, unsigned char* shm, int b, int hh, int cb) {
    LAS unsigned char* lds = (LAS unsigned char*)shm;
    unsigned char* wsb = (unsigned char*)p.ws;
    const bf16_t* pt = (const bf16_t*)(wsb + WS_PT);
    int tid = threadIdx.x;
    asm volatile("" : "+v"(tid));
    const int lane = tid & 63, w = __builtin_amdgcn_readfirstlane(tid >> 6), r = lane & 31, h = lane >> 5;
    const int tloc = 32 * w + r, t = 256 * cb + tloc, tok = b * SEQ + t;
    LAS float* kms = (LAS float*)(lds + AT_KMS);
    LAS int* lcnt = (LAS int*)(lds + AT_SELB);
    LAS int* lbase = lcnt + 32;
    int* mcnt = (int*)(wsb + WS_MCNT) + (b * 8 + hh) * 32;
    unsigned short* mlist = (unsigned short*)(wsb + WS_MLIST) + (size_t)((b * 8 + hh) * 32) * 8192;
    __syncthreads();
    {
        const f32x4 v = ((const f32x4*)((const float*)(wsb + WS_KMEAN) + (size_t)(b * 8 + hh) * 2048))[tid];
        *(LAS f32x4*)(kms + tid * 4) = v;
    }
    if (tid < 32) lcnt[tid] = 0;
    __syncthreads();
    float qv[32];
    {
        const bf16_t* qrow = pt + ((size_t)(HG_MQ + hh) * NTOK + tok) * 64 + 8 * h;
#pragma unroll
        for (int kk = 0; kk < 4; ++kk) {
            const u32x4 qq = *(const u32x4*)(qrow + 16 * kk);
            qv[kk * 8 + 0] = bf_lo(qq.x); qv[kk * 8 + 1] = bf_hi(qq.x);
            qv[kk * 8 + 2] = bf_lo(qq.y); qv[kk * 8 + 3] = bf_hi(qq.y);
            qv[kk * 8 + 4] = bf_lo(qq.z); qv[kk * 8 + 5] = bf_hi(qq.z);
            qv[kk * 8 + 6] = bf_lo(qq.w); qv[kk * 8 + 7] = bf_hi(qq.w);
        }
    }
    float b0 = -INFINITY, b1 = -INFINITY, b2 = -INFINITY;
    int i0 = 0, i1 = 0, i2 = 0;
    for (int n = 0; n < cb; ++n) {
        float s = 0.f;
#pragma unroll
        for (int kk = 0; kk < 4; ++kk) {
            const f32x4 ka = *(LAS const f32x4*)(kms + n * 64 + 16 * kk + 8 * h), kb = *(LAS const f32x4*)(kms + n * 64 + 16 * kk + 8 * h + 4);
            s += qv[kk * 8 + 0] * ka[0] + qv[kk * 8 + 1] * ka[1] + qv[kk * 8 + 2] * ka[2] + qv[kk * 8 + 3] * ka[3];
            s += qv[kk * 8 + 4] * kb[0] + qv[kk * 8 + 5] * kb[1] + qv[kk * 8 + 6] * kb[2] + qv[kk * 8 + 7] * kb[3];
        }
        s += __shfl_xor(s, 32);
        if (s > b0) { b2 = b1; i2 = i1; b1 = b0; i1 = i0; b0 = s; i0 = n; }
        else if (s > b1) { b2 = b1; i2 = i1; b1 = s; i1 = n; }
        else if (s > b2) { b2 = s; i2 = n; }
    }
    const int nsel = cb < 3 ? cb : 3;
    int n0 = i0, n1 = i1, n2 = i2;
    if (nsel >= 2 && n1 < n0) { const int x = n0; n0 = n1; n1 = x; }
    if (nsel >= 3) {
        if (n2 < n1) { const int x = n1; n1 = n2; n2 = x; }
        if (n1 < n0) { const int x = n0; n0 = n1; n1 = x; }
    }
    int r0 = 0, r1 = 0, r2 = 0;
    if (h == 0) {
        r0 = atomicAdd((int*)(lcnt + n0), 1);
        if (nsel >= 2) r1 = atomicAdd((int*)(lcnt + n1), 1);
        if (nsel >= 3) r2 = atomicAdd((int*)(lcnt + n2), 1);
    }
    __syncthreads();
    if (tid < cb) lbase[tid] = atomicAdd(mcnt + tid, lcnt[tid]);
    __syncthreads();
    if (h == 0) {
        mlist[(size_t)n0 * 8192 + lbase[n0] + r0] = (unsigned short)(t | (0 << 13));
        if (nsel >= 2) mlist[(size_t)n1 * 8192 + lbase[n1] + r1] = (unsigned short)(t | (1 << 13));
        if (nsel >= 3) mlist[(size_t)n2 * 8192 + lbase[n2] + r2] = (unsigned short)(t | (2 << 13));
    }
}

__device__ __forceinline__ void moba_own_item(const Params& p, unsigned char* shm, int b, int hh, int cb) {
    LAS unsigned char* lds = (LAS unsigned char*)shm;
    unsigned char* wsb = (unsigned char*)p.ws;
    const bf16_t* pt = (const bf16_t*)(wsb + WS_PT);
    int tid = threadIdx.x;
    asm volatile("" : "+v"(tid));
    const int lane = tid & 63, w = __builtin_amdgcn_readfirstlane(tid >> 6), r = lane & 31, h = lane >> 5;
    const int tloc = 32 * w + r, t = 256 * cb + tloc, tok = b * SEQ + t;
    const float sl2 = exp2f(-((float)hh + 0.5f)) * LOG2E;
    const float ramp = sl2;
    bf16x8 qf[4];
    {
        const bf16_t* qrow = pt + ((size_t)(HG_MQ + hh) * NTOK + tok) * 64 + 8 * h;
#pragma unroll
        for (int kk = 0; kk < 4; ++kk) qf[kk] = *(const bf16x8*)(qrow + 16 * kk);
    }
    const bf16_t* Km = pt + ((size_t)(HG_MK + hh) * NTOK + (size_t)b * SEQ) * 64;
    const bf16_t* Vm = pt + ((size_t)(HG_MV + hh) * NTOK + (size_t)b * SEQ) * 64;
    f32x16 o0, o1;
#pragma unroll
    for (int i = 0; i < 16; ++i) { o0[i] = 0.f; o1[i] = 0.f; }
    float mref = 0.f, l = 0.f;
    const int wt = w >> 1;
#define ROW_(_i) (256 * cb + 64 * (3 - (_i)))
    AT_PASS(Km, Vm, true, 4, ROW_,
        const int tt = 3 - i;
        if (tt > wt) break;
        const float base0 = sl2 * (float)(64 * tt);
        if (tt == wt) {
            f32x16 s0, s1;
            at_scores(buf, qf, ramp, base0, base0 + sl2 * 32.0f, s0, s1);
            const int lim = tloc - 64 * tt - 4 * h;
            AT_MASK_LE(s0, s1, lim);
            mref = at_rowmax(s0, s1);
            l += at_exp(s0, s1, mref);
            at_pv(buf, s0, s1, o0, o1);
        } else {
            at_tile_pipe(buf, qf, ramp, base0, mref, sl2 * 32.0f, l, o0, o1);
        }
        )
#undef ROW_
    l += __shfl_xor(l, 32);
    part_store(part_rec(wsb, b, hh, t, 3), o0, o1, l, mref - sl2 * (float)tloc, h);
}

__device__ __forceinline__ void moba_gather_item(const Params& p, unsigned char* shm, int b, int hh, int n, int k, int cnt) {
    LAS unsigned char* lds = (LAS unsigned char*)shm;
    unsigned char* wsb = (unsigned char*)p.ws;
    const bf16_t* pt = (const bf16_t*)(wsb + WS_PT);
    int tid = threadIdx.x;
    asm volatile("" : "+v"(tid));
    const int lane = tid & 63, w = __builtin_amdgcn_readfirstlane(tid >> 6), r = lane & 31, h = lane >> 5;
    const unsigned short* mlist = (const unsigned short*)(wsb + WS_MLIST) + (size_t)((b * 8 + hh) * 32 + n) * 8192;
    const int li = 256 * k + 32 * w + r;
    const bool live = li < cnt;
    const unsigned ent = mlist[live ? li : cnt - 1];
    const int t = ent & 8191, slot = ent >> 13, tok = b * SEQ + t;
    const float sl2 = exp2f(-((float)hh + 0.5f)) * LOG2E;
    const float ramp = sl2;
    bf16x8 qf[4];
    {
        const bf16_t* qrow = pt + ((size_t)(HG_MQ + hh) * NTOK + tok) * 64 + 8 * h;
#pragma unroll
        for (int kk = 0; kk < 4; ++kk) qf[kk] = *(const bf16x8*)(qrow + 16 * kk);
    }
    const bf16_t* Km = pt + ((size_t)(HG_MK + hh) * NTOK + (size_t)b * SEQ) * 64;
    const bf16_t* Vm = pt + ((size_t)(HG_MV + hh) * NTOK + (size_t)b * SEQ) * 64;
    f32x16 o0, o1;
#pragma unroll
    for (int i = 0; i < 16; ++i) { o0[i] = 0.f; o1[i] = 0.f; }
    float mref = 0.f, l = 0.f;
    const float tb = sl2 * (float)(256 * n - t);
#define ROW_(_i) (256 * n + 64 * (3 - (_i)))
    AT_PASS(Km, Vm, true, 4, ROW_,
        const int tt = 3 - i;
        const float base0 = tb + sl2 * (float)(64 * tt);
        if (i == 0) {
            f32x16 s0, s1;
            at_scores(buf, qf, ramp, base0, base0 + sl2 * 32.0f, s0, s1);
            mref = at_rowmax(s0, s1);
            l += at_exp(s0, s1, mref);
            at_pv(buf, s0, s1, o0, o1);
        } else {
            at_tile_pipe(buf, qf, ramp, base0, mref, sl2 * 32.0f, l, o0, o1);
        }
        )
#undef ROW_
    l += __shfl_xor(l, 32);
    if (live) part_store(part_rec(wsb, b, hh, t, slot), o0, o1, l, mref, h);
}

__device__ __forceinline__ void f_moba_merge(const Params& p) {
    unsigned char* wsb = (unsigned char*)p.ws;
    const int tid = threadIdx.x;
    bf16_t* mixb = (bf16_t*)(wsb + WS_MIXB);
    for (int idx = blockIdx.x * 512 + tid; idx < NTOK * 8 * 8; idx += gridDim.x * 512) {
        const int dq = idx & 7, rho = idx >> 3;
        const int t = rho & (SEQ - 1), bh = rho >> 13, hh = bh & 7, b = bh >> 3;
        const int cbk = t >> 8, nsel = cbk < 3 ? cbk : 3;
        const unsigned char* row = wsb + WS_PART + (size_t)rho * PART_ROW;
        float lw[4];
        float M = -INFINITY;
        f32x2 lm[4];
#pragma unroll
        for (int s = 0; s < 4; ++s) {
            const bool on = (s == 3) || (s < nsel);
            lm[s] = on ? *(const f32x2*)(row + s * PART_REC + 128) : (f32x2){0.f, -INFINITY};
            M = fmaxf(M, lm[s][1]);
        }
        float W = 0.f;
#pragma unroll
        for (int s = 0; s < 4; ++s) { lw[s] = lm[s][0] * __builtin_amdgcn_exp2f(lm[s][1] - M); W += lw[s]; }
        float acc[8];
#pragma unroll
        for (int q = 0; q < 8; ++q) acc[q] = 0.f;
#pragma unroll
        for (int s = 0; s < 4; ++s) {
            const bool on = (s == 3) || (s < nsel);
            if (on) {
                const u32x4 v = *(const u32x4*)(row + s * PART_REC + dq * 16);
                acc[0] += lw[s] * bf_lo(v.x); acc[1] += lw[s] * bf_hi(v.x);
                acc[2] += lw[s] * bf_lo(v.y); acc[3] += lw[s] * bf_hi(v.y);
                acc[4] += lw[s] * bf_lo(v.z); acc[5] += lw[s] * bf_hi(v.z);
                acc[6] += lw[s] * bf_lo(v.w); acc[7] += lw[s] * bf_hi(v.w);
            }
        }
        const float inv = 1.0f / W;
        u32x4 o;
        o.x = pk_bf16(acc[0] * inv, acc[1] * inv);
        o.y = pk_bf16(acc[2] * inv, acc[3] * inv);
        o.z = pk_bf16(acc[4] * inv, acc[5] * inv);
        o.w = pk_bf16(acc[6] * inv, acc[7] * inv);
        *(u32x4*)(mixb + (size_t)(b * SEQ + t) * DM + hh * 64 + dq * 8) = o;
    }
}

__device__ __forceinline__ void f_moba_gate(const Params& p, unsigned char* shm) {
    for (int q = blockIdx.x; q < 1024; q += gridDim.x) {
        const int cb = q >> 5, bh = q & 31;
        if (cb >= 1) moba_gate_item(p, shm, bh >> 3, bh & 7, cb);
    }
    __syncthreads();
}

__device__ __forceinline__ void f_attn(const Params& p, unsigned char* shm) {
    const int G = gridDim.x, bx = blockIdx.x;
#pragma unroll 1
    for (int gg = 1; gg >= 0; --gg)
#pragma unroll 1
        for (int s = 0; s * G < 512; ++s) {
            const int q = s * G + ((s & 1) ? (G - 1 - bx) : bx);
            if (q < 512) nsa_item(p, shm, q & 3, gg, 127 - (q >> 2));
        }
    for (int q = bx; q < 1024; q += G) moba_own_item(p, shm, (q & 31) >> 3, q & 7, q >> 5);
    {
        LAS int* pre = (LAS int*)((LAS unsigned char*)shm + AT_IMPA);
        const int* mcnt = (const int*)((unsigned char*)p.ws + WS_MCNT);
        int tid = threadIdx.x;
        asm volatile("" : "+v"(tid));
        __syncthreads();
        {
            LAS int* wtot = pre + 1040;
            const int lane = tid & 63, w = tid >> 6;
            const int v0 = (mcnt[2 * tid] + 255) >> 8, v1 = (mcnt[2 * tid + 1] + 255) >> 8;
            int sc = v0 + v1;
#pragma unroll
            for (int d = 1; d < 64; d <<= 1) { const int u = __shfl_up(sc, d); if (lane >= d) sc += u; }
            if (lane == 63) wtot[w] = sc;
            __syncthreads();
            int woff = 0;
            for (int ww = 0; ww < w; ++ww) woff += wtot[ww];
            const int excl = woff + sc - (v0 + v1);
            pre[2 * tid] = excl;
            pre[2 * tid + 1] = excl + v0;
            if (tid == 511) pre[1024] = excl + v0 + v1;
        }
        __syncthreads();
        const int total = pre[1024];
        for (int it = bx; it < total; it += G) {
            int lo = 0, hi = 1024;
            while (hi - lo > 1) { const int mid = (lo + hi) >> 1; if (pre[mid] <= it) lo = mid; else hi = mid; }
            const int li = lo, k = it - pre[li];
            const int cnt = mcnt[li];
            moba_gather_item(p, shm, li >> 8, (li >> 5) & 7, li & 31, k, cnt);
        }
    }
    __syncthreads();
}

__device__ __forceinline__ void f_prologue(const Params& p, unsigned char* shm) {
    const int tid = threadIdx.x, lane = tid & 63, w = tid >> 6;
    unsigned char* wsb = (unsigned char*)p.ws;
    bf16_t* xn = (bf16_t*)(wsb + WS_XN);
    {
        float4* km = (float4*)(wsb + WS_KMEAN);
        for (int i = blockIdx.x * 512 + tid; i < 16384; i += gridDim.x * 512) km[i] = make_float4(0.f, 0.f, 0.f, 0.f);
        int* mc = (int*)(wsb + WS_MCNT);
        for (int i = blockIdx.x * 512 + tid; i < 1024; i += gridDim.x * 512) mc[i] = 0;
    }
    for (int row = blockIdx.x * 8 + w; row < NTOK; row += gridDim.x * 8) {
        const float4* xr = (const float4*)(p.x + (size_t)row * DM);
        float4 v[4];
        float ss = 0.f;
#pragma unroll
        for (int j = 0; j < 4; ++j) { v[j] = xr[lane + 64 * j]; ss += dot4(v[j], v[j]); }
        ss = wave_sum(ss);
        const float r = 1.0f / sqrtf(ss * (1.0f / DM) + 1e-5f);
        const float4* g4 = (const float4*)p.attn_g;
        u32x2* o = (u32x2*)(xn + (size_t)row * DM);
#pragma unroll
        for (int j = 0; j < 4; ++j) {
            const float4 g = g4[lane + 64 * j];
            u32x2 ov;
            ov.x = pk_bf16(v[j].x * r * g.x, v[j].y * r * g.y);
            ov.y = pk_bf16(v[j].z * r * g.z, v[j].w * r * g.w);
            o[lane + 64 * j] = ov;
        }
    }
    float* T = (float*)shm;
    bf16_t* btin = (bf16_t*)(wsb + WS_BTIN);
    bf16_t* btout = (bf16_t*)(wsb + WS_BTOUT);
    bf16_t* btup = (bf16_t*)(wsb + WS_BTUP);
    bf16_t* btdn = (bf16_t*)(wsb + WS_BTDN);
    bf16_t* w1t = (bf16_t*)(wsb + WS_W1T);
    bf16_t* w2t = (bf16_t*)(wsb + WS_W2T);
    const auto ident = [](int c) { return c; };
    cv_run(T, 16 * 48, [&](int it, const float*& W, int& K, int& ncols, int& ldw, bf16_t*& WT, int& k0, int& n0) {
        const int g4 = it >> 2, sub = it & 3, kt = (g4 / 24) * 2 + (sub >> 1), nt = (g4 % 24) * 2 + (sub & 1);
        W = p.w_in; K = DM; ncols = INC; ldw = INC; WT = btin; k0 = kt * 64; n0 = nt * 64; }, ident);
    cv_run(T, 16 * 16, [&](int it, const float*& W, int& K, int& ncols, int& ldw, bf16_t*& WT, int& k0, int& n0) {
        const int g4 = it >> 2, sub = it & 3, kt = (g4 >> 3) * 2 + (sub >> 1), nt = (g4 & 7) * 2 + (sub & 1);
        W = p.w_out; K = DM; ncols = DM; ldw = DM; WT = btout; k0 = kt * 64; n0 = nt * 64; }, ident);
    cv_run(T, NE * 16 * 32, [&](int it, const float*& W, int& K, int& ncols, int& ldw, bf16_t*& WT, int& k0, int& n0) {
        const int e = it >> 9, r = it & 511;
        const int g4 = r >> 2, sub = r & 3, kt = (g4 >> 4) * 2 + (sub >> 1), nt = (g4 & 15) * 2 + (sub & 1);
        W = p.w_up + (size_t)e * DM * DFF2; K = DM; ncols = DFF2; ldw = DFF2; WT = btup + (size_t)e * DFF2 * DM; k0 = kt * 64; n0 = nt * 64; },
        [](int c) { const int a = c >> 1, isu = c & 1; return (a >> 7) * 256 + isu * 128 + (a & 127); });
    cv_run(T, NE * 16 * 16, [&](int it, const float*& W, int& K, int& ncols, int& ldw, bf16_t*& WT, int& k0, int& n0) {
        const int e = it >> 8, r = it & 255;
        const int g4 = r >> 2, sub = r & 3, kt = (g4 >> 3) * 2 + (sub >> 1), nt = (g4 & 7) * 2 + (sub & 1);
        W = p.w_down + (size_t)e * DM * DM; K = DM; ncols = DM; ldw = DM; WT = btdn + (size_t)e * DM * DM; k0 = kt * 64; n0 = nt * 64; }, ident);
    cv_run(T, 2 * 33, [&](int it, const float*& W, int& K, int& ncols, int& ldw, bf16_t*& WT, int& k0, int& n0) {
        const int kv = it / 33, r = it % 33;
        ncols = 64; ldw = 64; n0 = 0;
        if (r < 32) { W = kv ? p.w1v : p.w1k; K = 2048; WT = w1t + (size_t)kv * 64 * 2048; k0 = r * 64; }
        else        { W = kv ? p.w2v : p.w2k; K = 64;   WT = w2t + (size_t)kv * 64 * 64;   k0 = 0; } }, ident);
    __syncthreads();
    if (blockIdx.x == gridDim.x - 1) {
        const int o = tid & 127, part = tid >> 7, kv = o >> 6, n = o & 63;
        const float* pe = kv ? p.pe_v : p.pe_k;
        const float* w1 = kv ? p.w1v : p.w1k;
        float s = 0.f;
        for (int ff = part * 512; ff < part * 512 + 512; ++ff) s += pe[ff] * w1[ff * 64 + n];
        T[part * 128 + o] = s;
        __syncthreads();
        if (tid < 128) ((float*)(wsb + WS_C1))[tid] = T[tid] + T[128 + tid] + T[256 + tid] + T[384 + tid];
    }
    __syncthreads();
}

__device__ __forceinline__ void f_cmp(const Params& p, unsigned char* shm) {
    unsigned char* wsb = (unsigned char*)p.ws;
    const bf16_t* pt = (const bf16_t*)(wsb + WS_PT);
    const bf16_t* w1t = (const bf16_t*)(wsb + WS_W1T);
    const bf16_t* w2t = (const bf16_t*)(wsb + WS_W2T);
    const float* c1 = (const float*)(wsb + WS_C1);
    const int tid = threadIdx.x, lane = tid & 63, w = __builtin_amdgcn_readfirstlane(tid >> 6), fr = lane & 15, fq = lane >> 4;
    LAS float* part = (LAS float*)shm;
    LAS unsigned char* h1buf = (LAS unsigned char*)shm + 32768;
    for (int it = blockIdx.x; it < 512; it += gridDim.x) {
        const int rg = it & 31, g = (it >> 5) & 1, b = (it >> 6) & 3, kv = it >> 8;
        const int hg = (kv ? HG_VC : HG_KC) + g;
        const bf16_t* arow = pt + ((size_t)hg * NTOK + (size_t)b * SEQ + 16 * (16 * rg + fr)) * 64 + 8 * fq + 256 * w;
        const bf16_t* brow = w1t + ((size_t)kv * 64 + fr) * 2048 + 8 * fq + 256 * w;
        f32x4 acc[4];
#pragma unroll
        for (int nt = 0; nt < 4; ++nt) acc[nt] = (f32x4){0.f, 0.f, 0.f, 0.f};
#pragma unroll
        for (int kk = 0; kk < 8; ++kk) {
            const bf16x8 a = *(const bf16x8*)(arow + 32 * kk);
#pragma unroll
            for (int nt = 0; nt < 4; ++nt) {
                const bf16x8 bb = *(const bf16x8*)(brow + (size_t)nt * 16 * 2048 + 32 * kk);
                acc[nt] = __builtin_amdgcn_mfma_f32_16x16x32_bf16(a, bb, acc[nt], 0, 0, 0);
            }
        }
        __syncthreads();
#pragma unroll
        for (int nt = 0; nt < 4; ++nt)
#pragma unroll
            for (int reg = 0; reg < 4; ++reg) part[w * 1024 + (4 * fq + reg) * 64 + nt * 16 + fr] = acc[nt][reg];
        __syncthreads();
        {
#pragma unroll
            for (int q = 0; q < 2; ++q) {
                const int o = tid + 512 * q, row = o >> 6, col = o & 63;
                float s = c1[kv * 64 + col];
#pragma unroll
                for (int ww = 0; ww < 8; ++ww) s += part[ww * 1024 + o];
                *(LAS unsigned short*)(h1buf + row * 144 + col * 2) = (unsigned short)(pk_bf16(gelu_tanh(s), 0.f) & 0xffffu);
            }
        }
        __syncthreads();
        if (w == 0) {
            f32x4 acc2[4];
#pragma unroll
            for (int nt = 0; nt < 4; ++nt) acc2[nt] = (f32x4){0.f, 0.f, 0.f, 0.f};
#pragma unroll
            for (int k2 = 0; k2 < 2; ++k2) {
                const bf16x8 a2 = *(LAS const bf16x8*)(h1buf + fr * 144 + (32 * k2 + 8 * fq) * 2);
#pragma unroll
                for (int nt = 0; nt < 4; ++nt) {
                    const bf16x8 b2 = *(const bf16x8*)(w2t + ((size_t)kv * 64 + nt * 16 + fr) * 64 + 32 * k2 + 8 * fq);
                    acc2[nt] = __builtin_amdgcn_mfma_f32_16x16x32_bf16(a2, b2, acc2[nt], 0, 0, 0);
                }
            }
            bf16_t* dst = (bf16_t*)(wsb + (kv ? WS_VCMP : WS_KCMP)) + (size_t)((b * 2 + g) * NCMPP + 16 * rg) * 64;
#pragma unroll
            for (int nt = 0; nt < 4; ++nt)
#pragma unroll
                for (int reg = 0; reg < 4; ++reg)
                    dst[(size_t)(4 * fq + reg) * 64 + nt * 16 + fr] = (bf16_t)(pk_bf16(acc2[nt][reg], 0.f) & 0xffffu);
        }
    }
    __syncthreads();
}

__device__ __forceinline__ void f_inproj(const Params& p, unsigned char* shm) {
    unsigned char* wsb = (unsigned char*)p.ws;
    const bf16_t* xn = (const bf16_t*)(wsb + WS_XN);
    const bf16_t* btin = (const bf16_t*)(wsb + WS_BTIN);
    bf16_t* pt = (bf16_t*)(wsb + WS_PT);
    float* gates = (float*)(wsb + WS_GATES);
    float* kmean = (float*)(wsb + WS_KMEAN);
    const int tid = threadIdx.x, wid = __builtin_amdgcn_readfirstlane(tid >> 6), lane = tid & 63, wr = wid >> 2, wc = wid & 3;
    constexpr int NTN = NIN_PAD / 256;
    gemm256_stream((LAS unsigned char*)shm,
        [&](int i, const char*& A, const char*& B, unsigned (&va)[2][2], const GPiece& pc) __attribute__((always_inline)) {
            const int it = xcd_unit(blockIdx.x + i * gridDim.x, (NTOK / 256) * NTN);
            if (it < 0) return false;
            const int pm = it / NTN, pn = it % NTN;
            A = (const char*)xn;
            B = (const char*)(btin + (size_t)pn * 256 * DM);
#pragma unroll
            for (int h = 0; h < 2; ++h)
#pragma unroll
                for (int j = 0; j < 2; ++j) va[h][j] = (unsigned)((pm * 256 + h * 128 + pc.R[j]) * DM + pc.C[j]) * 2u;
            return true;
        },
        [&](int i, f32x4 (&acc)[2][2][4][2]) __attribute__((always_inline)) {
        const int it = xcd_unit(blockIdx.x + i * gridDim.x, (NTOK / 256) * NTN);
        const int pm = it / NTN, pn = it % NTN;
        int le = lane;
        asm volatile("" : "+v"(le));
        const int er = le & 15, eq = le >> 4;
        if (pn < 11) {
#pragma unroll
            for (int bj = 0; bj < 2; ++bj) {
                const int hg = pn * 4 + bj * 2 + (wc >> 1);
                const float sc = (hg < 8 || (hg >= 24 && hg < 32)) ? QSCALE : 1.0f;
                bf16_t* base = pt + ((size_t)hg * NTOK + pm * 256 + wr * 64) * 64 + (wc & 1) * 32 + 8 * eq;
#pragma unroll
                for (int ai = 0; ai < 2; ++ai)
#pragma unroll
                    for (int m = 0; m < 4; ++m) {
                        const f32x4 a0 = acc[ai][bj][m][0], a1 = acc[ai][bj][m][1];
                        u32x4 ov;
                        ov.x = pk_bf16(a0[0] * sc, a0[1] * sc);
                        ov.y = pk_bf16(a0[2] * sc, a0[3] * sc);
                        ov.z = pk_bf16(a1[0] * sc, a1[1] * sc);
                        ov.w = pk_bf16(a1[2] * sc, a1[3] * sc);
                        *(u32x4*)(base + (size_t)(ai * 128 + m * 16 + er) * 64) = ov;
                    }
                if (hg >= HG_MK && hg < HG_MK + 8) {
                    const int b = (pm * 256) / SEQ, nblk = ((pm * 256) % SEQ) >> 8, h = hg - HG_MK;
                    float* kb = kmean + (size_t)((b * 8 + h) * 32 + nblk) * 64 + (wc & 1) * 32 + 8 * eq;
#pragma unroll
                    for (int n = 0; n < 2; ++n) {
                        f32x4 s = acc[0][bj][0][n];
#pragma unroll
                        for (int m = 1; m < 4; ++m) s += acc[0][bj][m][n];
#pragma unroll
                        for (int m = 0; m < 4; ++m) s += acc[1][bj][m][n];
#pragma unroll
                        for (int o = 1; o < 16; o <<= 1) {
                            s[0] += __shfl_xor(s[0], o);
                            s[1] += __shfl_xor(s[1], o);
                            s[2] += __shfl_xor(s[2], o);
                            s[3] += __shfl_xor(s[3], o);
                        }
                        if (er == 0) {
                            float* d = kb + 4 * n;
                            unsafeAtomicAdd(d + 0, s[0]);
                            unsafeAtomicAdd(d + 1, s[1]);
                            unsafeAtomicAdd(d + 2, s[2]);
                            unsafeAtomicAdd(d + 3, s[3]);
                        }
                    }
                }
            }
        } else if (wc == 0) {
#pragma unroll
            for (int n = 0; n < 2; ++n) {
                const int gc = 8 * eq + 4 * n;
                if (gc < 24) {
#pragma unroll
                    for (int ai = 0; ai < 2; ++ai)
#pragma unroll
                        for (int m = 0; m < 4; ++m) {
                            const f32x4 a = acc[ai][0][m][n];
                            const int row = pm * 256 + ai * 128 + wr * 64 + m * 16 + er;
                            f32x4 sg;
                            sg[0] = 1.0f / (1.0f + __expf(-a[0]));
                            sg[1] = 1.0f / (1.0f + __expf(-a[1]));
                            sg[2] = 1.0f / (1.0f + __expf(-a[2]));
                            sg[3] = 1.0f / (1.0f + __expf(-a[3]));
                            *(f32x4*)(gates + (size_t)row * 24 + gc) = sg;
                        }
                }
            }
        }
    });
    __syncthreads();
}

__device__ __forceinline__ void f_outproj(const Params& p, unsigned char* shm) {
    unsigned char* wsb = (unsigned char*)p.ws;
    const bf16_t* mixb = (const bf16_t*)(wsb + WS_MIXB);
    const bf16_t* btout = (const bf16_t*)(wsb + WS_BTOUT);
    const int tid = threadIdx.x, wid = __builtin_amdgcn_readfirstlane(tid >> 6), lane = tid & 63, wr = wid >> 2, wc = wid & 3;
    gemm256_stream((LAS unsigned char*)shm,
        [&](int i, const char*& A, const char*& B, unsigned (&va)[2][2], const GPiece& pc) __attribute__((always_inline)) {
            const int it = xcd_unit(blockIdx.x + i * gridDim.x, (NTOK / 256) * 4);
            if (it < 0) return false;
            const int pm = it >> 2, pn = it & 3;
            A = (const char*)mixb;
            B = (const char*)(btout + (size_t)pn * 256 * DM);
#pragma unroll
            for (int h = 0; h < 2; ++h)
#pragma unroll
                for (int j = 0; j < 2; ++j) va[h][j] = (unsigned)((pm * 256 + h * 128 + pc.R[j]) * DM + pc.C[j]) * 2u;
            return true;
        },
        [&](int i, f32x4 (&acc)[2][2][4][2]) __attribute__((always_inline)) {
        const int it = xcd_unit(blockIdx.x + i * gridDim.x, (NTOK / 256) * 4);
        const int pm = it >> 2, pn = it & 3;
        int le = lane;
        asm volatile("" : "+v"(le));
        const int er = le & 15, eq = le >> 4;
#pragma unroll
        for (int ai = 0; ai < 2; ++ai)
#pragma unroll
            for (int m = 0; m < 4; ++m) {
                const size_t rowoff = (size_t)(pm * 256 + ai * 128 + wr * 64 + m * 16 + er) * DM;
#pragma unroll
                for (int bj = 0; bj < 2; ++bj)
#pragma unroll
                    for (int n = 0; n < 2; ++n) {
                        const size_t o = rowoff + pn * 256 + bj * 128 + wc * 32 + 8 * eq + 4 * n;
                        const f32x4 xv = *(const f32x4*)(p.x + o);
                        *(f32x4*)(p.out + o) = xv + acc[ai][bj][m][n];
                    }
            }
    });
    __syncthreads();
}

__device__ __forceinline__ float wave_max_fast(float x) {
    x = fmaxf(x, __int_as_float(__builtin_amdgcn_mov_dpp(__float_as_int(x), 0xB1, 0xF, 0xF, true)));
    x = fmaxf(x, __int_as_float(__builtin_amdgcn_mov_dpp(__float_as_int(x), 0x4E, 0xF, 0xF, true)));
    x = fmaxf(x, __int_as_float(__builtin_amdgcn_mov_dpp(__float_as_int(x), 0x141, 0xF, 0xF, true)));
    x = fmaxf(x, __int_as_float(__builtin_amdgcn_mov_dpp(__float_as_int(x), 0x140, 0xF, 0xF, true)));
    x = fmaxf(x, __shfl_xor(x, 16));
    x = fmaxf(x, __shfl_xor(x, 32));
    return x;
}
__device__ __forceinline__ void f_router(const Params& p, unsigned char* shm) {
    const int tid = threadIdx.x, lane = tid & 63, w = tid >> 6;
    unsigned char* wsb = (unsigned char*)p.ws;
    float* Wl = (float*)shm;
    int* hist = (int*)(shm + 147456);
    bf16_t* hb = (bf16_t*)(wsb + WS_H);
    int* sele = (int*)(wsb + WS_SELE);
    float* selw = (float*)(wsb + WS_SELW);
    int* selr = (int*)(wsb + WS_SELR);
    int* bcnt = (int*)(wsb + WS_BCNT);
    __syncthreads();
    for (int idx = tid; idx < 8192; idx += 512) {
        const int k = idx >> 3, e4 = idx & 7;
        const float4 v = ((const float4*)p.w_router)[idx];
        const int rho = ((k >> 8) * 4 + (k & 3)) * 64 + ((k >> 2) & 63);
        *(float4*)(Wl + rho * 36 + e4 * 4) = v;
    }
    const float bias = p.b_router[lane >> 1];
    const float4* g4 = (const float4*)p.ffn_g;
    float4 gv[4];
#pragma unroll
    for (int j = 0; j < 4; ++j) gv[j] = g4[lane + 64 * j];
    for (int c = blockIdx.x; c < NTOK / 128; c += gridDim.x) {
        __syncthreads();
        if (tid < 32) hist[tid] = 0;
        __syncthreads();
        float4 vn[4];
        {
            const float4* xr = (const float4*)(p.out + (size_t)(c * 128 + w * 16) * DM);
#pragma unroll
            for (int j = 0; j < 4; ++j) vn[j] = xr[lane + 64 * j];
        }
        for (int rr = 0; rr < 16; ++rr) {
            const int row = c * 128 + w * 16 + rr;
            float4 v[4];
#pragma unroll
            for (int j = 0; j < 4; ++j) v[j] = vn[j];
            if (rr + 1 < 16) {
                const float4* xr = (const float4*)(p.out + (size_t)(row + 1) * DM);
#pragma unroll
                for (int j = 0; j < 4; ++j) vn[j] = xr[lane + 64 * j];
            }
            float ss = 0.f;
#pragma unroll
            for (int j = 0; j < 4; ++j) ss += dot4(v[j], v[j]);
            ss = wave_sum(ss);
            const float r = 1.0f / sqrtf(ss * (1.0f / DM) + 1e-5f);
            u32x2* o = (u32x2*)(hb + (size_t)row * DM);
#pragma unroll
            for (int j = 0; j < 4; ++j) {
                v[j] = make_float4(v[j].x * r * gv[j].x, v[j].y * r * gv[j].y, v[j].z * r * gv[j].z, v[j].w * r * gv[j].w);
                u32x2 ov;
                ov.x = pk_bf16(v[j].x, v[j].y);
                ov.y = pk_bf16(v[j].z, v[j].w);
                o[lane + 64 * j] = ov;
            }
            float lg[32];
#pragma unroll
            for (int e = 0; e < 32; ++e) lg[e] = 0.f;
#pragma unroll
            for (int j = 0; j < 4; ++j) {
                const float hv[4] = {v[j].x, v[j].y, v[j].z, v[j].w};
#pragma unroll
                for (int cc = 0; cc < 4; ++cc) {
                    const float4* wr = (const float4*)(Wl + ((j * 4 + cc) * 64 + lane) * 36);
#pragma unroll
                    for (int e4 = 0; e4 < 8; ++e4) {
                        const float4 wv = wr[e4];
                        lg[e4 * 4 + 0] += hv[cc] * wv.x;
                        lg[e4 * 4 + 1] += hv[cc] * wv.y;
                        lg[e4 * 4 + 2] += hv[cc] * wv.z;
                        lg[e4 * 4 + 3] += hv[cc] * wv.w;
                    }
                }
            }
#define RS_STEP(N, OFF, BIT)                                                                                           \
            {                                                                                                          \
                const bool up_ = (lane >> (BIT)) & 1;                                                                  \
                _Pragma("unroll") for (int i_ = 0; i_ < (N); ++i_) {                                                     \
                    const float send_ = up_ ? lg[i_] : lg[(N) + i_];                                                   \
                    const float keep_ = up_ ? lg[(N) + i_] : lg[i_];                                                   \
                    lg[i_] = keep_ + __shfl_xor(send_, (OFF));                                                         \
                }                                                                                                      \
            }
            RS_STEP(16, 32, 5)
            RS_STEP(8, 16, 4)
            RS_STEP(4, 8, 3)
            RS_STEP(2, 4, 2)
            RS_STEP(1, 2, 1)
#undef RS_STEP
            float val = lg[0] + __shfl_xor(lg[0], 1) + bias;
            float tv[4];
            int ti[4];
#pragma unroll
            for (int s = 0; s < 4; ++s) {
                const float mx = wave_max_fast(val);
                const unsigned long long bal = __ballot(val == mx);
                const int ln = __ffsll((long long)bal) - 1;
                tv[s] = mx;
                ti[s] = ln >> 1;
                if ((lane >> 1) == (ln >> 1)) val = -INFINITY;
            }
            const float e1 = __expf(tv[1] - tv[0]), e2 = __expf(tv[2] - tv[0]), e3 = __expf(tv[3] - tv[0]);
            const float inv = 1.0f / (1.0f + e1 + e2 + e3);
            if (lane == 0) {
                const float wv[4] = {inv, e1 * inv, e2 * inv, e3 * inv};
#pragma unroll
                for (int s = 0; s < 4; ++s) {
                    sele[row * 4 + s] = ti[s];
                    selw[row * 4 + s] = wv[s];
                    selr[row * 4 + s] = atomicAdd(&hist[ti[s]], 1);
                }
            }
        }
        __syncthreads();
        if (tid < 32) bcnt[c * 32 + tid] = hist[tid];
    }
    __syncthreads();
}

__device__ __forceinline__ void f_fill(const Params& p, unsigned char* shm) {
    const int tid = threadIdx.x;
    unsigned char* wsb = (unsigned char*)p.ws;
    const int* sele = (const int*)(wsb + WS_SELE);
    const float* selw = (const float*)(wsb + WS_SELW);
    const int* selr = (const int*)(wsb + WS_SELR);
    int* selp = (int*)(wsb + WS_SELP);
    const int* bcnt = (const int*)(wsb + WS_BCNT);
    int* gcnt = (int*)(wsb + WS_GCNT);
    int* rtok = (int*)(wsb + WS_RTOK);
    float* rw = (float*)(wsb + WS_RW);
    int* pa = (int*)shm;
    int* pb = pa + 512;
    int* tot = pb + 512;
    int* base = tot + 32;
    int* pstart = base + 32;
    for (int c = blockIdx.x; c < NTOK / 128; c += gridDim.x) {
        __syncthreads();
        {
            const int e = tid & 31, part = tid >> 5;
            int sa = 0, sb = 0;
            for (int cc = part * 16; cc < part * 16 + 16; ++cc) {
                const int v = bcnt[cc * 32 + e];
                sa += v;
                sb += (cc < c) ? v : 0;
            }
            pa[part * 32 + e] = sa;
            pb[part * 32 + e] = sb;
        }
        __syncthreads();
        if (tid < 32) {
            int sa = 0, sb = 0;
            for (int q = 0; q < 16; ++q) { sa += pa[q * 32 + tid]; sb += pb[q * 32 + tid]; }
            tot[tid] = sa;
            base[tid] = sb;
        }
        __syncthreads();
        if (tid == 0) {
            int a = 0;
            for (int e = 0; e < NE; ++e) { pstart[e] = a; a += ((tot[e] + 255) >> 8) << 8; }
            pstart[NE] = a;
        }
        __syncthreads();
        {
            const int i = c * 512 + tid;
            const int e = sele[i];
            const int pos = pstart[e] + base[e] + selr[i];
            rtok[pos] = i >> 2;
            rw[pos] = selw[i];
            selp[i] = pos;
        }
        if (c == 0) {
            if (tid < 32) gcnt[tid] = tot[tid];
            for (int e = 0; e < NE; ++e) {
                const int r0 = pstart[e] + tot[e], r1 = pstart[e + 1];
                for (int r = r0 + tid; r < r1; r += 512) { rtok[r] = 0; rw[r] = 0.f; }
            }
        }
    }
    __syncthreads();
}

__device__ __forceinline__ void f_build_tiles(const Params& p, int* tb) {
    const int* gcnt = (const int*)((unsigned char*)p.ws + WS_GCNT);
    __syncthreads();
    if (threadIdx.x == 0) {
        int a = 0, t = 0;
        for (int e = 0; e < NE; ++e) {
            tb[e] = a;
            tb[40 + e] = t;
            const int nt = (gcnt[e] + 255) >> 8;
            a += nt << 8;
            t += nt;
        }
        tb[32] = a;
        tb[40 + 32] = t;
    }
    __syncthreads();
}

__device__ __forceinline__ void f_up(const Params& p, unsigned char* shm) {
    unsigned char* wsb = (unsigned char*)p.ws;
    int* tb = (int*)(shm + GEMM_LDS_BYTES);
    f_build_tiles(p, tb);
    const int T = tb[40 + 32];
    const bf16_t* hb = (const bf16_t*)(wsb + WS_H);
    const bf16_t* btup = (const bf16_t*)(wsb + WS_BTUP);
    bf16_t* act = (bf16_t*)(wsb + WS_ACT);
    const int* rtok = (const int*)(wsb + WS_RTOK);
    const int tid = threadIdx.x, wid = __builtin_amdgcn_readfirstlane(tid >> 6), lane = tid & 63, wr = wid >> 2, wc = wid & 3;
    gemm256_stream((LAS unsigned char*)shm,
        [&](int i, const char*& A, const char*& B, unsigned (&va)[2][2], const GPiece& pc) __attribute__((always_inline)) {
            const int it = xcd_unit(blockIdx.x + i * gridDim.x, T * 8);
            if (it < 0) return false;
            const int vt = it >> 3, pn = it & 7;
            int e = 0;
            while (tb[40 + e + 1] <= vt) ++e;
            const int rowbase = tb[e] + (vt - tb[40 + e]) * 256;
            A = (const char*)hb;
            B = (const char*)(btup + ((size_t)e * DFF2 + pn * 256) * DM);
#pragma unroll
            for (int h = 0; h < 2; ++h)
#pragma unroll
                for (int j = 0; j < 2; ++j) va[h][j] = (unsigned)(rtok[rowbase + h * 128 + pc.R[j]] * DM + pc.C[j]) * 2u;
            return true;
        },
        [&](int i, f32x4 (&acc)[2][2][4][2]) __attribute__((always_inline)) {
        const int it = xcd_unit(blockIdx.x + i * gridDim.x, T * 8);
        const int vt = it >> 3, pn = it & 7;
        int e = 0;
        while (tb[40 + e + 1] <= vt) ++e;
        const int rowbase = tb[e] + (vt - tb[40 + e]) * 256;
        int le = lane;
        asm volatile("" : "+v"(le));
        const int er = le & 15, eq = le >> 4;
        const float* bias = p.b_up + (size_t)e * DFF2;
        const int a0 = pn * 128 + wc * 32 + 8 * eq;
        float bg[8], bu[8];
        {
            const float4 q0 = *(const float4*)(bias + 2 * a0), q1 = *(const float4*)(bias + 2 * a0 + 4), q2 = *(const float4*)(bias + 2 * a0 + 8),
                         q3 = *(const float4*)(bias + 2 * a0 + 12);
            bg[0] = q0.x; bu[0] = q0.y; bg[1] = q0.z; bu[1] = q0.w; bg[2] = q1.x; bu[2] = q1.y; bg[3] = q1.z; bu[3] = q1.w;
            bg[4] = q2.x; bu[4] = q2.y; bg[5] = q2.z; bu[5] = q2.w; bg[6] = q3.x; bu[6] = q3.y; bg[7] = q3.z; bu[7] = q3.w;
        }
#pragma unroll
        for (int ai = 0; ai < 2; ++ai)
#pragma unroll
            for (int mm = 0; mm < 4; ++mm) {
                const int row = rowbase + ai * 128 + wr * 64 + mm * 16 + er;
                const f32x4 g0 = acc[ai][0][mm][0], g1 = acc[ai][0][mm][1], u0 = acc[ai][1][mm][0], u1 = acc[ai][1][mm][1];
                u32x4 ov;
                ov.x = pk_bf16(swiglu(g0[0] + bg[0], u0[0] + bu[0]), swiglu(g0[1] + bg[1], u0[1] + bu[1]));
                ov.y = pk_bf16(swiglu(g0[2] + bg[2], u0[2] + bu[2]), swiglu(g0[3] + bg[3], u0[3] + bu[3]));
                ov.z = pk_bf16(swiglu(g1[0] + bg[4], u1[0] + bu[4]), swiglu(g1[1] + bg[5], u1[1] + bu[5]));
                ov.w = pk_bf16(swiglu(g1[2] + bg[6], u1[2] + bu[6]), swiglu(g1[3] + bg[7], u1[3] + bu[7]));
                *(u32x4*)(act + (size_t)row * DM + a0) = ov;
            }
    });
    __syncthreads();
}

__device__ __forceinline__ void f_down(const Params& p, unsigned char* shm) {
    unsigned char* wsb = (unsigned char*)p.ws;
    int* tb = (int*)(shm + GEMM_LDS_BYTES);
    f_build_tiles(p, tb);
    const int T = tb[40 + 32];
    const bf16_t* act = (const bf16_t*)(wsb + WS_ACT);
    const bf16_t* btdn = (const bf16_t*)(wsb + WS_BTDN);
    bf16_t* yb = (bf16_t*)(wsb + WS_Y);
    const float* rw = (const float*)(wsb + WS_RW);
    const int tid = threadIdx.x, wid = __builtin_amdgcn_readfirstlane(tid >> 6), lane = tid & 63, wr = wid >> 2, wc = wid & 3;
    gemm256_stream((LAS unsigned char*)shm,
        [&](int i, const char*& A, const char*& B, unsigned (&va)[2][2], const GPiece& pc) __attribute__((always_inline)) {
            const int it = xcd_unit(blockIdx.x + i * gridDim.x, T * 4);
            if (it < 0) return false;
            const int vt = it >> 2, pn = it & 3;
            int e = 0;
            while (tb[40 + e + 1] <= vt) ++e;
            const int rowbase = tb[e] + (vt - tb[40 + e]) * 256;
            A = (const char*)(act + (size_t)rowbase * DM);
            B = (const char*)(btdn + ((size_t)e * DM + pn * 256) * DM);
#pragma unroll
            for (int h = 0; h < 2; ++h)
#pragma unroll
                for (int j = 0; j < 2; ++j) va[h][j] = (unsigned)((h * 128 + pc.R[j]) * DM + pc.C[j]) * 2u;
            return true;
        },
        [&](int i, f32x4 (&acc)[2][2][4][2]) __attribute__((always_inline)) {
        const int it = xcd_unit(blockIdx.x + i * gridDim.x, T * 4);
        const int vt = it >> 2, pn = it & 3;
        int e = 0;
        while (tb[40 + e + 1] <= vt) ++e;
        const int rowbase = tb[e] + (vt - tb[40 + e]) * 256;
        int le = lane;
        asm volatile("" : "+v"(le));
        const int er = le & 15, eq = le >> 4;
        const float* bias = p.b_down + (size_t)e * DM;
#pragma unroll
        for (int bj = 0; bj < 2; ++bj) {
            const int col = pn * 256 + bj * 128 + wc * 32 + 8 * eq;
            const float4 b0 = *(const float4*)(bias + col), b1 = *(const float4*)(bias + col + 4);
#pragma unroll
            for (int ai = 0; ai < 2; ++ai)
#pragma unroll
                for (int mm = 0; mm < 4; ++mm) {
                    const int row = rowbase + ai * 128 + wr * 64 + mm * 16 + er;
                    const float wgt = rw[row];
                    const f32x4 x0 = acc[ai][bj][mm][0], x1 = acc[ai][bj][mm][1];
                    u32x4 ov;
                    ov.x = pk_bf16((x0[0] + b0.x) * wgt, (x0[1] + b0.y) * wgt);
                    ov.y = pk_bf16((x0[2] + b0.z) * wgt, (x0[3] + b0.w) * wgt);
                    ov.z = pk_bf16((x1[0] + b1.x) * wgt, (x1[1] + b1.y) * wgt);
                    ov.w = pk_bf16((x1[2] + b1.z) * wgt, (x1[3] + b1.w) * wgt);
                    *(u32x4*)(yb + (size_t)row * DM + col) = ov;
                }
        }
    });
    __syncthreads();
}


__device__ __forceinline__ void f_final(const Params& p) {
    const int lane = threadIdx.x & 63, w = threadIdx.x >> 6;
    unsigned char* wsb = (unsigned char*)p.ws;
    const bf16_t* yb = (const bf16_t*)(wsb + WS_Y);
    const int* selp = (const int*)(wsb + WS_SELP);
    const float4* g4 = (const float4*)p.final_g;
    for (int row0 = blockIdx.x * 8 + w; row0 < NTOK / 2; row0 += gridDim.x * 8) {
        float4 v[2][4];
        u32x2 yv[2][4][4];
#pragma unroll
        for (int q = 0; q < 2; ++q) {
            const int row = row0 + q * (NTOK / 2);
            const float4* xr = (const float4*)(p.out + (size_t)row * DM);
            const int4 sp = *(const int4*)(selp + row * 4);
            const int pos[4] = {sp.x, sp.y, sp.z, sp.w};
#pragma unroll
            for (int j = 0; j < 4; ++j) v[q][j] = xr[lane + 64 * j];
#pragma unroll
            for (int k = 0; k < 4; ++k) {
                const u32x2* yr = (const u32x2*)(yb + (size_t)pos[k] * DM);
#pragma unroll
                for (int j = 0; j < 4; ++j) yv[q][k][j] = yr[lane + 64 * j];
            }
        }
#pragma unroll
        for (int q = 0; q < 2; ++q) {
            const int row = row0 + q * (NTOK / 2);
#pragma unroll
            for (int k = 0; k < 4; ++k)
#pragma unroll
                for (int j = 0; j < 4; ++j) {
                    v[q][j].x += bf_lo(yv[q][k][j].x);
                    v[q][j].y += bf_hi(yv[q][k][j].x);
                    v[q][j].z += bf_lo(yv[q][k][j].y);
                    v[q][j].w += bf_hi(yv[q][k][j].y);
                }
            float ss = 0.f;
#pragma unroll
            for (int j = 0; j < 4; ++j) ss += dot4(v[q][j], v[q][j]);
            ss = wave_sum(ss);
            const float r = 1.0f / sqrtf(ss * (1.0f / DM) + 1e-5f);
            float4* xo = (float4*)(p.out + (size_t)row * DM);
#pragma unroll
            for (int j = 0; j < 4; ++j) {
                const float4 g = g4[lane + 64 * j];
                xo[lane + 64 * j] = make_float4(v[q][j].x * r * g.x, v[q][j].y * r * g.y, v[q][j].z * r * g.z, v[q][j].w * r * g.w);
            }
        }
    }
}
#define XB_TMO      128
#define XB_XCNT(j)  (256  + 64 * (j))
#define XB_XSUB(j)  (1280 + 64 * (j))
#define XB_XGEN(j)  (2304 + 64 * (j))
#define XB_TOP      3328
#define XB_TOPGEN   3392
#define XCD_BAR_WORDS 3456
#define XB_SPIN_CAP (1u << 18)

__device__ __forceinline__ unsigned xb_ld(unsigned* p)              { return __hip_atomic_load(p, __ATOMIC_RELAXED, __HIP_MEMORY_SCOPE_AGENT); }
__device__ __forceinline__ unsigned xb_add(unsigned* p, unsigned v) { return __hip_atomic_fetch_add(p, v, __ATOMIC_RELAXED, __HIP_MEMORY_SCOPE_AGENT); }
__device__ __forceinline__ unsigned xb_xcc_id() { return (unsigned)__builtin_amdgcn_s_getreg((3 << 11) | 20) & 0xFu; }
#define XB_SPIN(cond, bar) do { unsigned _sp = 0; while (cond) { __builtin_amdgcn_s_sleep(1); \
    if ((++_sp & 255u) == 0u) { if (xb_ld(&(bar)[XB_TMO])) break; if (_sp > XB_SPIN_CAP) { atomicAdd(&(bar)[XB_TMO], 1u); break; } } } } while (0)

struct XcdBarrier {
    unsigned* bar; unsigned x;
    volatile LAS unsigned* st;
};

__device__ __forceinline__ XcdBarrier xcd_barrier_post(unsigned* bar, volatile LAS unsigned* st) {
    XcdBarrier b; b.bar = bar; b.x = xb_xcc_id(); b.st = st;
    if (threadIdx.x == 0) (void)xb_add(&bar[XB_XCNT(b.x)], 1u);
    return b;
}
__device__ __forceinline__ void xcd_barrier_complete(unsigned* bar, unsigned x, unsigned& nloc, unsigned& nx) {
    const unsigned G = gridDim.x * gridDim.y * gridDim.z;
    unsigned sum, cnt, mine, sp = 0u;
    for (;;) {
        sum = 0u; cnt = 0u; mine = 0u;
#pragma unroll
        for (unsigned j = 0; j < 16; ++j) { const unsigned c = xb_ld(&bar[XB_XCNT(j)]); sum += c; cnt += (c > 0u) ? 1u : 0u; mine = (j == x) ? c : mine; }
        if (sum == G) break;
        __builtin_amdgcn_s_sleep(1);
        if ((++sp & 255u) == 0u) { if (xb_ld(&bar[XB_TMO])) break; if (sp > XB_SPIN_CAP) { atomicAdd(&bar[XB_TMO], 1u); break; } }
    }
    nloc = mine > 0u ? mine : 1u; nx = cnt > 0u ? cnt : 1u;
}

__device__ __forceinline__ void xcd_barrier(const XcdBarrier& b) {
    asm volatile("s_waitcnt vmcnt(0)" ::: "memory");
    __syncthreads();
    if (threadIdx.x == 0) {
        unsigned* bar = b.bar;
        __builtin_amdgcn_s_waitcnt(0);
        unsigned nloc = b.st[0], nx = b.st[1];
        if (nloc == 0u) { xcd_barrier_complete(bar, b.x, nloc, nx); b.st[0] = nloc; b.st[1] = nx; }
        const unsigned old = xb_add(&bar[XB_XSUB(b.x)], 1u);
        const unsigned gen = old / nloc;
        if (old + 1u == (gen + 1u) * nloc) {
            __builtin_amdgcn_fence(__ATOMIC_RELEASE, "agent");
            asm volatile("s_waitcnt vmcnt(0)" ::: "memory");
            const unsigned og = xb_add(&bar[XB_TOP], 1u);
            const unsigned tg = og / nx;
            if (og + 1u == (tg + 1u) * nx) xb_add(&bar[XB_TOPGEN], 1u);
            else XB_SPIN(xb_ld(&bar[XB_TOPGEN]) == tg, bar);
            __builtin_amdgcn_fence(__ATOMIC_ACQUIRE, "agent");
            xb_add(&bar[XB_XGEN(b.x)], 1u);
            asm volatile("s_waitcnt vmcnt(0)" ::: "memory");
        } else {
            XB_SPIN(xb_ld(&bar[XB_XGEN(b.x)]) == gen, bar);
            __builtin_amdgcn_fence(__ATOMIC_ACQUIRE, "agent");
            asm volatile("s_waitcnt vmcnt(0)" ::: "memory");
        }
    }
    __syncthreads();
}


constexpr int NFPHASE = 11;
__global__ void __launch_bounds__(512) fast_kernel(Params p) {
    extern __shared__ __attribute__((aligned(16))) unsigned char shm[];
    cg::grid_group grid = cg::this_grid();
    const int lo = p.ph_lo, hi = p.ph_hi;
    if (lo < -1) grid.sync();
    XcdBarrier bar;
    if (hi - lo > 1) {
        volatile LAS unsigned* st = (volatile LAS unsigned*)((LAS unsigned char*)shm + (FAST_LDS_BYTES - 16));
        if (threadIdx.x < 4) st[threadIdx.x] = 0u;
        __syncthreads();
        bar = xcd_barrier_post((unsigned*)((unsigned char*)p.ws + WS_BAR), st);
    }
#define F_IN(k) (lo <= (k) && (k) < hi)
#define F_SYNC(k) do { if (F_IN(k) && F_IN((k) + 1)) xcd_barrier(bar); } while (0)
    if (F_IN(0)) f_prologue(p, shm);
    F_SYNC(0);
    if (F_IN(1)) f_inproj(p, shm);
    F_SYNC(1);
    if (F_IN(2)) { f_cmp(p, shm); f_moba_gate(p, shm); }
    F_SYNC(2);
    if (F_IN(3)) f_attn(p, shm);
    F_SYNC(3);
    if (F_IN(4)) f_moba_merge(p);
    F_SYNC(4);
    if (F_IN(5)) f_outproj(p, shm);
    F_SYNC(5);
    if (F_IN(6)) f_router(p, shm);
    F_SYNC(6);
    if (F_IN(7)) f_fill(p, shm);
    F_SYNC(7);
    if (F_IN(8)) f_up(p, shm);
    F_SYNC(8);
    if (F_IN(9)) f_down(p, shm);
    F_SYNC(9);
    if (F_IN(10)) f_final(p);
}

#ifndef MULTI_LAUNCH
#define MULTI_LAUNCH 0
#endif

extern "C" void kernel_launch(void* const* d_in, const int* in_sizes, int n_in, void* d_out, int out_size, void* d_ws,
                              size_t ws_size, hipStream_t stream) {
    static int grid = 0;
    if (!grid) {
        int dev = 0, cus = 0, per_cu = 0;
        (void)hipGetDevice(&dev);
        (void)hipDeviceGetAttribute(&cus, hipDeviceAttributeMultiprocessorCount, dev);
        (void)hipFuncSetAttribute((const void*)fast_kernel, hipFuncAttributeMaxDynamicSharedMemorySize, FAST_LDS_BYTES);
        (void)hipOccupancyMaxActiveBlocksPerMultiprocessor(&per_cu, fast_kernel, 512, FAST_LDS_BYTES);
        if (per_cu < 1) fprintf(stderr, "kernel_launch: occupancy query reports %d blocks per CU\n", per_cu);
        grid = cus;
        if (ws_size < WS_END) fprintf(stderr, "kernel_launch: workspace too small: %zu < %zu\n", ws_size, (size_t)WS_END);
    }
    Params p{};
    p.x = (const float*)d_in[0];
    p.attn_g = (const float*)d_in[1];
    p.w_in = (const float*)d_in[2];
    p.pe_k = (const float*)d_in[3];
    p.pe_v = (const float*)d_in[4];
    p.w1k = (const float*)d_in[5];
    p.w2k = (const float*)d_in[6];
    p.w1v = (const float*)d_in[7];
    p.w2v = (const float*)d_in[8];
    p.w_out = (const float*)d_in[9];
    p.ffn_g = (const float*)d_in[10];
    p.w_router = (const float*)d_in[11];
    p.b_router = (const float*)d_in[12];
    p.w_up = (const float*)d_in[13];
    p.b_up = (const float*)d_in[14];
    p.w_down = (const float*)d_in[15];
    p.b_down = (const float*)d_in[16];
    p.final_g = (const float*)d_in[17];
    p.out = (float*)d_out;
    p.ws = (float*)d_ws;
#if MULTI_LAUNCH
#ifndef PROBE_DUP_MASK
#define PROBE_DUP_MASK 0
#endif
    for (int ph = 0; ph < NFPHASE; ++ph) {
        const int reps = ((PROBE_DUP_MASK >> ph) & 1) ? 2 : 1;
        for (int r = 0; r < reps; ++r) {
            p.ph_lo = ph;
            p.ph_hi = ph + 1;
            hipLaunchKernelGGL(fast_kernel, dim3(grid), dim3(512), FAST_LDS_BYTES, stream, p);
        }

    }
#else
    p.ph_lo = 0;
    p.ph_hi = NFPHASE;
    (void)hipMemsetAsync((unsigned char*)d_ws + WS_BAR, 0, 16384, stream);
    void* args[] = {&p};
    hipError_t e = hipLaunchCooperativeKernel((void*)fast_kernel, dim3(grid), dim3(512), args, FAST_LDS_BYTES, stream);
    if (e != hipSuccess) fprintf(stderr, "cooperative launch failed: %s (grid %d)\n", hipGetErrorString(e), grid);
#endif
}
```

```cpp
#include <hip/hip_runtime.h>
#include <hip/hip_cooperative_groups.h>
#include <cstdio>
#include <cstdint>
namespace cg = cooperative_groups;

constexpr int NB = 4, SEQ = 8192, DM = 1024, NTOK = NB * SEQ;
constexpr int INC = 2840;
constexpr int NCMP = 511, NCMPP = 512;
constexpr int NE = 32, TOPK = 4, NK = NTOK * TOPK;
constexpr int DFF2 = 2048;
constexpr int NIN_PAD = 3072;
constexpr int PMAX = 139264;
constexpr float LOG2E = 1.4426950408889634f;
constexpr float QSCALE = 0.125f * LOG2E;
constexpr int HG_MQ = 0, HG_MK = 8, HG_MV = 16, HG_NQ = 24, HG_KC = 32, HG_VC = 34, HG_KS = 36, HG_VS = 38, HG_KW = 40,
              HG_VW = 42, NHG = 44;

constexpr size_t WS_BTUP  = 0;
constexpr size_t WS_BTDN  = WS_BTUP + (size_t)NE * DFF2 * DM * 2;
constexpr size_t WS_BTOUT = WS_BTDN + (size_t)NE * DM * DM * 2;
constexpr size_t WS_BTIN  = WS_BTOUT + (size_t)DM * DM * 2;
constexpr size_t WS_XN    = WS_BTIN + (size_t)NIN_PAD * DM * 2;
constexpr size_t WS_H     = WS_XN;
constexpr size_t WS_PT    = WS_XN + (size_t)NTOK * DM * 2;
constexpr size_t WS_GATES = WS_PT + (size_t)NHG * NTOK * 64 * 2;
constexpr size_t WS_KMEAN = WS_GATES + (size_t)NTOK * 24 * 4;
constexpr size_t WS_KCMP  = WS_KMEAN + 65536 * 4;
constexpr size_t WS_VCMP  = WS_KCMP + 262144 * 2;
constexpr size_t WS_MIXB  = WS_VCMP + 262144 * 2;
constexpr size_t WS_ACT   = WS_PT;
constexpr size_t WS_Y     = WS_ACT + (size_t)PMAX * DM * 2;
static_assert(WS_MIXB + (size_t)NTOK * DM * 2 <= WS_Y, "act overlay");
constexpr size_t WS_PART  = WS_Y;
constexpr size_t WS_MLIST = WS_PART + (size_t)NTOK * 8 * 544;
constexpr size_t WS_MCNT  = WS_MLIST + (size_t)1024 * 8192 * 2;
static_assert(WS_MCNT + 4096 <= WS_Y + (size_t)PMAX * DM * 2, "MoBA scratch overlays y");
constexpr size_t WS_SELE  = WS_Y + (size_t)PMAX * DM * 2;
constexpr size_t WS_SELW  = WS_SELE + (size_t)NK * 4;
constexpr size_t WS_SELR  = WS_SELW + (size_t)NK * 4;
constexpr size_t WS_SELP  = WS_SELR + (size_t)NK * 4;
constexpr size_t WS_BCNT  = WS_SELP + (size_t)NK * 4;
constexpr size_t WS_GCNT  = WS_BCNT + 256 * 32 * 4;
constexpr size_t WS_RTOK  = WS_GCNT + 256;
constexpr size_t WS_RW    = WS_RTOK + (size_t)PMAX * 4;
constexpr size_t WS_C1    = WS_RW + (size_t)PMAX * 4;
constexpr size_t WS_W1T   = WS_C1 + 512;
constexpr size_t WS_W2T   = WS_W1T + 2 * 64 * 2048 * 2;
constexpr size_t WS_BAR   = WS_W2T + 2 * 64 * 64 * 2;
constexpr size_t WS_END   = WS_BAR + 16384;

struct Params {
    const float *x, *attn_g, *w_in, *pe_k, *pe_v, *w1k, *w2k, *w1v, *w2v, *w_out, *ffn_g, *w_router, *b_router,
        *w_up, *b_up, *w_down, *b_down, *final_g;
    float* out;
    float* ws;
    int ph_lo, ph_hi;
};

typedef unsigned short bf16_t;
typedef short bf16x8 __attribute__((ext_vector_type(8)));
typedef float f32x4 __attribute__((ext_vector_type(4)));
typedef float f32x16 __attribute__((ext_vector_type(16)));
typedef unsigned u32x4 __attribute__((ext_vector_type(4)));
typedef unsigned u32x2 __attribute__((ext_vector_type(2)));

typedef float f32x2 __attribute__((ext_vector_type(2)));
typedef __bf16 bf16x2v __attribute__((ext_vector_type(2)));
__device__ __forceinline__ unsigned pk_bf16(float lo, float hi) {
    const f32x2 f = {lo, hi};
    return __builtin_bit_cast(unsigned, __builtin_convertvector(f, bf16x2v));
}
__device__ __forceinline__ float bf_lo(unsigned u) { return __uint_as_float(u << 16); }
__device__ __forceinline__ float bf_hi(unsigned u) { return __uint_as_float(u & 0xffff0000u); }
__device__ __forceinline__ float bf2f(bf16_t b) { return __uint_as_float((unsigned)b << 16); }

__device__ __forceinline__ float wave_sum(float v) {
#pragma unroll
    for (int o = 32; o > 0; o >>= 1) v += __shfl_xor(v, o);
    return v;
}
__device__ __forceinline__ float wave_max(float v) {
#pragma unroll
    for (int o = 32; o > 0; o >>= 1) v = fmaxf(v, __shfl_xor(v, o));
    return v;
}
__device__ __forceinline__ int wave_min_i(int v) {
#pragma unroll
    for (int o = 32; o > 0; o >>= 1) v = min(v, __shfl_xor(v, o));
    return v;
}
__device__ __forceinline__ float dot4(float4 a, float4 b) { return a.x * b.x + a.y * b.y + a.z * b.z + a.w * b.w; }

__device__ __forceinline__ float gelu_tanh(float x) {
    return 0.5f * x * (1.0f + tanhf(0.7978845608028654f * (x + 0.044715f * x * x * x)));
}
__device__ __forceinline__ float swiglu(float g, float u) {
    g = fminf(g, 7.0f);
    u = fminf(fmaxf(u, -7.0f), 7.0f);
    return g * (1.0f / (1.0f + __expf(-1.702f * g))) * (u + 1.0f);
}


constexpr int G_BM = 256, G_BK = 64, G_HALF = 128, G_HT = G_HALF * G_BK;
constexpr int GEMM_LDS_BYTES = 8 * G_HT * 2;
constexpr int FAST_LDS_BYTES = 155648;
__device__ __forceinline__ int lds_byte(int r, int c) {
    const int st = (r >> 4) * 2 + (c >> 5), rr = r & 15, cc = c & 31, ob = rr * 64 + cc * 2;
    return st * 1024 + (ob ^ (((ob >> 9) & 1) << 5));
}
__device__ __forceinline__ void stage_rc(int b, int& R, int& C) {
    const int st = b / 1024, sb = b % 1024, swz = sb ^ (((sb >> 9) & 1) << 5);
    R = (st >> 1) * 16 + swz / 64;
    C = (st & 1) * 32 + (swz % 64) / 2;
}

#define LAS __attribute__((address_space(3)))
template <class ARow>
__device__ __forceinline__ void gemm256_tile(LAS unsigned char* lds, const char* __restrict__ Abase, ARow arow,
                                             const char* __restrict__ Bbase, int K, f32x4 (&acc)[2][2][4][2]) {
    constexpr int HTB = G_HT * 2;
#define SA(b, h) (((b) * 2 + (h)) * HTB)
#define SB(b, h) ((4 + (b) * 2 + (h)) * HTB)
#define STAGE_A(b, h, kt)                                                                                              \
    do {                                                                                                               \
        _Pragma("unroll") for (int _i = 0; _i < 2; ++_i) __builtin_amdgcn_global_load_lds(                              \
            (const unsigned*)(Abase + (size_t)(kt) * (G_BK * 2) + voffA[h][_i]),                                       \
            (LAS unsigned*)(lds + SA(b, h) + ldsw + _i * 8192), 16, 0, 0);                                              \
    } while (0)
#define STAGE_B(b, h, kt)                                                                                              \
    do {                                                                                                               \
        _Pragma("unroll") for (int _i = 0; _i < 2; ++_i) __builtin_amdgcn_global_load_lds(                              \
            (const unsigned*)(Bbase + (size_t)(h) * hstep + (size_t)(kt) * (G_BK * 2) + voffB[_i]),                    \
            (LAS unsigned*)(lds + SB(b, h) + ldsw + _i * 8192), 16, 0, 0);                                              \
    } while (0)
#define LDA(dst, b, h)                                                                                                 \
    do {                                                                                                               \
        _Pragma("unroll") for (int m = 0; m < 4; ++m) _Pragma("unroll") for (int k = 0; k < 2; ++k) dst[m][k] =         \
            *(const LAS bf16x8*)(lds + SA(b, h) + aoff + m * 2048 + k * 1024);                                          \
    } while (0)
#define LDB(dst, b, h)                                                                                                 \
    do {                                                                                                               \
        _Pragma("unroll") for (int n = 0; n < 2; ++n) _Pragma("unroll") for (int k = 0; k < 2; ++k) dst[n][k] =         \
            *(const LAS bf16x8*)(lds + SB(b, h) + boff + n * 2048 + k * 1024);                                          \
    } while (0)
#define MMA(ai, bj, Af, Bf)                                                                                            \
    do {                                                                                                               \
        __builtin_amdgcn_s_setprio(1);                                                                                 \
        _Pragma("unroll") for (int m = 0; m < 4; ++m) _Pragma("unroll") for (int n = 0; n < 2; ++n)                     \
            _Pragma("unroll") for (int k = 0; k < 2; ++k) acc[ai][bj][m][n] =                                           \
                __builtin_amdgcn_mfma_f32_16x16x32_bf16(Bf[n][k], Af[m][k], acc[ai][bj][m][n], 0, 0, 0);               \
        __builtin_amdgcn_s_setprio(0);                                                                                 \
    } while (0)
#define WAIT_V(n) asm volatile("s_waitcnt vmcnt(" #n ")" ::: "memory")
#define WAIT_L(n) asm volatile("s_waitcnt lgkmcnt(" #n ")" ::: "memory")
#define BAR __builtin_amdgcn_s_barrier()
#define SCHED __builtin_amdgcn_sched_barrier(0)
    const int tid = threadIdx.x, wid = __builtin_amdgcn_readfirstlane(tid >> 6), lane = tid & 63, wr = wid >> 2, wc = wid & 3,
              fr = lane & 15, fq = lane >> 4;
    unsigned voffA[2][2], voffB[2];
#pragma unroll
    for (int i = 0; i < 2; ++i) {
        int R, C;
        stage_rc(tid * 16 + i * 8192, R, C);
        voffB[i] = (unsigned)(R * K + C) * 2u;
#pragma unroll
        for (int h = 0; h < 2; ++h) voffA[h][i] = (unsigned)arow(h * G_HALF + R) + (unsigned)C * 2u;
    }
    const size_t hstep = (size_t)G_HALF * K * 2;
    const unsigned ldsw = (unsigned)wid * 1024u;
    const int aoff = lds_byte(wr * 64 + fr, fq * 8), boff = lds_byte(wc * 32 + fr, fq * 8);
#pragma unroll
    for (int ai = 0; ai < 2; ++ai)
#pragma unroll
        for (int bj = 0; bj < 2; ++bj)
#pragma unroll
            for (int m = 0; m < 4; ++m)
#pragma unroll
                for (int n = 0; n < 2; ++n) acc[ai][bj][m][n] = (f32x4){0.f, 0.f, 0.f, 0.f};
    bf16x8 At[4][2], B0[2][2], B1[2][2];
    const int nt = K / G_BK;
    STAGE_B(0, 0, 0); STAGE_A(0, 0, 0);
    STAGE_B(0, 1, 0); STAGE_A(0, 1, 0);
    if (wr == 1) BAR;
    WAIT_V(4); BAR;
    STAGE_B(1, 0, 1); STAGE_A(1, 0, 1); STAGE_B(1, 1, 1);
    WAIT_V(6); BAR;
    for (int t = 0; t < nt - 2; t += 2) {
        LDB(B0, 0, 0); SCHED; LDA(At, 0, 0); STAGE_A(1, 1, t + 1);
        WAIT_L(8); BAR; WAIT_L(0); MMA(0, 0, At, B0); BAR; SCHED;
        LDB(B1, 0, 1); STAGE_B(0, 0, t + 2);
        BAR; WAIT_L(0); MMA(0, 1, At, B1); BAR;
        LDA(At, 0, 1); STAGE_A(0, 0, t + 2);
        BAR; WAIT_L(0); MMA(1, 0, At, B0); BAR; SCHED;
        STAGE_B(0, 1, t + 2);
        WAIT_V(6); BAR; MMA(1, 1, At, B1); BAR;
        LDB(B0, 1, 0); SCHED; LDA(At, 1, 0); STAGE_A(0, 1, t + 2);
        WAIT_L(8); BAR; WAIT_L(0); MMA(0, 0, At, B0); BAR; SCHED;
        LDB(B1, 1, 1); STAGE_B(1, 0, t + 3);
        BAR; WAIT_L(0); MMA(0, 1, At, B1); BAR;
        LDA(At, 1, 1); STAGE_A(1, 0, t + 3);
        BAR; WAIT_L(0); MMA(1, 0, At, B0); BAR; SCHED;
        STAGE_B(1, 1, t + 3);
        WAIT_V(6); BAR; MMA(1, 1, At, B1); BAR;
    }
    {
        LDB(B0, 0, 0); LDA(At, 0, 0); STAGE_A(1, 1, nt - 1);
        BAR; WAIT_L(0); MMA(0, 0, At, B0); BAR;
        LDB(B1, 0, 1); BAR; WAIT_L(0); MMA(0, 1, At, B1); BAR;
        LDA(At, 0, 1); WAIT_V(4); BAR; WAIT_L(0); MMA(1, 0, At, B0); MMA(1, 1, At, B1); BAR;
    }
    {
        LDB(B0, 1, 0); LDA(At, 1, 0); WAIT_V(2); BAR; WAIT_L(0); MMA(0, 0, At, B0); BAR;
        LDB(B1, 1, 1); WAIT_V(0); BAR; WAIT_L(0); MMA(0, 1, At, B1); BAR;
        LDA(At, 1, 1); BAR; WAIT_L(0); MMA(1, 0, At, B0); MMA(1, 1, At, B1); BAR;
    }
    if (wr == 0) BAR;
#undef SA
#undef SB
#undef STAGE_A
#undef STAGE_B
#undef LDA
#undef LDB
#undef MMA
}

struct GPiece { int R[2], C[2]; };
template <bool ALIGN_EPI = true, class UnitFn, class Epi>
__device__ __forceinline__ void gemm256_stream(LAS unsigned char* lds, UnitFn unit, Epi epi) {
    constexpr int K = 1024, nt = K / G_BK;
    constexpr int HTB = G_HT * 2;
#define SA(b, h) (((b) * 2 + (h)) * HTB)
#define SB(b, h) ((4 + (b) * 2 + (h)) * HTB)
#define STG(bufoff, gbase, voff)                                                                                       \
    do {                                                                                                               \
        _Pragma("unroll") for (int _i = 0; _i < 2; ++_i) __builtin_amdgcn_global_load_lds(                              \
            (const unsigned*)((gbase) + (voff)[_i]), (LAS unsigned*)(lds + (bufoff) + ldsw + _i * 8192), 16, 0, 0);     \
    } while (0)
#define LDA(dst, b, h)                                                                                                 \
    do {                                                                                                               \
        _Pragma("unroll") for (int m = 0; m < 4; ++m) _Pragma("unroll") for (int k = 0; k < 2; ++k) dst[m][k] =         \
            *(const LAS bf16x8*)(lds + SA(b, h) + aoff + m * 2048 + k * 1024);                                          \
    } while (0)
#define LDB(dst, b, h)                                                                                                 \
    do {                                                                                                               \
        _Pragma("unroll") for (int n = 0; n < 2; ++n) _Pragma("unroll") for (int k = 0; k < 2; ++k) dst[n][k] =         \
            *(const LAS bf16x8*)(lds + SB(b, h) + boff + n * 2048 + k * 1024);                                          \
    } while (0)
#define MMA(ai, bj, Af, Bf)                                                                                            \
    do {                                                                                                               \
        __builtin_amdgcn_s_setprio(1);                                                                                 \
        _Pragma("unroll") for (int m = 0; m < 4; ++m) _Pragma("unroll") for (int n = 0; n < 2; ++n)                     \
            _Pragma("unroll") for (int k = 0; k < 2; ++k) acc[ai][bj][m][n] =                                           \
                __builtin_amdgcn_mfma_f32_16x16x32_bf16(Bf[n][k], Af[m][k], acc[ai][bj][m][n], 0, 0, 0);               \
        __builtin_amdgcn_s_setprio(0);                                                                                 \
    } while (0)
    const int tid = threadIdx.x, wid = __builtin_amdgcn_readfirstlane(tid >> 6), lane = tid & 63, wr = wid >> 2, wc = wid & 3,
              fr = lane & 15, fq = lane >> 4;
    GPiece pc;
    unsigned voffB[2];
#pragma unroll
    for (int i = 0; i < 2; ++i) {
        stage_rc(tid * 16 + i * 8192, pc.R[i], pc.C[i]);
        const int rho = pc.R[i] & 31, pn_ = rho >> 4, pi_ = rho & 15;
        const int Rb = (pc.R[i] & ~31) + 8 * (pi_ >> 2) + 4 * pn_ + (pi_ & 3);
        voffB[i] = (unsigned)(Rb * K + pc.C[i]) * 2u;
    }
    constexpr size_t hstep = (size_t)G_HALF * K * 2, kstep = G_BK * 2;
    const unsigned ldsw = (unsigned)wid * 1024u;
    const int aoff = lds_byte(wr * 64 + fr, fq * 8), boff = lds_byte(wc * 32 + fr, fq * 8);
    const char *cA, *cB, *nA, *nB;
    unsigned vc[2][2], vn[2][2];
    if (!unit(0, cA, cB, vc, pc)) return;
    f32x4 acc[2][2][4][2];
#pragma unroll
    for (int ai = 0; ai < 2; ++ai)
#pragma unroll
        for (int bj = 0; bj < 2; ++bj)
#pragma unroll
            for (int m = 0; m < 4; ++m)
#pragma unroll
                for (int n = 0; n < 2; ++n) acc[ai][bj][m][n] = (f32x4){0.f, 0.f, 0.f, 0.f};
    bf16x8 At[4][2], B0[2][2], B1[2][2];
    STG(SB(0, 0), cB, voffB); STG(SB(0, 1), cB + hstep, voffB); STG(SA(0, 0), cA, vc[0]); STG(SA(0, 1), cA, vc[1]);
    if (wr == 1) BAR;
    WAIT_V(2); BAR;
    STG(SB(1, 0), cB + kstep, voffB); STG(SA(1, 0), cA + kstep, vc[0]); STG(SB(1, 1), cB + hstep + kstep, voffB);
    WAIT_V(6); BAR;
    for (int ui = 0;; ++ui) {
        const bool has_next = unit(ui + 1, nA, nB, vn, pc);
        if (!has_next) {
            nA = cA; nB = cB;
#pragma unroll
            for (int h = 0; h < 2; ++h)
#pragma unroll
                for (int i = 0; i < 2; ++i) vn[h][i] = vc[h][i];
        }
        for (int t = 0; t < nt; t += 2) {
            const bool last = (t == nt - 2);
            const char* a1 = cA + (size_t)(t + 1) * kstep;
            const char* a2 = last ? nA : cA + (size_t)(t + 2) * kstep;
            const char* b2 = last ? nB : cB + (size_t)(t + 2) * kstep;
            const char* a3 = a2 + kstep;
            const char* b3 = b2 + kstep;
            unsigned v2[2][2];
#pragma unroll
            for (int h = 0; h < 2; ++h)
#pragma unroll
                for (int i = 0; i < 2; ++i) v2[h][i] = last ? vn[h][i] : vc[h][i];
            LDB(B0, 0, 0); LDB(B1, 0, 1); SCHED; LDA(At, 0, 0); STG(SA(1, 1), a1, vc[1]);
            WAIT_V(8); WAIT_L(0); BAR; MMA(0, 0, At, B0); MMA(0, 1, At, B1); BAR; SCHED;
            LDA(At, 0, 1); STG(SB(0, 0), b2, voffB); STG(SB(0, 1), b2 + hstep, voffB); STG(SA(0, 0), a2, v2[0]);
            WAIT_V(8); WAIT_L(0); BAR; MMA(1, 0, At, B0); MMA(1, 1, At, B1); BAR; SCHED;
            LDB(B0, 1, 0); LDB(B1, 1, 1); SCHED; LDA(At, 1, 0); STG(SA(0, 1), a2, v2[1]);
            WAIT_V(8); WAIT_L(0); BAR; MMA(0, 0, At, B0); MMA(0, 1, At, B1); BAR; SCHED;
            LDA(At, 1, 1); STG(SB(1, 0), b3, voffB); STG(SB(1, 1), b3 + hstep, voffB); STG(SA(1, 0), a3, v2[0]);
            WAIT_V(8); WAIT_L(0); BAR; MMA(1, 0, At, B0); MMA(1, 1, At, B1); BAR; SCHED;
        }
        if (ALIGN_EPI) { if (wr == 0) BAR; }
        epi(ui, acc);
        if (!has_next) break;
#pragma unroll
        for (int ai = 0; ai < 2; ++ai)
#pragma unroll
            for (int bj = 0; bj < 2; ++bj)
#pragma unroll
                for (int m = 0; m < 4; ++m)
#pragma unroll
                    for (int n = 0; n < 2; ++n) acc[ai][bj][m][n] = (f32x4){0.f, 0.f, 0.f, 0.f};
        cA = nA; cB = nB;
#pragma unroll
        for (int h = 0; h < 2; ++h)
#pragma unroll
            for (int i = 0; i < 2; ++i) vc[h][i] = vn[h][i];
        if (ALIGN_EPI) { if (wr == 1) BAR; }
    }
    WAIT_V(0);
    if (!ALIGN_EPI) { if (wr == 0) BAR; }
    BAR;
#undef SA
#undef SB
#undef STG
#undef LDA
#undef LDB
#undef MMA
}

__device__ __forceinline__ int xcd_unit(int seq, int total) {
    if (seq >= total) return -1;
    const int q = total >> 3, rem = total & 7, x = seq & 7, off = seq >> 3;
    return (x < rem ? x * (q + 1) : rem * (q + 1) + (x - rem) * q) + off;
}

constexpr int CV_T = 64 * 65 + 32;
struct CvRegs { float4 v[4][2]; };
template <class Item>
__device__ __forceinline__ void cv_fetch(CvRegs& rg, int it0, int nitems, Item item) {
    const int tid = threadIdx.x;
#pragma unroll
    for (int j = 0; j < 4; ++j) {
        const float* W; bf16_t* WT; int K, ncols, ldw, k0, n0;
        const int it = (it0 + j < nitems) ? it0 + j : nitems - 1;
        item(it, W, K, ncols, ldw, WT, k0, n0);
#pragma unroll
        for (int i = 0; i < 2; ++i) {
            const int idx = tid + i * 512, kr = idx >> 4, c4 = idx & 15;
            float4 v = make_float4(0.f, 0.f, 0.f, 0.f);
            if (n0 + c4 * 4 < ncols) v = *(const float4*)(W + (size_t)(k0 + kr) * ldw + n0 + c4 * 4);
            rg.v[j][i] = v;
        }
    }
}
__device__ __forceinline__ void cv_to_lds(float* T, const CvRegs& rg) {
    const int tid = threadIdx.x;
#pragma unroll
    for (int j = 0; j < 4; ++j)
#pragma unroll
        for (int i = 0; i < 2; ++i) {
            const int idx = tid + i * 512, kr = idx >> 4, c4 = idx & 15;
            float* Tj = T + j * CV_T;
            Tj[(c4 * 4 + 0) * 65 + kr] = rg.v[j][i].x;
            Tj[(c4 * 4 + 1) * 65 + kr] = rg.v[j][i].y;
            Tj[(c4 * 4 + 2) * 65 + kr] = rg.v[j][i].z;
            Tj[(c4 * 4 + 3) * 65 + kr] = rg.v[j][i].w;
        }
}
template <class ORow>
__device__ __forceinline__ void cv_store(const float* T, int K, bf16_t* __restrict__ WT, ORow orow, int k0, int n0) {
    const int tid = threadIdx.x;
    const int n = tid >> 3, c = tid & 7;
    const float* sp = T + n * 65 + c * 8;
    u32x4 o;
    o.x = pk_bf16(sp[0], sp[1]);
    o.y = pk_bf16(sp[2], sp[3]);
    o.z = pk_bf16(sp[4], sp[5]);
    o.w = pk_bf16(sp[6], sp[7]);
    const int r = orow(n0 + n);
    *(u32x4*)(WT + (size_t)r * K + k0 + c * 8) = o;
}
template <class Item, class ORow>
__device__ __forceinline__ void cv_run(float* T, int nitems, Item item, ORow orow) {
    const int step = gridDim.x * 4;
    int it0 = blockIdx.x * 4;
    if (it0 >= nitems) return;
    CvRegs cur;
    cv_fetch(cur, it0, nitems, item);
    for (; it0 < nitems; it0 += step) {
        __syncthreads();
        cv_to_lds(T, cur);
        if (it0 + step < nitems) cv_fetch(cur, it0 + step, nitems, item);
        __syncthreads();
#pragma unroll
        for (int j = 0; j < 4; ++j)
            if (it0 + j < nitems) {
                const float* W; bf16_t* WT; int K, ncols, ldw, k0, n0;
                item(it0 + j, W, K, ncols, ldw, WT, k0, n0);
                cv_store(T + j * CV_T, K, WT, orow, k0, n0);
            }
    }
}

constexpr int AT_KP = 144, AT_VP = 136, AT_KB = 64 * AT_KP, AT_VB = 64 * AT_VP, AT_BUF = AT_KB + AT_VB;
constexpr int AT_IMPA = 36864, AT_IMPB = AT_IMPA + 32768, AT_KMS = AT_IMPA;
constexpr int AT_OLDS = 36864, AT_OP = 68;
constexpr int AT_SELB = AT_OLDS + 256 * AT_OP * 4;
constexpr int AT_CAND = AT_SELB + 1024;
constexpr int AT_TOKM = AT_CAND + 4096;
constexpr int AT_MREF = AT_TOKM + 1024;
constexpr int AT_LACC = AT_MREF + 1024;
constexpr int AT_JLIST = AT_LACC + 1024;
constexpr int AT_QS = AT_JLIST + 1024;
static_assert(AT_QS + 256 * 144 <= FAST_LDS_BYTES - 16, "attention LDS map");
__device__ __forceinline__ int nth_set_bit64(unsigned lo, unsigned hi, int n) {
    const int cl = __popc(lo);
    unsigned m = lo;
    int base = 0;
    if (n >= cl) { n -= cl; m = hi; base = 32; }
    int pos = 0;
#pragma unroll
    for (int sh = 16; sh >= 1; sh >>= 1) {
        const int cnt = __popc((m >> pos) & ((1u << sh) - 1u));
        if (n >= cnt) { n -= cnt; pos += sh; }
    }
    return base + pos;
}
#define MFMA32(a, b, c) __builtin_amdgcn_mfma_f32_32x32x16_bf16(a, b, c, 0, 0, 0)
#define CREG(reg) (((reg) & 3) + 8 * ((reg) >> 2))

__device__ __forceinline__ float quad_sum(float x) {
    x += __int_as_float(__builtin_amdgcn_mov_dpp(__float_as_int(x), 0xB1, 0xF, 0xF, true));
    x += __int_as_float(__builtin_amdgcn_mov_dpp(__float_as_int(x), 0x4E, 0xF, 0xF, true));
    return x;
}
struct AtStage { u32x4 k, v; };
__device__ __forceinline__ void at_load(AtStage& st, const bf16_t* __restrict__ Kg, const bf16_t* __restrict__ Vg, bool with_v, unsigned koff, unsigned voff) {
    st.k = *(const u32x4*)((const char*)Kg + koff);
    if (with_v) st.v = *(const u32x4*)((const char*)Vg + voff);
}
__device__ __forceinline__ void at_store(const AtStage& st, LAS unsigned char* buf, bool with_v) {
    const int tid = threadIdx.x;
    *(LAS u32x4*)(buf + (tid >> 3) * AT_KP + (tid & 7) * 16) = st.k;
    if (with_v) {
        LAS unsigned short* vt = (LAS unsigned short*)(buf + AT_KB + (tid >> 6) * 8 * AT_VP + (tid & 63) * 2);
        vt[0 * (AT_VP / 2)] = (unsigned short)(st.v.x & 0xffffu);
        vt[1 * (AT_VP / 2)] = (unsigned short)(st.v.x >> 16);
        vt[2 * (AT_VP / 2)] = (unsigned short)(st.v.y & 0xffffu);
        vt[3 * (AT_VP / 2)] = (unsigned short)(st.v.y >> 16);
        vt[4 * (AT_VP / 2)] = (unsigned short)(st.v.z & 0xffffu);
        vt[5 * (AT_VP / 2)] = (unsigned short)(st.v.z >> 16);
        vt[6 * (AT_VP / 2)] = (unsigned short)(st.v.w & 0xffffu);
        vt[7 * (AT_VP / 2)] = (unsigned short)(st.v.w >> 16);
    }
}
__device__ __forceinline__ void at_scores(LAS const unsigned char* buf, const bf16x8 (&qf)[4], float ramp, float base0, float base1,
                                          f32x16& s0, f32x16& s1) {
    const int lane = threadIdx.x & 63, r = lane & 31, h = lane >> 5;
    LAS const unsigned char* kb = buf + r * AT_KP + h * 16;
    {
        const float b0 = fmaf(ramp, (float)(4 * h), base0), b1 = fmaf(ramp, (float)(4 * h), base1);
#pragma unroll
        for (int i = 0; i < 16; ++i) { s0[i] = fmaf(ramp, (float)CREG(i), b0); s1[i] = fmaf(ramp, (float)CREG(i), b1); }
    }
#pragma unroll
    for (int kk = 0; kk < 4; ++kk) {
        const bf16x8 k0 = *(LAS const bf16x8*)(kb + kk * 32);
        const bf16x8 k1 = *(LAS const bf16x8*)(kb + 32 * AT_KP + kk * 32);
        s0 = MFMA32(k0, qf[kk], s0);
        s1 = MFMA32(k1, qf[kk], s1);
    }
}
__device__ __forceinline__ bf16x8 at_pack8(const f32x16& P, int s2) {
    u32x4 w;
    if (s2 == 0) { w.x = pk_bf16(P[0], P[1]); w.y = pk_bf16(P[2], P[3]); w.z = pk_bf16(P[4], P[5]); w.w = pk_bf16(P[6], P[7]); }
    else         { w.x = pk_bf16(P[8], P[9]); w.y = pk_bf16(P[10], P[11]); w.z = pk_bf16(P[12], P[13]); w.w = pk_bf16(P[14], P[15]); }
    return __builtin_bit_cast(bf16x8, w);
}
__device__ __forceinline__ void at_pv(LAS const unsigned char* buf, const f32x16& p0, const f32x16& p1, f32x16& o0, f32x16& o1) {
    const int lane = threadIdx.x & 63, r = lane & 31, h = lane >> 5;
    LAS const unsigned char* vb = buf + AT_KB + r * AT_VP + h * 8;
#pragma unroll
    for (int half = 0; half < 2; ++half) {
#pragma unroll
        for (int s2 = 0; s2 < 2; ++s2) {
            const bf16x8 pf = at_pack8(half ? p1 : p0, s2);
            const int ko = (32 * half + 16 * s2) * 2;
            const u32x2 a0 = *(LAS const u32x2*)(vb + ko), a1 = *(LAS const u32x2*)(vb + ko + 16);
            const u32x2 b0 = *(LAS const u32x2*)(vb + 32 * AT_VP + ko), b1 = *(LAS const u32x2*)(vb + 32 * AT_VP + ko + 16);
            const u32x4 va = {a0.x, a0.y, a1.x, a1.y}, vbb = {b0.x, b0.y, b1.x, b1.y};
            o0 = MFMA32(__builtin_bit_cast(bf16x8, va), pf, o0);
            o1 = MFMA32(__builtin_bit_cast(bf16x8, vbb), pf, o1);
        }
    }
}
__device__ __forceinline__ float at_rowmax(const f32x16& s0, const f32x16& s1) {
    float m = fmaxf(s0[0], s1[0]);
#pragma unroll
    for (int i = 1; i < 16; ++i) m = fmaxf(m, fmaxf(s0[i], s1[i]));
    return fmaxf(m, __shfl_xor(m, 32));
}
#define AT_MASK_LE(S0, S1, lim)  do { _Pragma("unroll") for (int i_ = 0; i_ < 16; ++i_) { if (CREG(i_) > (lim)) S0[i_] = -INFINITY; if (CREG(i_) + 32 > (lim)) S1[i_] = -INFINITY; } } while (0)
#define AT_MASK_GE(S0, S1, lo)   do { _Pragma("unroll") for (int i_ = 0; i_ < 16; ++i_) { if (CREG(i_) < (lo)) S0[i_] = -INFINITY; if (CREG(i_) + 32 < (lo)) S1[i_] = -INFINITY; } } while (0)
__device__ __forceinline__ float at_exp(f32x16& s0, f32x16& s1, float mref) {
    float l = 0.f;
#pragma unroll
    for (int i = 0; i < 16; ++i) {
        s0[i] = __builtin_amdgcn_exp2f(s0[i] - mref);
        s1[i] = __builtin_amdgcn_exp2f(s1[i] - mref);
        l += s0[i] + s1[i];
    }
    return l;
}

#define AT_PIN(x) asm volatile("" : "+v"(x))
__device__ __forceinline__ void at_tile_pipe(LAS const unsigned char* buf, const bf16x8 (&qf)[4], float ramp, float base0, float mrow,
                                             float sl2x32, float& l, f32x16& o0, f32x16& o1) {
    const int lane = threadIdx.x & 63, r = lane & 31, h = lane >> 5;
    LAS const unsigned char* kb = buf + r * AT_KP + h * 16;
    LAS const unsigned char* vb = buf + AT_KB + r * AT_VP + h * 8;
    const float c0 = fmaf(ramp, (float)(4 * h), base0 - mrow), c1 = c0 + sl2x32;
    f32x16 s0, s1;
#pragma unroll
    for (int i = 0; i < 16; ++i) { s0[i] = fmaf(ramp, (float)CREG(i), c0); s1[i] = fmaf(ramp, (float)CREG(i), c1); }
    bf16x8 kf[4];
#pragma unroll
    for (int kk = 0; kk < 4; ++kk) kf[kk] = *(LAS const bf16x8*)(kb + kk * 32);
#pragma unroll
    for (int kk = 0; kk < 4; ++kk) s0 = MFMA32(kf[kk], qf[kk], s0);
#pragma unroll
    for (int kk = 0; kk < 4; ++kk) kf[kk] = *(LAS const bf16x8*)(kb + 32 * AT_KP + kk * 32);
    __builtin_amdgcn_sched_barrier(0);
    u32x2 vf[4][2];
    float ls = 0.f;
#pragma unroll
    for (int kk = 0; kk < 4; ++kk) {
        s1 = MFMA32(kf[kk], qf[kk], s1);
        vf[kk][0] = *(LAS const u32x2*)(vb + (kk & 1) * 32 * AT_VP + (16 * (kk >> 1)) * 2);
        vf[kk][1] = *(LAS const u32x2*)(vb + (kk & 1) * 32 * AT_VP + (16 * (kk >> 1)) * 2 + 16);
#pragma unroll
        for (int q = 0; q < 4; ++q) { s0[4 * kk + q] = __builtin_amdgcn_exp2f(s0[4 * kk + q]); ls += s0[4 * kk + q]; }
        AT_PIN(ls);
        __builtin_amdgcn_sched_barrier(0);
    }
    const bf16x8 pa = at_pack8(s0, 0), pb = at_pack8(s0, 1);
#pragma unroll
    for (int st = 0; st < 4; ++st) {
        const int s2 = st >> 1, dt = st & 1;
        const u32x4 vv = {vf[st][0].x, vf[st][0].y, vf[st][1].x, vf[st][1].y};
        if (dt == 0) o0 = MFMA32(__builtin_bit_cast(bf16x8, vv), s2 ? pb : pa, o0);
        else         o1 = MFMA32(__builtin_bit_cast(bf16x8, vv), s2 ? pb : pa, o1);
        vf[st][0] = *(LAS const u32x2*)(vb + dt * 32 * AT_VP + (32 + 16 * s2) * 2);
        vf[st][1] = *(LAS const u32x2*)(vb + dt * 32 * AT_VP + (32 + 16 * s2) * 2 + 16);
#pragma unroll
        for (int q = 0; q < 4; ++q) { s1[4 * st + q] = __builtin_amdgcn_exp2f(s1[4 * st + q]); ls += s1[4 * st + q]; }
        AT_PIN(ls);
        __builtin_amdgcn_sched_barrier(0);
    }
    const bf16x8 pc = at_pack8(s1, 0), pd = at_pack8(s1, 1);
#pragma unroll
    for (int st = 0; st < 4; ++st) {
        const int s2 = st >> 1, dt = st & 1;
        const u32x4 vv = {vf[st][0].x, vf[st][0].y, vf[st][1].x, vf[st][1].y};
        if (dt == 0) o0 = MFMA32(__builtin_bit_cast(bf16x8, vv), s2 ? pd : pc, o0);
        else         o1 = MFMA32(__builtin_bit_cast(bf16x8, vv), s2 ? pd : pc, o1);
    }
    l += ls;
}

#define AT_PASS(Kg, Vg, WITHV, NTILE, ROW, ...)                                                                        \
    {                                                                                                                  \
        AtStage st0_, st1_;                                                                                            \
        const int nt_ = (NTILE);                                                                                       \
        unsigned koff_ = (threadIdx.x >> 3) * 128 + (threadIdx.x & 7) * 16, voff_ = (threadIdx.x & 63) * 128 + (threadIdx.x >> 6) * 16; \
        asm volatile("" : "+v"(koff_), "+v"(voff_));     \
        __syncthreads();                                                                                               \
        at_load(st0_, (Kg) + (size_t)(ROW(0)) * 64, (Vg) + (size_t)(ROW(0)) * 64, WITHV, koff_, voff_);                 \
        at_store(st0_, lds, WITHV);                                                                                    \
        { const int i1_ = nt_ > 1 ? 1 : 0; at_load(st1_, (Kg) + (size_t)(ROW(i1_)) * 64, (Vg) + (size_t)(ROW(i1_)) * 64, WITHV, koff_, voff_); } \
        __syncthreads();                                                                                               \
        for (int i0_ = 0; i0_ < nt_; i0_ += 2) {                                                                       \
            {                                                                                                          \
                const int i = i0_;                                                                                     \
                LAS unsigned char* buf = lds;                                                                          \
                { const int in_ = (i + 2 < nt_) ? i + 2 : nt_ - 1;     \
                  at_load(st0_, (Kg) + (size_t)(ROW(in_)) * 64, (Vg) + (size_t)(ROW(in_)) * 64, WITHV, koff_, voff_); }        \
                do { __VA_ARGS__ } while (0);                                                                          \
                if (i + 1 < nt_) at_store(st1_, lds + AT_BUF, WITHV);                                                  \
                __syncthreads();                                                                                       \
            }                                                                                                          \
            if (i0_ + 1 < nt_) {                                                                                       \
                const int i = i0_ + 1;                                                                                 \
                LAS unsigned char* buf = lds + AT_BUF;                                                                 \
                { const int in_ = (i + 2 < nt_) ? i + 2 : nt_ - 1;                                                     \
                  at_load(st1_, (Kg) + (size_t)(ROW(in_)) * 64, (Vg) + (size_t)(ROW(in_)) * 64, WITHV, koff_, voff_); }        \
                do { __VA_ARGS__ } while (0);                                                                          \
                if (i + 1 < nt_) at_store(st0_, lds, WITHV);                                                           \
                __syncthreads();                                                                                       \
            }                                                                                                          \
        }                                                                                                              \
    }

__device__ __forceinline__ void nsa_item(const Params& p, unsigned char* shm, int b, int g, int c) {
    LAS unsigned char* lds = (LAS unsigned char*)shm;
    unsigned char* wsb = (unsigned char*)p.ws;
    const bf16_t* pt = (const bf16_t*)(wsb + WS_PT);
    int tid = threadIdx.x;
    asm volatile("" : "+v"(tid));
    const int lane = tid & 63, w = __builtin_amdgcn_readfirstlane(tid >> 6), r = lane & 31, h = lane >> 5;
    const int tokl = 8 * w + (r >> 2), head = r & 3, hq = 4 * g + head, t = 64 * c + tokl, tok = b * SEQ + t;
    const float sl2 = exp2f(-(float)(hq + 1)) * LOG2E;
    const float ramp = sl2;
    bf16x8 qf[4];
    {
        const bf16_t* qrow = pt + ((size_t)(HG_NQ + hq) * NTOK + tok) * 64 + 8 * h;
#pragma unroll
        for (int kk = 0; kk < 4; ++kk) qf[kk] = *(const bf16x8*)(qrow + 16 * kk);
    }
    const float* gl = (const float*)(wsb + WS_GATES);
#define GATE_(br, dst) float dst; { int go_ = tok * 24 + hq * 3 + (br); asm volatile("" : "+v"(go_)); dst = gl[go_]; }
    f32x16 R0, R1;
#pragma unroll
    for (int i = 0; i < 16; ++i) { R0[i] = 0.f; R1[i] = 0.f; }
    LAS float* impA = (LAS float*)(lds + AT_IMPA);
    LAS float* impB = (LAS float*)(lds + AT_IMPB);
    LAS unsigned* selb = (LAS unsigned*)(lds + AT_SELB);

    {
        const bf16_t* Kc = (const bf16_t*)(wsb + WS_KCMP) + (size_t)(b * 2 + g) * NCMPP * 64;
        const bf16_t* Vc = (const bf16_t*)(wsb + WS_VCMP) + (size_t)(b * 2 + g) * NCMPP * 64;
        const int ntile = (4 * c + 3 + 63) >> 6;
        const int imax = (t >= 31) ? ((t - 31) >> 4) : -1;
        const float ramp16 = sl2 * 16.0f;
        float m = -INFINITY, l = 0.f;
#define ROW_(_i) (64 * (_i))
        AT_PASS(Kc, Vc, false, ntile, ROW_,
            f32x16 s0, s1;
            const float base0 = sl2 * (float)(16 * 64 * i + 31 - 64 * c), base1 = base0 + sl2 * 512.0f;
            at_scores(buf, qf, ramp16, base0, base1, s0, s1);
            const int lim = imax - 64 * i - 4 * h;
            AT_MASK_LE(s0, s1, lim);
            const float tm = at_rowmax(s0, s1);
            const float mn = fmaxf(m, tm);
            if (mn > -INFINITY) {
                l *= __builtin_amdgcn_exp2f(m - mn);
                l += at_exp(s0, s1, mn);
                m = mn;
            }
        )
        l += __shfl_xor(l, 32);
        const float inv = (l > 0.f) ? 1.0f / l : 0.f;
        const float mfin = (m > -INFINITY) ? m : 0.f;
        f32x16 o0, o1;
#pragma unroll
        for (int i = 0; i < 16; ++i) { o0[i] = 0.f; o1[i] = 0.f; }
        AT_PASS(Kc, Vc, true, ntile, ROW_,
            f32x16 s0, s1;
            const float base0 = sl2 * (float)(16 * 64 * i + 31 - 64 * c), base1 = base0 + sl2 * 512.0f;
            at_scores(buf, qf, ramp16, base0, base1, s0, s1);
            const int lim = imax - 64 * i - 4 * h;
            AT_MASK_LE(s0, s1, lim);
            (void)at_exp(s0, s1, mfin);
_Pragma("unroll")
            for (int q = 0; q < 16; ++q) { s0[q] *= inv; s1[q] *= inv; }
_Pragma("unroll")
            for (int hf = 0; hf < 2; ++hf)
_Pragma("unroll")
                for (int u = 0; u < 4; ++u) {
                    const f32x16& P = hf ? s1 : s0;
                    float A = 2.0f * (P[4 * u] + P[4 * u + 1] + P[4 * u + 2]) + P[4 * u + 3], Bv = P[4 * u + 3];
                    A = quad_sum(A);
                    Bv = quad_sum(Bv);
                    const int j = 16 * i + 8 * hf + 2 * u + h;
                    if (head == 0) impA[tokl * 128 + j] = A;
                    if (head == 1) impB[tokl * 128 + j] = Bv;
                }
            at_pv(buf, s0, s1, o0, o1);
        )
#undef ROW_
        GATE_(0, g0)
#pragma unroll
        for (int i = 0; i < 16; ++i) { R0[i] = g0 * o0[i]; R1[i] = g0 * o1[i]; }
    }

    unsigned sw0, sw1, sw2, sw3;
    {
        __syncthreads();
        for (int tk = 0; tk < 8; ++tk) {
            const int tl = 8 * w + tk;
            unsigned long long ba, bb;
            if (c < 16) {
                ba = (1ull << (c + 1)) - 1ull;
                bb = 0ull;
            } else {
                const int jA = lane, jB = lane + 64;
                const float vA = (jA >= 1 && jA <= c - 2) ? impA[tl * 128 + jA] + impB[tl * 128 + jA - 1] : -1.0f;
                const float vB = (jB <= c - 2) ? impA[tl * 128 + jB] + impB[tl * 128 + jB - 1] : -1.0f;
                LAS float* cand = (LAS float*)(lds + AT_CAND) + w * 128;
                cand[jA] = vA;
                cand[jB] = vB;
                asm volatile("s_waitcnt lgkmcnt(0)" ::: "memory");
                int rA = 0, rB = 0;
                for (int j4 = 0; j4 < 128; j4 += 4) {
                    const f32x4 cv = *(LAS const f32x4*)(cand + j4);
#pragma unroll
                    for (int q = 0; q < 4; ++q) {
                        const int jj = j4 + q;
                        rA += (cv[q] > vA || (cv[q] == vA && jj < jA)) ? 1 : 0;
                        rB += (cv[q] > vB || (cv[q] == vB && jj < jB)) ? 1 : 0;
                    }
                }
                asm volatile("s_waitcnt lgkmcnt(0)" ::: "memory");
                const bool sA = (jA == 0) || (jA == c - 1) || (jA == c) || (vA >= 0.f && rA < 13);
                const bool sB = (jB == c - 1) || (jB == c) || (vB >= 0.f && rB < 13);
                ba = __ballot(sA);
                bb = __ballot(sB);
            }
            if (lane == 0) {
                selb[tl * 4 + 0] = (unsigned)ba;
                selb[tl * 4 + 1] = (unsigned)(ba >> 32);
                selb[tl * 4 + 2] = (unsigned)bb;
                selb[tl * 4 + 3] = (unsigned)(bb >> 32);
            }
        }
        __syncthreads();
        sw0 = selb[tokl * 4 + 0];
        sw1 = selb[tokl * 4 + 1];
        sw2 = selb[tokl * 4 + 2];
        sw3 = selb[tokl * 4 + 3];
    }

    {
        const bf16_t* Ks = pt + ((size_t)(HG_KS + g) * NTOK + (size_t)b * SEQ) * 64;
        const bf16_t* Vs = pt + ((size_t)(HG_VS + g) * NTOK + (size_t)b * SEQ) * 64;
        LAS unsigned* tokm = (LAS unsigned*)(lds + AT_TOKM);
        LAS float* olds = (LAS float*)(lds + AT_OLDS);
        LAS float* mrefs = (LAS float*)(lds + AT_MREF);
        LAS float* lacc = (LAS float*)(lds + AT_LACC);
        LAS int* jlist = (LAS int*)(lds + AT_JLIST);
        LAS unsigned char* qs = lds + AT_QS;
        const int myrow = tokl * 4 + head;
        __syncthreads();
#pragma unroll
        for (int kk = 0; kk < 4; ++kk) *(LAS bf16x8*)(qs + myrow * 144 + (16 * kk + 8 * h) * 2) = qf[kk];
        {
            const unsigned wd = selb[lane * 4 + (w >> 1)];
#pragma unroll
            for (int jj = 0; jj < 16; ++jj) {
                const int j = 16 * w + jj;
                const unsigned long long mk = __ballot(((wd >> (j & 31)) & 1u) && j <= c);
                if (lane == 0) { tokm[2 * j] = (unsigned)mk; tokm[2 * j + 1] = (unsigned)(mk >> 32); }
            }
        }
        __syncthreads();
        if (w == 0) {
            const int j1 = c - lane, j2 = c - 64 - lane;
            const bool n1 = j1 >= 0 && (tokm[2 * (j1 < 0 ? 0 : j1)] | tokm[2 * (j1 < 0 ? 0 : j1) + 1]) != 0u;
            const bool n2 = j2 >= 0 && (tokm[2 * (j2 < 0 ? 0 : j2)] | tokm[2 * (j2 < 0 ? 0 : j2) + 1]) != 0u;
            const unsigned long long b1 = __ballot(n1), b2 = __ballot(n2);
            const unsigned long long lt = (1ull << lane) - 1ull;
            const int c1 = __popcll(b1);
            if (n1) jlist[1 + __popcll(b1 & lt)] = j1;
            if (n2) jlist[1 + c1 + __popcll(b2 & lt)] = j2;
            if (lane == 0) jlist[0] = c1 + __popcll(b2);
        }
        __syncthreads();
        const int nj = jlist[0];
#define ROW_(_i) (64 * jlist[1 + (_i)])
        AT_PASS(Ks, Vs, true, nj, ROW_,
            const int j = jlist[1 + i];
            const float base0 = sl2 * (float)(64 * (j - c));
            if (i == 0) {
                f32x16 s0, s1, a0, a1;
                _Pragma("unroll") for (int q = 0; q < 16; ++q) { a0[q] = 0.f; a1[q] = 0.f; }
                at_scores(buf, qf, ramp, base0, base0 + sl2 * 32.0f, s0, s1);
                const int lim = tokl - 4 * h;
                AT_MASK_LE(s0, s1, lim);
                const float mr = at_rowmax(s0, s1);
                const float lp = at_exp(s0, s1, mr);
                at_pv(buf, s0, s1, a0, a1);
                LAS float* orow = olds + myrow * AT_OP + 4 * h;
                _Pragma("unroll") for (int u = 0; u < 4; ++u) {
                    *(LAS f32x4*)(orow + 8 * u) = (f32x4){a0[4 * u], a0[4 * u + 1], a0[4 * u + 2], a0[4 * u + 3]};
                    *(LAS f32x4*)(orow + 32 + 8 * u) = (f32x4){a1[4 * u], a1[4 * u + 1], a1[4 * u + 2], a1[4 * u + 3]};
                }
                const float lt = lp + __shfl_xor(lp, 32);
                if (h == 0) { mrefs[myrow] = mr; lacc[myrow] = lt; }
            } else {
                const unsigned mlo = tokm[2 * j], mhi = tokm[2 * j + 1];
                const int nact = __popc(mlo) + __popc(mhi);
                if (8 * w >= nact) break;
                const int ct = 8 * w + (r >> 2);
                const bool valid = ct < nact;
                const int tau = nth_set_bit64(mlo, mhi, valid ? ct : 0);
                const int row = tau * 4 + head;
                bf16x8 q2[4];
                _Pragma("unroll") for (int kk = 0; kk < 4; ++kk) q2[kk] = *(LAS const bf16x8*)(qs + row * 144 + (16 * kk + 8 * h) * 2);
                const float mrow = valid ? mrefs[row] : INFINITY;
                LAS float* orow = olds + row * AT_OP + 4 * h;
                f32x16 a0, a1;
                _Pragma("unroll") for (int u = 0; u < 4; ++u) {
                    const f32x4 x0 = *(LAS const f32x4*)(orow + 8 * u), x1 = *(LAS const f32x4*)(orow + 32 + 8 * u);
                    a0[4 * u] = x0[0]; a0[4 * u + 1] = x0[1]; a0[4 * u + 2] = x0[2]; a0[4 * u + 3] = x0[3];
                    a1[4 * u] = x1[0]; a1[4 * u + 1] = x1[1]; a1[4 * u + 2] = x1[2]; a1[4 * u + 3] = x1[3];
                }
                float lp = 0.f;
                at_tile_pipe(buf, q2, ramp, base0, mrow, sl2 * 32.0f, lp, a0, a1);
                const float lt = lp + __shfl_xor(lp, 32);
                if (valid) {
                    _Pragma("unroll") for (int u = 0; u < 4; ++u) {
                        *(LAS f32x4*)(orow + 8 * u) = (f32x4){a0[4 * u], a0[4 * u + 1], a0[4 * u + 2], a0[4 * u + 3]};
                        *(LAS f32x4*)(orow + 32 + 8 * u) = (f32x4){a1[4 * u], a1[4 * u + 1], a1[4 * u + 2], a1[4 * u + 3]};
                    }
                    if (h == 0) lacc[row] += lt;
                }
            }
        )
#undef ROW_
        __syncthreads();
        {
            const float l = lacc[myrow];
            GATE_(1, g1)
            const float sc = g1 / l;
            LAS const float* orow = olds + myrow * AT_OP + 4 * h;
#pragma unroll
            for (int u = 0; u < 4; ++u)
#pragma unroll
                for (int q = 0; q < 4; ++q) { R0[4 * u + q] += sc * orow[8 * u + q]; R1[4 * u + q] += sc * orow[32 + 8 * u + q]; }
        }
    }

    {
        const bf16_t* Kw = pt + ((size_t)(HG_KW + g) * NTOK + (size_t)b * SEQ) * 64;
        const bf16_t* Vw = pt + ((size_t)(HG_VW + g) * NTOK + (size_t)b * SEQ) * 64;
        f32x16 o0, o1;
#pragma unroll
        for (int i = 0; i < 16; ++i) { o0[i] = 0.f; o1[i] = 0.f; }
        float mref = 0.f, l = 0.f;
        const int ntile = (c >= 8) ? 9 : (c + 1);
#define ROW_(_i) (64 * (c - (_i)))
        AT_PASS(Kw, Vw, true, ntile, ROW_,
            const float base0 = sl2 * (float)(-64 * i);
            if (i == 0 || i == 8) {
                f32x16 s0, s1;
                at_scores(buf, qf, ramp, base0, base0 + sl2 * 32.0f, s0, s1);
                if (i == 0) {
                    const int lim = tokl - 4 * h;
                    AT_MASK_LE(s0, s1, lim);
                    mref = at_rowmax(s0, s1);
                } else {
                    const int lo = tokl + 1 - 4 * h;
                    AT_MASK_GE(s0, s1, lo);
                }
                l += at_exp(s0, s1, mref);
                at_pv(buf, s0, s1, o0, o1);
            } else {
                at_tile_pipe(buf, qf, ramp, base0, mref, sl2 * 32.0f, l, o0, o1);
            }
        )
#undef ROW_
        l += __shfl_xor(l, 32);
        GATE_(2, g2)
        const float sc = g2 / l;
#pragma unroll
        for (int i = 0; i < 16; ++i) { R0[i] += sc * o0[i]; R1[i] += sc * o1[i]; }
    }

    {
        bf16_t* orow = (bf16_t*)(wsb + WS_MIXB) + (size_t)tok * DM + 512 + hq * 64 + 4 * h;
#pragma unroll
        for (int u = 0; u < 4; ++u) {
            u32x2 a, bq;
            a.x = pk_bf16(R0[4 * u], R0[4 * u + 1]);
            a.y = pk_bf16(R0[4 * u + 2], R0[4 * u + 3]);
            bq.x = pk_bf16(R1[4 * u], R1[4 * u + 1]);
            bq.y = pk_bf16(R1[4 * u + 2], R1[4 * u + 3]);
            *(u32x2*)(orow + 8 * u) = a;
            *(u32x2*)(orow + 32 + 8 * u) = bq;
        }
    }
}

constexpr int PART_REC = 136, PART_ROW = 4 * PART_REC;
__device__ __forceinline__ unsigned char* part_rec(unsigned char* wsb, int b, int hh, int t, int slot) {
    return wsb + WS_PART + ((size_t)((b * 8 + hh) * SEQ + t)) * PART_ROW + slot * PART_REC;
}
__device__ __forceinline__ void part_store(unsigned char* rec, const f32x16& o0, const f32x16& o1, float l, float m, int h) {
    const float sc = 1.0f / l;
    bf16_t* orow = (bf16_t*)rec + 4 * h;
#pragma unroll
    for (int u = 0; u < 4; ++u) {
        u32x2 a, bq;
        a.x = pk_bf16(sc * o0[4 * u], sc * o0[4 * u + 1]);
        a.y = pk_bf16(sc * o0[4 * u + 2], sc * o0[4 * u + 3]);
        bq.x = pk_bf16(sc * o1[4 * u], sc * o1[4 * u + 1]);
        bq.y = pk_bf16(sc * o1[4 * u + 2], sc * o1[4 * u + 3]);
        *(u32x2*)(orow + 8 * u) = a;
        *(u32x2*)(orow + 32 + 8 * u) = bq;
    }
    if (h == 0) { f32x2 lm = {l, m}; *(f32x2*)(rec + 128) = lm; }
}

__device__ __forceinline__ void moba_gate_item(const Params& p, unsigned char* shm, int b, int hh, int cb) {
    LAS unsigned char* lds = (LAS unsigned char*)shm;
    unsigned char* wsb = (unsigned char*)p.ws;
    const bf16_t* pt = (const bf16_t*)(wsb + WS_PT);
    int tid = threadIdx.x;
    asm volatile("" : "+v"(tid));
    const int lane = tid & 63, w = __builtin_amdgcn_readfirstlane(tid >> 6), r = lane & 31, h = lane >> 5;
    const int tloc = 32 * w + r, t = 256 * cb + tloc, tok = b * SEQ + t;
    LAS float* kms = (LAS float*)(lds + AT_KMS);
    LAS int* lcnt = (LAS int*)(lds + AT_SELB);
    LAS int* lbase = lcnt + 32;
    int* mcnt = (int*)(wsb + WS_MCNT) + (b * 8 + hh) * 32;
    unsigned short* mlist = (unsigned short*)(wsb + WS_MLIST) + (size_t)((b * 8 + hh) * 32) * 8192;
    __syncthreads();
    {
        const f32x4 v = ((const f32x4*)((const float*)(wsb + WS_KMEAN) + (size_t)(b * 8 + hh) * 2048))[tid];
        *(LAS f32x4*)(kms + tid * 4) = v;
    }
    if (tid < 32) lcnt[tid] = 0;
    __syncthreads();
    float qv[32];
    {
        const bf16_t* qrow = pt + ((size_t)(HG_MQ + hh) * NTOK + tok) * 64 + 8 * h;
#pragma unroll
        for (int kk = 0; kk < 4; ++kk) {
            const u32x4 qq = *(const u32x4*)(qrow + 16 * kk);
            qv[kk * 8 + 0] = bf_lo(qq.x); qv[kk * 8 + 1] = bf_hi(qq.x);
            qv[kk * 8 + 2] = bf_lo(qq.y); qv[kk * 8 + 3] = bf_hi(qq.y);
            qv[kk * 8 + 4] = bf_lo(qq.z); qv[kk * 8 + 5] = bf_hi(qq.z);
            qv[kk * 8 + 6] = bf_lo(qq.w); qv[kk * 8 + 7] = bf_hi(qq.w);
        }
    }
    float b0 = -INFINITY, b1 = -INFINITY, b2 = -INFINITY;
    int i0 = 0, i1 = 0, i2 = 0;
    for (int n = 0; n < cb; ++n) {
        float s = 0.f;
#pragma unroll
        for (int kk = 0; kk < 4; ++kk) {
            const f32x4 ka = *(LAS const f32x4*)(kms + n * 64 + 16 * kk + 8 * h), kb = *(LAS const f32x4*)(kms + n * 64 + 16 * kk + 8 * h + 4);
            s += qv[kk * 8 + 0] * ka[0] + qv[kk * 8 + 1] * ka[1] + qv[kk * 8 + 2] * ka[2] + qv[kk * 8 + 3] * ka[3];
            s += qv[kk * 8 + 4] * kb[0] + qv[kk * 8 + 5] * kb[1] + qv[kk * 8 + 6] * kb[2] + qv[kk * 8 + 7] * kb[3];
        }
        s += __shfl_xor(s, 32);
        if (s > b0) { b2 = b1; i2 = i1; b1 = b0; i1 = i0; b0 = s; i0 = n; }
        else if (s > b1) { b2 = b1; i2 = i1; b1 = s; i1 = n; }
        else if (s > b2) { b2 = s; i2 = n; }
    }
    const int nsel = cb < 3 ? cb : 3;
    int n0 = i0, n1 = i1, n2 = i2;
    if (nsel >= 2 && n1 < n0) { const int x = n0; n0 = n1; n1 = x; }
    if (nsel >= 3) {
        if (n2 < n1) { const int x = n1; n1 = n2; n2 = x; }
        if (n1 < n0) { const int x = n0; n0 = n1; n1 = x; }
    }
    int r0 = 0, r1 = 0, r2 = 0;
    if (h == 0) {
        r0 = atomicAdd((int*)(lcnt + n0), 1);
        if (nsel >= 2) r1 = atomicAdd((int*)(lcnt + n1), 1);
        if (nsel >= 3) r2 = atomicAdd((int*)(lcnt + n2), 1);
    }
    __syncthreads();
    if (tid < cb) lbase[tid] = atomicAdd(mcnt + tid, lcnt[tid]);
    __syncthreads();
    if (h == 0) {
        mlist[(size_t)n0 * 8192 + lbase[n0] + r0] = (unsigned short)(t | (0 << 13));
        if (nsel >= 2) mlist[(size_t)n1 * 8192 + lbase[n1] + r1] = (unsigned short)(t | (1 << 13));
        if (nsel >= 3) mlist[(size_t)n2 * 8192 + lbase[n2] + r2] = (unsigned short)(t | (2 << 13));
    }
}

__device__ __forceinline__ void moba_own_item(const Params& p, unsigned char* shm, int b, int hh, int cb) {
    LAS unsigned char* lds = (LAS unsigned char*)shm;
    unsigned char* wsb = (unsigned char*)p.ws;
    const bf16_t* pt = (const bf16_t*)(wsb + WS_PT);
    int tid = threadIdx.x;
    asm volatile("" : "+v"(tid));
    const int lane = tid & 63, w = __builtin_amdgcn_readfirstlane(tid >> 6), r = lane & 31, h = lane >> 5;
    const int tloc = 32 * w + r, t = 256 * cb + tloc, tok = b * SEQ + t;
    const float sl2 = exp2f(-((float)hh + 0.5f)) * LOG2E;
    const float ramp = sl2;
    bf16x8 qf[4];
    {
        const bf16_t* qrow = pt + ((size_t)(HG_MQ + hh) * NTOK + tok) * 64 + 8 * h;
#pragma unroll
        for (int kk = 0; kk < 4; ++kk) qf[kk] = *(const bf16x8*)(qrow + 16 * kk);
    }
    const bf16_t* Km = pt + ((size_t)(HG_MK + hh) * NTOK + (size_t)b * SEQ) * 64;
    const bf16_t* Vm = pt + ((size_t)(HG_MV + hh) * NTOK + (size_t)b * SEQ) * 64;
    f32x16 o0, o1;
#pragma unroll
    for (int i = 0; i < 16; ++i) { o0[i] = 0.f; o1[i] = 0.f; }
    float mref = 0.f, l = 0.f;
    const int wt = w >> 1;
#define ROW_(_i) (256 * cb + 64 * (3 - (_i)))
    AT_PASS(Km, Vm, true, 4, ROW_,
        const int tt = 3 - i;
        if (tt > wt) break;
        const float base0 = sl2 * (float)(64 * tt);
        if (tt == wt) {
            f32x16 s0, s1;
            at_scores(buf, qf, ramp, base0, base0 + sl2 * 32.0f, s0, s1);
            const int lim = tloc - 64 * tt - 4 * h;
            AT_MASK_LE(s0, s1, lim);
            mref = at_rowmax(s0, s1);
            l += at_exp(s0, s1, mref);
            at_pv(buf, s0, s1, o0, o1);
        } else {
            at_tile_pipe(buf, qf, ramp, base0, mref, sl2 * 32.0f, l, o0, o1);
        }
        )
#undef ROW_
    l += __shfl_xor(l, 32);
    part_store(part_rec(wsb, b, hh, t, 3), o0, o1, l, mref - sl2 * (float)tloc, h);
}

__device__ __forceinline__ void moba_gather_item(const Params& p, unsigned char* shm, int b, int hh, int n, int k, int cnt) {
    LAS unsigned char* lds = (LAS unsigned char*)shm;
    unsigned char* wsb = (unsigned char*)p.ws;
    const bf16_t* pt = (const bf16_t*)(wsb + WS_PT);
    int tid = threadIdx.x;
    asm volatile("" : "+v"(tid));
    const int lane = tid & 63, w = __builtin_amdgcn_readfirstlane(tid >> 6), r = lane & 31, h = lane >> 5;
    const unsigned short* mlist = (const unsigned short*)(wsb + WS_MLIST) + (size_t)((b * 8 + hh) * 32 + n) * 8192;
    const int li = 256 * k + 32 * w + r;
    const bool live = li < cnt;
    const unsigned ent = mlist[live ? li : cnt - 1];
    const int t = ent & 8191, slot = ent >> 13, tok = b * SEQ + t;
    const float sl2 = exp2f(-((float)hh + 0.5f)) * LOG2E;
    const float ramp = sl2;
    bf16x8 qf[4];
    {
        const bf16_t* qrow = pt + ((size_t)(HG_MQ + hh) * NTOK + tok) * 64 + 8 * h;
#pragma unroll
        for (int kk = 0; kk < 4; ++kk) qf[kk] = *(const bf16x8*)(qrow + 16 * kk);
    }
    const bf16_t* Km = pt + ((size_t)(HG_MK + hh) * NTOK + (size_t)b * SEQ) * 64;
    const bf16_t* Vm = pt + ((size_t)(HG_MV + hh) * NTOK + (size_t)b * SEQ) * 64;
    f32x16 o0, o1;
#pragma unroll
    for (int i = 0; i < 16; ++i) { o0[i] = 0.f; o1[i] = 0.f; }
    float mref = 0.f, l = 0.f;
    const float tb = sl2 * (float)(256 * n - t);
#define ROW_(_i) (256 * n + 64 * (3 - (_i)))
    AT_PASS(Km, Vm, true, 4, ROW_,
        const int tt = 3 - i;
        const float base0 = tb + sl2 * (float)(64 * tt);
        if (i == 0) {
            f32x16 s0, s1;
            at_scores(buf, qf, ramp, base0, base0 + sl2 * 32.0f, s0, s1);
            mref = at_rowmax(s0, s1);
            l += at_exp(s0, s1, mref);
            at_pv(buf, s0, s1, o0, o1);
        } else {
            at_tile_pipe(buf, qf, ramp, base0, mref, sl2 * 32.0f, l, o0, o1);
        }
        )
#undef ROW_
    l += __shfl_xor(l, 32);
    if (live) part_store(part_rec(wsb, b, hh, t, slot), o0, o1, l, mref, h);
}

__device__ __forceinline__ void f_moba_merge(const Params& p) {
    unsigned char* wsb = (unsigned char*)p.ws;
    const int tid = threadIdx.x;
    bf16_t* mixb = (bf16_t*)(wsb + WS_MIXB);
    for (int idx = blockIdx.x * 512 + tid; idx < NTOK * 8 * 8; idx += gridDim.x * 512) {
        const int dq = idx & 7, rho = idx >> 3;
        const int t = rho & (SEQ - 1), bh = rho >> 13, hh = bh & 7, b = bh >> 3;
        const int cbk = t >> 8, nsel = cbk < 3 ? cbk : 3;
        const unsigned char* row = wsb + WS_PART + (size_t)rho * PART_ROW;
        float lw[4];
        float M = -INFINITY;
        f32x2 lm[4];
#pragma unroll
        for (int s = 0; s < 4; ++s) {
            const bool on = (s == 3) || (s < nsel);
            lm[s] = on ? *(const f32x2*)(row + s * PART_REC + 128) : (f32x2){0.f, -INFINITY};
            M = fmaxf(M, lm[s][1]);
        }
        float W = 0.f;
#pragma unroll
        for (int s = 0; s < 4; ++s) { lw[s] = lm[s][0] * __builtin_amdgcn_exp2f(lm[s][1] - M); W += lw[s]; }
        float acc[8];
#pragma unroll
        for (int q = 0; q < 8; ++q) acc[q] = 0.f;
#pragma unroll
        for (int s = 0; s < 4; ++s) {
            const bool on = (s == 3) || (s < nsel);
            if (on) {
                const u32x4 v = *(const u32x4*)(row + s * PART_REC + dq * 16);
                acc[0] += lw[s] * bf_lo(v.x); acc[1] += lw[s] * bf_hi(v.x);
                acc[2] += lw[s] * bf_lo(v.y); acc[3] += lw[s] * bf_hi(v.y);
                acc[4] += lw[s] * bf_lo(v.z); acc[5] += lw[s] * bf_hi(v.z);
                acc[6] += lw[s] * bf_lo(v.w); acc[7] += lw[s] * bf_hi(v.w);
            }
        }
        const float inv = 1.0f / W;
        u32x4 o;
        o.x = pk_bf16(acc[0] * inv, acc[1] * inv);
        o.y = pk_bf16(acc[2] * inv, acc[3] * inv);
        o.z = pk_bf16(acc[4] * inv, acc[5] * inv);
        o.w = pk_bf16(acc[6] * inv, acc[7] * inv);
        *(u32x4*)(mixb + (size_t)(b * SEQ + t) * DM + hh * 64 + dq * 8) = o;
    }
}

__device__ __forceinline__ void f_moba_gate(const Params& p, unsigned char* shm) {
    for (int q = blockIdx.x; q < 1024; q += gridDim.x) {
        const int cb = q >> 5, bh = q & 31;
        if (cb >= 1) moba_gate_item(p, shm, bh >> 3, bh & 7, cb);
    }
    __syncthreads();
}

constexpr int AT_TAIL = AT_QS + 256 * 144;
static_assert(AT_TAIL + 2064 + 64 <= FAST_LDS_BYTES - 16, "attention queue tables");
__device__ __forceinline__ void f_attn(const Params& p, unsigned char* shm) {
    LAS unsigned short* pre = (LAS unsigned short*)((LAS unsigned char*)shm + AT_TAIL);
    LAS int* wtot = (LAS int*)((LAS unsigned char*)shm + AT_TAIL + 2064);
    const int* mcnt = (const int*)((unsigned char*)p.ws + WS_MCNT);
    int* qctr = (int*)((unsigned char*)p.ws + WS_MCNT) + 1024;
    int tid = threadIdx.x;
    asm volatile("" : "+v"(tid));
    __syncthreads();
    {
        const int lane = tid & 63, w = tid >> 6;
        const int v0 = (mcnt[2 * tid] + 255) >> 8, v1 = (mcnt[2 * tid + 1] + 255) >> 8;
        int sc = v0 + v1;
#pragma unroll
        for (int d = 1; d < 64; d <<= 1) { const int u = __shfl_up(sc, d); if (lane >= d) sc += u; }
        if (lane == 63) wtot[w] = sc;
        __syncthreads();
        int woff = 0;
        for (int ww = 0; ww < w; ++ww) woff += wtot[ww];
        const int excl = woff + sc - (v0 + v1);
        pre[2 * tid] = (unsigned short)excl;
        pre[2 * tid + 1] = (unsigned short)(excl + v0);
        if (tid == 511) pre[1024] = (unsigned short)(excl + v0 + v1);
    }
    __syncthreads();
    const int limit = 2048 + (int)pre[1024];
    int ticket = 0;
    if (tid == 0) ticket = atomicAdd(qctr, 1);
    for (;;) {
        __syncthreads();
        if (tid == 0) wtot[8] = ticket;
        __syncthreads();
        const int it = wtot[8];
        if (it >= limit) break;
        if (tid == 0) ticket = atomicAdd(qctr, 1);
        if (it < 1024) {
            const int q = it & 511;
            nsa_item(p, shm, q & 3, it < 512 ? 1 : 0, 127 - (q >> 2));
        } else if (it < 2048) {
            const int q = it - 1024;
            moba_own_item(p, shm, (q & 31) >> 3, q & 7, q >> 5);
        } else {
            const int gi = it - 2048;
            int lo = 0, hi = 1024;
            while (hi - lo > 1) { const int mid = (lo + hi) >> 1; if ((int)pre[mid] <= gi) lo = mid; else hi = mid; }
            const int li = lo, k = gi - (int)pre[li];
            moba_gather_item(p, shm, li >> 8, (li >> 5) & 7, li & 31, k, mcnt[li]);
        }
    }
    __syncthreads();
}

__device__ __forceinline__ void f_prologue(const Params& p, unsigned char* shm) {
    const int tid = threadIdx.x, lane = tid & 63, w = tid >> 6;
    unsigned char* wsb = (unsigned char*)p.ws;
    bf16_t* xn = (bf16_t*)(wsb + WS_XN);
    {
        float4* km = (float4*)(wsb + WS_KMEAN);
        for (int i = blockIdx.x * 512 + tid; i < 16384; i += gridDim.x * 512) km[i] = make_float4(0.f, 0.f, 0.f, 0.f);
        int* mc = (int*)(wsb + WS_MCNT);
        for (int i = blockIdx.x * 512 + tid; i < 1024 + 16; i += gridDim.x * 512) mc[i] = 0;
    }
    for (int row = blockIdx.x * 8 + w; row < NTOK; row += gridDim.x * 8) {
        const float4* xr = (const float4*)(p.x + (size_t)row * DM);
        float4 v[4];
        float ss = 0.f;
#pragma unroll
        for (int j = 0; j < 4; ++j) { v[j] = xr[lane + 64 * j]; ss += dot4(v[j], v[j]); }
        ss = wave_sum(ss);
        const float r = 1.0f / sqrtf(ss * (1.0f / DM) + 1e-5f);
        const float4* g4 = (const float4*)p.attn_g;
        u32x2* o = (u32x2*)(xn + (size_t)row * DM);
#pragma unroll
        for (int j = 0; j < 4; ++j) {
            const float4 g = g4[lane + 64 * j];
            u32x2 ov;
            ov.x = pk_bf16(v[j].x * r * g.x, v[j].y * r * g.y);
            ov.y = pk_bf16(v[j].z * r * g.z, v[j].w * r * g.w);
            o[lane + 64 * j] = ov;
        }
    }
    float* T = (float*)shm;
    bf16_t* btin = (bf16_t*)(wsb + WS_BTIN);
    bf16_t* btout = (bf16_t*)(wsb + WS_BTOUT);
    bf16_t* btup = (bf16_t*)(wsb + WS_BTUP);
    bf16_t* btdn = (bf16_t*)(wsb + WS_BTDN);
    bf16_t* w1t = (bf16_t*)(wsb + WS_W1T);
    bf16_t* w2t = (bf16_t*)(wsb + WS_W2T);
    const auto ident = [](int c) { return c; };
    cv_run(T, 16 * 48, [&](int it, const float*& W, int& K, int& ncols, int& ldw, bf16_t*& WT, int& k0, int& n0) {
        const int g4 = it >> 2, sub = it & 3, kt = (g4 / 24) * 2 + (sub >> 1), nt = (g4 % 24) * 2 + (sub & 1);
        W = p.w_in; K = DM; ncols = INC; ldw = INC; WT = btin; k0 = kt * 64; n0 = nt * 64; }, ident);
    cv_run(T, 16 * 16, [&](int it, const float*& W, int& K, int& ncols, int& ldw, bf16_t*& WT, int& k0, int& n0) {
        const int g4 = it >> 2, sub = it & 3, kt = (g4 >> 3) * 2 + (sub >> 1), nt = (g4 & 7) * 2 + (sub & 1);
        W = p.w_out; K = DM; ncols = DM; ldw = DM; WT = btout; k0 = kt * 64; n0 = nt * 64; }, ident);
    cv_run(T, NE * 16 * 32, [&](int it, const float*& W, int& K, int& ncols, int& ldw, bf16_t*& WT, int& k0, int& n0) {
        const int e = it >> 9, r = it & 511;
        const int g4 = r >> 2, sub = r & 3, kt = (g4 >> 4) * 2 + (sub >> 1), nt = (g4 & 15) * 2 + (sub & 1);
        W = p.w_up + (size_t)e * DM * DFF2; K = DM; ncols = DFF2; ldw = DFF2; WT = btup + (size_t)e * DFF2 * DM; k0 = kt * 64; n0 = nt * 64; },
        [](int c) { const int a = c >> 1, isu = c & 1; return (a >> 7) * 256 + isu * 128 + (a & 127); });
    cv_run(T, NE * 16 * 16, [&](int it, const float*& W, int& K, int& ncols, int& ldw, bf16_t*& WT, int& k0, int& n0) {
        const int e = it >> 8, r = it & 255;
        const int g4 = r >> 2, sub = r & 3, kt = (g4 >> 3) * 2 + (sub >> 1), nt = (g4 & 7) * 2 + (sub & 1);
        W = p.w_down + (size_t)e * DM * DM; K = DM; ncols = DM; ldw = DM; WT = btdn + (size_t)e * DM * DM; k0 = kt * 64; n0 = nt * 64; }, ident);
    cv_run(T, 2 * 33, [&](int it, const float*& W, int& K, int& ncols, int& ldw, bf16_t*& WT, int& k0, int& n0) {
        const int kv = it / 33, r = it % 33;
        ncols = 64; ldw = 64; n0 = 0;
        if (r < 32) { W = kv ? p.w1v : p.w1k; K = 2048; WT = w1t + (size_t)kv * 64 * 2048; k0 = r * 64; }
        else        { W = kv ? p.w2v : p.w2k; K = 64;   WT = w2t + (size_t)kv * 64 * 64;   k0 = 0; } }, ident);
    __syncthreads();
    if (blockIdx.x == gridDim.x - 1) {
        const int o = tid & 127, part = tid >> 7, kv = o >> 6, n = o & 63;
        const float* pe = kv ? p.pe_v : p.pe_k;
        const float* w1 = kv ? p.w1v : p.w1k;
        float s = 0.f;
        for (int ff = part * 512; ff < part * 512 + 512; ++ff) s += pe[ff] * w1[ff * 64 + n];
        T[part * 128 + o] = s;
        __syncthreads();
        if (tid < 128) ((float*)(wsb + WS_C1))[tid] = T[tid] + T[128 + tid] + T[256 + tid] + T[384 + tid];
    }
    __syncthreads();
}

__device__ __forceinline__ void f_cmp(const Params& p, unsigned char* shm) {
    unsigned char* wsb = (unsigned char*)p.ws;
    const bf16_t* pt = (const bf16_t*)(wsb + WS_PT);
    const bf16_t* w1t = (const bf16_t*)(wsb + WS_W1T);
    const bf16_t* w2t = (const bf16_t*)(wsb + WS_W2T);
    const float* c1 = (const float*)(wsb + WS_C1);
    const int tid = threadIdx.x, lane = tid & 63, w = __builtin_amdgcn_readfirstlane(tid >> 6), fr = lane & 15, fq = lane >> 4;
    LAS float* part = (LAS float*)shm;
    LAS unsigned char* h1buf = (LAS unsigned char*)shm + 32768;
    for (int it = blockIdx.x; it < 512; it += gridDim.x) {
        const int rg = it & 31, g = (it >> 5) & 1, b = (it >> 6) & 3, kv = it >> 8;
        const int hg = (kv ? HG_VC : HG_KC) + g;
        const bf16_t* arow = pt + ((size_t)hg * NTOK + (size_t)b * SEQ + 16 * (16 * rg + fr)) * 64 + 8 * fq + 256 * w;
        const bf16_t* brow = w1t + ((size_t)kv * 64 + fr) * 2048 + 8 * fq + 256 * w;
        f32x4 acc[4];
#pragma unroll
        for (int nt = 0; nt < 4; ++nt) acc[nt] = (f32x4){0.f, 0.f, 0.f, 0.f};
#pragma unroll
        for (int kk = 0; kk < 8; ++kk) {
            const bf16x8 a = *(const bf16x8*)(arow + 32 * kk);
#pragma unroll
            for (int nt = 0; nt < 4; ++nt) {
                const bf16x8 bb = *(const bf16x8*)(brow + (size_t)nt * 16 * 2048 + 32 * kk);
                acc[nt] = __builtin_amdgcn_mfma_f32_16x16x32_bf16(a, bb, acc[nt], 0, 0, 0);
            }
        }
        __syncthreads();
#pragma unroll
        for (int nt = 0; nt < 4; ++nt)
#pragma unroll
            for (int reg = 0; reg < 4; ++reg) part[w * 1024 + (4 * fq + reg) * 64 + nt * 16 + fr] = acc[nt][reg];
        __syncthreads();
        {
#pragma unroll
            for (int q = 0; q < 2; ++q) {
                const int o = tid + 512 * q, row = o >> 6, col = o & 63;
                float s = c1[kv * 64 + col];
#pragma unroll
                for (int ww = 0; ww < 8; ++ww) s += part[ww * 1024 + o];
                *(LAS unsigned short*)(h1buf + row * 144 + col * 2) = (unsigned short)(pk_bf16(gelu_tanh(s), 0.f) & 0xffffu);
            }
        }
        __syncthreads();
        if (w == 0) {
            f32x4 acc2[4];
#pragma unroll
            for (int nt = 0; nt < 4; ++nt) acc2[nt] = (f32x4){0.f, 0.f, 0.f, 0.f};
#pragma unroll
            for (int k2 = 0; k2 < 2; ++k2) {
                const bf16x8 a2 = *(LAS const bf16x8*)(h1buf + fr * 144 + (32 * k2 + 8 * fq) * 2);
#pragma unroll
                for (int nt = 0; nt < 4; ++nt) {
                    const bf16x8 b2 = *(const bf16x8*)(w2t + ((size_t)kv * 64 + nt * 16 + fr) * 64 + 32 * k2 + 8 * fq);
                    acc2[nt] = __builtin_amdgcn_mfma_f32_16x16x32_bf16(a2, b2, acc2[nt], 0, 0, 0);
                }
            }
            bf16_t* dst = (bf16_t*)(wsb + (kv ? WS_VCMP : WS_KCMP)) + (size_t)((b * 2 + g) * NCMPP + 16 * rg) * 64;
#pragma unroll
            for (int nt = 0; nt < 4; ++nt)
#pragma unroll
                for (int reg = 0; reg < 4; ++reg)
                    dst[(size_t)(4 * fq + reg) * 64 + nt * 16 + fr] = (bf16_t)(pk_bf16(acc2[nt][reg], 0.f) & 0xffffu);
        }
    }
    __syncthreads();
}

__device__ __forceinline__ void f_inproj(const Params& p, unsigned char* shm) {
    unsigned char* wsb = (unsigned char*)p.ws;
    const bf16_t* xn = (const bf16_t*)(wsb + WS_XN);
    const bf16_t* btin = (const bf16_t*)(wsb + WS_BTIN);
    bf16_t* pt = (bf16_t*)(wsb + WS_PT);
    float* gates = (float*)(wsb + WS_GATES);
    float* kmean = (float*)(wsb + WS_KMEAN);
    const int tid = threadIdx.x, wid = __builtin_amdgcn_readfirstlane(tid >> 6), lane = tid & 63, wr = wid >> 2, wc = wid & 3;
    constexpr int NTN = NIN_PAD / 256;
    gemm256_stream((LAS unsigned char*)shm,
        [&](int i, const char*& A, const char*& B, unsigned (&va)[2][2], const GPiece& pc) __attribute__((always_inline)) {
            const int it = xcd_unit(blockIdx.x + i * gridDim.x, (NTOK / 256) * NTN);
            if (it < 0) return false;
            const int pm = it / NTN, pn = it % NTN;
            A = (const char*)xn;
            B = (const char*)(btin + (size_t)pn * 256 * DM);
#pragma unroll
            for (int h = 0; h < 2; ++h)
#pragma unroll
                for (int j = 0; j < 2; ++j) va[h][j] = (unsigned)((pm * 256 + h * 128 + pc.R[j]) * DM + pc.C[j]) * 2u;
            return true;
        },
        [&](int i, f32x4 (&acc)[2][2][4][2]) __attribute__((always_inline)) {
        const int it = xcd_unit(blockIdx.x + i * gridDim.x, (NTOK / 256) * NTN);
        const int pm = it / NTN, pn = it % NTN;
        int le = lane;
        asm volatile("" : "+v"(le));
        const int er = le & 15, eq = le >> 4;
        if (pn < 11) {
#pragma unroll
            for (int bj = 0; bj < 2; ++bj) {
                const int hg = pn * 4 + bj * 2 + (wc >> 1);
                const float sc = (hg < 8 || (hg >= 24 && hg < 32)) ? QSCALE : 1.0f;
                bf16_t* base = pt + ((size_t)hg * NTOK + pm * 256 + wr * 64) * 64 + (wc & 1) * 32 + 8 * eq;
#pragma unroll
                for (int ai = 0; ai < 2; ++ai)
#pragma unroll
                    for (int m = 0; m < 4; ++m) {
                        const f32x4 a0 = acc[ai][bj][m][0], a1 = acc[ai][bj][m][1];
                        u32x4 ov;
                        ov.x = pk_bf16(a0[0] * sc, a0[1] * sc);
                        ov.y = pk_bf16(a0[2] * sc, a0[3] * sc);
                        ov.z = pk_bf16(a1[0] * sc, a1[1] * sc);
                        ov.w = pk_bf16(a1[2] * sc, a1[3] * sc);
                        *(u32x4*)(base + (size_t)(ai * 128 + m * 16 + er) * 64) = ov;
                    }
                if (hg >= HG_MK && hg < HG_MK + 8) {
                    const int b = (pm * 256) / SEQ, nblk = ((pm * 256) % SEQ) >> 8, h = hg - HG_MK;
                    float* kb = kmean + (size_t)((b * 8 + h) * 32 + nblk) * 64 + (wc & 1) * 32 + 8 * eq;
#pragma unroll
                    for (int n = 0; n < 2; ++n) {
                        f32x4 s = acc[0][bj][0][n];
#pragma unroll
                        for (int m = 1; m < 4; ++m) s += acc[0][bj][m][n];
#pragma unroll
                        for (int m = 0; m < 4; ++m) s += acc[1][bj][m][n];
#pragma unroll
                        for (int o = 1; o < 16; o <<= 1) {
                            s[0] += __shfl_xor(s[0], o);
                            s[1] += __shfl_xor(s[1], o);
                            s[2] += __shfl_xor(s[2], o);
                            s[3] += __shfl_xor(s[3], o);
                        }
                        if (er == 0) {
                            float* d = kb + 4 * n;
                            unsafeAtomicAdd(d + 0, s[0]);
                            unsafeAtomicAdd(d + 1, s[1]);
                            unsafeAtomicAdd(d + 2, s[2]);
                            unsafeAtomicAdd(d + 3, s[3]);
                        }
                    }
                }
            }
        } else if (wc == 0) {
#pragma unroll
            for (int n = 0; n < 2; ++n) {
                const int gc = 8 * eq + 4 * n;
                if (gc < 24) {
#pragma unroll
                    for (int ai = 0; ai < 2; ++ai)
#pragma unroll
                        for (int m = 0; m < 4; ++m) {
                            const f32x4 a = acc[ai][0][m][n];
                            const int row = pm * 256 + ai * 128 + wr * 64 + m * 16 + er;
                            f32x4 sg;
                            sg[0] = 1.0f / (1.0f + __expf(-a[0]));
                            sg[1] = 1.0f / (1.0f + __expf(-a[1]));
                            sg[2] = 1.0f / (1.0f + __expf(-a[2]));
                            sg[3] = 1.0f / (1.0f + __expf(-a[3]));
                            *(f32x4*)(gates + (size_t)row * 24 + gc) = sg;
                        }
                }
            }
        }
    });
    __syncthreads();
}

__device__ __forceinline__ void f_outproj(const Params& p, unsigned char* shm) {
    unsigned char* wsb = (unsigned char*)p.ws;
    const bf16_t* mixb = (const bf16_t*)(wsb + WS_MIXB);
    const bf16_t* btout = (const bf16_t*)(wsb + WS_BTOUT);
    const int tid = threadIdx.x, wid = __builtin_amdgcn_readfirstlane(tid >> 6), lane = tid & 63, wr = wid >> 2, wc = wid & 3;
    gemm256_stream((LAS unsigned char*)shm,
        [&](int i, const char*& A, const char*& B, unsigned (&va)[2][2], const GPiece& pc) __attribute__((always_inline)) {
            const int it = xcd_unit(blockIdx.x + i * gridDim.x, (NTOK / 256) * 4);
            if (it < 0) return false;
            const int pm = it >> 2, pn = it & 3;
            A = (const char*)mixb;
            B = (const char*)(btout + (size_t)pn * 256 * DM);
#pragma unroll
            for (int h = 0; h < 2; ++h)
#pragma unroll
                for (int j = 0; j < 2; ++j) va[h][j] = (unsigned)((pm * 256 + h * 128 + pc.R[j]) * DM + pc.C[j]) * 2u;
            return true;
        },
        [&](int i, f32x4 (&acc)[2][2][4][2]) __attribute__((always_inline)) {
        const int it = xcd_unit(blockIdx.x + i * gridDim.x, (NTOK / 256) * 4);
        const int pm = it >> 2, pn = it & 3;
        int le = lane;
        asm volatile("" : "+v"(le));
        const int er = le & 15, eq = le >> 4;
#pragma unroll
        for (int ai = 0; ai < 2; ++ai)
#pragma unroll
            for (int m = 0; m < 4; ++m) {
                const size_t rowoff = (size_t)(pm * 256 + ai * 128 + wr * 64 + m * 16 + er) * DM;
#pragma unroll
                for (int bj = 0; bj < 2; ++bj)
#pragma unroll
                    for (int n = 0; n < 2; ++n) {
                        const size_t o = rowoff + pn * 256 + bj * 128 + wc * 32 + 8 * eq + 4 * n;
                        const f32x4 xv = *(const f32x4*)(p.x + o);
                        *(f32x4*)(p.out + o) = xv + acc[ai][bj][m][n];
                    }
            }
    });
    __syncthreads();
}

__device__ __forceinline__ float wave_max_fast(float x) {
    x = fmaxf(x, __int_as_float(__builtin_amdgcn_mov_dpp(__float_as_int(x), 0xB1, 0xF, 0xF, true)));
    x = fmaxf(x, __int_as_float(__builtin_amdgcn_mov_dpp(__float_as_int(x), 0x4E, 0xF, 0xF, true)));
    x = fmaxf(x, __int_as_float(__builtin_amdgcn_mov_dpp(__float_as_int(x), 0x141, 0xF, 0xF, true)));
    x = fmaxf(x, __int_as_float(__builtin_amdgcn_mov_dpp(__float_as_int(x), 0x140, 0xF, 0xF, true)));
    x = fmaxf(x, __shfl_xor(x, 16));
    x = fmaxf(x, __shfl_xor(x, 32));
    return x;
}
__device__ __forceinline__ void f_router(const Params& p, unsigned char* shm) {
    const int tid = threadIdx.x, lane = tid & 63, w = tid >> 6;
    unsigned char* wsb = (unsigned char*)p.ws;
    float* Wl = (float*)shm;
    int* hist = (int*)(shm + 147456);
    bf16_t* hb = (bf16_t*)(wsb + WS_H);
    int* sele = (int*)(wsb + WS_SELE);
    float* selw = (float*)(wsb + WS_SELW);
    int* selr = (int*)(wsb + WS_SELR);
    int* bcnt = (int*)(wsb + WS_BCNT);
    __syncthreads();
    for (int idx = tid; idx < 8192; idx += 512) {
        const int k = idx >> 3, e4 = idx & 7;
        const float4 v = ((const float4*)p.w_router)[idx];
        const int rho = ((k >> 8) * 4 + (k & 3)) * 64 + ((k >> 2) & 63);
        *(float4*)(Wl + rho * 36 + e4 * 4) = v;
    }
    const float bias = p.b_router[lane >> 1];
    const float4* g4 = (const float4*)p.ffn_g;
    float4 gv[4];
#pragma unroll
    for (int j = 0; j < 4; ++j) gv[j] = g4[lane + 64 * j];
    for (int c = blockIdx.x; c < NTOK / 128; c += gridDim.x) {
        __syncthreads();
        if (tid < 32) hist[tid] = 0;
        __syncthreads();
        float4 vn[4];
        {
            const float4* xr = (const float4*)(p.out + (size_t)(c * 128 + w * 16) * DM);
#pragma unroll
            for (int j = 0; j < 4; ++j) vn[j] = xr[lane + 64 * j];
        }
        for (int rr = 0; rr < 16; ++rr) {
            const int row = c * 128 + w * 16 + rr;
            float4 v[4];
#pragma unroll
            for (int j = 0; j < 4; ++j) v[j] = vn[j];
            if (rr + 1 < 16) {
                const float4* xr = (const float4*)(p.out + (size_t)(row + 1) * DM);
#pragma unroll
                for (int j = 0; j < 4; ++j) vn[j] = xr[lane + 64 * j];
            }
            float ss = 0.f;
#pragma unroll
            for (int j = 0; j < 4; ++j) ss += dot4(v[j], v[j]);
            ss = wave_sum(ss);
            const float r = 1.0f / sqrtf(ss * (1.0f / DM) + 1e-5f);
            u32x2* o = (u32x2*)(hb + (size_t)row * DM);
#pragma unroll
            for (int j = 0; j < 4; ++j) {
                v[j] = make_float4(v[j].x * r * gv[j].x, v[j].y * r * gv[j].y, v[j].z * r * gv[j].z, v[j].w * r * gv[j].w);
                u32x2 ov;
                ov.x = pk_bf16(v[j].x, v[j].y);
                ov.y = pk_bf16(v[j].z, v[j].w);
                o[lane + 64 * j] = ov;
            }
            float lg[32];
#pragma unroll
            for (int e = 0; e < 32; ++e) lg[e] = 0.f;
#pragma unroll
            for (int j = 0; j < 4; ++j) {
                const float hv[4] = {v[j].x, v[j].y, v[j].z, v[j].w};
#pragma unroll
                for (int cc = 0; cc < 4; ++cc) {
                    const float4* wr = (const float4*)(Wl + ((j * 4 + cc) * 64 + lane) * 36);
#pragma unroll
                    for (int e4 = 0; e4 < 8; ++e4) {
                        const float4 wv = wr[e4];
                        lg[e4 * 4 + 0] += hv[cc] * wv.x;
                        lg[e4 * 4 + 1] += hv[cc] * wv.y;
                        lg[e4 * 4 + 2] += hv[cc] * wv.z;
                        lg[e4 * 4 + 3] += hv[cc] * wv.w;
                    }
                }
            }
#define RS_STEP(N, OFF, BIT)                                                                                           \
            {                                                                                                          \
                const bool up_ = (lane >> (BIT)) & 1;                                                                  \
                _Pragma("unroll") for (int i_ = 0; i_ < (N); ++i_) {                                                     \
                    const float send_ = up_ ? lg[i_] : lg[(N) + i_];                                                   \
                    const float keep_ = up_ ? lg[(N) + i_] : lg[i_];                                                   \
                    lg[i_] = keep_ + __shfl_xor(send_, (OFF));                                                         \
                }                                                                                                      \
            }
            RS_STEP(16, 32, 5)
            RS_STEP(8, 16, 4)
            RS_STEP(4, 8, 3)
            RS_STEP(2, 4, 2)
            RS_STEP(1, 2, 1)
#undef RS_STEP
            float val = lg[0] + __shfl_xor(lg[0], 1) + bias;
            float tv[4];
            int ti[4];
#pragma unroll
            for (int s = 0; s < 4; ++s) {
                const float mx = wave_max_fast(val);
                const unsigned long long bal = __ballot(val == mx);
                const int ln = __ffsll((long long)bal) - 1;
                tv[s] = mx;
                ti[s] = ln >> 1;
                if ((lane >> 1) == (ln >> 1)) val = -INFINITY;
            }
            const float e1 = __expf(tv[1] - tv[0]), e2 = __expf(tv[2] - tv[0]), e3 = __expf(tv[3] - tv[0]);
            const float inv = 1.0f / (1.0f + e1 + e2 + e3);
            if (lane == 0) {
                const float wv[4] = {inv, e1 * inv, e2 * inv, e3 * inv};
#pragma unroll
                for (int s = 0; s < 4; ++s) {
                    sele[row * 4 + s] = ti[s];
                    selw[row * 4 + s] = wv[s];
                    selr[row * 4 + s] = atomicAdd(&hist[ti[s]], 1);
                }
            }
        }
        __syncthreads();
        if (tid < 32) bcnt[c * 32 + tid] = hist[tid];
    }
    __syncthreads();
}

__device__ __forceinline__ void f_fill(const Params& p, unsigned char* shm) {
    const int tid = threadIdx.x;
    unsigned char* wsb = (unsigned char*)p.ws;
    const int* sele = (const int*)(wsb + WS_SELE);
    const float* selw = (const float*)(wsb + WS_SELW);
    const int* selr = (const int*)(wsb + WS_SELR);
    int* selp = (int*)(wsb + WS_SELP);
    const int* bcnt = (const int*)(wsb + WS_BCNT);
    int* gcnt = (int*)(wsb + WS_GCNT);
    int* rtok = (int*)(wsb + WS_RTOK);
    float* rw = (float*)(wsb + WS_RW);
    int* pa = (int*)shm;
    int* pb = pa + 512;
    int* tot = pb + 512;
    int* base = tot + 32;
    int* pstart = base + 32;
    for (int c = blockIdx.x; c < NTOK / 128; c += gridDim.x) {
        __syncthreads();
        {
            const int e = tid & 31, part = tid >> 5;
            int sa = 0, sb = 0;
            for (int cc = part * 16; cc < part * 16 + 16; ++cc) {
                const int v = bcnt[cc * 32 + e];
                sa += v;
                sb += (cc < c) ? v : 0;
            }
            pa[part * 32 + e] = sa;
            pb[part * 32 + e] = sb;
        }
        __syncthreads();
        if (tid < 32) {
            int sa = 0, sb = 0;
            for (int q = 0; q < 16; ++q) { sa += pa[q * 32 + tid]; sb += pb[q * 32 + tid]; }
            tot[tid] = sa;
            base[tid] = sb;
        }
        __syncthreads();
        if (tid == 0) {
            int a = 0;
            for (int e = 0; e < NE; ++e) { pstart[e] = a; a += ((tot[e] + 255) >> 8) << 8; }
            pstart[NE] = a;
        }
        __syncthreads();
        {
            const int i = c * 512 + tid;
            const int e = sele[i];
            const int pos = pstart[e] + base[e] + selr[i];
            rtok[pos] = i >> 2;
            rw[pos] = selw[i];
            selp[i] = pos;
        }
        if (c == 0) {
            if (tid < 32) gcnt[tid] = tot[tid];
            for (int e = 0; e < NE; ++e) {
                const int r0 = pstart[e] + tot[e], r1 = pstart[e + 1];
                for (int r = r0 + tid; r < r1; r += 512) { rtok[r] = 0; rw[r] = 0.f; }
            }
        }
    }
    __syncthreads();
}

__device__ __forceinline__ void f_build_tiles(const Params& p, int* tb) {
    const int* gcnt = (const int*)((unsigned char*)p.ws + WS_GCNT);
    __syncthreads();
    if (threadIdx.x == 0) {
        int a = 0, t = 0;
        for (int e = 0; e < NE; ++e) {
            tb[e] = a;
            tb[40 + e] = t;
            const int nt = (gcnt[e] + 255) >> 8;
            a += nt << 8;
            t += nt;
        }
        tb[32] = a;
        tb[40 + 32] = t;
    }
    __syncthreads();
}

__device__ __forceinline__ void f_up(const Params& p, unsigned char* shm) {
    unsigned char* wsb = (unsigned char*)p.ws;
    int* tb = (int*)(shm + GEMM_LDS_BYTES);
    f_build_tiles(p, tb);
    const int T = tb[40 + 32];
    const bf16_t* hb = (const bf16_t*)(wsb + WS_H);
    const bf16_t* btup = (const bf16_t*)(wsb + WS_BTUP);
    bf16_t* act = (bf16_t*)(wsb + WS_ACT);
    const int* rtok = (const int*)(wsb + WS_RTOK);
    const int tid = threadIdx.x, wid = __builtin_amdgcn_readfirstlane(tid >> 6), lane = tid & 63, wr = wid >> 2, wc = wid & 3;
    gemm256_stream((LAS unsigned char*)shm,
        [&](int i, const char*& A, const char*& B, unsigned (&va)[2][2], const GPiece& pc) __attribute__((always_inline)) {
            const int it = xcd_unit(blockIdx.x + i * gridDim.x, T * 8);
            if (it < 0) return false;
            const int vt = it >> 3, pn = it & 7;
            int e = 0;
            while (tb[40 + e + 1] <= vt) ++e;
            const int rowbase = tb[e] + (vt - tb[40 + e]) * 256;
            A = (const char*)hb;
            B = (const char*)(btup + ((size_t)e * DFF2 + pn * 256) * DM);
#pragma unroll
            for (int h = 0; h < 2; ++h)
#pragma unroll
                for (int j = 0; j < 2; ++j) va[h][j] = (unsigned)(rtok[rowbase + h * 128 + pc.R[j]] * DM + pc.C[j]) * 2u;
            return true;
        },
        [&](int i, f32x4 (&acc)[2][2][4][2]) __attribute__((always_inline)) {
        const int it = xcd_unit(blockIdx.x + i * gridDim.x, T * 8);
        const int vt = it >> 3, pn = it & 7;
        int e = 0;
        while (tb[40 + e + 1] <= vt) ++e;
        const int rowbase = tb[e] + (vt - tb[40 + e]) * 256;
        int le = lane;
        asm volatile("" : "+v"(le));
        const int er = le & 15, eq = le >> 4;
        const float* bias = p.b_up + (size_t)e * DFF2;
        const int a0 = pn * 128 + wc * 32 + 8 * eq;
        float bg[8], bu[8];
        {
            const float4 q0 = *(const float4*)(bias + 2 * a0), q1 = *(const float4*)(bias + 2 * a0 + 4), q2 = *(const float4*)(bias + 2 * a0 + 8),
                         q3 = *(const float4*)(bias + 2 * a0 + 12);
            bg[0] = q0.x; bu[0] = q0.y; bg[1] = q0.z; bu[1] = q0.w; bg[2] = q1.x; bu[2] = q1.y; bg[3] = q1.z; bu[3] = q1.w;
            bg[4] = q2.x; bu[4] = q2.y; bg[5] = q2.z; bu[5] = q2.w; bg[6] = q3.x; bu[6] = q3.y; bg[7] = q3.z; bu[7] = q3.w;
        }
#pragma unroll
        for (int ai = 0; ai < 2; ++ai)
#pragma unroll
            for (int mm = 0; mm < 4; ++mm) {
                const int row = rowbase + ai * 128 + wr * 64 + mm * 16 + er;
                const f32x4 g0 = acc[ai][0][mm][0], g1 = acc[ai][0][mm][1], u0 = acc[ai][1][mm][0], u1 = acc[ai][1][mm][1];
                u32x4 ov;
                ov.x = pk_bf16(swiglu(g0[0] + bg[0], u0[0] + bu[0]), swiglu(g0[1] + bg[1], u0[1] + bu[1]));
                ov.y = pk_bf16(swiglu(g0[2] + bg[2], u0[2] + bu[2]), swiglu(g0[3] + bg[3], u0[3] + bu[3]));
                ov.z = pk_bf16(swiglu(g1[0] + bg[4], u1[0] + bu[4]), swiglu(g1[1] + bg[5], u1[1] + bu[5]));
                ov.w = pk_bf16(swiglu(g1[2] + bg[6], u1[2] + bu[6]), swiglu(g1[3] + bg[7], u1[3] + bu[7]));
                *(u32x4*)(act + (size_t)row * DM + a0) = ov;
            }
    });
    __syncthreads();
}

__device__ __forceinline__ void f_down(const Params& p, unsigned char* shm) {
    unsigned char* wsb = (unsigned char*)p.ws;
    int* tb = (int*)(shm + GEMM_LDS_BYTES);
    f_build_tiles(p, tb);
    const int T = tb[40 + 32];
    const bf16_t* act = (const bf16_t*)(wsb + WS_ACT);
    const bf16_t* btdn = (const bf16_t*)(wsb + WS_BTDN);
    bf16_t* yb = (bf16_t*)(wsb + WS_Y);
    const float* rw = (const float*)(wsb + WS_RW);
    const int tid = threadIdx.x, wid = __builtin_amdgcn_readfirstlane(tid >> 6), lane = tid & 63, wr = wid >> 2, wc = wid & 3;
    gemm256_stream((LAS unsigned char*)shm,
        [&](int i, const char*& A, const char*& B, unsigned (&va)[2][2], const GPiece& pc) __attribute__((always_inline)) {
            const int it = xcd_unit(blockIdx.x + i * gridDim.x, T * 4);
            if (it < 0) return false;
            const int vt = it >> 2, pn = it & 3;
            int e = 0;
            while (tb[40 + e + 1] <= vt) ++e;
            const int rowbase = tb[e] + (vt - tb[40 + e]) * 256;
            A = (const char*)(act + (size_t)rowbase * DM);
            B = (const char*)(btdn + ((size_t)e * DM + pn * 256) * DM);
#pragma unroll
            for (int h = 0; h < 2; ++h)
#pragma unroll
                for (int j = 0; j < 2; ++j) va[h][j] = (unsigned)((h * 128 + pc.R[j]) * DM + pc.C[j]) * 2u;
            return true;
        },
        [&](int i, f32x4 (&acc)[2][2][4][2]) __attribute__((always_inline)) {
        const int it = xcd_unit(blockIdx.x + i * gridDim.x, T * 4);
        const int vt = it >> 2, pn = it & 3;
        int e = 0;
        while (tb[40 + e + 1] <= vt) ++e;
        const int rowbase = tb[e] + (vt - tb[40 + e]) * 256;
        int le = lane;
        asm volatile("" : "+v"(le));
        const int er = le & 15, eq = le >> 4;
        const float* bias = p.b_down + (size_t)e * DM;
#pragma unroll
        for (int bj = 0; bj < 2; ++bj) {
            const int col = pn * 256 + bj * 128 + wc * 32 + 8 * eq;
            const float4 b0 = *(const float4*)(bias + col), b1 = *(const float4*)(bias + col + 4);
#pragma unroll
            for (int ai = 0; ai < 2; ++ai)
#pragma unroll
                for (int mm = 0; mm < 4; ++mm) {
                    const int row = rowbase + ai * 128 + wr * 64 + mm * 16 + er;
                    const float wgt = rw[row];
                    const f32x4 x0 = acc[ai][bj][mm][0], x1 = acc[ai][bj][mm][1];
                    u32x4 ov;
                    ov.x = pk_bf16((x0[0] + b0.x) * wgt, (x0[1] + b0.y) * wgt);
                    ov.y = pk_bf16((x0[2] + b0.z) * wgt, (x0[3] + b0.w) * wgt);
                    ov.z = pk_bf16((x1[0] + b1.x) * wgt, (x1[1] + b1.y) * wgt);
                    ov.w = pk_bf16((x1[2] + b1.z) * wgt, (x1[3] + b1.w) * wgt);
                    *(u32x4*)(yb + (size_t)row * DM + col) = ov;
                }
        }
    });
    __syncthreads();
}


__device__ __forceinline__ void f_final(const Params& p) {
    const int lane = threadIdx.x & 63, w = threadIdx.x >> 6;
    unsigned char* wsb = (unsigned char*)p.ws;
    const bf16_t* yb = (const bf16_t*)(wsb + WS_Y);
    const int* selp = (const int*)(wsb + WS_SELP);
    const float4* g4 = (const float4*)p.final_g;
    for (int row0 = blockIdx.x * 8 + w; row0 < NTOK / 2; row0 += gridDim.x * 8) {
        float4 v[2][4];
        u32x2 yv[2][4][4];
#pragma unroll
        for (int q = 0; q < 2; ++q) {
            const int row = row0 + q * (NTOK / 2);
            const float4* xr = (const float4*)(p.out + (size_t)row * DM);
            const int4 sp = *(const int4*)(selp + row * 4);
            const int pos[4] = {sp.x, sp.y, sp.z, sp.w};
#pragma unroll
            for (int j = 0; j < 4; ++j) v[q][j] = xr[lane + 64 * j];
#pragma unroll
            for (int k = 0; k < 4; ++k) {
                const u32x2* yr = (const u32x2*)(yb + (size_t)pos[k] * DM);
#pragma unroll
                for (int j = 0; j < 4; ++j) yv[q][k][j] = yr[lane + 64 * j];
            }
        }
#pragma unroll
        for (int q = 0; q < 2; ++q) {
            const int row = row0 + q * (NTOK / 2);
#pragma unroll
            for (int k = 0; k < 4; ++k)
#pragma unroll
                for (int j = 0; j < 4; ++j) {
                    v[q][j].x += bf_lo(yv[q][k][j].x);
                    v[q][j].y += bf_hi(yv[q][k][j].x);
                    v[q][j].z += bf_lo(yv[q][k][j].y);
                    v[q][j].w += bf_hi(yv[q][k][j].y);
                }
            float ss = 0.f;
#pragma unroll
            for (int j = 0; j < 4; ++j) ss += dot4(v[q][j], v[q][j]);
            ss = wave_sum(ss);
            const float r = 1.0f / sqrtf(ss * (1.0f / DM) + 1e-5f);
            float4* xo = (float4*)(p.out + (size_t)row * DM);
#pragma unroll
            for (int j = 0; j < 4; ++j) {
                const float4 g = g4[lane + 64 * j];
                xo[lane + 64 * j] = make_float4(v[q][j].x * r * g.x, v[q][j].y * r * g.y, v[q][j].z * r * g.z, v[q][j].w * r * g.w);
            }
        }
    }
}
#define XB_TMO      128
#define XB_XCNT(j)  (256  + 64 * (j))
#define XB_XSUB(j)  (1280 + 64 * (j))
#define XB_XGEN(j)  (2304 + 64 * (j))
#define XB_TOP      3328
#define XB_TOPGEN   3392
#define XCD_BAR_WORDS 3456
#define XB_SPIN_CAP (1u << 18)

__device__ __forceinline__ unsigned xb_ld(unsigned* p)              { return __hip_atomic_load(p, __ATOMIC_RELAXED, __HIP_MEMORY_SCOPE_AGENT); }
__device__ __forceinline__ unsigned xb_add(unsigned* p, unsigned v) { return __hip_atomic_fetch_add(p, v, __ATOMIC_RELAXED, __HIP_MEMORY_SCOPE_AGENT); }
__device__ __forceinline__ unsigned xb_xcc_id() { return (unsigned)__builtin_amdgcn_s_getreg((3 << 11) | 20) & 0xFu; }
#define XB_SPIN(cond, bar) do { unsigned _sp = 0; while (cond) { __builtin_amdgcn_s_sleep(1); \
    if ((++_sp & 255u) == 0u) { if (xb_ld(&(bar)[XB_TMO])) break; if (_sp > XB_SPIN_CAP) { atomicAdd(&(bar)[XB_TMO], 1u); break; } } } } while (0)

struct XcdBarrier {
    unsigned* bar; unsigned x;
    volatile LAS unsigned* st;
};

__device__ __forceinline__ XcdBarrier xcd_barrier_post(unsigned* bar, volatile LAS unsigned* st) {
    XcdBarrier b; b.bar = bar; b.x = xb_xcc_id(); b.st = st;
    if (threadIdx.x == 0) (void)xb_add(&bar[XB_XCNT(b.x)], 1u);
    return b;
}
__device__ __forceinline__ void xcd_barrier_complete(unsigned* bar, unsigned x, unsigned& nloc, unsigned& nx) {
    const unsigned G = gridDim.x * gridDim.y * gridDim.z;
    unsigned sum, cnt, mine, sp = 0u;
    for (;;) {
        sum = 0u; cnt = 0u; mine = 0u;
#pragma unroll
        for (unsigned j = 0; j < 16; ++j) { const unsigned c = xb_ld(&bar[XB_XCNT(j)]); sum += c; cnt += (c > 0u) ? 1u : 0u; mine = (j == x) ? c : mine; }
        if (sum == G) break;
        __builtin_amdgcn_s_sleep(1);
        if ((++sp & 255u) == 0u) { if (xb_ld(&bar[XB_TMO])) break; if (sp > XB_SPIN_CAP) { atomicAdd(&bar[XB_TMO], 1u); break; } }
    }
    nloc = mine > 0u ? mine : 1u; nx = cnt > 0u ? cnt : 1u;
}

__device__ __forceinline__ void xcd_barrier(const XcdBarrier& b) {
    asm volatile("s_waitcnt vmcnt(0)" ::: "memory");
    __syncthreads();
    if (threadIdx.x == 0) {
        unsigned* bar = b.bar;
        __builtin_amdgcn_s_waitcnt(0);
        unsigned nloc = b.st[0], nx = b.st[1];
        if (nloc == 0u) { xcd_barrier_complete(bar, b.x, nloc, nx); b.st[0] = nloc; b.st[1] = nx; }
        const unsigned old = xb_add(&bar[XB_XSUB(b.x)], 1u);
        const unsigned gen = old / nloc;
        if (old + 1u == (gen + 1u) * nloc) {
            __builtin_amdgcn_fence(__ATOMIC_RELEASE, "agent");
            asm volatile("s_waitcnt vmcnt(0)" ::: "memory");
            const unsigned og = xb_add(&bar[XB_TOP], 1u);
            const unsigned tg = og / nx;
            if (og + 1u == (tg + 1u) * nx) xb_add(&bar[XB_TOPGEN], 1u);
            else XB_SPIN(xb_ld(&bar[XB_TOPGEN]) == tg, bar);
            __builtin_amdgcn_fence(__ATOMIC_ACQUIRE, "agent");
            xb_add(&bar[XB_XGEN(b.x)], 1u);
            asm volatile("s_waitcnt vmcnt(0)" ::: "memory");
        } else {
            XB_SPIN(xb_ld(&bar[XB_XGEN(b.x)]) == gen, bar);
            __builtin_amdgcn_fence(__ATOMIC_ACQUIRE, "agent");
            asm volatile("s_waitcnt vmcnt(0)" ::: "memory");
        }
    }
    __syncthreads();
}


constexpr int NFPHASE = 11;
__global__ void __launch_bounds__(512) fast_kernel(Params p) {
    extern __shared__ __attribute__((aligned(16))) unsigned char shm[];
    cg::grid_group grid = cg::this_grid();
    const int lo = p.ph_lo, hi = p.ph_hi;
    if (lo < -1) grid.sync();
    XcdBarrier bar;
    if (hi - lo > 1) {
        volatile LAS unsigned* st = (volatile LAS unsigned*)((LAS unsigned char*)shm + (FAST_LDS_BYTES - 16));
        if (threadIdx.x < 4) st[threadIdx.x] = 0u;
        __syncthreads();
        bar = xcd_barrier_post((unsigned*)((unsigned char*)p.ws + WS_BAR), st);
    }
#define F_IN(k) (lo <= (k) && (k) < hi)
#define F_SYNC(k) do { if (F_IN(k) && F_IN((k) + 1)) xcd_barrier(bar); } while (0)
    if (F_IN(0)) f_prologue(p, shm);
    F_SYNC(0);
    if (F_IN(1)) f_inproj(p, shm);
    F_SYNC(1);
    if (F_IN(2)) { f_cmp(p, shm); f_moba_gate(p, shm); }
    F_SYNC(2);
    if (F_IN(3)) f_attn(p, shm);
    F_SYNC(3);
    if (F_IN(4)) f_moba_merge(p);
    F_SYNC(4);
    if (F_IN(5)) f_outproj(p, shm);
    F_SYNC(5);
    if (F_IN(6)) f_router(p, shm);
    F_SYNC(6);
    if (F_IN(7)) f_fill(p, shm);
    F_SYNC(7);
    if (F_IN(8)) f_up(p, shm);
    F_SYNC(8);
    if (F_IN(9)) f_down(p, shm);
    F_SYNC(9);
    if (F_IN(10)) f_final(p);
}

#ifndef MULTI_LAUNCH
#define MULTI_LAUNCH 0
#endif

extern "C" void kernel_launch(void* const* d_in, const int* in_sizes, int n_in, void* d_out, int out_size, void* d_ws,
                              size_t ws_size, hipStream_t stream) {
    static int grid = 0;
    if (!grid) {
        int dev = 0, cus = 0, per_cu = 0;
        (void)hipGetDevice(&dev);
        (void)hipDeviceGetAttribute(&cus, hipDeviceAttributeMultiprocessorCount, dev);
        (void)hipFuncSetAttribute((const void*)fast_kernel, hipFuncAttributeMaxDynamicSharedMemorySize, FAST_LDS_BYTES);
        (void)hipOccupancyMaxActiveBlocksPerMultiprocessor(&per_cu, fast_kernel, 512, FAST_LDS_BYTES);
        if (per_cu < 1) fprintf(stderr, "kernel_launch: occupancy query reports %d blocks per CU\n", per_cu);
        grid = cus;
        if (ws_size < WS_END) fprintf(stderr, "kernel_launch: workspace too small: %zu < %zu\n", ws_size, (size_t)WS_END);
    }
    Params p{};
    p.x = (const float*)d_in[0];
    p.attn_g = (const float*)d_in[1];
    p.w_in = (const float*)d_in[2];
    p.pe_k = (const float*)d_in[3];
    p.pe_v = (const float*)d_in[4];
    p.w1k = (const float*)d_in[5];
    p.w2k = (const float*)d_in[6];
    p.w1v = (const float*)d_in[7];
    p.w2v = (const float*)d_in[8];
    p.w_out = (const float*)d_in[9];
    p.ffn_g = (const float*)d_in[10];
    p.w_router = (const float*)d_in[11];
    p.b_router = (const float*)d_in[12];
    p.w_up = (const float*)d_in[13];
    p.b_up = (const float*)d_in[14];
    p.w_down = (const float*)d_in[15];
    p.b_down = (const float*)d_in[16];
    p.final_g = (const float*)d_in[17];
    p.out = (float*)d_out;
    p.ws = (float*)d_ws;
#if MULTI_LAUNCH
#ifndef PROBE_DUP_MASK
#define PROBE_DUP_MASK 0
#endif
    for (int ph = 0; ph < NFPHASE; ++ph) {
        const int reps = ((PROBE_DUP_MASK >> ph) & 1) ? 2 : 1;
        for (int r = 0; r < reps; ++r) {
            p.ph_lo = ph;
            p.ph_hi = ph + 1;
            hipLaunchKernelGGL(fast_kernel, dim3(grid), dim3(512), FAST_LDS_BYTES, stream, p);
        }

    }
#else
    p.ph_lo = 0;
    p.ph_hi = NFPHASE;
    (void)hipMemsetAsync((unsigned char*)d_ws + WS_BAR, 0, 16384, stream);
    void* args[] = {&p};
    hipError_t e = hipLaunchCooperativeKernel((void*)fast_kernel, dim3(grid), dim3(512), args, FAST_LDS_BYTES, stream);
    if (e != hipSuccess) fprintf(stderr, "cooperative launch failed: %s (grid %d)\n", hipGetErrorString(e), grid);
#endif
}
```

```cpp
#include <hip/hip_runtime.h>
#include <hip/hip_cooperative_groups.h>
#include <cstdio>
#include <cstdint>
namespace cg = cooperative_groups;

constexpr int NB = 4, SEQ = 8192, DM = 1024, NTOK = NB * SEQ;
constexpr int INC = 2840;
constexpr int NCMP = 511, NCMPP = 512;
constexpr int NE = 32, TOPK = 4, NK = NTOK * TOPK;
constexpr int DFF2 = 2048;
constexpr int NIN_PAD = 3072;
constexpr int PMAX = 139264;
constexpr float LOG2E = 1.4426950408889634f;
constexpr float QSCALE = 0.125f * LOG2E;
constexpr int HG_MQ = 0, HG_MK = 8, HG_MV = 16, HG_NQ = 24, HG_KC = 32, HG_VC = 34, HG_KS = 36, HG_VS = 38, HG_KW = 40,
              HG_VW = 42, NHG = 44;

constexpr size_t WS_BTUP  = 0;
constexpr size_t WS_BTDN  = WS_BTUP + (size_t)NE * DFF2 * DM * 2;
constexpr size_t WS_BTOUT = WS_BTDN + (size_t)NE * DM * DM * 2;
constexpr size_t WS_BTIN  = WS_BTOUT + (size_t)DM * DM * 2;
constexpr size_t WS_XN    = WS_BTIN + (size_t)NIN_PAD * DM * 2;
constexpr size_t WS_H     = WS_XN;
constexpr size_t WS_PT    = WS_XN + (size_t)NTOK * DM * 2;
constexpr size_t WS_GATES = WS_PT + (size_t)NHG * NTOK * 64 * 2;
constexpr size_t WS_KMEAN = WS_GATES + (size_t)NTOK * 24 * 4;
constexpr size_t WS_KCMP  = WS_KMEAN + 65536 * 4;
constexpr size_t WS_VCMP  = WS_KCMP + 262144 * 2;
constexpr size_t WS_MIXB  = WS_VCMP + 262144 * 2;
constexpr size_t WS_ACT   = WS_PT;
constexpr size_t WS_Y     = WS_ACT + (size_t)PMAX * DM * 2;
static_assert(WS_MIXB + (size_t)NTOK * DM * 2 <= WS_Y, "act overlay");
constexpr size_t WS_PART  = WS_Y;
constexpr size_t WS_MLIST = WS_PART + (size_t)NTOK * 8 * 544;
constexpr size_t WS_MCNT  = WS_MLIST + (size_t)1024 * 8192 * 2;
static_assert(WS_MCNT + 4096 <= WS_Y + (size_t)PMAX * DM * 2, "MoBA scratch overlays y");
constexpr size_t WS_SELE  = WS_Y + (size_t)PMAX * DM * 2;
constexpr size_t WS_SELW  = WS_SELE + (size_t)NK * 4;
constexpr size_t WS_SELR  = WS_SELW + (size_t)NK * 4;
constexpr size_t WS_SELP  = WS_SELR + (size_t)NK * 4;
constexpr size_t WS_BCNT  = WS_SELP + (size_t)NK * 4;
constexpr size_t WS_GCNT  = WS_BCNT + 256 * 32 * 4;
constexpr size_t WS_RTOK  = WS_GCNT + 256;
constexpr size_t WS_RW    = WS_RTOK + (size_t)PMAX * 4;
constexpr size_t WS_C1    = WS_RW + (size_t)PMAX * 4;
constexpr size_t WS_W1T   = WS_C1 + 512;
constexpr size_t WS_W2T   = WS_W1T + 2 * 64 * 2048 * 2;
constexpr size_t WS_BAR   = WS_W2T + 2 * 64 * 64 * 2;
constexpr size_t WS_END   = WS_BAR + 16384;

struct Params {
    const float *x, *attn_g, *w_in, *pe_k, *pe_v, *w1k, *w2k, *w1v, *w2v, *w_out, *ffn_g, *w_router, *b_router,
        *w_up, *b_up, *w_down, *b_down, *final_g;
    float* out;
    float* ws;
    int ph_lo, ph_hi;
};

typedef unsigned short bf16_t;
typedef short bf16x8 __attribute__((ext_vector_type(8)));
typedef float f32x4 __attribute__((ext_vector_type(4)));
typedef float f32x16 __attribute__((ext_vector_type(16)));
typedef unsigned u32x4 __attribute__((ext_vector_type(4)));
typedef unsigned u32x2 __attribute__((ext_vector_type(2)));

typedef float f32x2 __attribute__((ext_vector_type(2)));
typedef __bf16 bf16x2v __attribute__((ext_vector_type(2)));
__device__ __forceinline__ unsigned pk_bf16(float lo, float hi) {
    const f32x2 f = {lo, hi};
    return __builtin_bit_cast(unsigned, __builtin_convertvector(f, bf16x2v));
}
__device__ __forceinline__ float bf_lo(unsigned u) { return __uint_as_float(u << 16); }
__device__ __forceinline__ float bf_hi(unsigned u) { return __uint_as_float(u & 0xffff0000u); }
__device__ __forceinline__ float bf2f(bf16_t b) { return __uint_as_float((unsigned)b << 16); }

__device__ __forceinline__ float wave_sum(float v) {
#pragma unroll
    for (int o = 32; o > 0; o >>= 1) v += __shfl_xor(v, o);
    return v;
}
__device__ __forceinline__ float wave_max(float v) {
#pragma unroll
    for (int o = 32; o > 0; o >>= 1) v = fmaxf(v, __shfl_xor(v, o));
    return v;
}
__device__ __forceinline__ int wave_min_i(int v) {
#pragma unroll
    for (int o = 32; o > 0; o >>= 1) v = min(v, __shfl_xor(v, o));
    return v;
}
__device__ __forceinline__ float dot4(float4 a, float4 b) { return a.x * b.x + a.y * b.y + a.z * b.z + a.w * b.w; }

__device__ __forceinline__ float gelu_tanh(float x) {
    return 0.5f * x * (1.0f + tanhf(0.7978845608028654f * (x + 0.044715f * x * x * x)));
}
__device__ __forceinline__ float swiglu(float g, float u) {
    g = fminf(g, 7.0f);
    u = fminf(fmaxf(u, -7.0f), 7.0f);
    return g * (1.0f / (1.0f + __expf(-1.702f * g))) * (u + 1.0f);
}


constexpr int G_BM = 256, G_BK = 64, G_HALF = 128, G_HT = G_HALF * G_BK;
constexpr int GEMM_LDS_BYTES = 8 * G_HT * 2;
constexpr int FAST_LDS_BYTES = 155648;
__device__ __forceinline__ int lds_byte(int r, int c) {
    const int st = (r >> 4) * 2 + (c >> 5), rr = r & 15, cc = c & 31, ob = rr * 64 + cc * 2;
    return st * 1024 + (ob ^ (((ob >> 9) & 1) << 5));
}
__device__ __forceinline__ void stage_rc(int b, int& R, int& C) {
    const int st = b / 1024, sb = b % 1024, swz = sb ^ (((sb >> 9) & 1) << 5);
    R = (st >> 1) * 16 + swz / 64;
    C = (st & 1) * 32 + (swz % 64) / 2;
}

#define LAS __attribute__((address_space(3)))
template <class ARow>
__device__ __forceinline__ void gemm256_tile(LAS unsigned char* lds, const char* __restrict__ Abase, ARow arow,
                                             const char* __restrict__ Bbase, int K, f32x4 (&acc)[2][2][4][2]) {
    constexpr int HTB = G_HT * 2;
#define SA(b, h) (((b) * 2 + (h)) * HTB)
#define SB(b, h) ((4 + (b) * 2 + (h)) * HTB)
#define STAGE_A(b, h, kt)                                                                                              \
    do {                                                                                                               \
        _Pragma("unroll") for (int _i = 0; _i < 2; ++_i) __builtin_amdgcn_global_load_lds(                              \
            (const unsigned*)(Abase + (size_t)(kt) * (G_BK * 2) + voffA[h][_i]),                                       \
            (LAS unsigned*)(lds + SA(b, h) + ldsw + _i * 8192), 16, 0, 0);                                              \
    } while (0)
#define STAGE_B(b, h, kt)                                                                                              \
    do {                                                                                                               \
        _Pragma("unroll") for (int _i = 0; _i < 2; ++_i) __builtin_amdgcn_global_load_lds(                              \
            (const unsigned*)(Bbase + (size_t)(h) * hstep + (size_t)(kt) * (G_BK * 2) + voffB[_i]),                    \
            (LAS unsigned*)(lds + SB(b, h) + ldsw + _i * 8192), 16, 0, 0);                                              \
    } while (0)
#define LDA(dst, b, h)                                                                                                 \
    do {                                                                                                               \
        _Pragma("unroll") for (int m = 0; m < 4; ++m) _Pragma("unroll") for (int k = 0; k < 2; ++k) dst[m][k] =         \
            *(const LAS bf16x8*)(lds + SA(b, h) + aoff + m * 2048 + k * 1024);                                          \
    } while (0)
#define LDB(dst, b, h)                                                                                                 \
    do {                                                                                                               \
        _Pragma("unroll") for (int n = 0; n < 2; ++n) _Pragma("unroll") for (int k = 0; k < 2; ++k) dst[n][k] =         \
            *(const LAS bf16x8*)(lds + SB(b, h) + boff + n * 2048 + k * 1024);                                          \
    } while (0)
#define MMA(ai, bj, Af, Bf)                                                                                            \
    do {                                                                                                               \
        __builtin_amdgcn_s_setprio(1);                                                                                 \
        _Pragma("unroll") for (int m = 0; m < 4; ++m) _Pragma("unroll") for (int n = 0; n < 2; ++n)                     \
            _Pragma("unroll") for (int k = 0; k < 2; ++k) acc[ai][bj][m][n] =                                           \
                __builtin_amdgcn_mfma_f32_16x16x32_bf16(Bf[n][k], Af[m][k], acc[ai][bj][m][n], 0, 0, 0);               \
        __builtin_amdgcn_s_setprio(0);                                                                                 \
    } while (0)
#define WAIT_V(n) asm volatile("s_waitcnt vmcnt(" #n ")" ::: "memory")
#define WAIT_L(n) asm volatile("s_waitcnt lgkmcnt(" #n ")" ::: "memory")
#define BAR __builtin_amdgcn_s_barrier()
#define SCHED __builtin_amdgcn_sched_barrier(0)
    const int tid = threadIdx.x, wid = __builtin_amdgcn_readfirstlane(tid >> 6), lane = tid & 63, wr = wid >> 2, wc = wid & 3,
              fr = lane & 15, fq = lane >> 4;
    unsigned voffA[2][2], voffB[2];
#pragma unroll
    for (int i = 0; i < 2; ++i) {
        int R, C;
        stage_rc(tid * 16 + i * 8192, R, C);
        voffB[i] = (unsigned)(R * K + C) * 2u;
#pragma unroll
        for (int h = 0; h < 2; ++h) voffA[h][i] = (unsigned)arow(h * G_HALF + R) + (unsigned)C * 2u;
    }
    const size_t hstep = (size_t)G_HALF * K * 2;
    const unsigned ldsw = (unsigned)wid * 1024u;
    const int aoff = lds_byte(wr * 64 + fr, fq * 8), boff = lds_byte(wc * 32 + fr, fq * 8);
#pragma unroll
    for (int ai = 0; ai < 2; ++ai)
#pragma unroll
        for (int bj = 0; bj < 2; ++bj)
#pragma unroll
            for (int m = 0; m < 4; ++m)
#pragma unroll
                for (int n = 0; n < 2; ++n) acc[ai][bj][m][n] = (f32x4){0.f, 0.f, 0.f, 0.f};
    bf16x8 At[4][2], B0[2][2], B1[2][2];
    const int nt = K / G_BK;
    STAGE_B(0, 0, 0); STAGE_A(0, 0, 0);
    STAGE_B(0, 1, 0); STAGE_A(0, 1, 0);
    if (wr == 1) BAR;
    WAIT_V(4); BAR;
    STAGE_B(1, 0, 1); STAGE_A(1, 0, 1); STAGE_B(1, 1, 1);
    WAIT_V(6); BAR;
    for (int t = 0; t < nt - 2; t += 2) {
        LDB(B0, 0, 0); SCHED; LDA(At, 0, 0); STAGE_A(1, 1, t + 1);
        WAIT_L(8); BAR; WAIT_L(0); MMA(0, 0, At, B0); BAR; SCHED;
        LDB(B1, 0, 1); STAGE_B(0, 0, t + 2);
        BAR; WAIT_L(0); MMA(0, 1, At, B1); BAR;
        LDA(At, 0, 1); STAGE_A(0, 0, t + 2);
        BAR; WAIT_L(0); MMA(1, 0, At, B0); BAR; SCHED;
        STAGE_B(0, 1, t + 2);
        WAIT_V(6); BAR; MMA(1, 1, At, B1); BAR;
        LDB(B0, 1, 0); SCHED; LDA(At, 1, 0); STAGE_A(0, 1, t + 2);
        WAIT_L(8); BAR; WAIT_L(0); MMA(0, 0, At, B0); BAR; SCHED;
        LDB(B1, 1, 1); STAGE_B(1, 0, t + 3);
        BAR; WAIT_L(0); MMA(0, 1, At, B1); BAR;
        LDA(At, 1, 1); STAGE_A(1, 0, t + 3);
        BAR; WAIT_L(0); MMA(1, 0, At, B0); BAR; SCHED;
        STAGE_B(1, 1, t + 3);
        WAIT_V(6); BAR; MMA(1, 1, At, B1); BAR;
    }
    {
        LDB(B0, 0, 0); LDA(At, 0, 0); STAGE_A(1, 1, nt - 1);
        BAR; WAIT_L(0); MMA(0, 0, At, B0); BAR;
        LDB(B1, 0, 1); BAR; WAIT_L(0); MMA(0, 1, At, B1); BAR;
        LDA(At, 0, 1); WAIT_V(4); BAR; WAIT_L(0); MMA(1, 0, At, B0); MMA(1, 1, At, B1); BAR;
    }
    {
        LDB(B0, 1, 0); LDA(At, 1, 0); WAIT_V(2); BAR; WAIT_L(0); MMA(0, 0, At, B0); BAR;
        LDB(B1, 1, 1); WAIT_V(0); BAR; WAIT_L(0); MMA(0, 1, At, B1); BAR;
        LDA(At, 1, 1); BAR; WAIT_L(0); MMA(1, 0, At, B0); MMA(1, 1, At, B1); BAR;
    }
    if (wr == 0) BAR;
#undef SA
#undef SB
#undef STAGE_A
#undef STAGE_B
#undef LDA
#undef LDB
#undef MMA
}

struct GPiece { int R[2], C[2]; };
template <bool ALIGN_EPI = true, class UnitFn, class Epi>
__device__ __forceinline__ void gemm256_stream(LAS unsigned char* lds, UnitFn unit, Epi epi) {
    constexpr int K = 1024, nt = K / G_BK;
    constexpr int HTB = G_HT * 2;
#define SA(b, h) (((b) * 2 + (h)) * HTB)
#define SB(b, h) ((4 + (b) * 2 + (h)) * HTB)
#define STG(bufoff, gbase, voff)                                                                                       \
    do {                                                                                                               \
        _Pragma("unroll") for (int _i = 0; _i < 2; ++_i) __builtin_amdgcn_global_load_lds(                              \
            (const unsigned*)((gbase) + (voff)[_i]), (LAS unsigned*)(lds + (bufoff) + ldsw + _i * 8192), 16, 0, 0);     \
    } while (0)
#define LDA(dst, b, h)                                                                                                 \
    do {                                                                                                               \
        _Pragma("unroll") for (int m = 0; m < 4; ++m) _Pragma("unroll") for (int k = 0; k < 2; ++k) dst[m][k] =         \
            *(const LAS bf16x8*)(lds + SA(b, h) + aoff + m * 2048 + k * 1024);                                          \
    } while (0)
#define LDB(dst, b, h)                                                                                                 \
    do {                                                                                                               \
        _Pragma("unroll") for (int n = 0; n < 2; ++n) _Pragma("unroll") for (int k = 0; k < 2; ++k) dst[n][k] =         \
            *(const LAS bf16x8*)(lds + SB(b, h) + boff + n * 2048 + k * 1024);                                          \
    } while (0)
#define MMA(ai, bj, Af, Bf)                                                                                            \
    do {                                                                                                               \
        __builtin_amdgcn_s_setprio(1);                                                                                 \
        _Pragma("unroll") for (int m = 0; m < 4; ++m) _Pragma("unroll") for (int n = 0; n < 2; ++n)                     \
            _Pragma("unroll") for (int k = 0; k < 2; ++k) acc[ai][bj][m][n] =                                           \
                __builtin_amdgcn_mfma_f32_16x16x32_bf16(Bf[n][k], Af[m][k], acc[ai][bj][m][n], 0, 0, 0);               \
        __builtin_amdgcn_s_setprio(0);                                                                                 \
    } while (0)
    const int tid = threadIdx.x, wid = __builtin_amdgcn_readfirstlane(tid >> 6), lane = tid & 63, wr = wid >> 2, wc = wid & 3,
              fr = lane & 15, fq = lane >> 4;
    GPiece pc;
    unsigned voffB[2];
#pragma unroll
    for (int i = 0; i < 2; ++i) {
        stage_rc(tid * 16 + i * 8192, pc.R[i], pc.C[i]);
        const int rho = pc.R[i] & 31, pn_ = rho >> 4, pi_ = rho & 15;
        const int Rb = (pc.R[i] & ~31) + 8 * (pi_ >> 2) + 4 * pn_ + (pi_ & 3);
        voffB[i] = (unsigned)(Rb * K + pc.C[i]) * 2u;
    }
    constexpr size_t hstep = (size_t)G_HALF * K * 2, kstep = G_BK * 2;
    const unsigned ldsw = (unsigned)wid * 1024u;
    const int aoff = lds_byte(wr * 64 + fr, fq * 8), boff = lds_byte(wc * 32 + fr, fq * 8);
    const char *cA, *cB, *nA, *nB;
    unsigned vc[2][2], vn[2][2];
    if (!unit(0, cA, cB, vc, pc)) return;
    f32x4 acc[2][2][4][2];
#pragma unroll
    for (int ai = 0; ai < 2; ++ai)
#pragma unroll
        for (int bj = 0; bj < 2; ++bj)
#pragma unroll
            for (int m = 0; m < 4; ++m)
#pragma unroll
                for (int n = 0; n < 2; ++n) acc[ai][bj][m][n] = (f32x4){0.f, 0.f, 0.f, 0.f};
    bf16x8 At[4][2], B0[2][2], B1[2][2];
    STG(SB(0, 0), cB, voffB); STG(SB(0, 1), cB + hstep, voffB); STG(SA(0, 0), cA, vc[0]); STG(SA(0, 1), cA, vc[1]);
    if (wr == 1) BAR;
    WAIT_V(2); BAR;
    STG(SB(1, 0), cB + kstep, voffB); STG(SA(1, 0), cA + kstep, vc[0]); STG(SB(1, 1), cB + hstep + kstep, voffB);
    WAIT_V(6); BAR;
    for (int ui = 0;; ++ui) {
        const bool has_next = unit(ui + 1, nA, nB, vn, pc);
        if (!has_next) {
            nA = cA; nB = cB;
#pragma unroll
            for (int h = 0; h < 2; ++h)
#pragma unroll
                for (int i = 0; i < 2; ++i) vn[h][i] = vc[h][i];
        }
        for (int t = 0; t < nt; t += 2) {
            const bool last = (t == nt - 2);
            const char* a1 = cA + (size_t)(t + 1) * kstep;
            const char* a2 = last ? nA : cA + (size_t)(t + 2) * kstep;
            const char* b2 = last ? nB : cB + (size_t)(t + 2) * kstep;
            const char* a3 = a2 + kstep;
            const char* b3 = b2 + kstep;
            unsigned v2[2][2];
#pragma unroll
            for (int h = 0; h < 2; ++h)
#pragma unroll
                for (int i = 0; i < 2; ++i) v2[h][i] = last ? vn[h][i] : vc[h][i];
            LDB(B0, 0, 0); LDB(B1, 0, 1); SCHED; LDA(At, 0, 0); STG(SA(1, 1), a1, vc[1]);
            WAIT_V(8); WAIT_L(0); BAR; MMA(0, 0, At, B0); MMA(0, 1, At, B1); BAR; SCHED;
            LDA(At, 0, 1); STG(SB(0, 0), b2, voffB); STG(SB(0, 1), b2 + hstep, voffB); STG(SA(0, 0), a2, v2[0]);
            WAIT_V(8); WAIT_L(0); BAR; MMA(1, 0, At, B0); MMA(1, 1, At, B1); BAR; SCHED;
            LDB(B0, 1, 0); LDB(B1, 1, 1); SCHED; LDA(At, 1, 0); STG(SA(0, 1), a2, v2[1]);
            WAIT_V(8); WAIT_L(0); BAR; MMA(0, 0, At, B0); MMA(0, 1, At, B1); BAR; SCHED;
            LDA(At, 1, 1); STG(SB(1, 0), b3, voffB); STG(SB(1, 1), b3 + hstep, voffB); STG(SA(1, 0), a3, v2[0]);
            WAIT_V(8); WAIT_L(0); BAR; MMA(1, 0, At, B0); MMA(1, 1, At, B1); BAR; SCHED;
        }
        if (ALIGN_EPI) { if (wr == 0) BAR; }
        epi(ui, acc);
        if (!has_next) break;
#pragma unroll
        for (int ai = 0; ai < 2; ++ai)
#pragma unroll
            for (int bj = 0; bj < 2; ++bj)
#pragma unroll
                for (int m = 0; m < 4; ++m)
#pragma unroll
                    for (int n = 0; n < 2; ++n) acc[ai][bj][m][n] = (f32x4){0.f, 0.f, 0.f, 0.f};
        cA = nA; cB = nB;
#pragma unroll
        for (int h = 0; h < 2; ++h)
#pragma unroll
            for (int i = 0; i < 2; ++i) vc[h][i] = vn[h][i];
        if (ALIGN_EPI) { if (wr == 1) BAR; }
    }
    WAIT_V(0);
    if (!ALIGN_EPI) { if (wr == 0) BAR; }
    BAR;
#undef SA
#undef SB
#undef STG
#undef LDA
#undef LDB
#undef MMA
}

__device__ __forceinline__ int xcd_unit(int seq, int total) {
    if (seq >= total) return -1;
    const int q = total >> 3, rem = total & 7, x = seq & 7, off = seq >> 3;
    return (x < rem ? x * (q + 1) : rem * (q + 1) + (x - rem) * q) + off;
}

constexpr int CV_T = 64 * 65 + 32;
struct CvRegs { float4 v[4][2]; };
template <class Item>
__device__ __forceinline__ void cv_fetch(CvRegs& rg, int it0, int nitems, Item item) {
    const int tid = threadIdx.x;
#pragma unroll
    for (int j = 0; j < 4; ++j) {
        const float* W; bf16_t* WT; int K, ncols, ldw, k0, n0;
        const int it = (it0 + j < nitems) ? it0 + j : nitems - 1;
        item(it, W, K, ncols, ldw, WT, k0, n0);
#pragma unroll
        for (int i = 0; i < 2; ++i) {
            const int idx = tid + i * 512, kr = idx >> 4, c4 = idx & 15;
            float4 v = make_float4(0.f, 0.f, 0.f, 0.f);
            if (n0 + c4 * 4 < ncols) v = *(const float4*)(W + (size_t)(k0 + kr) * ldw + n0 + c4 * 4);
            rg.v[j][i] = v;
        }
    }
}
__device__ __forceinline__ void cv_to_lds(float* T, const CvRegs& rg) {
    const int tid = threadIdx.x;
#pragma unroll
    for (int j = 0; j < 4; ++j)
#pragma unroll
        for (int i = 0; i < 2; ++i) {
            const int idx = tid + i * 512, kr = idx >> 4, c4 = idx & 15;
            float* Tj = T + j * CV_T;
            Tj[(c4 * 4 + 0) * 65 + kr] = rg.v[j][i].x;
            Tj[(c4 * 4 + 1) * 65 + kr] = rg.v[j][i].y;
            Tj[(c4 * 4 + 2) * 65 + kr] = rg.v[j][i].z;
            Tj[(c4 * 4 + 3) * 65 + kr] = rg.v[j][i].w;
        }
}
template <class ORow>
__device__ __forceinline__ void cv_store(const float* T, int K, bf16_t* __restrict__ WT, ORow orow, int k0, int n0) {
    const int tid = threadIdx.x;
    const int n = tid >> 3, c = tid & 7;
    const float* sp = T + n * 65 + c * 8;
    u32x4 o;
    o.x = pk_bf16(sp[0], sp[1]);
    o.y = pk_bf16(sp[2], sp[3]);
    o.z = pk_bf16(sp[4], sp[5]);
    o.w = pk_bf16(sp[6], sp[7]);
    const int r = orow(n0 + n);
    *(u32x4*)(WT + (size_t)r * K + k0 + c * 8) = o;
}
template <class Item, class ORow>
__device__ __forceinline__ void cv_run(float* T, int nitems, Item item, ORow orow) {
    const int step = gridDim.x * 4;
    int it0 = blockIdx.x * 4;
    if (it0 >= nitems) return;
    CvRegs cur;
    cv_fetch(cur, it0, nitems, item);
    for (; it0 < nitems; it0 += step) {
        __syncthreads();
        cv_to_lds(T, cur);
        if (it0 + step < nitems) cv_fetch(cur, it0 + step, nitems, item);
        __syncthreads();
#pragma unroll
        for (int j = 0; j < 4; ++j)
            if (it0 + j < nitems) {
                const float* W; bf16_t* WT; int K, ncols, ldw, k0, n0;
                item(it0 + j, W, K, ncols, ldw, WT, k0, n0);
                cv_store(T + j * CV_T, K, WT, orow, k0, n0);
            }
    }
}

constexpr int AT_KP = 144, AT_VP = 136, AT_KB = 64 * AT_KP, AT_VB = 64 * AT_VP, AT_BUF = AT_KB + AT_VB;
constexpr int AT_IMPA = 36864, AT_IMPB = AT_IMPA + 32768, AT_KMS = AT_IMPA;
constexpr int AT_OLDS = 36864, AT_OP = 68;
constexpr int AT_SELB = AT_OLDS + 256 * AT_OP * 4;
constexpr int AT_CAND = AT_SELB + 1024;
constexpr int AT_TOKM = AT_CAND + 4096;
constexpr int AT_MREF = AT_TOKM + 1024;
constexpr int AT_LACC = AT_MREF + 1024;
constexpr int AT_JLIST = AT_LACC + 1024;
constexpr int AT_QS = AT_JLIST + 1024;
static_assert(AT_QS + 256 * 144 <= FAST_LDS_BYTES - 16, "attention LDS map");
__device__ __forceinline__ int nth_set_bit64(unsigned lo, unsigned hi, int n) {
    const int cl = __popc(lo);
    unsigned m = lo;
    int base = 0;
    if (n >= cl) { n -= cl; m = hi; base = 32; }
    int pos = 0;
#pragma unroll
    for (int sh = 16; sh >= 1; sh >>= 1) {
        const int cnt = __popc((m >> pos) & ((1u << sh) - 1u));
        if (n >= cnt) { n -= cnt; pos += sh; }
    }
    return base + pos;
}
#define MFMA32(a, b, c) __builtin_amdgcn_mfma_f32_32x32x16_bf16(a, b, c, 0, 0, 0)
#define CREG(reg) (((reg) & 3) + 8 * ((reg) >> 2))

__device__ __forceinline__ float quad_sum(float x) {
    x += __int_as_float(__builtin_amdgcn_mov_dpp(__float_as_int(x), 0xB1, 0xF, 0xF, true));
    x += __int_as_float(__builtin_amdgcn_mov_dpp(__float_as_int(x), 0x4E, 0xF, 0xF, true));
    return x;
}
struct AtStage { u32x4 k, v; };
__device__ __forceinline__ void at_load(AtStage& st, const bf16_t* __restrict__ Kg, const bf16_t* __restrict__ Vg, bool with_v, unsigned koff, unsigned voff) {
    st.k = *(const u32x4*)((const char*)Kg + koff);
    if (with_v) st.v = *(const u32x4*)((const char*)Vg + voff);
}
__device__ __forceinline__ void at_store(const AtStage& st, LAS unsigned char* buf, bool with_v) {
    const int tid = threadIdx.x;
    *(LAS u32x4*)(buf + (tid >> 3) * AT_KP + (tid & 7) * 16) = st.k;
    if (with_v) {
        LAS unsigned short* vt = (LAS unsigned short*)(buf + AT_KB + (tid >> 6) * 8 * AT_VP + (tid & 63) * 2);
        vt[0 * (AT_VP / 2)] = (unsigned short)(st.v.x & 0xffffu);
        vt[1 * (AT_VP / 2)] = (unsigned short)(st.v.x >> 16);
        vt[2 * (AT_VP / 2)] = (unsigned short)(st.v.y & 0xffffu);
        vt[3 * (AT_VP / 2)] = (unsigned short)(st.v.y >> 16);
        vt[4 * (AT_VP / 2)] = (unsigned short)(st.v.z & 0xffffu);
        vt[5 * (AT_VP / 2)] = (unsigned short)(st.v.z >> 16);
        vt[6 * (AT_VP / 2)] = (unsigned short)(st.v.w & 0xffffu);
        vt[7 * (AT_VP / 2)] = (unsigned short)(st.v.w >> 16);
    }
}
__device__ __forceinline__ void at_scores(LAS const unsigned char* buf, const bf16x8 (&qf)[4], float ramp, float base0, float base1,
                                          f32x16& s0, f32x16& s1) {
    const int lane = threadIdx.x & 63, r = lane & 31, h = lane >> 5;
    LAS const unsigned char* kb = buf + r * AT_KP + h * 16;
    {
        const float b0 = fmaf(ramp, (float)(4 * h), base0), b1 = fmaf(ramp, (float)(4 * h), base1);
#pragma unroll
        for (int i = 0; i < 16; ++i) { s0[i] = fmaf(ramp, (float)CREG(i), b0); s1[i] = fmaf(ramp, (float)CREG(i), b1); }
    }
#pragma unroll
    for (int kk = 0; kk < 4; ++kk) {
        const bf16x8 k0 = *(LAS const bf16x8*)(kb + kk * 32);
        const bf16x8 k1 = *(LAS const bf16x8*)(kb + 32 * AT_KP + kk * 32);
        s0 = MFMA32(k0, qf[kk], s0);
        s1 = MFMA32(k1, qf[kk], s1);
    }
}
__device__ __forceinline__ bf16x8 at_pack8(const f32x16& P, int s2) {
    u32x4 w;
    if (s2 == 0) { w.x = pk_bf16(P[0], P[1]); w.y = pk_bf16(P[2], P[3]); w.z = pk_bf16(P[4], P[5]); w.w = pk_bf16(P[6], P[7]); }
    else         { w.x = pk_bf16(P[8], P[9]); w.y = pk_bf16(P[10], P[11]); w.z = pk_bf16(P[12], P[13]); w.w = pk_bf16(P[14], P[15]); }
    return __builtin_bit_cast(bf16x8, w);
}
__device__ __forceinline__ void at_pv(LAS const unsigned char* buf, const f32x16& p0, const f32x16& p1, f32x16& o0, f32x16& o1) {
    const int lane = threadIdx.x & 63, r = lane & 31, h = lane >> 5;
    LAS const unsigned char* vb = buf + AT_KB + r * AT_VP + h * 8;
#pragma unroll
    for (int half = 0; half < 2; ++half) {
#pragma unroll
        for (int s2 = 0; s2 < 2; ++s2) {
            const bf16x8 pf = at_pack8(half ? p1 : p0, s2);
            const int ko = (32 * half + 16 * s2) * 2;
            const u32x2 a0 = *(LAS const u32x2*)(vb + ko), a1 = *(LAS const u32x2*)(vb + ko + 16);
            const u32x2 b0 = *(LAS const u32x2*)(vb + 32 * AT_VP + ko), b1 = *(LAS const u32x2*)(vb + 32 * AT_VP + ko + 16);
            const u32x4 va = {a0.x, a0.y, a1.x, a1.y}, vbb = {b0.x, b0.y, b1.x, b1.y};
            o0 = MFMA32(__builtin_bit_cast(bf16x8, va), pf, o0);
            o1 = MFMA32(__builtin_bit_cast(bf16x8, vbb), pf, o1);
        }
    }
}
__device__ __forceinline__ float at_rowmax(const f32x16& s0, const f32x16& s1) {
    float m = fmaxf(s0[0], s1[0]);
#pragma unroll
    for (int i = 1; i < 16; ++i) m = fmaxf(m, fmaxf(s0[i], s1[i]));
    return fmaxf(m, __shfl_xor(m, 32));
}
#define AT_MASK_LE(S0, S1, lim)  do { _Pragma("unroll") for (int i_ = 0; i_ < 16; ++i_) { if (CREG(i_) > (lim)) S0[i_] = -INFINITY; if (CREG(i_) + 32 > (lim)) S1[i_] = -INFINITY; } } while (0)
#define AT_MASK_GE(S0, S1, lo)   do { _Pragma("unroll") for (int i_ = 0; i_ < 16; ++i_) { if (CREG(i_) < (lo)) S0[i_] = -INFINITY; if (CREG(i_) + 32 < (lo)) S1[i_] = -INFINITY; } } while (0)
__device__ __forceinline__ float at_exp(f32x16& s0, f32x16& s1, float mref) {
    float l = 0.f;
#pragma unroll
    for (int i = 0; i < 16; ++i) {
        s0[i] = __builtin_amdgcn_exp2f(s0[i] - mref);
        s1[i] = __builtin_amdgcn_exp2f(s1[i] - mref);
        l += s0[i] + s1[i];
    }
    return l;
}

#define AT_PIN(x) asm volatile("" : "+v"(x))
template <int PV = 0>
__device__ __forceinline__ void at_tile_pipe(LAS const unsigned char* buf, const bf16x8 (&qf)[4], float ramp, float base0, float mrow,
                                             float sl2x32, float& l, f32x16& o0, f32x16& o1) {
    const int lane = threadIdx.x & 63, r = lane & 31, h = lane >> 5;
    LAS const unsigned char* kb = buf + r * AT_KP + h * 16;
    LAS const unsigned char* vb = buf + AT_KB + r * AT_VP + h * 8;
    const float c0 = fmaf(ramp, (float)(4 * h), base0 - mrow), c1 = c0 + sl2x32;
    f32x16 s0, s1;
#pragma unroll
    for (int i = 0; i < 16; ++i) { s0[i] = fmaf(ramp, (float)CREG(i), c0); s1[i] = fmaf(ramp, (float)CREG(i), c1); }
    bf16x8 kf[4];
#pragma unroll
    for (int kk = 0; kk < 4; ++kk) kf[kk] = *(LAS const bf16x8*)(kb + kk * 32);
#pragma unroll
    for (int kk = 0; kk < 4; ++kk) if (PV != 3) s0 = MFMA32(kf[kk], qf[kk], s0);
#pragma unroll
    for (int kk = 0; kk < 4; ++kk) kf[kk] = *(LAS const bf16x8*)(kb + 32 * AT_KP + kk * 32);
    __builtin_amdgcn_sched_barrier(0);
    u32x2 vf[4][2];
    float ls = 0.f;
#pragma unroll
    for (int kk = 0; kk < 4; ++kk) {
        if (PV != 3) s1 = MFMA32(kf[kk], qf[kk], s1); else s1[kk] += __builtin_bit_cast(f32x4, kf[kk])[0];
        vf[kk][0] = *(LAS const u32x2*)(vb + (kk & 1) * 32 * AT_VP + (16 * (kk >> 1)) * 2);
        vf[kk][1] = *(LAS const u32x2*)(vb + (kk & 1) * 32 * AT_VP + (16 * (kk >> 1)) * 2 + 16);
#pragma unroll
        for (int q = 0; q < 4; ++q) { s0[4 * kk + q] = (PV == 1) ? s0[4 * kk + q] * 0.5f : __builtin_amdgcn_exp2f(s0[4 * kk + q]); ls += s0[4 * kk + q]; }
        AT_PIN(ls);
        __builtin_amdgcn_sched_barrier(0);
    }
    const bf16x8 pa = at_pack8(s0, 0), pb = at_pack8(s0, 1);
#pragma unroll
    for (int st = 0; st < 4; ++st) {
        const int s2 = st >> 1, dt = st & 1;
        const u32x4 vv = {vf[st][0].x, vf[st][0].y, vf[st][1].x, vf[st][1].y};
        if (PV == 2) { o0[st] += __builtin_bit_cast(f32x4, vv)[0] + __builtin_bit_cast(f32x4, s2 ? pb : pa)[1]; }
        else if (dt == 0) o0 = MFMA32(__builtin_bit_cast(bf16x8, vv), s2 ? pb : pa, o0);
        else         o1 = MFMA32(__builtin_bit_cast(bf16x8, vv), s2 ? pb : pa, o1);
        vf[st][0] = *(LAS const u32x2*)(vb + dt * 32 * AT_VP + (32 + 16 * s2) * 2);
        vf[st][1] = *(LAS const u32x2*)(vb + dt * 32 * AT_VP + (32 + 16 * s2) * 2 + 16);
#pragma unroll
        for (int q = 0; q < 4; ++q) { s1[4 * st + q] = (PV == 1) ? s1[4 * st + q] * 0.5f : __builtin_amdgcn_exp2f(s1[4 * st + q]); ls += s1[4 * st + q]; }
        AT_PIN(ls);
        __builtin_amdgcn_sched_barrier(0);
    }
    const bf16x8 pc = at_pack8(s1, 0), pd = at_pack8(s1, 1);
#pragma unroll
    for (int st = 0; st < 4; ++st) {
        const int s2 = st >> 1, dt = st & 1;
        const u32x4 vv = {vf[st][0].x, vf[st][0].y, vf[st][1].x, vf[st][1].y};
        if (PV == 2) { o1[st] += __builtin_bit_cast(f32x4, vv)[0] + __builtin_bit_cast(f32x4, s2 ? pd : pc)[1]; }
        else if (dt == 0) o0 = MFMA32(__builtin_bit_cast(bf16x8, vv), s2 ? pd : pc, o0);
        else         o1 = MFMA32(__builtin_bit_cast(bf16x8, vv), s2 ? pd : pc, o1);
    }
    l += ls;
}

#define AT_PASS(Kg, Vg, WITHV, NTILE, ROW, ...)                                                                        \
    {                                                                                                                  \
        AtStage st0_, st1_;                                                                                            \
        const int nt_ = (NTILE);                                                                                       \
        unsigned koff_ = (threadIdx.x >> 3) * 128 + (threadIdx.x & 7) * 16, voff_ = (threadIdx.x & 63) * 128 + (threadIdx.x >> 6) * 16; \
        asm volatile("" : "+v"(koff_), "+v"(voff_));     \
        __syncthreads();                                                                                               \
        at_load(st0_, (Kg) + (size_t)(ROW(0)) * 64, (Vg) + (size_t)(ROW(0)) * 64, WITHV, koff_, voff_);                 \
        at_store(st0_, lds, WITHV);                                                                                    \
        { const int i1_ = nt_ > 1 ? 1 : 0; at_load(st1_, (Kg) + (size_t)(ROW(i1_)) * 64, (Vg) + (size_t)(ROW(i1_)) * 64, WITHV, koff_, voff_); } \
        __syncthreads();                                                                                               \
        for (int i0_ = 0; i0_ < nt_; i0_ += 2) {                                                                       \
            {                                                                                                          \
                const int i = i0_;                                                                                     \
                LAS unsigned char* buf = lds;                                                                          \
                { const int in_ = (i + 2 < nt_) ? i + 2 : nt_ - 1;     \
                  at_load(st0_, (Kg) + (size_t)(ROW(in_)) * 64, (Vg) + (size_t)(ROW(in_)) * 64, WITHV, koff_, voff_); }        \
                do { __VA_ARGS__ } while (0);                                                                          \
                if (i + 1 < nt_) at_store(st1_, lds + AT_BUF, WITHV);                                                  \
                __syncthreads();                                                                                       \
            }                                                                                                          \
            if (i0_ + 1 < nt_) {                                                                                       \
                const int i = i0_ + 1;                                                                                 \
                LAS unsigned char* buf = lds + AT_BUF;                                                                 \
                { const int in_ = (i + 2 < nt_) ? i + 2 : nt_ - 1;                                                     \
                  at_load(st1_, (Kg) + (size_t)(ROW(in_)) * 64, (Vg) + (size_t)(ROW(in_)) * 64, WITHV, koff_, voff_); }        \
                do { __VA_ARGS__ } while (0);                                                                          \
                if (i + 1 < nt_) at_store(st0_, lds, WITHV);                                                           \
                __syncthreads();                                                                                       \
            }                                                                                                          \
        }                                                                                                              \
    }

template <int PM = 0>
__device__ __forceinline__ void nsa_item(const Params& p, unsigned char* shm, int b, int g, int c) {
    LAS unsigned char* lds = (LAS unsigned char*)shm;
    unsigned char* wsb = (unsigned char*)p.ws;
    const bf16_t* pt = (const bf16_t*)(wsb + WS_PT);
    int tid = threadIdx.x;
    asm volatile("" : "+v"(tid));
    const int lane = tid & 63, w = __builtin_amdgcn_readfirstlane(tid >> 6), r = lane & 31, h = lane >> 5;
    const int tokl = 8 * w + (r >> 2), head = r & 3, hq = 4 * g + head, t = 64 * c + tokl, tok = b * SEQ + t;
    const float sl2 = exp2f(-(float)(hq + 1)) * LOG2E;
    const float ramp = sl2;
    bf16x8 qf[4];
    {
        const bf16_t* qrow = pt + ((size_t)(HG_NQ + hq) * NTOK + tok) * 64 + 8 * h;
#pragma unroll
        for (int kk = 0; kk < 4; ++kk) qf[kk] = *(const bf16x8*)(qrow + 16 * kk);
    }
    const float* gl = (const float*)(wsb + WS_GATES);
#define GATE_(br, dst) float dst; { int go_ = tok * 24 + hq * 3 + (br); asm volatile("" : "+v"(go_)); dst = gl[go_]; }
    f32x16 R0, R1;
#pragma unroll
    for (int i = 0; i < 16; ++i) { R0[i] = 0.f; R1[i] = 0.f; }
    LAS float* impA = (LAS float*)(lds + AT_IMPA);
    LAS float* impB = (LAS float*)(lds + AT_IMPB);
    LAS unsigned* selb = (LAS unsigned*)(lds + AT_SELB);

    if (!(PM & 1)) {
        const bf16_t* Kc = (const bf16_t*)(wsb + WS_KCMP) + (size_t)(b * 2 + g) * NCMPP * 64;
        const bf16_t* Vc = (const bf16_t*)(wsb + WS_VCMP) + (size_t)(b * 2 + g) * NCMPP * 64;
        const int ntile = (4 * c + 3 + 63) >> 6;
        const int imax = (t >= 31) ? ((t - 31) >> 4) : -1;
        const float ramp16 = sl2 * 16.0f;
        float m = -INFINITY, l = 0.f;
#define ROW_(_i) (64 * (_i))
        AT_PASS(Kc, Vc, false, ntile, ROW_,
            f32x16 s0, s1;
            const float base0 = sl2 * (float)(16 * 64 * i + 31 - 64 * c), base1 = base0 + sl2 * 512.0f;
            at_scores(buf, qf, ramp16, base0, base1, s0, s1);
            if (64 * i + 63 > 4 * c - 2) {
                const int lim = imax - 64 * i - 4 * h;
                AT_MASK_LE(s0, s1, lim);
            }
            const float tm = at_rowmax(s0, s1);
            const float mn = fmaxf(m, tm);
            if (mn > -INFINITY) {
                l *= __builtin_amdgcn_exp2f(m - mn);
                l += at_exp(s0, s1, mn);
                m = mn;
            }
        )
        l += __shfl_xor(l, 32);
        const float inv = (l > 0.f) ? 1.0f / l : 0.f;
        const float mfin = (m > -INFINITY) ? m : 0.f;
        f32x16 o0, o1;
#pragma unroll
        for (int i = 0; i < 16; ++i) { o0[i] = 0.f; o1[i] = 0.f; }
        AT_PASS(Kc, Vc, true, ntile, ROW_,
            f32x16 s0, s1;
            const float base0 = sl2 * (float)(16 * 64 * i + 31 - 64 * c), base1 = base0 + sl2 * 512.0f;
            at_scores(buf, qf, ramp16, base0, base1, s0, s1);
            if (64 * i + 63 > 4 * c - 2) {
                const int lim = imax - 64 * i - 4 * h;
                AT_MASK_LE(s0, s1, lim);
            }
            (void)at_exp(s0, s1, mfin);
_Pragma("unroll")
            for (int q = 0; q < 16; ++q) { s0[q] *= inv; s1[q] *= inv; }
_Pragma("unroll")
            for (int hf = 0; hf < 2; ++hf)
_Pragma("unroll")
                for (int u = 0; u < 4; ++u) {
                    const f32x16& P = hf ? s1 : s0;
                    float A = 2.0f * (P[4 * u] + P[4 * u + 1] + P[4 * u + 2]) + P[4 * u + 3], Bv = P[4 * u + 3];
                    A = quad_sum(A);
                    Bv = quad_sum(Bv);
                    const int j = 16 * i + 8 * hf + 2 * u + h;
                    if (head == 0) impA[tokl * 128 + j] = A;
                    if (head == 1) impB[tokl * 128 + j] = Bv;
                }
            at_pv(buf, s0, s1, o0, o1);
        )
#undef ROW_
        GATE_(0, g0)
#pragma unroll
        for (int i = 0; i < 16; ++i) { R0[i] = g0 * o0[i]; R1[i] = g0 * o1[i]; }
    }

    unsigned sw0, sw1, sw2, sw3;
    {
        __syncthreads();
        for (int tk = 0; tk < ((PM & 2) ? 0 : 8); ++tk) {
            const int tl = 8 * w + tk;
            unsigned long long ba, bb;
            if (c < 16) {
                ba = (1ull << (c + 1)) - 1ull;
                bb = 0ull;
            } else {
                const int jA = lane, jB = lane + 64;
                const bool okA = (jA >= 1 && jA <= c - 2), okB = (jB <= c - 2);
                const float vA = okA ? impA[tl * 128 + jA] + impB[tl * 128 + jA - 1] : 0.f;
                const float vB = okB ? impA[tl * 128 + jB] + impB[tl * 128 + jB - 1] : 0.f;
                const unsigned kA = okA ? __float_as_uint(vA) + 1u : 0u, kB = okB ? __float_as_uint(vB) + 1u : 0u;
                unsigned K = 0u;
#pragma unroll
                for (int bit = 31; bit >= 0; --bit) {
                    const unsigned tt = K | (1u << bit);
                    const int cn = __popcll(__ballot(kA >= tt)) + __popcll(__ballot(kB >= tt));
                    if (cn >= 13) K = tt;
                }
                const unsigned long long gtA = __ballot(kA > K), gtB = __ballot(kB > K), eqA = __ballot(kA == K), eqB = __ballot(kB == K);
                const int need = 13 - (__popcll(gtA) + __popcll(gtB));
                const unsigned long long lt = (1ull << lane) - 1ull;
                const bool sA = (jA == 0) || (jA == c - 1) || (jA == c) || (kA > K) || (kA == K && __popcll(eqA & lt) < need);
                const bool sB = (jB == c - 1) || (jB == c) || (kB > K) || (kB == K && __popcll(eqA) + __popcll(eqB & lt) < need);
                ba = __ballot(sA);
                bb = __ballot(sB);
            }
            if (lane == 0) {
                selb[tl * 4 + 0] = (unsigned)ba;
                selb[tl * 4 + 1] = (unsigned)(ba >> 32);
                selb[tl * 4 + 2] = (unsigned)bb;
                selb[tl * 4 + 3] = (unsigned)(bb >> 32);
            }
        }
        __syncthreads();
        sw0 = selb[tokl * 4 + 0];
        sw1 = selb[tokl * 4 + 1];
        sw2 = selb[tokl * 4 + 2];
        sw3 = selb[tokl * 4 + 3];
    }

    if (!(PM & 4)) {
        const bf16_t* Ks = pt + ((size_t)(HG_KS + g) * NTOK + (size_t)b * SEQ) * 64;
        const bf16_t* Vs = pt + ((size_t)(HG_VS + g) * NTOK + (size_t)b * SEQ) * 64;
        LAS unsigned* tokm = (LAS unsigned*)(lds + AT_TOKM);
        LAS float* olds = (LAS float*)(lds + AT_OLDS);
        LAS float* mrefs = (LAS float*)(lds + AT_MREF);
        LAS float* lacc = (LAS float*)(lds + AT_LACC);
        LAS int* jlist = (LAS int*)(lds + AT_JLIST);
        LAS unsigned char* qs = lds + AT_QS;
        const int myrow = tokl * 4 + head;
        __syncthreads();
#pragma unroll
        for (int kk = 0; kk < 4; ++kk) *(LAS bf16x8*)(qs + myrow * 144 + (16 * kk + 8 * h) * 2) = qf[kk];
        {
            const unsigned wd = selb[lane * 4 + (w >> 1)];
#pragma unroll
            for (int jj = 0; jj < 16; ++jj) {
                const int j = 16 * w + jj;
                const unsigned long long mk = __ballot(((wd >> (j & 31)) & 1u) && j <= c);
                if (lane == 0) { tokm[2 * j] = (unsigned)mk; tokm[2 * j + 1] = (unsigned)(mk >> 32); }
            }
        }
        __syncthreads();
        if (w == 0) {
            const int j1 = c - lane, j2 = c - 64 - lane;
            const bool n1 = j1 >= 0 && (tokm[2 * (j1 < 0 ? 0 : j1)] | tokm[2 * (j1 < 0 ? 0 : j1) + 1]) != 0u;
            const bool n2 = j2 >= 0 && (tokm[2 * (j2 < 0 ? 0 : j2)] | tokm[2 * (j2 < 0 ? 0 : j2) + 1]) != 0u;
            const unsigned long long b1 = __ballot(n1), b2 = __ballot(n2);
            const unsigned long long lt = (1ull << lane) - 1ull;
            const int c1 = __popcll(b1);
            if (n1) jlist[1 + __popcll(b1 & lt)] = j1;
            if (n2) jlist[1 + c1 + __popcll(b2 & lt)] = j2;
            if (lane == 0) jlist[0] = c1 + __popcll(b2);
        }
        __syncthreads();
        const int nj = jlist[0];
#define ROW_(_i) (64 * jlist[1 + (_i)])
        AT_PASS(Ks, Vs, true, nj, ROW_,
            const int j = jlist[1 + i];
            const float base0 = sl2 * (float)(64 * (j - c));
            if (i == 0) {
                f32x16 s0, s1, a0, a1;
                _Pragma("unroll") for (int q = 0; q < 16; ++q) { a0[q] = 0.f; a1[q] = 0.f; }
                at_scores(buf, qf, ramp, base0, base0 + sl2 * 32.0f, s0, s1);
                const int lim = tokl - 4 * h;
                AT_MASK_LE(s0, s1, lim);
                const float mr = at_rowmax(s0, s1);
                const float lp = at_exp(s0, s1, mr);
                at_pv(buf, s0, s1, a0, a1);
                LAS float* orow = olds + myrow * AT_OP + 4 * h;
                _Pragma("unroll") for (int u = 0; u < 4; ++u) {
                    *(LAS f32x4*)(orow + 8 * u) = (f32x4){a0[4 * u], a0[4 * u + 1], a0[4 * u + 2], a0[4 * u + 3]};
                    *(LAS f32x4*)(orow + 32 + 8 * u) = (f32x4){a1[4 * u], a1[4 * u + 1], a1[4 * u + 2], a1[4 * u + 3]};
                }
                const float lt = lp + __shfl_xor(lp, 32);
                if (h == 0) { mrefs[myrow] = mr; lacc[myrow] = lt; }
            } else {
                const unsigned mlo = tokm[2 * j], mhi = tokm[2 * j + 1];
                const int nact = __popc(mlo) + __popc(mhi);
                if (8 * w >= nact) break;
                const int ct = 8 * w + (r >> 2);
                const bool valid = ct < nact;
                const int tau = nth_set_bit64(mlo, mhi, valid ? ct : 0);
                const int row = tau * 4 + head;
                bf16x8 q2[4];
                _Pragma("unroll") for (int kk = 0; kk < 4; ++kk) q2[kk] = *(LAS const bf16x8*)(qs + row * 144 + (16 * kk + 8 * h) * 2);
                const float mrow = valid ? mrefs[row] : INFINITY;
                LAS float* orow = olds + row * AT_OP + 4 * h;
                f32x16 a0, a1;
                _Pragma("unroll") for (int u = 0; u < 4; ++u) {
                    const f32x4 x0 = *(LAS const f32x4*)(orow + 8 * u), x1 = *(LAS const f32x4*)(orow + 32 + 8 * u);
                    a0[4 * u] = x0[0]; a0[4 * u + 1] = x0[1]; a0[4 * u + 2] = x0[2]; a0[4 * u + 3] = x0[3];
                    a1[4 * u] = x1[0]; a1[4 * u + 1] = x1[1]; a1[4 * u + 2] = x1[2]; a1[4 * u + 3] = x1[3];
                }
                float lp = 0.f;
                at_tile_pipe(buf, q2, ramp, base0, mrow, sl2 * 32.0f, lp, a0, a1);
                const float lt = lp + __shfl_xor(lp, 32);
                if (valid) {
                    _Pragma("unroll") for (int u = 0; u < 4; ++u) {
                        *(LAS f32x4*)(orow + 8 * u) = (f32x4){a0[4 * u], a0[4 * u + 1], a0[4 * u + 2], a0[4 * u + 3]};
                        *(LAS f32x4*)(orow + 32 + 8 * u) = (f32x4){a1[4 * u], a1[4 * u + 1], a1[4 * u + 2], a1[4 * u + 3]};
                    }
                    if (h == 0) lacc[row] += lt;
                }
            }
        )
#undef ROW_
        __syncthreads();
        {
            const float l = lacc[myrow];
            GATE_(1, g1)
            const float sc = g1 / l;
            LAS const float* orow = olds + myrow * AT_OP + 4 * h;
#pragma unroll
            for (int u = 0; u < 4; ++u)
#pragma unroll
                for (int q = 0; q < 4; ++q) { R0[4 * u + q] += sc * orow[8 * u + q]; R1[4 * u + q] += sc * orow[32 + 8 * u + q]; }
        }
    }

    if (!(PM & 8)) {
        const bf16_t* Kw = pt + ((size_t)(HG_KW + g) * NTOK + (size_t)b * SEQ) * 64;
        const bf16_t* Vw = pt + ((size_t)(HG_VW + g) * NTOK + (size_t)b * SEQ) * 64;
        f32x16 o0, o1;
#pragma unroll
        for (int i = 0; i < 16; ++i) { o0[i] = 0.f; o1[i] = 0.f; }
        float mref = 0.f, l = 0.f;
        const int ntile = (c >= 8) ? 9 : (c + 1);
#define ROW_(_i) (64 * (c - (_i)))
        AT_PASS(Kw, Vw, true, ntile, ROW_,
            const float base0 = sl2 * (float)(-64 * i);
            if (i == 0 || i == 8) {
                f32x16 s0, s1;
                at_scores(buf, qf, ramp, base0, base0 + sl2 * 32.0f, s0, s1);
                if (i == 0) {
                    const int lim = tokl - 4 * h;
                    AT_MASK_LE(s0, s1, lim);
                    mref = at_rowmax(s0, s1);
                } else {
                    const int lo = tokl + 1 - 4 * h;
                    AT_MASK_GE(s0, s1, lo);
                }
                l += at_exp(s0, s1, mref);
                at_pv(buf, s0, s1, o0, o1);
            } else {
                at_tile_pipe(buf, qf, ramp, base0, mref, sl2 * 32.0f, l, o0, o1);
            }
        )
#undef ROW_
        l += __shfl_xor(l, 32);
        GATE_(2, g2)
        const float sc = g2 / l;
#pragma unroll
        for (int i = 0; i < 16; ++i) { R0[i] += sc * o0[i]; R1[i] += sc * o1[i]; }
    }

    {
        bf16_t* orow = (bf16_t*)(wsb + ((PM & 16) ? (WS_Y + ((size_t)176 << 20)) : WS_MIXB)) + (size_t)tok * DM + 512 + hq * 64 + 4 * h;
#pragma unroll
        for (int u = 0; u < 4; ++u) {
            u32x2 a, bq;
            a.x = pk_bf16(R0[4 * u], R0[4 * u + 1]);
            a.y = pk_bf16(R0[4 * u + 2], R0[4 * u + 3]);
            bq.x = pk_bf16(R1[4 * u], R1[4 * u + 1]);
            bq.y = pk_bf16(R1[4 * u + 2], R1[4 * u + 3]);
            *(u32x2*)(orow + 8 * u) = a;
            *(u32x2*)(orow + 32 + 8 * u) = bq;
        }
    }
}

constexpr int PART_REC = 136, PART_ROW = 4 * PART_REC;
__device__ __forceinline__ unsigned char* part_rec(unsigned char* wsb, int b, int hh, int t, int slot) {
    return wsb + WS_PART + ((size_t)((b * 8 + hh) * SEQ + t)) * PART_ROW + slot * PART_REC;
}
__device__ __forceinline__ void part_store(unsigned char* rec, const f32x16& o0, const f32x16& o1, float l, float m, int h) {
    const float sc = 1.0f / l;
    bf16_t* orow = (bf16_t*)rec + 4 * h;
#pragma unroll
    for (int u = 0; u < 4; ++u) {
        u32x2 a, bq;
        a.x = pk_bf16(sc * o0[4 * u], sc * o0[4 * u + 1]);
        a.y = pk_bf16(sc * o0[4 * u + 2], sc * o0[4 * u + 3]);
        bq.x = pk_bf16(sc * o1[4 * u], sc * o1[4 * u + 1]);
        bq.y = pk_bf16(sc * o1[4 * u + 2], sc * o1[4 * u + 3]);
        *(u32x2*)(orow + 8 * u) = a;
        *(u32x2*)(orow + 32 + 8 * u) = bq;
    }
    if (h == 0) { f32x2 lm = {l, m}; *(f32x2*)(rec + 128) = lm; }
}

__device__ __forceinline__ void moba_gate_item(const Params& p, unsigned char* shm, int b, int hh, int cb) {
    LAS unsigned char* lds = (LAS unsigned char*)shm;
    unsigned char* wsb = (unsigned char*)p.ws;
    const bf16_t* pt = (const bf16_t*)(wsb + WS_PT);
    int tid = threadIdx.x;
    asm volatile("" : "+v"(tid));
    const int lane = tid & 63, w = __builtin_amdgcn_readfirstlane(tid >> 6), r = lane & 31, h = lane >> 5;
    const int tloc = 32 * w + r, t = 256 * cb + tloc, tok = b * SEQ + t;
    LAS float* kms = (LAS float*)(lds + AT_KMS);
    LAS int* lcnt = (LAS int*)(lds + AT_SELB);
    LAS int* lbase = lcnt + 32;
    int* mcnt = (int*)(wsb + WS_MCNT) + (b * 8 + hh) * 32;
    unsigned short* mlist = (unsigned short*)(wsb + WS_MLIST) + (size_t)((b * 8 + hh) * 32) * 8192;
    __syncthreads();
    {
        const f32x4 v = ((const f32x4*)((const float*)(wsb + WS_KMEAN) + (size_t)(b * 8 + hh) * 2048))[tid];
        *(LAS f32x4*)(kms + tid * 4) = v;
    }
    if (tid < 32) lcnt[tid] = 0;
    __syncthreads();
    float qv[32];
    {
        const bf16_t* qrow = pt + ((size_t)(HG_MQ + hh) * NTOK + tok) * 64 + 8 * h;
#pragma unroll
        for (int kk = 0; kk < 4; ++kk) {
            const u32x4 qq = *(const u32x4*)(qrow + 16 * kk);
            qv[kk * 8 + 0] = bf_lo(qq.x); qv[kk * 8 + 1] = bf_hi(qq.x);
            qv[kk * 8 + 2] = bf_lo(qq.y); qv[kk * 8 + 3] = bf_hi(qq.y);
            qv[kk * 8 + 4] = bf_lo(qq.z); qv[kk * 8 + 5] = bf_hi(qq.z);
            qv[kk * 8 + 6] = bf_lo(qq.w); qv[kk * 8 + 7] = bf_hi(qq.w);
        }
    }
    float b0 = -INFINITY, b1 = -INFINITY, b2 = -INFINITY;
    int i0 = 0, i1 = 0, i2 = 0;
    for (int n = 0; n < cb; ++n) {
        float s = 0.f;
#pragma unroll
        for (int kk = 0; kk < 4; ++kk) {
            const f32x4 ka = *(LAS const f32x4*)(kms + n * 64 + 16 * kk + 8 * h), kb = *(LAS const f32x4*)(kms + n * 64 + 16 * kk + 8 * h + 4);
            s += qv[kk * 8 + 0] * ka[0] + qv[kk * 8 + 1] * ka[1] + qv[kk * 8 + 2] * ka[2] + qv[kk * 8 + 3] * ka[3];
            s += qv[kk * 8 + 4] * kb[0] + qv[kk * 8 + 5] * kb[1] + qv[kk * 8 + 6] * kb[2] + qv[kk * 8 + 7] * kb[3];
        }
        s += __shfl_xor(s, 32);
        if (s > b0) { b2 = b1; i2 = i1; b1 = b0; i1 = i0; b0 = s; i0 = n; }
        else if (s > b1) { b2 = b1; i2 = i1; b1 = s; i1 = n; }
        else if (s > b2) { b2 = s; i2 = n; }
    }
    const int nsel = cb < 3 ? cb : 3;
    int n0 = i0, n1 = i1, n2 = i2;
    if (nsel >= 2 && n1 < n0) { const int x = n0; n0 = n1; n1 = x; }
    if (nsel >= 3) {
        if (n2 < n1) { const int x = n1; n1 = n2; n2 = x; }
        if (n1 < n0) { const int x = n0; n0 = n1; n1 = x; }
    }
    int r0 = 0, r1 = 0, r2 = 0;
    if (h == 0) {
        r0 = atomicAdd((int*)(lcnt + n0), 1);
        if (nsel >= 2) r1 = atomicAdd((int*)(lcnt + n1), 1);
        if (nsel >= 3) r2 = atomicAdd((int*)(lcnt + n2), 1);
    }
    __syncthreads();
    if (tid < cb) lbase[tid] = atomicAdd(mcnt + tid, lcnt[tid]);
    __syncthreads();
    if (h == 0) {
        mlist[(size_t)n0 * 8192 + lbase[n0] + r0] = (unsigned short)(t | (0 << 13));
        if (nsel >= 2) mlist[(size_t)n1 * 8192 + lbase[n1] + r1] = (unsigned short)(t | (1 << 13));
        if (nsel >= 3) mlist[(size_t)n2 * 8192 + lbase[n2] + r2] = (unsigned short)(t | (2 << 13));
    }
}

__device__ __forceinline__ void moba_own_item(const Params& p, unsigned char* shm, int b, int hh, int cb) {
    LAS unsigned char* lds = (LAS unsigned char*)shm;
    unsigned char* wsb = (unsigned char*)p.ws;
    const bf16_t* pt = (const bf16_t*)(wsb + WS_PT);
    int tid = threadIdx.x;
    asm volatile("" : "+v"(tid));
    const int lane = tid & 63, w = __builtin_amdgcn_readfirstlane(tid >> 6), r = lane & 31, h = lane >> 5;
    const int tloc = 32 * w + r, t = 256 * cb + tloc, tok = b * SEQ + t;
    const float sl2 = exp2f(-((float)hh + 0.5f)) * LOG2E;
    const float ramp = sl2;
    bf16x8 qf[4];
    {
        const bf16_t* qrow = pt + ((size_t)(HG_MQ + hh) * NTOK + tok) * 64 + 8 * h;
#pragma unroll
        for (int kk = 0; kk < 4; ++kk) qf[kk] = *(const bf16x8*)(qrow + 16 * kk);
    }
    const bf16_t* Km = pt + ((size_t)(HG_MK + hh) * NTOK + (size_t)b * SEQ) * 64;
    const bf16_t* Vm = pt + ((size_t)(HG_MV + hh) * NTOK + (size_t)b * SEQ) * 64;
    f32x16 o0, o1;
#pragma unroll
    for (int i = 0; i < 16; ++i) { o0[i] = 0.f; o1[i] = 0.f; }
    float mref = 0.f, l = 0.f;
    const int wt = w >> 1;
#define ROW_(_i) (256 * cb + 64 * (3 - (_i)))
    AT_PASS(Km, Vm, true, 4, ROW_,
        const int tt = 3 - i;
        if (tt > wt) break;
        const float base0 = sl2 * (float)(64 * tt);
        if (tt == wt) {
            f32x16 s0, s1;
            at_scores(buf, qf, ramp, base0, base0 + sl2 * 32.0f, s0, s1);
            const int lim = tloc - 64 * tt - 4 * h;
            AT_MASK_LE(s0, s1, lim);
            mref = at_rowmax(s0, s1);
            l += at_exp(s0, s1, mref);
            at_pv(buf, s0, s1, o0, o1);
        } else {
            at_tile_pipe(buf, qf, ramp, base0, mref, sl2 * 32.0f, l, o0, o1);
        }
        )
#undef ROW_
    l += __shfl_xor(l, 32);
    part_store(part_rec(wsb, b, hh, t, 3), o0, o1, l, mref - sl2 * (float)tloc, h);
}

template <int PV = 0>
__device__ __forceinline__ void moba_gather_item(const Params& p, unsigned char* shm, int b, int hh, int n, int k, int cnt) {
    LAS unsigned char* lds = (LAS unsigned char*)shm;
    unsigned char* wsb = (unsigned char*)p.ws;
    const bf16_t* pt = (const bf16_t*)(wsb + WS_PT);
    int tid = threadIdx.x;
    asm volatile("" : "+v"(tid));
    const int lane = tid & 63, w = __builtin_amdgcn_readfirstlane(tid >> 6), r = lane & 31, h = lane >> 5;
    const unsigned short* mlist = (const unsigned short*)(wsb + WS_MLIST) + (size_t)((b * 8 + hh) * 32 + n) * 8192;
    const int li = 256 * k + 32 * w + r;
    const bool live = li < cnt;
    const unsigned ent = mlist[live ? li : cnt - 1];
    const int t = ent & 8191, slot = ent >> 13, tok = b * SEQ + t;
    const float sl2 = exp2f(-((float)hh + 0.5f)) * LOG2E;
    const float ramp = sl2;
    bf16x8 qf[4];
    {
        const bf16_t* qrow = pt + ((size_t)(HG_MQ + hh) * NTOK + tok) * 64 + 8 * h;
#pragma unroll
        for (int kk = 0; kk < 4; ++kk) qf[kk] = *(const bf16x8*)(qrow + 16 * kk);
    }
    const bf16_t* Km = pt + ((size_t)(HG_MK + hh) * NTOK + (size_t)b * SEQ) * 64;
    const bf16_t* Vm = pt + ((size_t)(HG_MV + hh) * NTOK + (size_t)b * SEQ) * 64;
    f32x16 o0, o1;
#pragma unroll
    for (int i = 0; i < 16; ++i) { o0[i] = 0.f; o1[i] = 0.f; }
    float mref = 0.f, l = 0.f;
    const float tb = sl2 * (float)(256 * n - t);
#define ROW_(_i) (256 * n + 64 * (3 - (_i)))
    AT_PASS(Km, Vm, true, 4, ROW_,
        const int tt = 3 - i;
        const float base0 = tb + sl2 * (float)(64 * tt);
        if (i == 0) {
            f32x16 s0, s1;
            at_scores(buf, qf, ramp, base0, base0 + sl2 * 32.0f, s0, s1);
            mref = at_rowmax(s0, s1);
            l += at_exp(s0, s1, mref);
            at_pv(buf, s0, s1, o0, o1);
        } else {
            at_tile_pipe<PV>(buf, qf, ramp, base0, mref, sl2 * 32.0f, l, o0, o1);
        }
        )
#undef ROW_
    l += __shfl_xor(l, 32);
    if (live) part_store(part_rec(wsb, b, hh, t, slot), o0, o1, l, mref, h);
}

__device__ __forceinline__ void f_moba_merge(const Params& p) {
    unsigned char* wsb = (unsigned char*)p.ws;
    const int tid = threadIdx.x;
    bf16_t* mixb = (bf16_t*)(wsb + WS_MIXB);
    for (int idx = blockIdx.x * 512 + tid; idx < NTOK * 8 * 8; idx += gridDim.x * 512) {
        const int dq = idx & 7, rho = idx >> 3;
        const int t = rho & (SEQ - 1), bh = rho >> 13, hh = bh & 7, b = bh >> 3;
        const int cbk = t >> 8, nsel = cbk < 3 ? cbk : 3;
        const unsigned char* row = wsb + WS_PART + (size_t)rho * PART_ROW;
        float lw[4];
        float M = -INFINITY;
        f32x2 lm[4];
#pragma unroll
        for (int s = 0; s < 4; ++s) {
            const bool on = (s == 3) || (s < nsel);
            lm[s] = on ? *(const f32x2*)(row + s * PART_REC + 128) : (f32x2){0.f, -INFINITY};
            M = fmaxf(M, lm[s][1]);
        }
        float W = 0.f;
#pragma unroll
        for (int s = 0; s < 4; ++s) { lw[s] = lm[s][0] * __builtin_amdgcn_exp2f(lm[s][1] - M); W += lw[s]; }
        float acc[8];
#pragma unroll
        for (int q = 0; q < 8; ++q) acc[q] = 0.f;
#pragma unroll
        for (int s = 0; s < 4; ++s) {
            const bool on = (s == 3) || (s < nsel);
            if (on) {
                const u32x4 v = *(const u32x4*)(row + s * PART_REC + dq * 16);
                acc[0] += lw[s] * bf_lo(v.x); acc[1] += lw[s] * bf_hi(v.x);
                acc[2] += lw[s] * bf_lo(v.y); acc[3] += lw[s] * bf_hi(v.y);
                acc[4] += lw[s] * bf_lo(v.z); acc[5] += lw[s] * bf_hi(v.z);
                acc[6] += lw[s] * bf_lo(v.w); acc[7] += lw[s] * bf_hi(v.w);
            }
        }
        const float inv = 1.0f / W;
        u32x4 o;
        o.x = pk_bf16(acc[0] * inv, acc[1] * inv);
        o.y = pk_bf16(acc[2] * inv, acc[3] * inv);
        o.z = pk_bf16(acc[4] * inv, acc[5] * inv);
        o.w = pk_bf16(acc[6] * inv, acc[7] * inv);
        *(u32x4*)(mixb + (size_t)(b * SEQ + t) * DM + hh * 64 + dq * 8) = o;
    }
}

__device__ __forceinline__ void f_moba_gate(const Params& p, unsigned char* shm) {
    for (int q = blockIdx.x; q < 1024; q += gridDim.x) {
        const int cb = q >> 5, bh = q & 31;
        if (cb >= 1) moba_gate_item(p, shm, bh >> 3, bh & 7, cb);
    }
    __syncthreads();
}

constexpr int AT_TAIL = AT_QS + 256 * 144;
static_assert(AT_TAIL + 2064 + 64 <= FAST_LDS_BYTES - 16, "attention queue tables");
__device__ __forceinline__ void f_attn(const Params& p, unsigned char* shm) {
    LAS unsigned short* pre = (LAS unsigned short*)((LAS unsigned char*)shm + AT_TAIL);
    LAS int* wtot = (LAS int*)((LAS unsigned char*)shm + AT_TAIL + 2064);
    const int* mcnt = (const int*)((unsigned char*)p.ws + WS_MCNT);
    int* qctr = (int*)((unsigned char*)p.ws + WS_MCNT) + 1024;
    int tid = threadIdx.x;
    asm volatile("" : "+v"(tid));
    __syncthreads();
    {
        const int lane = tid & 63, w = tid >> 6;
        const int v0 = (mcnt[2 * tid] + 255) >> 8, v1 = (mcnt[2 * tid + 1] + 255) >> 8;
        int sc = v0 + v1;
#pragma unroll
        for (int d = 1; d < 64; d <<= 1) { const int u = __shfl_up(sc, d); if (lane >= d) sc += u; }
        if (lane == 63) wtot[w] = sc;
        __syncthreads();
        int woff = 0;
        for (int ww = 0; ww < w; ++ww) woff += wtot[ww];
        const int excl = woff + sc - (v0 + v1);
        pre[2 * tid] = (unsigned short)excl;
        pre[2 * tid + 1] = (unsigned short)(excl + v0);
        if (tid == 511) pre[1024] = (unsigned short)(excl + v0 + v1);
    }
    __syncthreads();
    const int limit = 2048 + (int)pre[1024];
    int ticket = 0;
    if (tid == 0) ticket = atomicAdd(qctr, 1);
    for (;;) {
        __syncthreads();
        if (tid == 0) wtot[8] = ticket;
        __syncthreads();
        const int it = wtot[8];
        if (it >= limit) break;
        if (tid == 0) ticket = atomicAdd(qctr, 1);
        if (it < 1024) {
            const int q = it & 511;
            nsa_item(p, shm, q & 3, it < 512 ? 1 : 0, 127 - (q >> 2));
        } else if (it < 2048) {
            const int q = it - 1024;
            moba_own_item(p, shm, (q & 31) >> 3, q & 7, q >> 5);
        } else {
            const int gi = it - 2048;
            int lo = 0, hi = 1024;
            while (hi - lo > 1) { const int mid = (lo + hi) >> 1; if ((int)pre[mid] <= gi) lo = mid; else hi = mid; }
            const int li = lo, k = gi - (int)pre[li];
            moba_gather_item(p, shm, li >> 8, (li >> 5) & 7, li & 31, k, mcnt[li]);
        }
    }
    __syncthreads();
}


template <int PM>
__device__ __forceinline__ void f_probe_nsa(const Params& p, unsigned char* shm) {
    for (int q = blockIdx.x; q < 1024; q += gridDim.x) nsa_item<PM>(p, shm, (q & 7) >> 1, q & 1, 127 - (q >> 3));
}
template <int PV>
__device__ __forceinline__ void f_probe_gather(const Params& p, unsigned char* shm) {
    const int* mcnt = (const int*)((unsigned char*)p.ws + WS_MCNT);
    for (int li = 0; li < 1024; ++li) {
        const int cnt = mcnt[li], nch = (cnt + 255) >> 8;
        for (int k = 0; k < nch; ++k)
            if (((li * 37 + k) & 255) == (int)blockIdx.x % 256) moba_gather_item<PV>(p, shm, li >> 8, (li >> 5) & 7, li & 31, k, cnt);
    }
}
__device__ __forceinline__ void f_prologue(const Params& p, unsigned char* shm) {
    const int tid = threadIdx.x, lane = tid & 63, w = tid >> 6;
    unsigned char* wsb = (unsigned char*)p.ws;
    bf16_t* xn = (bf16_t*)(wsb + WS_XN);
    {
        float4* km = (float4*)(wsb + WS_KMEAN);
        for (int i = blockIdx.x * 512 + tid; i < 16384; i += gridDim.x * 512) km[i] = make_float4(0.f, 0.f, 0.f, 0.f);
        int* mc = (int*)(wsb + WS_MCNT);
        for (int i = blockIdx.x * 512 + tid; i < 1024 + 16; i += gridDim.x * 512) mc[i] = 0;
    }
    for (int row = blockIdx.x * 8 + w; row < NTOK; row += gridDim.x * 8) {
        const float4* xr = (const float4*)(p.x + (size_t)row * DM);
        float4 v[4];
        float ss = 0.f;
#pragma unroll
        for (int j = 0; j < 4; ++j) { v[j] = xr[lane + 64 * j]; ss += dot4(v[j], v[j]); }
        ss = wave_sum(ss);
        const float r = 1.0f / sqrtf(ss * (1.0f / DM) + 1e-5f);
        const float4* g4 = (const float4*)p.attn_g;
        u32x2* o = (u32x2*)(xn + (size_t)row * DM);
#pragma unroll
        for (int j = 0; j < 4; ++j) {
            const float4 g = g4[lane + 64 * j];
            u32x2 ov;
            ov.x = pk_bf16(v[j].x * r * g.x, v[j].y * r * g.y);
            ov.y = pk_bf16(v[j].z * r * g.z, v[j].w * r * g.w);
            o[lane + 64 * j] = ov;
        }
    }
    float* T = (float*)shm;
    bf16_t* btin = (bf16_t*)(wsb + WS_BTIN);
    bf16_t* btout = (bf16_t*)(wsb + WS_BTOUT);
    bf16_t* btup = (bf16_t*)(wsb + WS_BTUP);
    bf16_t* btdn = (bf16_t*)(wsb + WS_BTDN);
    bf16_t* w1t = (bf16_t*)(wsb + WS_W1T);
    bf16_t* w2t = (bf16_t*)(wsb + WS_W2T);
    const auto ident = [](int c) { return c; };
    cv_run(T, 16 * 48, [&](int it, const float*& W, int& K, int& ncols, int& ldw, bf16_t*& WT, int& k0, int& n0) {
        const int g4 = it >> 2, sub = it & 3, kt = (g4 / 24) * 2 + (sub >> 1), nt = (g4 % 24) * 2 + (sub & 1);
        W = p.w_in; K = DM; ncols = INC; ldw = INC; WT = btin; k0 = kt * 64; n0 = nt * 64; }, ident);
    cv_run(T, 16 * 16, [&](int it, const float*& W, int& K, int& ncols, int& ldw, bf16_t*& WT, int& k0, int& n0) {
        const int g4 = it >> 2, sub = it & 3, kt = (g4 >> 3) * 2 + (sub >> 1), nt = (g4 & 7) * 2 + (sub & 1);
        W = p.w_out; K = DM; ncols = DM; ldw = DM; WT = btout; k0 = kt * 64; n0 = nt * 64; }, ident);
    cv_run(T, NE * 16 * 32, [&](int it, const float*& W, int& K, int& ncols, int& ldw, bf16_t*& WT, int& k0, int& n0) {
        const int e = it >> 9, r = it & 511;
        const int g4 = r >> 2, sub = r & 3, kt = (g4 >> 4) * 2 + (sub >> 1), nt = (g4 & 15) * 2 + (sub & 1);
        W = p.w_up + (size_t)e * DM * DFF2; K = DM; ncols = DFF2; ldw = DFF2; WT = btup + (size_t)e * DFF2 * DM; k0 = kt * 64; n0 = nt * 64; },
        [](int c) { const int a = c >> 1, isu = c & 1; return (a >> 7) * 256 + isu * 128 + (a & 127); });
    cv_run(T, NE * 16 * 16, [&](int it, const float*& W, int& K, int& ncols, int& ldw, bf16_t*& WT, int& k0, int& n0) {
        const int e = it >> 8, r = it & 255;
        const int g4 = r >> 2, sub = r & 3, kt = (g4 >> 3) * 2 + (sub >> 1), nt = (g4 & 7) * 2 + (sub & 1);
        W = p.w_down + (size_t)e * DM * DM; K = DM; ncols = DM; ldw = DM; WT = btdn + (size_t)e * DM * DM; k0 = kt * 64; n0 = nt * 64; }, ident);
    cv_run(T, 2 * 33, [&](int it, const float*& W, int& K, int& ncols, int& ldw, bf16_t*& WT, int& k0, int& n0) {
        const int kv = it / 33, r = it % 33;
        ncols = 64; ldw = 64; n0 = 0;
        if (r < 32) { W = kv ? p.w1v : p.w1k; K = 2048; WT = w1t + (size_t)kv * 64 * 2048; k0 = r * 64; }
        else        { W = kv ? p.w2v : p.w2k; K = 64;   WT = w2t + (size_t)kv * 64 * 64;   k0 = 0; } }, ident);
    __syncthreads();
    if (blockIdx.x == gridDim.x - 1) {
        const int o = tid & 127, part = tid >> 7, kv = o >> 6, n = o & 63;
        const float* pe = kv ? p.pe_v : p.pe_k;
        const float* w1 = kv ? p.w1v : p.w1k;
        float s = 0.f;
        for (int ff = part * 512; ff < part * 512 + 512; ++ff) s += pe[ff] * w1[ff * 64 + n];
        T[part * 128 + o] = s;
        __syncthreads();
        if (tid < 128) ((float*)(wsb + WS_C1))[tid] = T[tid] + T[128 + tid] + T[256 + tid] + T[384 + tid];
    }
    __syncthreads();
}

__device__ __forceinline__ void f_cmp(const Params& p, unsigned char* shm) {
    unsigned char* wsb = (unsigned char*)p.ws;
    const bf16_t* pt = (const bf16_t*)(wsb + WS_PT);
    const bf16_t* w1t = (const bf16_t*)(wsb + WS_W1T);
    const bf16_t* w2t = (const bf16_t*)(wsb + WS_W2T);
    const float* c1 = (const float*)(wsb + WS_C1);
    const int tid = threadIdx.x, lane = tid & 63, w = __builtin_amdgcn_readfirstlane(tid >> 6), fr = lane & 15, fq = lane >> 4;
    LAS float* part = (LAS float*)shm;
    LAS unsigned char* h1buf = (LAS unsigned char*)shm + 32768;
    for (int it = blockIdx.x; it < 512; it += gridDim.x) {
        const int rg = it & 31, g = (it >> 5) & 1, b = (it >> 6) & 3, kv = it >> 8;
        const int hg = (kv ? HG_VC : HG_KC) + g;
        const bf16_t* arow = pt + ((size_t)hg * NTOK + (size_t)b * SEQ + 16 * (16 * rg + fr)) * 64 + 8 * fq + 256 * w;
        const bf16_t* brow = w1t + ((size_t)kv * 64 + fr) * 2048 + 8 * fq + 256 * w;
        f32x4 acc[4];
#pragma unroll
        for (int nt = 0; nt < 4; ++nt) acc[nt] = (f32x4){0.f, 0.f, 0.f, 0.f};
#pragma unroll
        for (int kk = 0; kk < 8; ++kk) {
            const bf16x8 a = *(const bf16x8*)(arow + 32 * kk);
#pragma unroll
            for (int nt = 0; nt < 4; ++nt) {
                const bf16x8 bb = *(const bf16x8*)(brow + (size_t)nt * 16 * 2048 + 32 * kk);
                acc[nt] = __builtin_amdgcn_mfma_f32_16x16x32_bf16(a, bb, acc[nt], 0, 0, 0);
            }
        }
        __syncthreads();
#pragma unroll
        for (int nt = 0; nt < 4; ++nt)
#pragma unroll
            for (int reg = 0; reg < 4; ++reg) part[w * 1024 + (4 * fq + reg) * 64 + nt * 16 + fr] = acc[nt][reg];
        __syncthreads();
        {
#pragma unroll
            for (int q = 0; q < 2; ++q) {
                const int o = tid + 512 * q, row = o >> 6, col = o & 63;
                float s = c1[kv * 64 + col];
#pragma unroll
                for (int ww = 0; ww < 8; ++ww) s += part[ww * 1024 + o];
                *(LAS unsigned short*)(h1buf + row * 144 + col * 2) = (unsigned short)(pk_bf16(gelu_tanh(s), 0.f) & 0xffffu);
            }
        }
        __syncthreads();
        if (w == 0) {
            f32x4 acc2[4];
#pragma unroll
            for (int nt = 0; nt < 4; ++nt) acc2[nt] = (f32x4){0.f, 0.f, 0.f, 0.f};
#pragma unroll
            for (int k2 = 0; k2 < 2; ++k2) {
                const bf16x8 a2 = *(LAS const bf16x8*)(h1buf + fr * 144 + (32 * k2 + 8 * fq) * 2);
#pragma unroll
                for (int nt = 0; nt < 4; ++nt) {
                    const bf16x8 b2 = *(const bf16x8*)(w2t + ((size_t)kv * 64 + nt * 16 + fr) * 64 + 32 * k2 + 8 * fq);
                    acc2[nt] = __builtin_amdgcn_mfma_f32_16x16x32_bf16(a2, b2, acc2[nt], 0, 0, 0);
                }
            }
            bf16_t* dst = (bf16_t*)(wsb + (kv ? WS_VCMP : WS_KCMP)) + (size_t)((b * 2 + g) * NCMPP + 16 * rg) * 64;
#pragma unroll
            for (int nt = 0; nt < 4; ++nt)
#pragma unroll
                for (int reg = 0; reg < 4; ++reg)
                    dst[(size_t)(4 * fq + reg) * 64 + nt * 16 + fr] = (bf16_t)(pk_bf16(acc2[nt][reg], 0.f) & 0xffffu);
        }
    }
    __syncthreads();
}

__device__ __forceinline__ void f_inproj(const Params& p, unsigned char* shm) {
    unsigned char* wsb = (unsigned char*)p.ws;
    const bf16_t* xn = (const bf16_t*)(wsb + WS_XN);
    const bf16_t* btin = (const bf16_t*)(wsb + WS_BTIN);
    bf16_t* pt = (bf16_t*)(wsb + WS_PT);
    float* gates = (float*)(wsb + WS_GATES);
    float* kmean = (float*)(wsb + WS_KMEAN);
    const int tid = threadIdx.x, wid = __builtin_amdgcn_readfirstlane(tid >> 6), lane = tid & 63, wr = wid >> 2, wc = wid & 3;
    constexpr int NTN = NIN_PAD / 256;
    gemm256_stream((LAS unsigned char*)shm,
        [&](int i, const char*& A, const char*& B, unsigned (&va)[2][2], const GPiece& pc) __attribute__((always_inline)) {
            const int it = xcd_unit(blockIdx.x + i * gridDim.x, (NTOK / 256) * NTN);
            if (it < 0) return false;
            const int pm = it / NTN, pn = it % NTN;
            A = (const char*)xn;
            B = (const char*)(btin + (size_t)pn * 256 * DM);
#pragma unroll
            for (int h = 0; h < 2; ++h)
#pragma unroll
                for (int j = 0; j < 2; ++j) va[h][j] = (unsigned)((pm * 256 + h * 128 + pc.R[j]) * DM + pc.C[j]) * 2u;
            return true;
        },
        [&](int i, f32x4 (&acc)[2][2][4][2]) __attribute__((always_inline)) {
        const int it = xcd_unit(blockIdx.x + i * gridDim.x, (NTOK / 256) * NTN);
        const int pm = it / NTN, pn = it % NTN;
        int le = lane;
        asm volatile("" : "+v"(le));
        const int er = le & 15, eq = le >> 4;
        if (pn < 11) {
#pragma unroll
            for (int bj = 0; bj < 2; ++bj) {
                const int hg = pn * 4 + bj * 2 + (wc >> 1);
                const float sc = (hg < 8 || (hg >= 24 && hg < 32)) ? QSCALE : 1.0f;
                bf16_t* base = pt + ((size_t)hg * NTOK + pm * 256 + wr * 64) * 64 + (wc & 1) * 32 + 8 * eq;
#pragma unroll
                for (int ai = 0; ai < 2; ++ai)
#pragma unroll
                    for (int m = 0; m < 4; ++m) {
                        const f32x4 a0 = acc[ai][bj][m][0], a1 = acc[ai][bj][m][1];
                        u32x4 ov;
                        ov.x = pk_bf16(a0[0] * sc, a0[1] * sc);
                        ov.y = pk_bf16(a0[2] * sc, a0[3] * sc);
                        ov.z = pk_bf16(a1[0] * sc, a1[1] * sc);
                        ov.w = pk_bf16(a1[2] * sc, a1[3] * sc);
                        *(u32x4*)(base + (size_t)(ai * 128 + m * 16 + er) * 64) = ov;
                    }
                if (hg >= HG_MK && hg < HG_MK + 8) {
                    const int b = (pm * 256) / SEQ, nblk = ((pm * 256) % SEQ) >> 8, h = hg - HG_MK;
                    float* kb = kmean + (size_t)((b * 8 + h) * 32 + nblk) * 64 + (wc & 1) * 32 + 8 * eq;
#pragma unroll
                    for (int n = 0; n < 2; ++n) {
                        f32x4 s = acc[0][bj][0][n];
#pragma unroll
                        for (int m = 1; m < 4; ++m) s += acc[0][bj][m][n];
#pragma unroll
                        for (int m = 0; m < 4; ++m) s += acc[1][bj][m][n];
#pragma unroll
                        for (int o = 1; o < 16; o <<= 1) {
                            s[0] += __shfl_xor(s[0], o);
                            s[1] += __shfl_xor(s[1], o);
                            s[2] += __shfl_xor(s[2], o);
                            s[3] += __shfl_xor(s[3], o);
                        }
                        if (er == 0) {
                            float* d = kb + 4 * n;
                            unsafeAtomicAdd(d + 0, s[0]);
                            unsafeAtomicAdd(d + 1, s[1]);
                            unsafeAtomicAdd(d + 2, s[2]);
                            unsafeAtomicAdd(d + 3, s[3]);
                        }
                    }
                }
            }
        } else if (wc == 0) {
#pragma unroll
            for (int n = 0; n < 2; ++n) {
                const int gc = 8 * eq + 4 * n;
                if (gc < 24) {
#pragma unroll
                    for (int ai = 0; ai < 2; ++ai)
#pragma unroll
                        for (int m = 0; m < 4; ++m) {
                            const f32x4 a = acc[ai][0][m][n];
                            const int row = pm * 256 + ai * 128 + wr * 64 + m * 16 + er;
                            f32x4 sg;
                            sg[0] = 1.0f / (1.0f + __expf(-a[0]));
                            sg[1] = 1.0f / (1.0f + __expf(-a[1]));
                            sg[2] = 1.0f / (1.0f + __expf(-a[2]));
                            sg[3] = 1.0f / (1.0f + __expf(-a[3]));
                            *(f32x4*)(gates + (size_t)row * 24 + gc) = sg;
                        }
                }
            }
        }
    });
    __syncthreads();
}

__device__ __forceinline__ void f_outproj(const Params& p, unsigned char* shm) {
    unsigned char* wsb = (unsigned char*)p.ws;
    const bf16_t* mixb = (const bf16_t*)(wsb + WS_MIXB);
    const bf16_t* btout = (const bf16_t*)(wsb + WS_BTOUT);
    const int tid = threadIdx.x, wid = __builtin_amdgcn_readfirstlane(tid >> 6), lane = tid & 63, wr = wid >> 2, wc = wid & 3;
    gemm256_stream((LAS unsigned char*)shm,
        [&](int i, const char*& A, const char*& B, unsigned (&va)[2][2], const GPiece& pc) __attribute__((always_inline)) {
            const int it = xcd_unit(blockIdx.x + i * gridDim.x, (NTOK / 256) * 4);
            if (it < 0) return false;
            const int pm = it >> 2, pn = it & 3;
            A = (const char*)mixb;
            B = (const char*)(btout + (size_t)pn * 256 * DM);
#pragma unroll
            for (int h = 0; h < 2; ++h)
#pragma unroll
                for (int j = 0; j < 2; ++j) va[h][j] = (unsigned)((pm * 256 + h * 128 + pc.R[j]) * DM + pc.C[j]) * 2u;
            return true;
        },
        [&](int i, f32x4 (&acc)[2][2][4][2]) __attribute__((always_inline)) {
        const int it = xcd_unit(blockIdx.x + i * gridDim.x, (NTOK / 256) * 4);
        const int pm = it >> 2, pn = it & 3;
        int le = lane;
        asm volatile("" : "+v"(le));
        const int er = le & 15, eq = le >> 4;
#pragma unroll
        for (int ai = 0; ai < 2; ++ai)
#pragma unroll
            for (int m = 0; m < 4; ++m) {
                const size_t rowoff = (size_t)(pm * 256 + ai * 128 + wr * 64 + m * 16 + er) * DM;
#pragma unroll
                for (int bj = 0; bj < 2; ++bj)
#pragma unroll
                    for (int n = 0; n < 2; ++n) {
                        const size_t o = rowoff + pn * 256 + bj * 128 + wc * 32 + 8 * eq + 4 * n;
                        const f32x4 xv = *(const f32x4*)(p.x + o);
                        *(f32x4*)(p.out + o) = xv + acc[ai][bj][m][n];
                    }
            }
    });
    __syncthreads();
}

__device__ __forceinline__ float wave_max_fast(float x) {
    x = fmaxf(x, __int_as_float(__builtin_amdgcn_mov_dpp(__float_as_int(x), 0xB1, 0xF, 0xF, true)));
    x = fmaxf(x, __int_as_float(__builtin_amdgcn_mov_dpp(__float_as_int(x), 0x4E, 0xF, 0xF, true)));
    x = fmaxf(x, __int_as_float(__builtin_amdgcn_mov_dpp(__float_as_int(x), 0x141, 0xF, 0xF, true)));
    x = fmaxf(x, __int_as_float(__builtin_amdgcn_mov_dpp(__float_as_int(x), 0x140, 0xF, 0xF, true)));
    x = fmaxf(x, __shfl_xor(x, 16));
    x = fmaxf(x, __shfl_xor(x, 32));
    return x;
}
__device__ __forceinline__ void f_router(const Params& p, unsigned char* shm) {
    const int tid = threadIdx.x, lane = tid & 63, w = tid >> 6;
    unsigned char* wsb = (unsigned char*)p.ws;
    float* Wl = (float*)shm;
    int* hist = (int*)(shm + 147456);
    bf16_t* hb = (bf16_t*)(wsb + WS_H);
    int* sele = (int*)(wsb + WS_SELE);
    float* selw = (float*)(wsb + WS_SELW);
    int* selr = (int*)(wsb + WS_SELR);
    int* bcnt = (int*)(wsb + WS_BCNT);
    __syncthreads();
    for (int idx = tid; idx < 8192; idx += 512) {
        const int k = idx >> 3, e4 = idx & 7;
        const float4 v = ((const float4*)p.w_router)[idx];
        const int rho = ((k >> 8) * 4 + (k & 3)) * 64 + ((k >> 2) & 63);
        *(float4*)(Wl + rho * 36 + e4 * 4) = v;
    }
    const float bias = p.b_router[lane >> 1];
    const float4* g4 = (const float4*)p.ffn_g;
    float4 gv[4];
#pragma unroll
    for (int j = 0; j < 4; ++j) gv[j] = g4[lane + 64 * j];
    for (int c = blockIdx.x; c < NTOK / 128; c += gridDim.x) {
        __syncthreads();
        if (tid < 32) hist[tid] = 0;
        __syncthreads();
        float4 vn[4];
        {
            const float4* xr = (const float4*)(p.out + (size_t)(c * 128 + w * 16) * DM);
#pragma unroll
            for (int j = 0; j < 4; ++j) vn[j] = xr[lane + 64 * j];
        }
        for (int rr = 0; rr < 16; ++rr) {
            const int row = c * 128 + w * 16 + rr;
            float4 v[4];
#pragma unroll
            for (int j = 0; j < 4; ++j) v[j] = vn[j];
            if (rr + 1 < 16) {
                const float4* xr = (const float4*)(p.out + (size_t)(row + 1) * DM);
#pragma unroll
                for (int j = 0; j < 4; ++j) vn[j] = xr[lane + 64 * j];
            }
            float ss = 0.f;
#pragma unroll
            for (int j = 0; j < 4; ++j) ss += dot4(v[j], v[j]);
            ss = wave_sum(ss);
            const float r = 1.0f / sqrtf(ss * (1.0f / DM) + 1e-5f);
            u32x2* o = (u32x2*)(hb + (size_t)row * DM);
#pragma unroll
            for (int j = 0; j < 4; ++j) {
                v[j] = make_float4(v[j].x * r * gv[j].x, v[j].y * r * gv[j].y, v[j].z * r * gv[j].z, v[j].w * r * gv[j].w);
                u32x2 ov;
                ov.x = pk_bf16(v[j].x, v[j].y);
                ov.y = pk_bf16(v[j].z, v[j].w);
                o[lane + 64 * j] = ov;
            }
            float lg[32];
#pragma unroll
            for (int e = 0; e < 32; ++e) lg[e] = 0.f;
#pragma unroll
            for (int j = 0; j < 4; ++j) {
                const float hv[4] = {v[j].x, v[j].y, v[j].z, v[j].w};
#pragma unroll
                for (int cc = 0; cc < 4; ++cc) {
                    const float4* wr = (const float4*)(Wl + ((j * 4 + cc) * 64 + lane) * 36);
#pragma unroll
                    for (int e4 = 0; e4 < 8; ++e4) {
                        const float4 wv = wr[e4];
                        lg[e4 * 4 + 0] += hv[cc] * wv.x;
                        lg[e4 * 4 + 1] += hv[cc] * wv.y;
                        lg[e4 * 4 + 2] += hv[cc] * wv.z;
                        lg[e4 * 4 + 3] += hv[cc] * wv.w;
                    }
                }
            }
#define RS_STEP(N, OFF, BIT)                                                                                           \
            {                                                                                                          \
                const bool up_ = (lane >> (BIT)) & 1;                                                                  \
                _Pragma("unroll") for (int i_ = 0; i_ < (N); ++i_) {                                                     \
                    const float send_ = up_ ? lg[i_] : lg[(N) + i_];                                                   \
                    const float keep_ = up_ ? lg[(N) + i_] : lg[i_];                                                   \
                    lg[i_] = keep_ + __shfl_xor(send_, (OFF));                                                         \
                }                                                                                                      \
            }
            RS_STEP(16, 32, 5)
            RS_STEP(8, 16, 4)
            RS_STEP(4, 8, 3)
            RS_STEP(2, 4, 2)
            RS_STEP(1, 2, 1)
#undef RS_STEP
            float val = lg[0] + __shfl_xor(lg[0], 1) + bias;
            float tv[4];
            int ti[4];
#pragma unroll
            for (int s = 0; s < 4; ++s) {
                const float mx = wave_max_fast(val);
                const unsigned long long bal = __ballot(val == mx);
                const int ln = __ffsll((long long)bal) - 1;
                tv[s] = mx;
                ti[s] = ln >> 1;
                if ((lane >> 1) == (ln >> 1)) val = -INFINITY;
            }
            const float e1 = __expf(tv[1] - tv[0]), e2 = __expf(tv[2] - tv[0]), e3 = __expf(tv[3] - tv[0]);
            const float inv = 1.0f / (1.0f + e1 + e2 + e3);
            if (lane == 0) {
                const float wv[4] = {inv, e1 * inv, e2 * inv, e3 * inv};
#pragma unroll
                for (int s = 0; s < 4; ++s) {
                    sele[row * 4 + s] = ti[s];
                    selw[row * 4 + s] = wv[s];
                    selr[row * 4 + s] = atomicAdd(&hist[ti[s]], 1);
                }
            }
        }
        __syncthreads();
        if (tid < 32) bcnt[c * 32 + tid] = hist[tid];
    }
    __syncthreads();
}

__device__ __forceinline__ void f_fill(const Params& p, unsigned char* shm) {
    const int tid = threadIdx.x;
    unsigned char* wsb = (unsigned char*)p.ws;
    const int* sele = (const int*)(wsb + WS_SELE);
    const float* selw = (const float*)(wsb + WS_SELW);
    const int* selr = (const int*)(wsb + WS_SELR);
    int* selp = (int*)(wsb + WS_SELP);
    const int* bcnt = (const int*)(wsb + WS_BCNT);
    int* gcnt = (int*)(wsb + WS_GCNT);
    int* rtok = (int*)(wsb + WS_RTOK);
    float* rw = (float*)(wsb + WS_RW);
    int* pa = (int*)shm;
    int* pb = pa + 512;
    int* tot = pb + 512;
    int* base = tot + 32;
    int* pstart = base + 32;
    for (int c = blockIdx.x; c < NTOK / 128; c += gridDim.x) {
        __syncthreads();
        {
            const int e = tid & 31, part = tid >> 5;
            int sa = 0, sb = 0;
            for (int cc = part * 16; cc < part * 16 + 16; ++cc) {
                const int v = bcnt[cc * 32 + e];
                sa += v;
                sb += (cc < c) ? v : 0;
            }
            pa[part * 32 + e] = sa;
            pb[part * 32 + e] = sb;
        }
        __syncthreads();
        if (tid < 32) {
            int sa = 0, sb = 0;
            for (int q = 0; q < 16; ++q) { sa += pa[q * 32 + tid]; sb += pb[q * 32 + tid]; }
            tot[tid] = sa;
            base[tid] = sb;
        }
        __syncthreads();
        if (tid == 0) {
            int a = 0;
            for (int e = 0; e < NE; ++e) { pstart[e] = a; a += ((tot[e] + 255) >> 8) << 8; }
            pstart[NE] = a;
        }
        __syncthreads();
        {
            const int i = c * 512 + tid;
            const int e = sele[i];
            const int pos = pstart[e] + base[e] + selr[i];
            rtok[pos] = i >> 2;
            rw[pos] = selw[i];
            selp[i] = pos;
        }
        if (c == 0) {
            if (tid < 32) gcnt[tid] = tot[tid];
            for (int e = 0; e < NE; ++e) {
                const int r0 = pstart[e] + tot[e], r1 = pstart[e + 1];
                for (int r = r0 + tid; r < r1; r += 512) { rtok[r] = 0; rw[r] = 0.f; }
            }
        }
    }
    __syncthreads();
}

__device__ __forceinline__ void f_build_tiles(const Params& p, int* tb) {
    const int* gcnt = (const int*)((unsigned char*)p.ws + WS_GCNT);
    __syncthreads();
    if (threadIdx.x == 0) {
        int a = 0, t = 0;
        for (int e = 0; e < NE; ++e) {
            tb[e] = a;
            tb[40 + e] = t;
            const int nt = (gcnt[e] + 255) >> 8;
            a += nt << 8;
            t += nt;
        }
        tb[32] = a;
        tb[40 + 32] = t;
    }
    __syncthreads();
}

__device__ __forceinline__ void f_up(const Params& p, unsigned char* shm) {
    unsigned char* wsb = (unsigned char*)p.ws;
    int* tb = (int*)(shm + GEMM_LDS_BYTES);
    f_build_tiles(p, tb);
    const int T = tb[40 + 32];
    const bf16_t* hb = (const bf16_t*)(wsb + WS_H);
    const bf16_t* btup = (const bf16_t*)(wsb + WS_BTUP);
    bf16_t* act = (bf16_t*)(wsb + WS_ACT);
    const int* rtok = (const int*)(wsb + WS_RTOK);
    const int tid = threadIdx.x, wid = __builtin_amdgcn_readfirstlane(tid >> 6), lane = tid & 63, wr = wid >> 2, wc = wid & 3;
    gemm256_stream((LAS unsigned char*)shm,
        [&](int i, const char*& A, const char*& B, unsigned (&va)[2][2], const GPiece& pc) __attribute__((always_inline)) {
            const int it = xcd_unit(blockIdx.x + i * gridDim.x, T * 8);
            if (it < 0) return false;
            const int vt = it >> 3, pn = it & 7;
            int e = 0;
            while (tb[40 + e + 1] <= vt) ++e;
            const int rowbase = tb[e] + (vt - tb[40 + e]) * 256;
            A = (const char*)hb;
            B = (const char*)(btup + ((size_t)e * DFF2 + pn * 256) * DM);
#pragma unroll
            for (int h = 0; h < 2; ++h)
#pragma unroll
                for (int j = 0; j < 2; ++j) va[h][j] = (unsigned)(rtok[rowbase + h * 128 + pc.R[j]] * DM + pc.C[j]) * 2u;
            return true;
        },
        [&](int i, f32x4 (&acc)[2][2][4][2]) __attribute__((always_inline)) {
        const int it = xcd_unit(blockIdx.x + i * gridDim.x, T * 8);
        const int vt = it >> 3, pn = it & 7;
        int e = 0;
        while (tb[40 + e + 1] <= vt) ++e;
        const int rowbase = tb[e] + (vt - tb[40 + e]) * 256;
        int le = lane;
        asm volatile("" : "+v"(le));
        const int er = le & 15, eq = le >> 4;
        const float* bias = p.b_up + (size_t)e * DFF2;
        const int a0 = pn * 128 + wc * 32 + 8 * eq;
        float bg[8], bu[8];
        {
            const float4 q0 = *(const float4*)(bias + 2 * a0), q1 = *(const float4*)(bias + 2 * a0 + 4), q2 = *(const float4*)(bias + 2 * a0 + 8),
                         q3 = *(const float4*)(bias + 2 * a0 + 12);
            bg[0] = q0.x; bu[0] = q0.y; bg[1] = q0.z; bu[1] = q0.w; bg[2] = q1.x; bu[2] = q1.y; bg[3] = q1.z; bu[3] = q1.w;
            bg[4] = q2.x; bu[4] = q2.y; bg[5] = q2.z; bu[5] = q2.w; bg[6] = q3.x; bu[6] = q3.y; bg[7] = q3.z; bu[7] = q3.w;
        }
#pragma unroll
        for (int ai = 0; ai < 2; ++ai)
#pragma unroll
            for (int mm = 0; mm < 4; ++mm) {
                const int row = rowbase + ai * 128 + wr * 64 + mm * 16 + er;
                const f32x4 g0 = acc[ai][0][mm][0], g1 = acc[ai][0][mm][1], u0 = acc[ai][1][mm][0], u1 = acc[ai][1][mm][1];
                u32x4 ov;
                ov.x = pk_bf16(swiglu(g0[0] + bg[0], u0[0] + bu[0]), swiglu(g0[1] + bg[1], u0[1] + bu[1]));
                ov.y = pk_bf16(swiglu(g0[2] + bg[2], u0[2] + bu[2]), swiglu(g0[3] + bg[3], u0[3] + bu[3]));
                ov.z = pk_bf16(swiglu(g1[0] + bg[4], u1[0] + bu[4]), swiglu(g1[1] + bg[5], u1[1] + bu[5]));
                ov.w = pk_bf16(swiglu(g1[2] + bg[6], u1[2] + bu[6]), swiglu(g1[3] + bg[7], u1[3] + bu[7]));
                *(u32x4*)(act + (size_t)row * DM + a0) = ov;
            }
    });
    __syncthreads();
}

__device__ __forceinline__ void f_down(const Params& p, unsigned char* shm) {
    unsigned char* wsb = (unsigned char*)p.ws;
    int* tb = (int*)(shm + GEMM_LDS_BYTES);
    f_build_tiles(p, tb);
    const int T = tb[40 + 32];
    const bf16_t* act = (const bf16_t*)(wsb + WS_ACT);
    const bf16_t* btdn = (const bf16_t*)(wsb + WS_BTDN);
    bf16_t* yb = (bf16_t*)(wsb + WS_Y);
    const float* rw = (const float*)(wsb + WS_RW);
    const int tid = threadIdx.x, wid = __builtin_amdgcn_readfirstlane(tid >> 6), lane = tid & 63, wr = wid >> 2, wc = wid & 3;
    gemm256_stream((LAS unsigned char*)shm,
        [&](int i, const char*& A, const char*& B, unsigned (&va)[2][2], const GPiece& pc) __attribute__((always_inline)) {
            const int it = xcd_unit(blockIdx.x + i * gridDim.x, T * 4);
            if (it < 0) return false;
            const int vt = it >> 2, pn = it & 3;
            int e = 0;
            while (tb[40 + e + 1] <= vt) ++e;
            const int rowbase = tb[e] + (vt - tb[40 + e]) * 256;
            A = (const char*)(act + (size_t)rowbase * DM);
            B = (const char*)(btdn + ((size_t)e * DM + pn * 256) * DM);
#pragma unroll
            for (int h = 0; h < 2; ++h)
#pragma unroll
                for (int j = 0; j < 2; ++j) va[h][j] = (unsigned)((h * 128 + pc.R[j]) * DM + pc.C[j]) * 2u;
            return true;
        },
        [&](int i, f32x4 (&acc)[2][2][4][2]) __attribute__((always_inline)) {
        const int it = xcd_unit(blockIdx.x + i * gridDim.x, T * 4);
        const int vt = it >> 2, pn = it & 3;
        int e = 0;
        while (tb[40 + e + 1] <= vt) ++e;
        const int rowbase = tb[e] + (vt - tb[40 + e]) * 256;
        int le = lane;
        asm volatile("" : "+v"(le));
        const int er = le & 15, eq = le >> 4;
        const float* bias = p.b_down + (size_t)e * DM;
#pragma unroll
        for (int bj = 0; bj < 2; ++bj) {
            const int col = pn * 256 + bj * 128 + wc * 32 + 8 * eq;
            const float4 b0 = *(const float4*)(bias + col), b1 = *(const float4*)(bias + col + 4);
#pragma unroll
            for (int ai = 0; ai < 2; ++ai)
#pragma unroll
                for (int mm = 0; mm < 4; ++mm) {
                    const int row = rowbase + ai * 128 + wr * 64 + mm * 16 + er;
                    const float wgt = rw[row];
                    const f32x4 x0 = acc[ai][bj][mm][0], x1 = acc[ai][bj][mm][1];
                    u32x4 ov;
                    ov.x = pk_bf16((x0[0] + b0.x) * wgt, (x0[1] + b0.y) * wgt);
                    ov.y = pk_bf16((x0[2] + b0.z) * wgt, (x0[3] + b0.w) * wgt);
                    ov.z = pk_bf16((x1[0] + b1.x) * wgt, (x1[1] + b1.y) * wgt);
                    ov.w = pk_bf16((x1[2] + b1.z) * wgt, (x1[3] + b1.w) * wgt);
                    *(u32x4*)(yb + (size_t)row * DM + col) = ov;
                }
        }
    });
    __syncthreads();
}


__device__ __forceinline__ void f_final(const Params& p) {
    const int lane = threadIdx.x & 63, w = threadIdx.x >> 6;
    unsigned char* wsb = (unsigned char*)p.ws;
    const bf16_t* yb = (const bf16_t*)(wsb + WS_Y);
    const int* selp = (const int*)(wsb + WS_SELP);
    const float4* g4 = (const float4*)p.final_g;
    for (int row0 = blockIdx.x * 8 + w; row0 < NTOK / 2; row0 += gridDim.x * 8) {
        float4 v[2][4];
        u32x2 yv[2][4][4];
#pragma unroll
        for (int q = 0; q < 2; ++q) {
            const int row = row0 + q * (NTOK / 2);
            const float4* xr = (const float4*)(p.out + (size_t)row * DM);
            const int4 sp = *(const int4*)(selp + row * 4);
            const int pos[4] = {sp.x, sp.y, sp.z, sp.w};
#pragma unroll
            for (int j = 0; j < 4; ++j) v[q][j] = xr[lane + 64 * j];
#pragma unroll
            for (int k = 0; k < 4; ++k) {
                const u32x2* yr = (const u32x2*)(yb + (size_t)pos[k] * DM);
#pragma unroll
                for (int j = 0; j < 4; ++j) yv[q][k][j] = yr[lane + 64 * j];
            }
        }
#pragma unroll
        for (int q = 0; q < 2; ++q) {
            const int row = row0 + q * (NTOK / 2);
#pragma unroll
            for (int k = 0; k < 4; ++k)
#pragma unroll
                for (int j = 0; j < 4; ++j) {
                    v[q][j].x += bf_lo(yv[q][k][j].x);
                    v[q][j].y += bf_hi(yv[q][k][j].x);
                    v[q][j].z += bf_lo(yv[q][k][j].y);
                    v[q][j].w += bf_hi(yv[q][k][j].y);
                }
            float ss = 0.f;
#pragma unroll
            for (int j = 0; j < 4; ++j) ss += dot4(v[q][j], v[q][j]);
            ss = wave_sum(ss);
            const float r = 1.0f / sqrtf(ss * (1.0f / DM) + 1e-5f);
            float4* xo = (float4*)(p.out + (size_t)row * DM);
#pragma unroll
            for (int j = 0; j < 4; ++j) {
                const float4 g = g4[lane + 64 * j];
                xo[lane + 64 * j] = make_float4(v[q][j].x * r * g.x, v[q][j].y * r * g.y, v[q][j].z * r * g.z, v[q][j].w * r * g.w);
            }
        }
    }
}
#define XB_TMO      128
#define XB_XCNT(j)  (256  + 64 * (j))
#define XB_XSUB(j)  (1280 + 64 * (j))
#define XB_XGEN(j)  (2304 + 64 * (j))
#define XB_TOP      3328
#define XB_TOPGEN   3392
#define XCD_BAR_WORDS 3456
#define XB_SPIN_CAP (1u << 18)

__device__ __forceinline__ unsigned xb_ld(unsigned* p)              { return __hip_atomic_load(p, __ATOMIC_RELAXED, __HIP_MEMORY_SCOPE_AGENT); }
__device__ __forceinline__ unsigned xb_add(unsigned* p, unsigned v) { return __hip_atomic_fetch_add(p, v, __ATOMIC_RELAXED, __HIP_MEMORY_SCOPE_AGENT); }
__device__ __forceinline__ unsigned xb_xcc_id() { return (unsigned)__builtin_amdgcn_s_getreg((3 << 11) | 20) & 0xFu; }
#define XB_SPIN(cond, bar) do { unsigned _sp = 0; while (cond) { __builtin_amdgcn_s_sleep(1); \
    if ((++_sp & 255u) == 0u) { if (xb_ld(&(bar)[XB_TMO])) break; if (_sp > XB_SPIN_CAP) { atomicAdd(&(bar)[XB_TMO], 1u); break; } } } } while (0)

struct XcdBarrier {
    unsigned* bar; unsigned x;
    volatile LAS unsigned* st;
};

__device__ __forceinline__ XcdBarrier xcd_barrier_post(unsigned* bar, volatile LAS unsigned* st) {
    XcdBarrier b; b.bar = bar; b.x = xb_xcc_id(); b.st = st;
    if (threadIdx.x == 0) (void)xb_add(&bar[XB_XCNT(b.x)], 1u);
    return b;
}
__device__ __forceinline__ void xcd_barrier_complete(unsigned* bar, unsigned x, unsigned& nloc, unsigned& nx) {
    const unsigned G = gridDim.x * gridDim.y * gridDim.z;
    unsigned sum, cnt, mine, sp = 0u;
    for (;;) {
        sum = 0u; cnt = 0u; mine = 0u;
#pragma unroll
        for (unsigned j = 0; j < 16; ++j) { const unsigned c = xb_ld(&bar[XB_XCNT(j)]); sum += c; cnt += (c > 0u) ? 1u : 0u; mine = (j == x) ? c : mine; }
        if (sum == G) break;
        __builtin_amdgcn_s_sleep(1);
        if ((++sp & 255u) == 0u) { if (xb_ld(&bar[XB_TMO])) break; if (sp > XB_SPIN_CAP) { atomicAdd(&bar[XB_TMO], 1u); break; } }
    }
    nloc = mine > 0u ? mine : 1u; nx = cnt > 0u ? cnt : 1u;
}

__device__ __forceinline__ void xcd_barrier(const XcdBarrier& b) {
    asm volatile("s_waitcnt vmcnt(0)" ::: "memory");
    __syncthreads();
    if (threadIdx.x == 0) {
        unsigned* bar = b.bar;
        __builtin_amdgcn_s_waitcnt(0);
        unsigned nloc = b.st[0], nx = b.st[1];
        if (nloc == 0u) { xcd_barrier_complete(bar, b.x, nloc, nx); b.st[0] = nloc; b.st[1] = nx; }
        const unsigned old = xb_add(&bar[XB_XSUB(b.x)], 1u);
        const unsigned gen = old / nloc;
        if (old + 1u == (gen + 1u) * nloc) {
            __builtin_amdgcn_fence(__ATOMIC_RELEASE, "agent");
            asm volatile("s_waitcnt vmcnt(0)" ::: "memory");
            const unsigned og = xb_add(&bar[XB_TOP], 1u);
            const unsigned tg = og / nx;
            if (og + 1u == (tg + 1u) * nx) xb_add(&bar[XB_TOPGEN], 1u);
            else XB_SPIN(xb_ld(&bar[XB_TOPGEN]) == tg, bar);
            __builtin_amdgcn_fence(__ATOMIC_ACQUIRE, "agent");
            xb_add(&bar[XB_XGEN(b.x)], 1u);
            asm volatile("s_waitcnt vmcnt(0)" ::: "memory");
        } else {
            XB_SPIN(xb_ld(&bar[XB_XGEN(b.x)]) == gen, bar);
            __builtin_amdgcn_fence(__ATOMIC_ACQUIRE, "agent");
            asm volatile("s_waitcnt vmcnt(0)" ::: "memory");
        }
    }
    __syncthreads();
}


constexpr int NFPHASE = 11;
__global__ void __launch_bounds__(512) fast_kernel(Params p) {
    extern __shared__ __attribute__((aligned(16))) unsigned char shm[];
    cg::grid_group grid = cg::this_grid();
    const int lo = p.ph_lo, hi = p.ph_hi;
    if (lo < -1) grid.sync();
    XcdBarrier bar;
    if (hi - lo > 1) {
        volatile LAS unsigned* st = (volatile LAS unsigned*)((LAS unsigned char*)shm + (FAST_LDS_BYTES - 16));
        if (threadIdx.x < 4) st[threadIdx.x] = 0u;
        __syncthreads();
        bar = xcd_barrier_post((unsigned*)((unsigned char*)p.ws + WS_BAR), st);
    }
#define F_IN(k) (lo <= (k) && (k) < hi)
#define F_SYNC(k) do { if (F_IN(k) && F_IN((k) + 1)) xcd_barrier(bar); } while (0)
    if (F_IN(0)) f_prologue(p, shm);
    F_SYNC(0);
    if (F_IN(1)) f_inproj(p, shm);
    F_SYNC(1);
    if (F_IN(2)) { f_cmp(p, shm); f_moba_gate(p, shm); }
    F_SYNC(2);
    if (F_IN(3)) f_attn(p, shm);
    F_SYNC(3);
    if (F_IN(4)) f_moba_merge(p);
    F_SYNC(4);
    if (F_IN(5)) f_outproj(p, shm);
    F_SYNC(5);
    if (F_IN(6)) f_router(p, shm);
    F_SYNC(6);
    if (F_IN(7)) f_fill(p, shm);
    F_SYNC(7);
    if (F_IN(8)) f_up(p, shm);
    F_SYNC(8);
    if (F_IN(9)) f_down(p, shm);
    F_SYNC(9);
    if (F_IN(10)) f_final(p);
}

#ifndef PROBE_KIND
#define PROBE_KIND -1
#endif
#if PROBE_KIND >= 0
__global__ void __launch_bounds__(512) probe_kernel(Params p) {
    extern __shared__ __attribute__((aligned(16))) unsigned char shm[];
#if PROBE_KIND >= 100
    f_probe_gather<PROBE_KIND - 100>(p, shm);
#else
    f_probe_nsa<PROBE_KIND>(p, shm);
#endif
}
#endif

#ifndef MULTI_LAUNCH
#define MULTI_LAUNCH 0
#endif

extern "C" void kernel_launch(void* const* d_in, const int* in_sizes, int n_in, void* d_out, int out_size, void* d_ws,
                              size_t ws_size, hipStream_t stream) {
    static int grid = 0;
    if (!grid) {
        int dev = 0, cus = 0, per_cu = 0;
        (void)hipGetDevice(&dev);
        (void)hipDeviceGetAttribute(&cus, hipDeviceAttributeMultiprocessorCount, dev);
        (void)hipFuncSetAttribute((const void*)fast_kernel, hipFuncAttributeMaxDynamicSharedMemorySize, FAST_LDS_BYTES);
        (void)hipOccupancyMaxActiveBlocksPerMultiprocessor(&per_cu, fast_kernel, 512, FAST_LDS_BYTES);
        if (per_cu < 1) fprintf(stderr, "kernel_launch: occupancy query reports %d blocks per CU\n", per_cu);
        grid = cus;
        if (ws_size < WS_END) fprintf(stderr, "kernel_launch: workspace too small: %zu < %zu\n", ws_size, (size_t)WS_END);
    }
    Params p{};
    p.x = (const float*)d_in[0];
    p.attn_g = (const float*)d_in[1];
    p.w_in = (const float*)d_in[2];
    p.pe_k = (const float*)d_in[3];
    p.pe_v = (const float*)d_in[4];
    p.w1k = (const float*)d_in[5];
    p.w2k = (const float*)d_in[6];
    p.w1v = (const float*)d_in[7];
    p.w2v = (const float*)d_in[8];
    p.w_out = (const float*)d_in[9];
    p.ffn_g = (const float*)d_in[10];
    p.w_router = (const float*)d_in[11];
    p.b_router = (const float*)d_in[12];
    p.w_up = (const float*)d_in[13];
    p.b_up = (const float*)d_in[14];
    p.w_down = (const float*)d_in[15];
    p.b_down = (const float*)d_in[16];
    p.final_g = (const float*)d_in[17];
    p.out = (float*)d_out;
    p.ws = (float*)d_ws;
#if MULTI_LAUNCH
#ifndef PROBE_DUP_MASK
#define PROBE_DUP_MASK 0
#endif
    for (int ph = 0; ph < NFPHASE; ++ph) {
        const int reps = ((PROBE_DUP_MASK >> ph) & 1) ? 2 : 1;
        for (int r = 0; r < reps; ++r) {
            p.ph_lo = ph;
            p.ph_hi = ph + 1;
            hipLaunchKernelGGL(fast_kernel, dim3(grid), dim3(512), FAST_LDS_BYTES, stream, p);
        }
#if PROBE_KIND >= 0
        if (ph == 3) {
            static bool pset = false;
            if (!pset) { (void)hipFuncSetAttribute((const void*)probe_kernel, hipFuncAttributeMaxDynamicSharedMemorySize, FAST_LDS_BYTES); pset = true; }
            hipLaunchKernelGGL(probe_kernel, dim3(grid), dim3(512), FAST_LDS_BYTES, stream, p);
        }
#endif
    }
#else
    p.ph_lo = 0;
    p.ph_hi = NFPHASE;
    (void)hipMemsetAsync((unsigned char*)d_ws + WS_BAR, 0, 16384, stream);
    void* args[] = {&p};
    hipError_t e = hipLaunchCooperativeKernel((void*)fast_kernel, dim3(grid), dim3(512), args, FAST_LDS_BYTES, stream);
    if (e != hipSuccess) fprintf(stderr, "cooperative launch failed: %s (grid %d)\n", hipGetErrorString(e), grid);
#endif
}
```

```cpp
#include <hip/hip_runtime.h>
#include <hip/hip_cooperative_groups.h>
#include <cstdio>
#include <cstdint>
namespace cg = cooperative_groups;

constexpr int NB = 4, SEQ = 8192, DM = 1024, NTOK = NB * SEQ;
constexpr int INC = 2840;
constexpr int NCMP = 511, NCMPP = 512;
constexpr int NE = 32, TOPK = 4, NK = NTOK * TOPK;
constexpr int DFF2 = 2048;
constexpr int NIN_PAD = 3072;
constexpr int PMAX = 139264;
constexpr float LOG2E = 1.4426950408889634f;
constexpr float QSCALE = 0.125f * LOG2E;
constexpr int HG_MQ = 0, HG_MK = 8, HG_MV = 16, HG_NQ = 24, HG_KC = 32, HG_VC = 34, HG_KS = 36, HG_VS = 38, HG_KW = 40,
              HG_VW = 42, NHG = 44;

constexpr size_t WS_BTUP  = 0;
constexpr size_t WS_BTDN  = WS_BTUP + (size_t)NE * DFF2 * DM * 2;
constexpr size_t WS_BTOUT = WS_BTDN + (size_t)NE * DM * DM * 2;
constexpr size_t WS_BTIN  = WS_BTOUT + (size_t)DM * DM * 2;
constexpr size_t WS_XN    = WS_BTIN + (size_t)NIN_PAD * DM * 2;
constexpr size_t WS_H     = WS_XN;
constexpr size_t WS_PT    = WS_XN + (size_t)NTOK * DM * 2;
constexpr size_t WS_GATES = WS_PT + (size_t)NHG * NTOK * 64 * 2;
constexpr size_t WS_KMEAN = WS_GATES + (size_t)NTOK * 24 * 4;
constexpr size_t WS_KCMP  = WS_KMEAN + 65536 * 4;
constexpr size_t WS_VCMP  = WS_KCMP + 262144 * 2;
constexpr size_t WS_MIXB  = WS_VCMP + 262144 * 2;
constexpr size_t WS_ACT   = WS_PT;
constexpr size_t WS_Y     = WS_ACT + (size_t)PMAX * DM * 2;
static_assert(WS_MIXB + (size_t)NTOK * DM * 2 <= WS_Y, "act overlay");
constexpr size_t WS_PART  = WS_Y;
constexpr size_t WS_MLIST = WS_PART + (size_t)NTOK * 8 * 544;
constexpr size_t WS_MCNT  = WS_MLIST + (size_t)1024 * 8192 * 2;
static_assert(WS_MCNT + 4096 <= WS_Y + (size_t)PMAX * DM * 2, "MoBA scratch overlays y");
constexpr size_t WS_SELE  = WS_Y + (size_t)PMAX * DM * 2;
constexpr size_t WS_SELW  = WS_SELE + (size_t)NK * 4;
constexpr size_t WS_SELR  = WS_SELW + (size_t)NK * 4;
constexpr size_t WS_SELP  = WS_SELR + (size_t)NK * 4;
constexpr size_t WS_BCNT  = WS_SELP + (size_t)NK * 4;
constexpr size_t WS_GCNT  = WS_BCNT + 256 * 32 * 4;
constexpr size_t WS_RTOK  = WS_GCNT + 256;
constexpr size_t WS_RW    = WS_RTOK + (size_t)PMAX * 4;
constexpr size_t WS_C1    = WS_RW + (size_t)PMAX * 4;
constexpr size_t WS_W1T   = WS_C1 + 512;
constexpr size_t WS_W2T   = WS_W1T + 2 * 64 * 2048 * 2;
constexpr size_t WS_BAR   = WS_W2T + 2 * 64 * 64 * 2;
constexpr size_t WS_C1P   = WS_BAR + 16384;
constexpr size_t WS_X1B   = WS_C1P + 64 * 128 * 4;
constexpr size_t WS_RWT   = WS_X1B + (size_t)NTOK * DM * 2;
constexpr size_t WS_END   = WS_RWT + 2 * 32 * 1024 * 2;

struct Params {
    const float *x, *attn_g, *w_in, *pe_k, *pe_v, *w1k, *w2k, *w1v, *w2v, *w_out, *ffn_g, *w_router, *b_router,
        *w_up, *b_up, *w_down, *b_down, *final_g;
    float* out;
    float* ws;
    int ph_lo, ph_hi;
};

typedef unsigned short bf16_t;
typedef short bf16x8 __attribute__((ext_vector_type(8)));
typedef float f32x4 __attribute__((ext_vector_type(4)));
typedef float f32x16 __attribute__((ext_vector_type(16)));
typedef unsigned u32x4 __attribute__((ext_vector_type(4)));
typedef unsigned u32x2 __attribute__((ext_vector_type(2)));

typedef float f32x2 __attribute__((ext_vector_type(2)));
typedef __bf16 bf16x2v __attribute__((ext_vector_type(2)));
__device__ __forceinline__ unsigned pk_bf16(float lo, float hi) {
    const f32x2 f = {lo, hi};
    return __builtin_bit_cast(unsigned, __builtin_convertvector(f, bf16x2v));
}
__device__ __forceinline__ float bf_lo(unsigned u) { return __uint_as_float(u << 16); }
__device__ __forceinline__ float bf_hi(unsigned u) { return __uint_as_float(u & 0xffff0000u); }
__device__ __forceinline__ float bf2f(bf16_t b) { return __uint_as_float((unsigned)b << 16); }

#ifndef MULTI_LAUNCH
#define MULTI_LAUNCH 0
#endif
#if MULTI_LAUNCH
#define PROBE_SKIP_EPI do { if (p.ph_lo >= 100 && p.ph_lo < 200 && acc[0][0][0][0][0] != 1234.567f) return; } while (0)
#else
#define PROBE_SKIP_EPI do { } while (0)
#endif
#ifdef PROBE_TIME_SUB
#ifndef PROBE_TIME_SUB_END
#define PROBE_TIME_SUB_END (PROBE_TIME_SUB + 1)
#endif
__shared__ long long probe_ts[4];
#endif
#ifdef PROBE_NSEC
#define N_TICK(j) do { if (threadIdx.x == 0) { const long long tn_ = wall_clock64(); if (probe_ts[3] == PROBE_NSEC) probe_ts[1] += tn_ - probe_ts[2]; probe_ts[2] = tn_; probe_ts[3] = (j); } } while (0)
#else
#define N_TICK(j) do { } while (0)
#endif
__device__ __forceinline__ void lane_swap32(float& a, float& b) {
    const u32x2 r = __builtin_amdgcn_permlane32_swap(__float_as_uint(a), __float_as_uint(b), false, false);
    a = __uint_as_float(r.x); b = __uint_as_float(r.y);
}
__device__ __forceinline__ void lane_swap16(float& a, float& b) {
    const u32x2 r = __builtin_amdgcn_permlane16_swap(__float_as_uint(a), __float_as_uint(b), false, false);
    a = __uint_as_float(r.x); b = __uint_as_float(r.y);
}
#define DPP_F(x, ctrl) __int_as_float(__builtin_amdgcn_mov_dpp(__float_as_int(x), (ctrl), 0xF, 0xF, true))
__device__ __forceinline__ float lane_xor8(float x) { return DPP_F(x, 0x128); }
__device__ __forceinline__ float lane_xor4(float x) { const float y = DPP_F(x, 0x141); return DPP_F(y, 0x1B); }
__device__ __forceinline__ float lane_xor2(float x) { return DPP_F(x, 0x4E); }
__device__ __forceinline__ float lane_xor1(float x) { return DPP_F(x, 0xB1); }
__device__ __forceinline__ float sum_xor32(float x) { float a = x, b = x; lane_swap32(a, b); return a + b; }
__device__ __forceinline__ float max_xor32(float x) { float a = x, b = x; lane_swap32(a, b); return fmaxf(a, b); }
__device__ __forceinline__ float wave_sum(float v) {
    v += lane_xor1(v);
    v += lane_xor2(v);
    v += DPP_F(v, 0x141);
    v += DPP_F(v, 0x140);
    { float a = v, b = v; lane_swap16(a, b); v = a + b; }
    { float a = v, b = v; lane_swap32(a, b); v = a + b; }
    return v;
}
__device__ __forceinline__ float wave_max(float v) {
#pragma unroll
    for (int o = 32; o > 0; o >>= 1) v = fmaxf(v, __shfl_xor(v, o));
    return v;
}
__device__ __forceinline__ int wave_min_i(int v) {
#pragma unroll
    for (int o = 32; o > 0; o >>= 1) v = min(v, __shfl_xor(v, o));
    return v;
}
__device__ __forceinline__ float dot4(float4 a, float4 b) { return a.x * b.x + a.y * b.y + a.z * b.z + a.w * b.w; }

__device__ __forceinline__ float gelu_tanh(float x) {
    return 0.5f * x * (1.0f + tanhf(0.7978845608028654f * (x + 0.044715f * x * x * x)));
}
__device__ __forceinline__ float swiglu(float g, float u) {
    g = fminf(g, 7.0f);
    u = fminf(fmaxf(u, -7.0f), 7.0f);
    return g * __builtin_amdgcn_rcpf(1.0f + __builtin_amdgcn_exp2f((-1.702f * LOG2E) * g)) * (u + 1.0f);
}


constexpr int G_BM = 256, G_BK = 64, G_HALF = 128, G_HT = G_HALF * G_BK;
constexpr int GEMM_LDS_BYTES = 8 * G_HT * 2;
constexpr int FAST_LDS_BYTES = 163584;
__device__ __forceinline__ int lds_byte(int r, int c) {
    const int st = (r >> 4) * 2 + (c >> 5), rr = r & 15, cc = c & 31, ob = rr * 64 + cc * 2;
    return st * 1024 + (ob ^ (((ob >> 9) & 1) << 5));
}
__device__ __forceinline__ void stage_rc(int b, int& R, int& C) {
    const int st = b / 1024, sb = b % 1024, swz = sb ^ (((sb >> 9) & 1) << 5);
    R = (st >> 1) * 16 + swz / 64;
    C = (st & 1) * 32 + (swz % 64) / 2;
}

#define LAS __attribute__((address_space(3)))
template <class ARow>
__device__ __forceinline__ void gemm256_tile(LAS unsigned char* lds, const char* __restrict__ Abase, ARow arow,
                                             const char* __restrict__ Bbase, int K, f32x4 (&acc)[2][2][4][2]) {
    constexpr int HTB = G_HT * 2;
#define SA(b, h) (((b) * 2 + (h)) * HTB)
#define SB(b, h) ((4 + (b) * 2 + (h)) * HTB)
#define STAGE_A(b, h, kt)                                                                                              \
    do {                                                                                                               \
        _Pragma("unroll") for (int _i = 0; _i < 2; ++_i) __builtin_amdgcn_global_load_lds(                              \
            (const unsigned*)(Abase + (size_t)(kt) * (G_BK * 2) + voffA[h][_i]),                                       \
            (LAS unsigned*)(lds + SA(b, h) + ldsw + _i * 8192), 16, 0, 0);                                              \
    } while (0)
#define STAGE_B(b, h, kt)                                                                                              \
    do {                                                                                                               \
        _Pragma("unroll") for (int _i = 0; _i < 2; ++_i) __builtin_amdgcn_global_load_lds(                              \
            (const unsigned*)(Bbase + (size_t)(h) * hstep + (size_t)(kt) * (G_BK * 2) + voffB[_i]),                    \
            (LAS unsigned*)(lds + SB(b, h) + ldsw + _i * 8192), 16, 0, 0);                                              \
    } while (0)
#define LDA(dst, b, h)                                                                                                 \
    do {                                                                                                               \
        _Pragma("unroll") for (int m = 0; m < 4; ++m) _Pragma("unroll") for (int k = 0; k < 2; ++k) dst[m][k] =         \
            *(const LAS bf16x8*)(lds + SA(b, h) + aoff + m * 2048 + k * 1024);                                          \
    } while (0)
#define LDB(dst, b, h)                                                                                                 \
    do {                                                                                                               \
        _Pragma("unroll") for (int n = 0; n < 2; ++n) _Pragma("unroll") for (int k = 0; k < 2; ++k) dst[n][k] =         \
            *(const LAS bf16x8*)(lds + SB(b, h) + boff + n * 2048 + k * 1024);                                          \
    } while (0)
#define MMA(ai, bj, Af, Bf)                                                                                            \
    do {                                                                                                               \
        __builtin_amdgcn_s_setprio(1);                                                                                 \
        _Pragma("unroll") for (int m = 0; m < 4; ++m) _Pragma("unroll") for (int n = 0; n < 2; ++n)                     \
            _Pragma("unroll") for (int k = 0; k < 2; ++k) acc[ai][bj][m][n] =                                           \
                __builtin_amdgcn_mfma_f32_16x16x32_bf16(Bf[n][k], Af[m][k], acc[ai][bj][m][n], 0, 0, 0);               \
        __builtin_amdgcn_s_setprio(0);                                                                                 \
    } while (0)
#define WAIT_V(n) asm volatile("s_waitcnt vmcnt(" #n ")" ::: "memory")
#define WAIT_L(n) asm volatile("s_waitcnt lgkmcnt(" #n ")" ::: "memory")
#define BAR __builtin_amdgcn_s_barrier()
#define SCHED __builtin_amdgcn_sched_barrier(0)
    const int tid = threadIdx.x, wid = __builtin_amdgcn_readfirstlane(tid >> 6), lane = tid & 63, wr = wid >> 2, wc = wid & 3,
              fr = lane & 15, fq = lane >> 4;
    unsigned voffA[2][2], voffB[2];
#pragma unroll
    for (int i = 0; i < 2; ++i) {
        int R, C;
        stage_rc(tid * 16 + i * 8192, R, C);
        voffB[i] = (unsigned)(R * K + C) * 2u;
#pragma unroll
        for (int h = 0; h < 2; ++h) voffA[h][i] = (unsigned)arow(h * G_HALF + R) + (unsigned)C * 2u;
    }
    const size_t hstep = (size_t)G_HALF * K * 2;
    const unsigned ldsw = (unsigned)wid * 1024u;
    const int aoff = lds_byte(wr * 64 + fr, fq * 8), boff = lds_byte(wc * 32 + fr, fq * 8);
#pragma unroll
    for (int ai = 0; ai < 2; ++ai)
#pragma unroll
        for (int bj = 0; bj < 2; ++bj)
#pragma unroll
            for (int m = 0; m < 4; ++m)
#pragma unroll
                for (int n = 0; n < 2; ++n) acc[ai][bj][m][n] = (f32x4){0.f, 0.f, 0.f, 0.f};
    bf16x8 At[4][2], B0[2][2], B1[2][2];
    const int nt = K / G_BK;
    STAGE_B(0, 0, 0); STAGE_A(0, 0, 0);
    STAGE_B(0, 1, 0); STAGE_A(0, 1, 0);
    if (wr == 1) BAR;
    WAIT_V(4); BAR;
    STAGE_B(1, 0, 1); STAGE_A(1, 0, 1); STAGE_B(1, 1, 1);
    WAIT_V(6); BAR;
    for (int t = 0; t < nt - 2; t += 2) {
        LDB(B0, 0, 0); SCHED; LDA(At, 0, 0); STAGE_A(1, 1, t + 1);
        WAIT_L(8); BAR; WAIT_L(0); MMA(0, 0, At, B0); BAR; SCHED;
        LDB(B1, 0, 1); STAGE_B(0, 0, t + 2);
        BAR; WAIT_L(0); MMA(0, 1, At, B1); BAR;
        LDA(At, 0, 1); STAGE_A(0, 0, t + 2);
        BAR; WAIT_L(0); MMA(1, 0, At, B0); BAR; SCHED;
        STAGE_B(0, 1, t + 2);
        WAIT_V(6); BAR; MMA(1, 1, At, B1); BAR;
        LDB(B0, 1, 0); SCHED; LDA(At, 1, 0); STAGE_A(0, 1, t + 2);
        WAIT_L(8); BAR; WAIT_L(0); MMA(0, 0, At, B0); BAR; SCHED;
        LDB(B1, 1, 1); STAGE_B(1, 0, t + 3);
        BAR; WAIT_L(0); MMA(0, 1, At, B1); BAR;
        LDA(At, 1, 1); STAGE_A(1, 0, t + 3);
        BAR; WAIT_L(0); MMA(1, 0, At, B0); BAR; SCHED;
        STAGE_B(1, 1, t + 3);
        WAIT_V(6); BAR; MMA(1, 1, At, B1); BAR;
    }
    {
        LDB(B0, 0, 0); LDA(At, 0, 0); STAGE_A(1, 1, nt - 1);
        BAR; WAIT_L(0); MMA(0, 0, At, B0); BAR;
        LDB(B1, 0, 1); BAR; WAIT_L(0); MMA(0, 1, At, B1); BAR;
        LDA(At, 0, 1); WAIT_V(4); BAR; WAIT_L(0); MMA(1, 0, At, B0); MMA(1, 1, At, B1); BAR;
    }
    {
        LDB(B0, 1, 0); LDA(At, 1, 0); WAIT_V(2); BAR; WAIT_L(0); MMA(0, 0, At, B0); BAR;
        LDB(B1, 1, 1); WAIT_V(0); BAR; WAIT_L(0); MMA(0, 1, At, B1); BAR;
        LDA(At, 1, 1); BAR; WAIT_L(0); MMA(1, 0, At, B0); MMA(1, 1, At, B1); BAR;
    }
    if (wr == 0) BAR;
#undef SA
#undef SB
#undef STAGE_A
#undef STAGE_B
#undef LDA
#undef LDB
#undef MMA
}

struct GPiece { int R[2], C[2]; };
template <bool ALIGN_EPI = true, class UnitFn, class Epi>
__device__ __forceinline__ void gemm256_stream(LAS unsigned char* lds, UnitFn unit, Epi epi) {
    constexpr int K = 1024, nt = K / G_BK;
    constexpr int HTB = G_HT * 2;
#define SA(b, h) (((b) * 2 + (h)) * HTB)
#define SB(b, h) ((4 + (b) * 2 + (h)) * HTB)
#define STG(bufoff, gbase, voff)                                                                                       \
    do {                                                                                                               \
        _Pragma("unroll") for (int _i = 0; _i < 2; ++_i) __builtin_amdgcn_global_load_lds(                              \
            (const unsigned*)((gbase) + (voff)[_i]), (LAS unsigned*)(lds + (bufoff) + ldsw + _i * 8192), 16, 0, 0);     \
    } while (0)
#define LDA(dst, b, h)                                                                                                 \
    do {                                                                                                               \
        _Pragma("unroll") for (int m = 0; m < 4; ++m) _Pragma("unroll") for (int k = 0; k < 2; ++k) dst[m][k] =         \
            *(const LAS bf16x8*)(lds + SA(b, h) + aoff + m * 2048 + k * 1024);                                          \
    } while (0)
#define LDB(dst, b, h)                                                                                                 \
    do {                                                                                                               \
        _Pragma("unroll") for (int n = 0; n < 2; ++n) _Pragma("unroll") for (int k = 0; k < 2; ++k) dst[n][k] =         \
            *(const LAS bf16x8*)(lds + SB(b, h) + boff + n * 2048 + k * 1024);                                          \
    } while (0)
#define MMA(ai, bj, Af, Bf)                                                                                            \
    do {                                                                                                               \
        __builtin_amdgcn_s_setprio(1);                                                                                 \
        _Pragma("unroll") for (int m = 0; m < 4; ++m) _Pragma("unroll") for (int n = 0; n < 2; ++n)                     \
            _Pragma("unroll") for (int k = 0; k < 2; ++k) acc[ai][bj][m][n] =                                           \
                __builtin_amdgcn_mfma_f32_16x16x32_bf16(Bf[n][k], Af[m][k], acc[ai][bj][m][n], 0, 0, 0);               \
        __builtin_amdgcn_s_setprio(0);                                                                                 \
    } while (0)
    const int tid = threadIdx.x, wid = __builtin_amdgcn_readfirstlane(tid >> 6), lane = tid & 63, wr = wid >> 2, wc = wid & 3,
              fr = lane & 15, fq = lane >> 4;
    GPiece pc;
    unsigned voffB[2];
#pragma unroll
    for (int i = 0; i < 2; ++i) {
        stage_rc(tid * 16 + i * 8192, pc.R[i], pc.C[i]);
        const int rho = pc.R[i] & 31, pn_ = rho >> 4, pi_ = rho & 15;
        const int Rb = (pc.R[i] & ~31) + 8 * (pi_ >> 2) + 4 * pn_ + (pi_ & 3);
        voffB[i] = (unsigned)(Rb * K + pc.C[i]) * 2u;
    }
    constexpr size_t hstep = (size_t)G_HALF * K * 2, kstep = G_BK * 2;
    const unsigned ldsw = (unsigned)wid * 1024u;
    const int aoff = lds_byte(wr * 64 + fr, fq * 8), boff = lds_byte(wc * 32 + fr, fq * 8);
    const char *cA, *cB, *nA, *nB;
    unsigned vc[2][2], vn[2][2];
    if (!unit(0, cA, cB, vc, pc)) return;
    f32x4 acc[2][2][4][2];
#pragma unroll
    for (int ai = 0; ai < 2; ++ai)
#pragma unroll
        for (int bj = 0; bj < 2; ++bj)
#pragma unroll
            for (int m = 0; m < 4; ++m)
#pragma unroll
                for (int n = 0; n < 2; ++n) acc[ai][bj][m][n] = (f32x4){0.f, 0.f, 0.f, 0.f};
    bf16x8 At[4][2], B0[2][2], B1[2][2];
    STG(SB(0, 0), cB, voffB); STG(SB(0, 1), cB + hstep, voffB); STG(SA(0, 0), cA, vc[0]); STG(SA(0, 1), cA, vc[1]);
    if (wr == 1) BAR;
    WAIT_V(2); BAR;
    STG(SB(1, 0), cB + kstep, voffB); STG(SA(1, 0), cA + kstep, vc[0]); STG(SB(1, 1), cB + hstep + kstep, voffB);
    WAIT_V(6); BAR;
    for (int ui = 0;; ++ui) {
        const bool has_next = unit(ui + 1, nA, nB, vn, pc);
        if (!has_next) {
            nA = cA; nB = cB;
#pragma unroll
            for (int h = 0; h < 2; ++h)
#pragma unroll
                for (int i = 0; i < 2; ++i) vn[h][i] = vc[h][i];
        }
        for (int t = 0; t < nt; t += 2) {
            const bool last = (t == nt - 2);
            const char* a1 = cA + (size_t)(t + 1) * kstep;
            const char* a2 = last ? nA : cA + (size_t)(t + 2) * kstep;
            const char* b2 = last ? nB : cB + (size_t)(t + 2) * kstep;
            const char* a3 = a2 + kstep;
            const char* b3 = b2 + kstep;
            unsigned v2[2][2];
#pragma unroll
            for (int h = 0; h < 2; ++h)
#pragma unroll
                for (int i = 0; i < 2; ++i) v2[h][i] = last ? vn[h][i] : vc[h][i];
            STG(SA(1, 1), a1, vc[1]); LDB(B0, 0, 0); LDB(B1, 0, 1); SCHED; LDA(At, 0, 0);
            WAIT_V(8); WAIT_L(0); BAR; MMA(0, 0, At, B0); MMA(0, 1, At, B1); BAR; SCHED;
            STG(SB(0, 0), b2, voffB); STG(SB(0, 1), b2 + hstep, voffB); STG(SA(0, 0), a2, v2[0]); LDA(At, 0, 1);
            WAIT_V(8); WAIT_L(0); BAR; MMA(1, 0, At, B0); MMA(1, 1, At, B1); BAR; SCHED;
            STG(SA(0, 1), a2, v2[1]); LDB(B0, 1, 0); LDB(B1, 1, 1); SCHED; LDA(At, 1, 0);
            WAIT_V(8); WAIT_L(0); BAR; MMA(0, 0, At, B0); MMA(0, 1, At, B1); BAR; SCHED;
            STG(SB(1, 0), b3, voffB); STG(SB(1, 1), b3 + hstep, voffB); STG(SA(1, 0), a3, v2[0]); LDA(At, 1, 1);
            WAIT_V(8); WAIT_L(0); BAR; MMA(1, 0, At, B0); MMA(1, 1, At, B1); BAR; SCHED;
        }
        if (ALIGN_EPI) { if (wr == 0) BAR; }
        epi(ui, acc);
        if (!has_next) break;
#pragma unroll
        for (int ai = 0; ai < 2; ++ai)
#pragma unroll
            for (int bj = 0; bj < 2; ++bj)
#pragma unroll
                for (int m = 0; m < 4; ++m)
#pragma unroll
                    for (int n = 0; n < 2; ++n) acc[ai][bj][m][n] = (f32x4){0.f, 0.f, 0.f, 0.f};
        cA = nA; cB = nB;
#pragma unroll
        for (int h = 0; h < 2; ++h)
#pragma unroll
            for (int i = 0; i < 2; ++i) vc[h][i] = vn[h][i];
        if (ALIGN_EPI) { if (wr == 1) BAR; }
    }
    WAIT_V(0);
    if (!ALIGN_EPI) { if (wr == 0) BAR; }
    BAR;
#undef SA
#undef SB
#undef STG
#undef LDA
#undef LDB
#undef MMA
}

__device__ __forceinline__ int xcd_unit(int seq, int total) {
    if (seq >= total) return -1;
    const int q = total >> 3, rem = total & 7, x = seq & 7, off = seq >> 3;
    return (x < rem ? x * (q + 1) : rem * (q + 1) + (x - rem) * q) + off;
}

constexpr int CV_T = 64 * 65 + 32;
struct CvRegs { float4 v[4][2]; };
template <class Item>
__device__ __forceinline__ void cv_fetch(CvRegs& rg, int it0, int nitems, Item item) {
    const int tid = threadIdx.x;
#pragma unroll
    for (int j = 0; j < 4; ++j) {
        const float* W; bf16_t* WT; int K, ncols, ldw, k0, n0;
        const int it = (it0 + j < nitems) ? it0 + j : nitems - 1;
        item(it, W, K, ncols, ldw, WT, k0, n0);
#pragma unroll
        for (int i = 0; i < 2; ++i) {
            const int idx = tid + i * 512, kr = idx >> 4, c4 = idx & 15;
            float4 v = make_float4(0.f, 0.f, 0.f, 0.f);
            if (n0 + c4 * 4 < ncols) v = *(const float4*)(W + (size_t)(k0 + kr) * ldw + n0 + c4 * 4);
            rg.v[j][i] = v;
        }
    }
}
__device__ __forceinline__ void cv_to_lds(float* T, const CvRegs& rg) {
    const int tid = threadIdx.x;
#pragma unroll
    for (int j = 0; j < 4; ++j)
#pragma unroll
        for (int i = 0; i < 2; ++i) {
            const int idx = tid + i * 512, kr = idx >> 4, c4 = idx & 15;
            float* Tj = T + j * CV_T;
            Tj[(c4 * 4 + 0) * 65 + kr] = rg.v[j][i].x;
            Tj[(c4 * 4 + 1) * 65 + kr] = rg.v[j][i].y;
            Tj[(c4 * 4 + 2) * 65 + kr] = rg.v[j][i].z;
            Tj[(c4 * 4 + 3) * 65 + kr] = rg.v[j][i].w;
        }
}
template <class ORow>
__device__ __forceinline__ void cv_store(const float* T, int K, bf16_t* __restrict__ WT, ORow orow, int k0, int n0) {
    const int tid = threadIdx.x;
    const int n = tid >> 3, c = tid & 7;
    const float* sp = T + n * 65 + c * 8;
    u32x4 o;
    o.x = pk_bf16(sp[0], sp[1]);
    o.y = pk_bf16(sp[2], sp[3]);
    o.z = pk_bf16(sp[4], sp[5]);
    o.w = pk_bf16(sp[6], sp[7]);
    const int r = orow(n0 + n);
    *(u32x4*)(WT + (size_t)r * K + k0 + c * 8) = o;
}
template <class Item, class ORow>
__device__ __forceinline__ void cv_run(float* T, int nitems, Item item, ORow orow) {
    const int step = gridDim.x * 4;
    int it0 = blockIdx.x * 4;
    if (it0 >= nitems) return;
    CvRegs cur;
    cv_fetch(cur, it0, nitems, item);
    for (; it0 < nitems; it0 += step) {
        __syncthreads();
        cv_to_lds(T, cur);
        if (it0 + step < nitems) cv_fetch(cur, it0 + step, nitems, item);
        __syncthreads();
#pragma unroll
        for (int j = 0; j < 4; ++j)
            if (it0 + j < nitems) {
                const float* W; bf16_t* WT; int K, ncols, ldw, k0, n0;
                item(it0 + j, W, K, ncols, ldw, WT, k0, n0);
                cv_store(T + j * CV_T, K, WT, orow, k0, n0);
            }
    }
}

constexpr int AT_KP = 144, AT_VP = 136, AT_KB = 64 * AT_KP, AT_VB = 64 * AT_VP, AT_BUF = AT_KB + AT_VB;
constexpr int AT_IMPA = 36864, AT_IMPB = AT_IMPA + 32768, AT_KMS = AT_IMPA;
constexpr int AT_OLDS = 36864, AT_OP = 68;
constexpr int AT_SELB = AT_OLDS + 256 * AT_OP * 4;
constexpr int AT_CAND = AT_SELB + 1024;
constexpr int AT_TOKM = AT_CAND + 4096;
constexpr int AT_MREF = AT_TOKM + 1024;
constexpr int AT_LACC = AT_MREF + 1024;
constexpr int AT_JLIST = AT_LACC + 1024;
constexpr int AT_QS = AT_JLIST + 1024;
static_assert(AT_QS + 256 * 144 <= FAST_LDS_BYTES - 16, "attention LDS map");
constexpr int AT_TAIL = AT_QS + 256 * 144;
static_assert(AT_TAIL + 2064 + 64 <= FAST_LDS_BYTES - 16, "attention queue tables");
constexpr int AT_CTMAP = AT_TAIL + 2176;
static_assert(AT_CTMAP + 8192 <= FAST_LDS_BYTES - 16, "compaction table");
__device__ __forceinline__ int nth_set_bit64(unsigned lo, unsigned hi, int n) {
    const int cl = __popc(lo);
    unsigned m = lo;
    int base = 0;
    if (n >= cl) { n -= cl; m = hi; base = 32; }
    int pos = 0;
#pragma unroll
    for (int sh = 16; sh >= 1; sh >>= 1) {
        const int cnt = __popc((m >> pos) & ((1u << sh) - 1u));
        if (n >= cnt) { n -= cnt; pos += sh; }
    }
    return base + pos;
}
#define MFMA32(a, b, c) __builtin_amdgcn_mfma_f32_32x32x16_bf16(a, b, c, 0, 0, 0)
#define CREG(reg) (((reg) & 3) + 8 * ((reg) >> 2))

__device__ __forceinline__ float quad_sum(float x) {
    x += __int_as_float(__builtin_amdgcn_mov_dpp(__float_as_int(x), 0xB1, 0xF, 0xF, true));
    x += __int_as_float(__builtin_amdgcn_mov_dpp(__float_as_int(x), 0x4E, 0xF, 0xF, true));
    return x;
}
struct AtStage { u32x4 k, v; };
__device__ __forceinline__ void at_load(AtStage& st, const bf16_t* __restrict__ Kg, const bf16_t* __restrict__ Vg, bool with_v, unsigned koff, unsigned voff) {
    st.k = *(const u32x4*)((const char*)Kg + koff);
    if (with_v) st.v = *(const u32x4*)((const char*)Vg + voff);
}
__device__ __forceinline__ void at_store(const AtStage& st, LAS unsigned char* buf, bool with_v) {
    const int tid = threadIdx.x;
    *(LAS u32x4*)(buf + (tid >> 3) * AT_KP + (tid & 7) * 16) = st.k;
    if (with_v) {
        LAS unsigned short* vt = (LAS unsigned short*)(buf + AT_KB + (tid >> 6) * 8 * AT_VP + (tid & 63) * 2);
        vt[0 * (AT_VP / 2)] = (unsigned short)(st.v.x & 0xffffu);
        vt[1 * (AT_VP / 2)] = (unsigned short)(st.v.x >> 16);
        vt[2 * (AT_VP / 2)] = (unsigned short)(st.v.y & 0xffffu);
        vt[3 * (AT_VP / 2)] = (unsigned short)(st.v.y >> 16);
        vt[4 * (AT_VP / 2)] = (unsigned short)(st.v.z & 0xffffu);
        vt[5 * (AT_VP / 2)] = (unsigned short)(st.v.z >> 16);
        vt[6 * (AT_VP / 2)] = (unsigned short)(st.v.w & 0xffffu);
        vt[7 * (AT_VP / 2)] = (unsigned short)(st.v.w >> 16);
    }
}
__device__ __forceinline__ void at_scores(LAS const unsigned char* buf, const bf16x8 (&qf)[4], float ramp, float base0, float base1,
                                          f32x16& s0, f32x16& s1) {
    const int lane = threadIdx.x & 63, r = lane & 31, h = lane >> 5;
    LAS const unsigned char* kb = buf + r * AT_KP + h * 16;
    {
        const float b0 = fmaf(ramp, (float)(4 * h), base0), b1 = fmaf(ramp, (float)(4 * h), base1);
#pragma unroll
        for (int i = 0; i < 16; ++i) { s0[i] = fmaf(ramp, (float)CREG(i), b0); s1[i] = fmaf(ramp, (float)CREG(i), b1); }
    }
#pragma unroll
    for (int kk = 0; kk < 4; ++kk) {
        const bf16x8 k0 = *(LAS const bf16x8*)(kb + kk * 32);
        const bf16x8 k1 = *(LAS const bf16x8*)(kb + 32 * AT_KP + kk * 32);
        s0 = MFMA32(k0, qf[kk], s0);
        s1 = MFMA32(k1, qf[kk], s1);
    }
}
__device__ __forceinline__ bf16x8 at_pack8(const f32x16& P, int s2) {
    u32x4 w;
    if (s2 == 0) { w.x = pk_bf16(P[0], P[1]); w.y = pk_bf16(P[2], P[3]); w.z = pk_bf16(P[4], P[5]); w.w = pk_bf16(P[6], P[7]); }
    else         { w.x = pk_bf16(P[8], P[9]); w.y = pk_bf16(P[10], P[11]); w.z = pk_bf16(P[12], P[13]); w.w = pk_bf16(P[14], P[15]); }
    return __builtin_bit_cast(bf16x8, w);
}
__device__ __forceinline__ void at_pv(LAS const unsigned char* buf, const f32x16& p0, const f32x16& p1, f32x16& o0, f32x16& o1) {
    const int lane = threadIdx.x & 63, r = lane & 31, h = lane >> 5;
    LAS const unsigned char* vb = buf + AT_KB + r * AT_VP + h * 8;
#pragma unroll
    for (int half = 0; half < 2; ++half) {
#pragma unroll
        for (int s2 = 0; s2 < 2; ++s2) {
            const bf16x8 pf = at_pack8(half ? p1 : p0, s2);
            const int ko = (32 * half + 16 * s2) * 2;
            const u32x2 a0 = *(LAS const u32x2*)(vb + ko), a1 = *(LAS const u32x2*)(vb + ko + 16);
            const u32x2 b0 = *(LAS const u32x2*)(vb + 32 * AT_VP + ko), b1 = *(LAS const u32x2*)(vb + 32 * AT_VP + ko + 16);
            const u32x4 va = {a0.x, a0.y, a1.x, a1.y}, vbb = {b0.x, b0.y, b1.x, b1.y};
            o0 = MFMA32(__builtin_bit_cast(bf16x8, va), pf, o0);
            o1 = MFMA32(__builtin_bit_cast(bf16x8, vbb), pf, o1);
        }
    }
}
__device__ __forceinline__ float at_rowmax(const f32x16& s0, const f32x16& s1) {
    float m = fmaxf(s0[0], s1[0]);
#pragma unroll
    for (int i = 1; i < 16; ++i) m = fmaxf(m, fmaxf(s0[i], s1[i]));
    return max_xor32(m);
}
#define AT_MASK_LE(S0, S1, lim)  do { _Pragma("unroll") for (int i_ = 0; i_ < 16; ++i_) { if (CREG(i_) > (lim)) S0[i_] = -INFINITY; if (CREG(i_) + 32 > (lim)) S1[i_] = -INFINITY; } } while (0)
#define AT_MASK_GE(S0, S1, lo)   do { _Pragma("unroll") for (int i_ = 0; i_ < 16; ++i_) { if (CREG(i_) < (lo)) S0[i_] = -INFINITY; if (CREG(i_) + 32 < (lo)) S1[i_] = -INFINITY; } } while (0)
__device__ __forceinline__ float at_exp(f32x16& s0, f32x16& s1, float mref) {
    float l = 0.f;
#pragma unroll
    for (int i = 0; i < 16; ++i) {
        s0[i] = __builtin_amdgcn_exp2f(s0[i] - mref);
        s1[i] = __builtin_amdgcn_exp2f(s1[i] - mref);
        l += s0[i] + s1[i];
    }
    return l;
}

#define AT_PIN(x) asm volatile("" : "+v"(x))
template <int PV = 0>
__device__ __forceinline__ void at_tile_pipe(LAS const unsigned char* buf, const bf16x8 (&qf)[4], float ramp, float base0, float mrow,
                                             float sl2x32, float& l, f32x16& o0, f32x16& o1) {
    const int lane = threadIdx.x & 63, r = lane & 31, h = lane >> 5;
    LAS const unsigned char* kb = buf + r * AT_KP + h * 16;
    LAS const unsigned char* vb = buf + AT_KB + r * AT_VP + h * 8;
    const float c0 = fmaf(ramp, (float)(4 * h), base0 - mrow), c1 = c0 + sl2x32;
    f32x16 s0, s1;
#pragma unroll
    for (int i = 0; i < 16; ++i) { s0[i] = fmaf(ramp, (float)CREG(i), c0); s1[i] = fmaf(ramp, (float)CREG(i), c1); }
    bf16x8 kf[4];
#pragma unroll
    for (int kk = 0; kk < 4; ++kk) kf[kk] = *(LAS const bf16x8*)(kb + kk * 32);
#pragma unroll
    for (int kk = 0; kk < 4; ++kk) if (PV != 3) s0 = MFMA32(kf[kk], qf[kk], s0);
#pragma unroll
    for (int kk = 0; kk < 4; ++kk) kf[kk] = *(LAS const bf16x8*)(kb + 32 * AT_KP + kk * 32);
    __builtin_amdgcn_sched_barrier(0);
    u32x2 vf[4][2];
    float ls = 0.f;
#pragma unroll
    for (int kk = 0; kk < 4; ++kk) {
        if (PV != 3) s1 = MFMA32(kf[kk], qf[kk], s1); else s1[kk] += __builtin_bit_cast(f32x4, kf[kk])[0];
        vf[kk][0] = *(LAS const u32x2*)(vb + (kk & 1) * 32 * AT_VP + (16 * (kk >> 1)) * 2);
        vf[kk][1] = *(LAS const u32x2*)(vb + (kk & 1) * 32 * AT_VP + (16 * (kk >> 1)) * 2 + 16);
#pragma unroll
        for (int q = 0; q < 4; ++q) { s0[4 * kk + q] = (PV == 1) ? s0[4 * kk + q] * 0.5f : __builtin_amdgcn_exp2f(s0[4 * kk + q]); ls += s0[4 * kk + q]; }
        AT_PIN(ls);
        __builtin_amdgcn_sched_barrier(0);
    }
    const bf16x8 pa = at_pack8(s0, 0), pb = at_pack8(s0, 1);
#pragma unroll
    for (int st = 0; st < 4; ++st) {
        const int s2 = st >> 1, dt = st & 1;
        const u32x4 vv = {vf[st][0].x, vf[st][0].y, vf[st][1].x, vf[st][1].y};
        if (PV == 2) { o0[st] += __builtin_bit_cast(f32x4, vv)[0] + __builtin_bit_cast(f32x4, s2 ? pb : pa)[1]; }
        else if (dt == 0) o0 = MFMA32(__builtin_bit_cast(bf16x8, vv), s2 ? pb : pa, o0);
        else         o1 = MFMA32(__builtin_bit_cast(bf16x8, vv), s2 ? pb : pa, o1);
        vf[st][0] = *(LAS const u32x2*)(vb + dt * 32 * AT_VP + (32 + 16 * s2) * 2);
        vf[st][1] = *(LAS const u32x2*)(vb + dt * 32 * AT_VP + (32 + 16 * s2) * 2 + 16);
#pragma unroll
        for (int q = 0; q < 4; ++q) { s1[4 * st + q] = (PV == 1) ? s1[4 * st + q] * 0.5f : __builtin_amdgcn_exp2f(s1[4 * st + q]); ls += s1[4 * st + q]; }
        AT_PIN(ls);
        __builtin_amdgcn_sched_barrier(0);
    }
    const bf16x8 pc = at_pack8(s1, 0), pd = at_pack8(s1, 1);
#pragma unroll
    for (int st = 0; st < 4; ++st) {
        const int s2 = st >> 1, dt = st & 1;
        const u32x4 vv = {vf[st][0].x, vf[st][0].y, vf[st][1].x, vf[st][1].y};
        if (PV == 2) { o1[st] += __builtin_bit_cast(f32x4, vv)[0] + __builtin_bit_cast(f32x4, s2 ? pd : pc)[1]; }
        else if (dt == 0) o0 = MFMA32(__builtin_bit_cast(bf16x8, vv), s2 ? pd : pc, o0);
        else         o1 = MFMA32(__builtin_bit_cast(bf16x8, vv), s2 ? pd : pc, o1);
    }
    l += ls;
}

#define AT_PASS(Kg, Vg, WITHV, NTILE, ROW, ...)                                                                        \
    {                                                                                                                  \
        AtStage st0_, st1_;                                                                                            \
        const int nt_ = (NTILE);                                                                                       \
        unsigned koff_ = (threadIdx.x >> 3) * 128 + (threadIdx.x & 7) * 16, voff_ = (threadIdx.x & 63) * 128 + (threadIdx.x >> 6) * 16; \
        asm volatile("" : "+v"(koff_), "+v"(voff_));     \
        __syncthreads();                                                                                               \
        at_load(st0_, (Kg) + (size_t)(ROW(0)) * 64, (Vg) + (size_t)(ROW(0)) * 64, WITHV, koff_, voff_);                 \
        at_store(st0_, lds, WITHV);                                                                                    \
        { const int i1_ = nt_ > 1 ? 1 : 0; at_load(st1_, (Kg) + (size_t)(ROW(i1_)) * 64, (Vg) + (size_t)(ROW(i1_)) * 64, WITHV, koff_, voff_); } \
        __syncthreads();                                                                                               \
        for (int i0_ = 0; i0_ < nt_; i0_ += 2) {                                                                       \
            {                                                                                                          \
                const int i = i0_;                                                                                     \
                LAS unsigned char* buf = lds;                                                                          \
                { const int in_ = (i + 2 < nt_) ? i + 2 : nt_ - 1;     \
                  at_load(st0_, (Kg) + (size_t)(ROW(in_)) * 64, (Vg) + (size_t)(ROW(in_)) * 64, WITHV, koff_, voff_); }        \
                do { __VA_ARGS__ } while (0);                                                                          \
                if (i + 1 < nt_) at_store(st1_, lds + AT_BUF, WITHV);                                                  \
                __syncthreads();                                                                                       \
            }                                                                                                          \
            if (i0_ + 1 < nt_) {                                                                                       \
                const int i = i0_ + 1;                                                                                 \
                LAS unsigned char* buf = lds + AT_BUF;                                                                 \
                { const int in_ = (i + 2 < nt_) ? i + 2 : nt_ - 1;                                                     \
                  at_load(st1_, (Kg) + (size_t)(ROW(in_)) * 64, (Vg) + (size_t)(ROW(in_)) * 64, WITHV, koff_, voff_); }        \
                do { __VA_ARGS__ } while (0);                                                                          \
                if (i + 1 < nt_) at_store(st0_, lds, WITHV);                                                           \
                __syncthreads();                                                                                       \
            }                                                                                                          \
        }                                                                                                              \
    }

#define AT_PASS4_STEP(SETL, SETS, BUFC, BUFN, ...)                                                                     \
            {                                                                                                          \
                LAS unsigned char* buf = lds + (BUFC);                                                                 \
                { const int in_ = (i + 4 < nt_) ? i + 4 : nt_ - 1;     \
                  at_load(SETL, Kg4_ + (size_t)(ROW4_(in_)) * 64, Vg4_ + (size_t)(ROW4_(in_)) * 64, true, koff_, voff_); } \
                do { __VA_ARGS__ } while (0);                                                                          \
                if (i + 1 < nt_) at_store(SETS, lds + (BUFN), true);                                                   \
                __syncthreads();                                                                                       \
            }
#define AT_PASS4(Kg, Vg, NTILE, ...)                                                                                   \
    {                                                                                                                  \
        AtStage s0_, s1_, s2_, s3_;                                                                                    \
        const int nt_ = (NTILE);                                                                                       \
        const bf16_t* Kg4_ = (Kg); const bf16_t* Vg4_ = (Vg);                                                          \
        unsigned koff_ = (threadIdx.x >> 3) * 128 + (threadIdx.x & 7) * 16, voff_ = (threadIdx.x & 63) * 128 + (threadIdx.x >> 6) * 16; \
        asm volatile("" : "+v"(koff_), "+v"(voff_));                                                                   \
        __syncthreads();                                                                                               \
        at_load(s0_, Kg4_ + (size_t)(ROW4_(0)) * 64, Vg4_ + (size_t)(ROW4_(0)) * 64, true, koff_, voff_);               \
        { const int i1_ = nt_ > 1 ? 1 : nt_ - 1; at_load(s1_, Kg4_ + (size_t)(ROW4_(i1_)) * 64, Vg4_ + (size_t)(ROW4_(i1_)) * 64, true, koff_, voff_); } \
        { const int i2_ = nt_ > 2 ? 2 : nt_ - 1; at_load(s2_, Kg4_ + (size_t)(ROW4_(i2_)) * 64, Vg4_ + (size_t)(ROW4_(i2_)) * 64, true, koff_, voff_); } \
        { const int i3_ = nt_ > 3 ? 3 : nt_ - 1; at_load(s3_, Kg4_ + (size_t)(ROW4_(i3_)) * 64, Vg4_ + (size_t)(ROW4_(i3_)) * 64, true, koff_, voff_); } \
        at_store(s0_, lds, true);                                                                                      \
        __syncthreads();                                                                                               \
        for (int i0_ = 0; i0_ < nt_; i0_ += 4) {                                                                       \
            { const int i = i0_; AT_PASS4_STEP(s0_, s1_, 0, AT_BUF, __VA_ARGS__) }                                      \
            if (i0_ + 1 < nt_) { const int i = i0_ + 1; AT_PASS4_STEP(s1_, s2_, AT_BUF, 0, __VA_ARGS__) }               \
            if (i0_ + 2 < nt_) { const int i = i0_ + 2; AT_PASS4_STEP(s2_, s3_, 0, AT_BUF, __VA_ARGS__) }               \
            if (i0_ + 3 < nt_) { const int i = i0_ + 3; AT_PASS4_STEP(s3_, s0_, AT_BUF, 0, __VA_ARGS__) }               \
        }                                                                                                              \
    }

template <int PM = 0>
__device__ __forceinline__ void nsa_item(const Params& p, unsigned char* shm, int b, int g, int c) {
    LAS unsigned char* lds = (LAS unsigned char*)shm;
    unsigned char* wsb = (unsigned char*)p.ws;
    const bf16_t* pt = (const bf16_t*)(wsb + WS_PT);
    int tid = threadIdx.x;
    asm volatile("" : "+v"(tid));
    const int lane = tid & 63, w = __builtin_amdgcn_readfirstlane(tid >> 6), r = lane & 31, h = lane >> 5;
    const int tokl = 8 * w + (r >> 2), head = r & 3, hq = 4 * g + head, t = 64 * c + tokl, tok = b * SEQ + t;
    const float sl2 = exp2f(-(float)(hq + 1)) * LOG2E;
    const float ramp = sl2;
    bf16x8 qf[4];
    {
        const bf16_t* qrow = pt + ((size_t)(HG_NQ + hq) * NTOK + tok) * 64 + 8 * h;
#pragma unroll
        for (int kk = 0; kk < 4; ++kk) qf[kk] = *(const bf16x8*)(qrow + 16 * kk);
    }
    const float* gl = (const float*)(wsb + WS_GATES);
#define GATE_(br, dst) float dst; { int go_ = tok * 24 + hq * 3 + (br); asm volatile("" : "+v"(go_)); dst = gl[go_]; }
    f32x16 R0, R1;
#pragma unroll
    for (int i = 0; i < 16; ++i) { R0[i] = 0.f; R1[i] = 0.f; }
    LAS float* impA = (LAS float*)(lds + AT_IMPA);
    LAS float* impB = (LAS float*)(lds + AT_IMPB);
    LAS unsigned* selb = (LAS unsigned*)(lds + AT_SELB);

    N_TICK(0);
    if (!(PM & 1)) {
        const bf16_t* Kc = (const bf16_t*)(wsb + WS_KCMP) + (size_t)(b * 2 + g) * NCMPP * 64;
        const bf16_t* Vc = (const bf16_t*)(wsb + WS_VCMP) + (size_t)(b * 2 + g) * NCMPP * 64;
        const int ntile = (4 * c + 3 + 63) >> 6;
        const int imax = (t >= 31) ? ((t - 31) >> 4) : -1;
        const float ramp16 = sl2 * 16.0f;
        float m = -INFINITY, l = 0.f;
#define ROW_(_i) (64 * (_i))
        AT_PASS(Kc, Vc, false, ntile, ROW_,
            f32x16 s0, s1;
            const float base0 = sl2 * (float)(16 * 64 * i + 31 - 64 * c), base1 = base0 + sl2 * 512.0f;
            at_scores(buf, qf, ramp16, base0, base1, s0, s1);
            if (64 * i + 63 > 4 * c - 2) {
                const int lim = imax - 64 * i - 4 * h;
                AT_MASK_LE(s0, s1, lim);
            }
            const float tm = at_rowmax(s0, s1);
            const float mn = fmaxf(m, tm);
            if (mn > -INFINITY) {
                l *= __builtin_amdgcn_exp2f(m - mn);
                l += at_exp(s0, s1, mn);
                m = mn;
            }
        )
        N_TICK(1);
        l = sum_xor32(l);
        const float inv = (l > 0.f) ? 1.0f / l : 0.f;
        const float mfin = (m > -INFINITY) ? m : 0.f;
        f32x16 o0, o1;
#pragma unroll
        for (int i = 0; i < 16; ++i) { o0[i] = 0.f; o1[i] = 0.f; }
        AT_PASS(Kc, Vc, true, ntile, ROW_,
            f32x16 s0, s1;
            const float base0 = sl2 * (float)(16 * 64 * i + 31 - 64 * c), base1 = base0 + sl2 * 512.0f;
            at_scores(buf, qf, ramp16, base0, base1, s0, s1);
            if (64 * i + 63 > 4 * c - 2) {
                const int lim = imax - 64 * i - 4 * h;
                AT_MASK_LE(s0, s1, lim);
            }
            (void)at_exp(s0, s1, mfin);
_Pragma("unroll")
            for (int q = 0; q < 16; ++q) { s0[q] *= inv; s1[q] *= inv; }
_Pragma("unroll")
            for (int hf = 0; hf < 2; ++hf)
_Pragma("unroll")
                for (int u = 0; u < 4; ++u) {
                    const f32x16& P = hf ? s1 : s0;
                    float A = 2.0f * (P[4 * u] + P[4 * u + 1] + P[4 * u + 2]) + P[4 * u + 3], Bv = P[4 * u + 3];
                    A = quad_sum(A);
                    Bv = quad_sum(Bv);
                    const int j = 16 * i + 8 * hf + 2 * u + h;
                    if (head == 0) impA[tokl * 128 + j] = A;
                    if (head == 1) impB[tokl * 128 + j] = Bv;
                }
            at_pv(buf, s0, s1, o0, o1);
        )
#undef ROW_
        GATE_(0, g0)
#pragma unroll
        for (int i = 0; i < 16; ++i) { R0[i] = g0 * o0[i]; R1[i] = g0 * o1[i]; }
    }

    N_TICK(2);
    unsigned sw0, sw1, sw2, sw3;
    {
        __syncthreads();
        for (int tk = 0; tk < ((PM & 2) ? 0 : 8); ++tk) {
            const int tl = 8 * w + tk;
            unsigned long long ba, bb;
            if (c < 16) {
                ba = (1ull << (c + 1)) - 1ull;
                bb = 0ull;
            } else {
                const int jA = lane, jB = lane + 64;
                const bool okA = (jA >= 1 && jA <= c - 2), okB = (jB <= c - 2);
                const float vA = okA ? impA[tl * 128 + jA] + impB[tl * 128 + jA - 1] : 0.f;
                const float vB = okB ? impA[tl * 128 + jB] + impB[tl * 128 + jB - 1] : 0.f;
                const unsigned kA = okA ? __float_as_uint(vA) + 1u : 0u, kB = okB ? __float_as_uint(vB) + 1u : 0u;
                unsigned K = 0u;
                for (int bit = 30; bit >= 0; --bit) {
                    const unsigned tt = K | (1u << bit);
                    const int cn = __popcll(__ballot(kA >= tt)) + __popcll(__ballot(kB >= tt));
                    if (cn >= 13) { K = tt; if (cn == 13) break; }
                }
                const unsigned long long gtA = __ballot(kA > K), gtB = __ballot(kB > K), eqA = __ballot(kA == K), eqB = __ballot(kB == K);
                const int need = 13 - (__popcll(gtA) + __popcll(gtB));
                const unsigned long long lt = (1ull << lane) - 1ull;
                const bool sA = (jA == 0) || (jA == c - 1) || (jA == c) || (kA > K) || (kA == K && __popcll(eqA & lt) < need);
                const bool sB = (jB == c - 1) || (jB == c) || (kB > K) || (kB == K && __popcll(eqA) + __popcll(eqB & lt) < need);
                ba = __ballot(sA);
                bb = __ballot(sB);
            }
            if (lane == 0) {
                selb[tl * 4 + 0] = (unsigned)ba;
                selb[tl * 4 + 1] = (unsigned)(ba >> 32);
                selb[tl * 4 + 2] = (unsigned)bb;
                selb[tl * 4 + 3] = (unsigned)(bb >> 32);
            }
        }
        __syncthreads();
        sw0 = selb[tokl * 4 + 0];
        sw1 = selb[tokl * 4 + 1];
        sw2 = selb[tokl * 4 + 2];
        sw3 = selb[tokl * 4 + 3];
    }

    N_TICK(3);
    if (!(PM & 4)) {
        const bf16_t* Ks = pt + ((size_t)(HG_KS + g) * NTOK + (size_t)b * SEQ) * 64;
        const bf16_t* Vs = pt + ((size_t)(HG_VS + g) * NTOK + (size_t)b * SEQ) * 64;
        LAS unsigned* tokm = (LAS unsigned*)(lds + AT_TOKM);
        LAS float* olds = (LAS float*)(lds + AT_OLDS);
        LAS float* mrefs = (LAS float*)(lds + AT_MREF);
        LAS float* lacc = (LAS float*)(lds + AT_LACC);
        LAS int* jlist = (LAS int*)(lds + AT_JLIST);
        LAS unsigned char* qs = lds + AT_QS;
        LAS unsigned char* ctm = lds + AT_CTMAP;
        const int myrow = tokl * 4 + head;
        __syncthreads();
#pragma unroll
        for (int kk = 0; kk < 4; ++kk) *(LAS bf16x8*)(qs + myrow * 144 + (16 * kk + 8 * h) * 2) = qf[kk];
        {
            const unsigned wd = selb[lane * 4 + (w >> 1)];
#pragma unroll
            for (int jj = 0; jj < 16; ++jj) {
                const int j = 16 * w + jj;
                const bool sel_ = ((wd >> (j & 31)) & 1u) && j <= c;
                const unsigned long long mk = __ballot(sel_);
                if (lane == 0) { tokm[2 * j] = (unsigned)mk; tokm[2 * j + 1] = (unsigned)(mk >> 32); }
                if (sel_) ctm[j * 64 + __popcll(mk & ((1ull << lane) - 1ull))] = (unsigned char)lane;
            }
        }
        __syncthreads();
        if (w == 0) {
            const int j1 = c - lane, j2 = c - 64 - lane;
            const bool n1 = j1 >= 0 && (tokm[2 * (j1 < 0 ? 0 : j1)] | tokm[2 * (j1 < 0 ? 0 : j1) + 1]) != 0u;
            const bool n2 = j2 >= 0 && (tokm[2 * (j2 < 0 ? 0 : j2)] | tokm[2 * (j2 < 0 ? 0 : j2) + 1]) != 0u;
            const unsigned long long b1 = __ballot(n1), b2 = __ballot(n2);
            const unsigned long long lt = (1ull << lane) - 1ull;
            const int c1 = __popcll(b1);
            if (n1) jlist[1 + __popcll(b1 & lt)] = j1;
            if (n2) jlist[1 + c1 + __popcll(b2 & lt)] = j2;
            if (lane == 0) jlist[0] = c1 + __popcll(b2);
        }
        __syncthreads();
        const int nj = jlist[0];
#define ROW4_(_i) (64 * jlist[1 + (_i)])
        AT_PASS4(Ks, Vs, nj,
            const int j = jlist[1 + i];
            const float base0 = sl2 * (float)(64 * (j - c));
            if (i == 0) {
                f32x16 s0, s1, a0, a1;
                _Pragma("unroll") for (int q = 0; q < 16; ++q) { a0[q] = 0.f; a1[q] = 0.f; }
                at_scores(buf, qf, ramp, base0, base0 + sl2 * 32.0f, s0, s1);
                const int lim = tokl - 4 * h;
                AT_MASK_LE(s0, s1, lim);
                const float mr = at_rowmax(s0, s1);
                const float lp = at_exp(s0, s1, mr);
                at_pv(buf, s0, s1, a0, a1);
                LAS float* orow = olds + myrow * AT_OP + 4 * h;
                _Pragma("unroll") for (int u = 0; u < 4; ++u) {
                    *(LAS f32x4*)(orow + 8 * u) = (f32x4){a0[4 * u], a0[4 * u + 1], a0[4 * u + 2], a0[4 * u + 3]};
                    *(LAS f32x4*)(orow + 32 + 8 * u) = (f32x4){a1[4 * u], a1[4 * u + 1], a1[4 * u + 2], a1[4 * u + 3]};
                }
                const float lt = sum_xor32(lp);
                if (h == 0) { mrefs[myrow] = mr; lacc[myrow] = lt; }
            } else {
                const unsigned mlo = tokm[2 * j], mhi = tokm[2 * j + 1];
                const int nact = __popc(mlo) + __popc(mhi);
                if (8 * w >= nact) break;
                const int ct = 8 * w + (r >> 2);
                const bool valid = ct < nact;
                const int tau = (int)ctm[j * 64 + (valid ? ct : 0)];
                const int row = tau * 4 + head;
                bf16x8 q2[4];
                _Pragma("unroll") for (int kk = 0; kk < 4; ++kk) q2[kk] = *(LAS const bf16x8*)(qs + row * 144 + (16 * kk + 8 * h) * 2);
                const float mrow = valid ? mrefs[row] : INFINITY;
                LAS float* orow = olds + row * AT_OP + 4 * h;
                f32x16 a0, a1;
                _Pragma("unroll") for (int u = 0; u < 4; ++u) {
                    const f32x4 x0 = *(LAS const f32x4*)(orow + 8 * u), x1 = *(LAS const f32x4*)(orow + 32 + 8 * u);
                    a0[4 * u] = x0[0]; a0[4 * u + 1] = x0[1]; a0[4 * u + 2] = x0[2]; a0[4 * u + 3] = x0[3];
                    a1[4 * u] = x1[0]; a1[4 * u + 1] = x1[1]; a1[4 * u + 2] = x1[2]; a1[4 * u + 3] = x1[3];
                }
                float lp = 0.f;
                at_tile_pipe(buf, q2, ramp, base0, mrow, sl2 * 32.0f, lp, a0, a1);
                const float lt = sum_xor32(lp);
                if (valid) {
                    _Pragma("unroll") for (int u = 0; u < 4; ++u) {
                        *(LAS f32x4*)(orow + 8 * u) = (f32x4){a0[4 * u], a0[4 * u + 1], a0[4 * u + 2], a0[4 * u + 3]};
                        *(LAS f32x4*)(orow + 32 + 8 * u) = (f32x4){a1[4 * u], a1[4 * u + 1], a1[4 * u + 2], a1[4 * u + 3]};
                    }
                    if (h == 0) lacc[row] += lt;
                }
            }
        )
#undef ROW4_
        __syncthreads();
        {
            const float l = lacc[myrow];
            GATE_(1, g1)
            const float sc = g1 / l;
            LAS const float* orow = olds + myrow * AT_OP + 4 * h;
#pragma unroll
            for (int u = 0; u < 4; ++u)
#pragma unroll
                for (int q = 0; q < 4; ++q) { R0[4 * u + q] += sc * orow[8 * u + q]; R1[4 * u + q] += sc * orow[32 + 8 * u + q]; }
        }
    }

    N_TICK(4);
    if (!(PM & 8)) {
        const bf16_t* Kw = pt + ((size_t)(HG_KW + g) * NTOK + (size_t)b * SEQ) * 64;
        const bf16_t* Vw = pt + ((size_t)(HG_VW + g) * NTOK + (size_t)b * SEQ) * 64;
        f32x16 o0, o1;
#pragma unroll
        for (int i = 0; i < 16; ++i) { o0[i] = 0.f; o1[i] = 0.f; }
        float mref = 0.f, l = 0.f;
        const int ntile = (c >= 8) ? 9 : (c + 1);
#define ROW_(_i) (64 * (c - (_i)))
        AT_PASS(Kw, Vw, true, ntile, ROW_,
            const float base0 = sl2 * (float)(-64 * i);
            if (i == 0 || i == 8) {
                f32x16 s0, s1;
                at_scores(buf, qf, ramp, base0, base0 + sl2 * 32.0f, s0, s1);
                if (i == 0) {
                    const int lim = tokl - 4 * h;
                    AT_MASK_LE(s0, s1, lim);
                    mref = at_rowmax(s0, s1);
                } else {
                    const int lo = tokl + 1 - 4 * h;
                    AT_MASK_GE(s0, s1, lo);
                }
                l += at_exp(s0, s1, mref);
                at_pv(buf, s0, s1, o0, o1);
            } else {
                at_tile_pipe(buf, qf, ramp, base0, mref, sl2 * 32.0f, l, o0, o1);
            }
        )
#undef ROW_
        l = sum_xor32(l);
        GATE_(2, g2)
        const float sc = g2 / l;
#pragma unroll
        for (int i = 0; i < 16; ++i) { R0[i] += sc * o0[i]; R1[i] += sc * o1[i]; }
    }

    N_TICK(5);
    {
        bf16_t* orow = (bf16_t*)(wsb + ((PM & 16) ? (WS_Y + ((size_t)176 << 20)) : WS_MIXB)) + (size_t)tok * DM + 512 + hq * 64 + 4 * h;
#pragma unroll
        for (int u = 0; u < 4; ++u) {
            u32x2 a, bq;
            a.x = pk_bf16(R0[4 * u], R0[4 * u + 1]);
            a.y = pk_bf16(R0[4 * u + 2], R0[4 * u + 3]);
            bq.x = pk_bf16(R1[4 * u], R1[4 * u + 1]);
            bq.y = pk_bf16(R1[4 * u + 2], R1[4 * u + 3]);
            *(u32x2*)(orow + 8 * u) = a;
            *(u32x2*)(orow + 32 + 8 * u) = bq;
        }
    }
    N_TICK(9);
}

constexpr int PART_REC = 136, PART_ROW = 4 * PART_REC;
__device__ __forceinline__ unsigned char* part_rec(unsigned char* wsb, int b, int hh, int t, int slot) {
    return wsb + WS_PART + ((size_t)((b * 8 + hh) * SEQ + t)) * PART_ROW + slot * PART_REC;
}
__device__ __forceinline__ void part_store(unsigned char* rec, const f32x16& o0, const f32x16& o1, float l, float m, int h) {
    const float sc = 1.0f / l;
    bf16_t* orow = (bf16_t*)rec + 4 * h;
#pragma unroll
    for (int u = 0; u < 4; ++u) {
        u32x2 a, bq;
        a.x = pk_bf16(sc * o0[4 * u], sc * o0[4 * u + 1]);
        a.y = pk_bf16(sc * o0[4 * u + 2], sc * o0[4 * u + 3]);
        bq.x = pk_bf16(sc * o1[4 * u], sc * o1[4 * u + 1]);
        bq.y = pk_bf16(sc * o1[4 * u + 2], sc * o1[4 * u + 3]);
        *(u32x2*)(orow + 8 * u) = a;
        *(u32x2*)(orow + 32 + 8 * u) = bq;
    }
    if (h == 0) { f32x2 lm = {l, m}; *(f32x2*)(rec + 128) = lm; }
}

__device__ __forceinline__ void moba_gate_item(const Params& p, unsigned char* shm, int b, int hh, int cb) {
    LAS unsigned char* lds = (LAS unsigned char*)shm;
    unsigned char* wsb = (unsigned char*)p.ws;
    const bf16_t* pt = (const bf16_t*)(wsb + WS_PT);
    int tid = threadIdx.x;
    asm volatile("" : "+v"(tid));
    const int lane = tid & 63, w = __builtin_amdgcn_readfirstlane(tid >> 6), r = lane & 31, h = lane >> 5;
    const int tloc = 32 * w + r, t = 256 * cb + tloc, tok = b * SEQ + t;
    LAS float* kms = (LAS float*)(lds + AT_KMS);
    LAS int* lcnt = (LAS int*)(lds + AT_SELB);
    LAS int* lbase = lcnt + 32;
    int* mcnt = (int*)(wsb + WS_MCNT) + (b * 8 + hh) * 32;
    unsigned short* mlist = (unsigned short*)(wsb + WS_MLIST) + (size_t)((b * 8 + hh) * 32) * 8192;
    __syncthreads();
    {
        const f32x4 v = ((const f32x4*)((const float*)(wsb + WS_KMEAN) + (size_t)(b * 8 + hh) * 2048))[tid];
        *(LAS f32x4*)(kms + tid * 4) = v;
    }
    if (tid < 32) lcnt[tid] = 0;
    __syncthreads();
    float qv[32];
    {
        const bf16_t* qrow = pt + ((size_t)(HG_MQ + hh) * NTOK + tok) * 64 + 8 * h;
#pragma unroll
        for (int kk = 0; kk < 4; ++kk) {
            const u32x4 qq = *(const u32x4*)(qrow + 16 * kk);
            qv[kk * 8 + 0] = bf_lo(qq.x); qv[kk * 8 + 1] = bf_hi(qq.x);
            qv[kk * 8 + 2] = bf_lo(qq.y); qv[kk * 8 + 3] = bf_hi(qq.y);
            qv[kk * 8 + 4] = bf_lo(qq.z); qv[kk * 8 + 5] = bf_hi(qq.z);
            qv[kk * 8 + 6] = bf_lo(qq.w); qv[kk * 8 + 7] = bf_hi(qq.w);
        }
    }
    float b0 = -INFINITY, b1 = -INFINITY, b2 = -INFINITY;
    int i0 = 0, i1 = 0, i2 = 0;
    for (int n = 0; n < cb; ++n) {
        float s = 0.f;
#pragma unroll
        for (int kk = 0; kk < 4; ++kk) {
            const f32x4 ka = *(LAS const f32x4*)(kms + n * 64 + 16 * kk + 8 * h), kb = *(LAS const f32x4*)(kms + n * 64 + 16 * kk + 8 * h + 4);
            s += qv[kk * 8 + 0] * ka[0] + qv[kk * 8 + 1] * ka[1] + qv[kk * 8 + 2] * ka[2] + qv[kk * 8 + 3] * ka[3];
            s += qv[kk * 8 + 4] * kb[0] + qv[kk * 8 + 5] * kb[1] + qv[kk * 8 + 6] * kb[2] + qv[kk * 8 + 7] * kb[3];
        }
        s = sum_xor32(s);
        if (s > b0) { b2 = b1; i2 = i1; b1 = b0; i1 = i0; b0 = s; i0 = n; }
        else if (s > b1) { b2 = b1; i2 = i1; b1 = s; i1 = n; }
        else if (s > b2) { b2 = s; i2 = n; }
    }
    const int nsel = cb < 3 ? cb : 3;
    int n0 = i0, n1 = i1, n2 = i2;
    if (nsel >= 2 && n1 < n0) { const int x = n0; n0 = n1; n1 = x; }
    if (nsel >= 3) {
        if (n2 < n1) { const int x = n1; n1 = n2; n2 = x; }
        if (n1 < n0) { const int x = n0; n0 = n1; n1 = x; }
    }
    int r0 = 0, r1 = 0, r2 = 0;
    if (h == 0) {
        r0 = atomicAdd((int*)(lcnt + n0), 1);
        if (nsel >= 2) r1 = atomicAdd((int*)(lcnt + n1), 1);
        if (nsel >= 3) r2 = atomicAdd((int*)(lcnt + n2), 1);
    }
    __syncthreads();
    if (tid < cb) lbase[tid] = atomicAdd(mcnt + tid, lcnt[tid]);
    __syncthreads();
    if (h == 0) {
        mlist[(size_t)n0 * 8192 + lbase[n0] + r0] = (unsigned short)(t | (0 << 13));
        if (nsel >= 2) mlist[(size_t)n1 * 8192 + lbase[n1] + r1] = (unsigned short)(t | (1 << 13));
        if (nsel >= 3) mlist[(size_t)n2 * 8192 + lbase[n2] + r2] = (unsigned short)(t | (2 << 13));
    }
}

__device__ __forceinline__ void moba_own_item(const Params& p, unsigned char* shm, int b, int hh, int cb) {
    LAS unsigned char* lds = (LAS unsigned char*)shm;
    unsigned char* wsb = (unsigned char*)p.ws;
    const bf16_t* pt = (const bf16_t*)(wsb + WS_PT);
    int tid = threadIdx.x;
    asm volatile("" : "+v"(tid));
    const int lane = tid & 63, w = __builtin_amdgcn_readfirstlane(tid >> 6), r = lane & 31, h = lane >> 5;
    const int tloc = 32 * w + r, t = 256 * cb + tloc, tok = b * SEQ + t;
    const float sl2 = exp2f(-((float)hh + 0.5f)) * LOG2E;
    const float ramp = sl2;
    bf16x8 qf[4];
    {
        const bf16_t* qrow = pt + ((size_t)(HG_MQ + hh) * NTOK + tok) * 64 + 8 * h;
#pragma unroll
        for (int kk = 0; kk < 4; ++kk) qf[kk] = *(const bf16x8*)(qrow + 16 * kk);
    }
    const bf16_t* Km = pt + ((size_t)(HG_MK + hh) * NTOK + (size_t)b * SEQ) * 64;
    const bf16_t* Vm = pt + ((size_t)(HG_MV + hh) * NTOK + (size_t)b * SEQ) * 64;
    f32x16 o0, o1;
#pragma unroll
    for (int i = 0; i < 16; ++i) { o0[i] = 0.f; o1[i] = 0.f; }
    float mref = 0.f, l = 0.f;
    const int wt = w >> 1;
    __syncthreads();
    {
        AtStage st[4];
        const unsigned koff = (tid >> 3) * 128 + (tid & 7) * 16, voff = (tid & 63) * 128 + (tid >> 6) * 16;
#pragma unroll
        for (int tt = 0; tt < 4; ++tt) at_load(st[tt], Km + (size_t)(256 * cb + 64 * tt) * 64, Vm + (size_t)(256 * cb + 64 * tt) * 64, true, koff, voff);
#pragma unroll
        for (int tt = 0; tt < 4; ++tt) at_store(st[tt], lds + tt * AT_BUF, true);
    }
    __syncthreads();
    {
        f32x16 s0, s1;
        const float base0 = sl2 * (float)(64 * wt);
        at_scores(lds + wt * AT_BUF, qf, ramp, base0, base0 + sl2 * 32.0f, s0, s1);
        const int lim = tloc - 64 * wt - 4 * h;
        AT_MASK_LE(s0, s1, lim);
        mref = at_rowmax(s0, s1);
        l += at_exp(s0, s1, mref);
        at_pv(lds + wt * AT_BUF, s0, s1, o0, o1);
    }
    for (int tt = wt - 1; tt >= 0; --tt) at_tile_pipe(lds + tt * AT_BUF, qf, ramp, sl2 * (float)(64 * tt), mref, sl2 * 32.0f, l, o0, o1);
    l = sum_xor32(l);
    part_store(part_rec(wsb, b, hh, t, 3), o0, o1, l, mref - sl2 * (float)tloc, h);
}

template <int PV = 0>
__device__ __forceinline__ void moba_gather_item(const Params& p, unsigned char* shm, int b, int hh, int n, int k, int cnt) {
    LAS unsigned char* lds = (LAS unsigned char*)shm;
    unsigned char* wsb = (unsigned char*)p.ws;
    const bf16_t* pt = (const bf16_t*)(wsb + WS_PT);
    int tid = threadIdx.x;
    asm volatile("" : "+v"(tid));
    const int lane = tid & 63, w = __builtin_amdgcn_readfirstlane(tid >> 6), r = lane & 31, h = lane >> 5;
    const unsigned short* mlist = (const unsigned short*)(wsb + WS_MLIST) + (size_t)((b * 8 + hh) * 32 + n) * 8192;
    const int li = 256 * k + 32 * w + r;
    const bool live = li < cnt;
    const unsigned ent = mlist[live ? li : cnt - 1];
    const int t = ent & 8191, slot = ent >> 13, tok = b * SEQ + t;
    const float sl2 = exp2f(-((float)hh + 0.5f)) * LOG2E;
    const float ramp = sl2;
    bf16x8 qf[4];
    {
        const bf16_t* qrow = pt + ((size_t)(HG_MQ + hh) * NTOK + tok) * 64 + 8 * h;
#pragma unroll
        for (int kk = 0; kk < 4; ++kk) qf[kk] = *(const bf16x8*)(qrow + 16 * kk);
    }
    const bf16_t* Km = pt + ((size_t)(HG_MK + hh) * NTOK + (size_t)b * SEQ) * 64;
    const bf16_t* Vm = pt + ((size_t)(HG_MV + hh) * NTOK + (size_t)b * SEQ) * 64;
    f32x16 o0, o1;
#pragma unroll
    for (int i = 0; i < 16; ++i) { o0[i] = 0.f; o1[i] = 0.f; }
    float mref = 0.f, l = 0.f;
    const float tb = sl2 * (float)(256 * n - t);
#define ROW_(_i) (256 * n + 64 * (3 - (_i)))
    AT_PASS(Km, Vm, true, 4, ROW_,
        const int tt = 3 - i;
        const float base0 = tb + sl2 * (float)(64 * tt);
        if (i == 0) {
            f32x16 s0, s1;
            at_scores(buf, qf, ramp, base0, base0 + sl2 * 32.0f, s0, s1);
            mref = at_rowmax(s0, s1);
            l += at_exp(s0, s1, mref);
            at_pv(buf, s0, s1, o0, o1);
        } else {
            at_tile_pipe<PV>(buf, qf, ramp, base0, mref, sl2 * 32.0f, l, o0, o1);
        }
        )
#undef ROW_
    l = sum_xor32(l);
    if (live) part_store(part_rec(wsb, b, hh, t, slot), o0, o1, l, mref, h);
}

constexpr int GL_CHUNKS = 8;
__device__ __forceinline__ void moba_list_item(const Params& p, unsigned char* shm, int b, int hh, int n, int k0, int nch, int cnt) {
    LAS unsigned char* lds = (LAS unsigned char*)shm;
    unsigned char* wsb = (unsigned char*)p.ws;
    const bf16_t* pt = (const bf16_t*)(wsb + WS_PT);
    int tid = threadIdx.x;
    asm volatile("" : "+v"(tid));
    const int lane = tid & 63, w = __builtin_amdgcn_readfirstlane(tid >> 6), r = lane & 31, h = lane >> 5;
    const unsigned short* mlist = (const unsigned short*)(wsb + WS_MLIST) + (size_t)((b * 8 + hh) * 32 + n) * 8192;
    const bf16_t* Km = pt + ((size_t)(HG_MK + hh) * NTOK + (size_t)b * SEQ + 256 * n) * 64;
    const bf16_t* Vm = pt + ((size_t)(HG_MV + hh) * NTOK + (size_t)b * SEQ + 256 * n) * 64;
    const bf16_t* Qm = pt + ((size_t)(HG_MQ + hh) * NTOK + (size_t)b * SEQ) * 64 + 8 * h;
    const float sl2 = exp2f(-((float)hh + 0.5f)) * LOG2E;
    const float ramp = sl2;
    int li = 256 * k0 + 32 * w + r;
    unsigned ent = mlist[li < cnt ? li : cnt - 1];
    __syncthreads();
    {
        AtStage st[4];
        const unsigned koff = (tid >> 3) * 128 + (tid & 7) * 16, voff = (tid & 63) * 128 + (tid >> 6) * 16;
#pragma unroll
        for (int tt = 0; tt < 4; ++tt) at_load(st[tt], Km + (size_t)(64 * tt) * 64, Vm + (size_t)(64 * tt) * 64, true, koff, voff);
#pragma unroll
        for (int tt = 0; tt < 4; ++tt) at_store(st[tt], lds + tt * AT_BUF, true);
    }
    bf16x8 qn[4];
    {
        const bf16_t* qrow = Qm + (size_t)(ent & 8191) * 64;
#pragma unroll
        for (int kk = 0; kk < 4; ++kk) qn[kk] = *(const bf16x8*)(qrow + 16 * kk);
    }
    __syncthreads();
    for (int c = 0; c < nch; ++c) {
        const bool live = li < cnt;
        const int t = ent & 8191, slot = ent >> 13;
        bf16x8 qf[4];
#pragma unroll
        for (int kk = 0; kk < 4; ++kk) qf[kk] = qn[kk];
        const bool more = c + 1 < nch;
        unsigned entn = ent;
        if (more) { const int lin = li + 256; entn = mlist[lin < cnt ? lin : cnt - 1]; }
        f32x16 o0, o1;
#pragma unroll
        for (int i = 0; i < 16; ++i) { o0[i] = 0.f; o1[i] = 0.f; }
        float mref = 0.f, l = 0.f;
        const float tb = sl2 * (float)(256 * n - t);
        {
            f32x16 s0, s1;
            const float base0 = tb + sl2 * 192.0f;
            at_scores(lds + 3 * AT_BUF, qf, ramp, base0, base0 + sl2 * 32.0f, s0, s1);
            mref = at_rowmax(s0, s1);
            l += at_exp(s0, s1, mref);
            at_pv(lds + 3 * AT_BUF, s0, s1, o0, o1);
        }
        if (more) {
            const bf16_t* qrow = Qm + (size_t)(entn & 8191) * 64;
#pragma unroll
            for (int kk = 0; kk < 4; ++kk) qn[kk] = *(const bf16x8*)(qrow + 16 * kk);
        }
        at_tile_pipe(lds + 2 * AT_BUF, qf, ramp, tb + sl2 * 128.0f, mref, sl2 * 32.0f, l, o0, o1);
        at_tile_pipe(lds + 1 * AT_BUF, qf, ramp, tb + sl2 * 64.0f, mref, sl2 * 32.0f, l, o0, o1);
        at_tile_pipe(lds, qf, ramp, tb, mref, sl2 * 32.0f, l, o0, o1);
        l = sum_xor32(l);
        if (live) part_store(part_rec(wsb, b, hh, t, slot), o0, o1, l, mref, h);
        ent = entn;
        li += 256;
    }
}

__device__ __forceinline__ void f_moba_merge(const Params& p) {
    unsigned char* wsb = (unsigned char*)p.ws;
    const int tid = threadIdx.x;
    bf16_t* mixb = (bf16_t*)(wsb + WS_MIXB);
    const int stride = gridDim.x * 512, total = NTOK * 8 * 8;
    for (int idx0 = blockIdx.x * 512 + tid; idx0 < total; idx0 += 2 * stride) {
        f32x2 lm[2][4];
        u32x4 vv[2][4];
#pragma unroll
        for (int u = 0; u < 2; ++u) {
            const int idx = idx0 + u * stride < total ? idx0 + u * stride : idx0;
            const int dq = idx & 7, rho = idx >> 3;
            const int cbk = (rho & (SEQ - 1)) >> 8, nsel = cbk < 3 ? cbk : 3;
            const unsigned char* row = wsb + WS_PART + (size_t)rho * PART_ROW;
#pragma unroll
            for (int s = 0; s < 4; ++s) {
                const bool on = (s == 3) || (s < nsel);
                lm[u][s] = on ? *(const f32x2*)(row + s * PART_REC + 128) : (f32x2){0.f, -INFINITY};
                vv[u][s] = on ? *(const u32x4*)(row + s * PART_REC + dq * 16) : (u32x4){0u, 0u, 0u, 0u};
            }
        }
#pragma unroll
        for (int u = 0; u < 2; ++u) {
            const int idx = idx0 + u * stride;
            if (idx < total) {
                const int dq = idx & 7, rho = idx >> 3;
                const int t = rho & (SEQ - 1), bh = rho >> 13, hh = bh & 7, b = bh >> 3;
                float M = fmaxf(fmaxf(lm[u][0][1], lm[u][1][1]), fmaxf(lm[u][2][1], lm[u][3][1]));
                float lw[4], W = 0.f;
#pragma unroll
                for (int s = 0; s < 4; ++s) { lw[s] = lm[u][s][0] * __builtin_amdgcn_exp2f(lm[u][s][1] - M); W += lw[s]; }
                float acc[8];
#pragma unroll
                for (int q = 0; q < 8; ++q) acc[q] = 0.f;
#pragma unroll
                for (int s = 0; s < 4; ++s) {
                    const u32x4 v = vv[u][s];
                    acc[0] += lw[s] * bf_lo(v.x); acc[1] += lw[s] * bf_hi(v.x);
                    acc[2] += lw[s] * bf_lo(v.y); acc[3] += lw[s] * bf_hi(v.y);
                    acc[4] += lw[s] * bf_lo(v.z); acc[5] += lw[s] * bf_hi(v.z);
                    acc[6] += lw[s] * bf_lo(v.w); acc[7] += lw[s] * bf_hi(v.w);
                }
                const float inv = __builtin_amdgcn_rcpf(W);
                u32x4 o;
                o.x = pk_bf16(acc[0] * inv, acc[1] * inv);
                o.y = pk_bf16(acc[2] * inv, acc[3] * inv);
                o.z = pk_bf16(acc[4] * inv, acc[5] * inv);
                o.w = pk_bf16(acc[6] * inv, acc[7] * inv);
                *(u32x4*)(mixb + (size_t)(b * SEQ + t) * DM + hh * 64 + dq * 8) = o;
            }
        }
    }
}

#define GATE_CB(k) (((k) & 1) ? 8 * (k) + 7 - c0 : 8 * (k) + c0)
__device__ __forceinline__ void f_moba_gate(const Params& p, unsigned char* shm) {
    for (int vb = blockIdx.x; vb < 256; vb += gridDim.x) {
        LAS unsigned char* lds = (LAS unsigned char*)shm;
        unsigned char* wsb = (unsigned char*)p.ws;
        const bf16_t* pt = (const bf16_t*)(wsb + WS_PT);
        int tid = threadIdx.x;
        asm volatile("" : "+v"(tid));
        const int lane = tid & 63, w = __builtin_amdgcn_readfirstlane(tid >> 6), r = lane & 31, h = lane >> 5;
        const int bh = vb & 31, b = bh >> 3, hh = bh & 7, c0 = vb >> 5;
        LAS float* kms = (LAS float*)(lds + AT_KMS);
        LAS int* lcnt = (LAS int*)(lds + AT_SELB);
        LAS int* lbase = lcnt + 128;
        int* mcnt = (int*)(wsb + WS_MCNT) + (b * 8 + hh) * 32;
        unsigned short* mlist = (unsigned short*)(wsb + WS_MLIST) + (size_t)((b * 8 + hh) * 32) * 8192;
        const int tloc = 32 * w + r;
        __syncthreads();
        {
            const f32x4 v = ((const f32x4*)((const float*)(wsb + WS_KMEAN) + (size_t)(b * 8 + hh) * 2048))[tid];
            *(LAS f32x4*)(kms + tid * 4) = v;
        }
        if (tid < 128) lcnt[tid] = 0;
        u32x4 qn[4];
        {
            const int cbf = c0 == 0 ? 15 : c0;
            const bf16_t* qrow = pt + ((size_t)(HG_MQ + hh) * NTOK + (size_t)b * SEQ + 256 * cbf + tloc) * 64 + 8 * h;
#pragma unroll
            for (int kk = 0; kk < 4; ++kk) qn[kk] = *(const u32x4*)(qrow + 16 * kk);
        }
        __syncthreads();
        unsigned selw[4] = {0u, 0u, 0u, 0u}, rkw[4] = {0u, 0u, 0u, 0u};
#pragma unroll
        for (int k = 0; k < 4; ++k) {
            const int cb = GATE_CB(k);
            if (cb >= 1) {
                f32x2 qv[16];
#pragma unroll
                for (int kk = 0; kk < 4; ++kk) {
                    qv[kk * 4 + 0] = (f32x2){bf_lo(qn[kk].x), bf_hi(qn[kk].x)};
                    qv[kk * 4 + 1] = (f32x2){bf_lo(qn[kk].y), bf_hi(qn[kk].y)};
                    qv[kk * 4 + 2] = (f32x2){bf_lo(qn[kk].z), bf_hi(qn[kk].z)};
                    qv[kk * 4 + 3] = (f32x2){bf_lo(qn[kk].w), bf_hi(qn[kk].w)};
                }
                if (k < 3) {
                    const bf16_t* qrow = pt + ((size_t)(HG_MQ + hh) * NTOK + (size_t)b * SEQ + 256 * GATE_CB(k + 1) + tloc) * 64 + 8 * h;
#pragma unroll
                    for (int kk = 0; kk < 4; ++kk) qn[kk] = *(const u32x4*)(qrow + 16 * kk);
                }
                float b0 = -INFINITY, b1 = -INFINITY, b2 = -INFINITY;
                int i0 = 0, i1 = 0, i2 = 0;
                for (int n = 0; n < cb; ++n) {
                    f32x2 s2 = {0.f, 0.f};
#pragma unroll
                    for (int kk = 0; kk < 4; ++kk) {
                        const f32x4 ka = *(LAS const f32x4*)(kms + n * 64 + 16 * kk + 8 * h), kb = *(LAS const f32x4*)(kms + n * 64 + 16 * kk + 8 * h + 4);
                        s2 = __builtin_elementwise_fma(qv[kk * 4 + 0], (f32x2){ka[0], ka[1]}, s2);
                        s2 = __builtin_elementwise_fma(qv[kk * 4 + 1], (f32x2){ka[2], ka[3]}, s2);
                        s2 = __builtin_elementwise_fma(qv[kk * 4 + 2], (f32x2){kb[0], kb[1]}, s2);
                        s2 = __builtin_elementwise_fma(qv[kk * 4 + 3], (f32x2){kb[2], kb[3]}, s2);
                    }
                    float s = sum_xor32(s2[0] + s2[1]);
                    if (s > b0) { b2 = b1; i2 = i1; b1 = b0; i1 = i0; b0 = s; i0 = n; }
                    else if (s > b1) { b2 = b1; i2 = i1; b1 = s; i1 = n; }
                    else if (s > b2) { b2 = s; i2 = n; }
                }
                const int nsel = cb < 3 ? cb : 3;
                int n0 = i0, n1 = i1, n2 = i2;
                if (nsel >= 2 && n1 < n0) { const int x = n0; n0 = n1; n1 = x; }
                if (nsel >= 3) {
                    if (n2 < n1) { const int x = n1; n1 = n2; n2 = x; }
                    if (n1 < n0) { const int x = n0; n0 = n1; n1 = x; }
                }
                int r0 = 0, r1 = 0, r2 = 0;
                if (h == 0) {
                    r0 = atomicAdd((int*)(lcnt + k * 32 + n0), 1);
                    if (nsel >= 2) r1 = atomicAdd((int*)(lcnt + k * 32 + n1), 1);
                    if (nsel >= 3) r2 = atomicAdd((int*)(lcnt + k * 32 + n2), 1);
                }
                selw[k] = (unsigned)n0 | ((unsigned)n1 << 5) | ((unsigned)n2 << 10) | ((unsigned)nsel << 15);
                rkw[k] = (unsigned)r0 | ((unsigned)r1 << 10) | ((unsigned)r2 << 20);
            }
        }
        __syncthreads();
        if (tid < 128) {
            const int k = tid >> 5, n = tid & 31, cnt = lcnt[tid];
            if (cnt > 0) lbase[tid] = atomicAdd(mcnt + n, cnt);
            (void)k;
        }
        __syncthreads();
        if (h == 0) {
#pragma unroll
            for (int k = 0; k < 4; ++k) {
                const int cb = GATE_CB(k);
                if (cb >= 1) {
                    const int t = 256 * cb + tloc;
                    const int n0 = selw[k] & 31, n1 = (selw[k] >> 5) & 31, n2 = (selw[k] >> 10) & 31, nsel = selw[k] >> 15;
                    const int r0 = rkw[k] & 1023, r1 = (rkw[k] >> 10) & 1023, r2 = rkw[k] >> 20;
                    mlist[(size_t)n0 * 8192 + lbase[k * 32 + n0] + r0] = (unsigned short)(t | (0 << 13));
                    if (nsel >= 2) mlist[(size_t)n1 * 8192 + lbase[k * 32 + n1] + r1] = (unsigned short)(t | (1 << 13));
                    if (nsel >= 3) mlist[(size_t)n2 * 8192 + lbase[k * 32 + n2] + r2] = (unsigned short)(t | (2 << 13));
                }
            }
        }
    }
    __syncthreads();
}
#undef GATE_CB

__device__ __forceinline__ void f_attn(const Params& p, unsigned char* shm) {
    LAS unsigned short* pre = (LAS unsigned short*)((LAS unsigned char*)shm + AT_TAIL);
    LAS int* wtot = (LAS int*)((LAS unsigned char*)shm + AT_TAIL + 2064);
    const int* mcnt = (const int*)((unsigned char*)p.ws + WS_MCNT);
    int* qctr = (int*)((unsigned char*)p.ws + WS_MCNT) + 1024;
    int tid = threadIdx.x;
    asm volatile("" : "+v"(tid));
    __syncthreads();
    {
        const int lane = tid & 63, w = tid >> 6;
        const int q0 = 2 * tid, q1 = 2 * tid + 1;
        const int v0 = (((mcnt[(q0 & 31) * 32 + (q0 >> 5)] + 255) >> 8) + GL_CHUNKS - 1) / GL_CHUNKS,
                  v1 = (((mcnt[(q1 & 31) * 32 + (q1 >> 5)] + 255) >> 8) + GL_CHUNKS - 1) / GL_CHUNKS;
        int sc = v0 + v1;
#pragma unroll
        for (int d = 1; d < 64; d <<= 1) { const int u = __shfl_up(sc, d); if (lane >= d) sc += u; }
        if (lane == 63) wtot[w] = sc;
        __syncthreads();
        int woff = 0;
        for (int ww = 0; ww < w; ++ww) woff += wtot[ww];
        const int excl = woff + sc - (v0 + v1);
        pre[2 * tid] = (unsigned short)excl;
        pre[2 * tid + 1] = (unsigned short)(excl + v0);
        if (tid == 511) pre[1024] = (unsigned short)(excl + v0 + v1);
    }
    __syncthreads();
    const int limit = 2048 + (int)pre[1024];
    int ticket = 0;
    if (tid == 0) ticket = atomicAdd(qctr, 1);
#ifdef PROBE_CAT
    long long pc_acc = 0, pc_prev = wall_clock64();
    int pc_cat = 4;
#endif
    for (;;) {
        __syncthreads();
#ifdef PROBE_CAT
        { const long long tn = wall_clock64(); if (pc_cat == PROBE_CAT) pc_acc += tn - pc_prev; pc_prev = tn; }
#endif
        if (tid == 0) wtot[8] = ticket;
        __syncthreads();
        const int it = wtot[8];
#ifdef PROBE_CAT
        pc_cat = it >= limit ? 5 : it < 512 ? 0 : it < 1024 ? 1 : it < 2048 ? 2 : 3;
#endif
        if (it >= limit) break;
        if (tid == 0) ticket = atomicAdd(qctr, 1);
        if (it < 1024) {
            const int q = it & 511;
            nsa_item(p, shm, q & 3, it < 512 ? 1 : 0, 127 - (q >> 2));
        } else if (it < 2048) {
            const int q = it - 1024;
            moba_own_item(p, shm, (q & 31) >> 3, q & 7, q >> 5);
        } else {
            const int gi = it - 2048;
            int lo = 0, hi = 1024;
            while (hi - lo > 1) { const int mid = (lo + hi) >> 1; if ((int)pre[mid] <= gi) lo = mid; else hi = mid; }
            const int li = lo, n = li >> 5, bh = li & 31, k0 = (gi - (int)pre[li]) * GL_CHUNKS, cnt = mcnt[bh * 32 + n], nchl = (cnt + 255) >> 8;
            moba_list_item(p, shm, bh >> 3, bh & 7, n, k0, nchl - k0 < GL_CHUNKS ? nchl - k0 : GL_CHUNKS, cnt);
        }
    }
    __syncthreads();
#ifdef PROBE_CAT
    if (threadIdx.x == 0) { probe_ts[0] = 0; probe_ts[1] = pc_acc; }
#endif
}


template <int PM>
__device__ __forceinline__ void f_probe_nsa(const Params& p, unsigned char* shm) {
    for (int q = blockIdx.x; q < 1024; q += gridDim.x) nsa_item<PM>(p, shm, (q & 7) >> 1, q & 1, 127 - (q >> 3));
}
template <int PV>
__device__ __forceinline__ void f_probe_gather(const Params& p, unsigned char* shm) {
    const int* mcnt = (const int*)((unsigned char*)p.ws + WS_MCNT);
    for (int li = 0; li < 1024; ++li) {
        const int cnt = mcnt[li], nch = (cnt + 255) >> 8;
        for (int k = 0; k < nch; ++k)
            if (((li * 37 + k) & 255) == (int)blockIdx.x % 256) moba_gather_item<PV>(p, shm, li >> 8, (li >> 5) & 7, li & 31, k, cnt);
    }
}
#ifdef PROBE_TIME_SUB
#define P_TICK(j) do { __syncthreads(); if (threadIdx.x == 0) { if ((j) == PROBE_TIME_SUB) probe_ts[0] = wall_clock64(); if ((j) == PROBE_TIME_SUB_END) probe_ts[1] = wall_clock64(); } } while (0)
#else
#define P_TICK(j) do { } while (0)
#endif
__device__ __forceinline__ void f_prologue(const Params& p, unsigned char* shm) {
    const int tid = threadIdx.x, lane = tid & 63, w = tid >> 6;
    P_TICK(0);
    unsigned char* wsb = (unsigned char*)p.ws;
    bf16_t* xn = (bf16_t*)(wsb + WS_XN);
    {
        float4* km = (float4*)(wsb + WS_KMEAN);
        for (int i = blockIdx.x * 512 + tid; i < 16384; i += gridDim.x * 512) km[i] = make_float4(0.f, 0.f, 0.f, 0.f);
        int* mc = (int*)(wsb + WS_MCNT);
        for (int i = blockIdx.x * 512 + tid; i < 1024 + 16; i += gridDim.x * 512) mc[i] = 0;
    }
    for (int row = blockIdx.x * 8 + w; row < NTOK; row += gridDim.x * 8) {
        const float4* xr = (const float4*)(p.x + (size_t)row * DM);
        float4 v[4];
        float ss = 0.f;
#pragma unroll
        for (int j = 0; j < 4; ++j) { v[j] = xr[lane + 64 * j]; ss += dot4(v[j], v[j]); }
        ss = wave_sum(ss);
        const float r = 1.0f / sqrtf(ss * (1.0f / DM) + 1e-5f);
        const float4* g4 = (const float4*)p.attn_g;
        u32x2* o = (u32x2*)(xn + (size_t)row * DM);
#pragma unroll
        for (int j = 0; j < 4; ++j) {
            const float4 g = g4[lane + 64 * j];
            u32x2 ov;
            ov.x = pk_bf16(v[j].x * r * g.x, v[j].y * r * g.y);
            ov.y = pk_bf16(v[j].z * r * g.z, v[j].w * r * g.w);
            o[lane + 64 * j] = ov;
        }
    }
    P_TICK(1);
    float* T = (float*)shm;
    bf16_t* btin = (bf16_t*)(wsb + WS_BTIN);
    bf16_t* btout = (bf16_t*)(wsb + WS_BTOUT);
    bf16_t* btup = (bf16_t*)(wsb + WS_BTUP);
    bf16_t* btdn = (bf16_t*)(wsb + WS_BTDN);
    bf16_t* w1t = (bf16_t*)(wsb + WS_W1T);
    bf16_t* w2t = (bf16_t*)(wsb + WS_W2T);
    const auto ident = [](int c) { return c; };
    cv_run(T, 16 * 48, [&](int it, const float*& W, int& K, int& ncols, int& ldw, bf16_t*& WT, int& k0, int& n0) {
        const int g4 = it >> 2, sub = it & 3, kt = (g4 / 24) * 2 + (sub >> 1), nt = (g4 % 24) * 2 + (sub & 1);
        W = p.w_in; K = DM; ncols = INC; ldw = INC; WT = btin; k0 = kt * 64; n0 = nt * 64; }, ident);
    cv_run(T, 16 * 16, [&](int it, const float*& W, int& K, int& ncols, int& ldw, bf16_t*& WT, int& k0, int& n0) {
        const int g4 = it >> 2, sub = it & 3, kt = (g4 >> 3) * 2 + (sub >> 1), nt = (g4 & 7) * 2 + (sub & 1);
        W = p.w_out; K = DM; ncols = DM; ldw = DM; WT = btout; k0 = kt * 64; n0 = nt * 64; }, ident);
    P_TICK(2);
    cv_run(T, NE * 16 * 32, [&](int it, const float*& W, int& K, int& ncols, int& ldw, bf16_t*& WT, int& k0, int& n0) {
        const int e = it >> 9, r = it & 511;
        const int g4 = r >> 2, sub = r & 3, kt = (g4 >> 4) * 2 + (sub >> 1), nt = (g4 & 15) * 2 + (sub & 1);
        W = p.w_up + (size_t)e * DM * DFF2; K = DM; ncols = DFF2; ldw = DFF2; WT = btup + (size_t)e * DFF2 * DM; k0 = kt * 64; n0 = nt * 64; },
        [](int c) { const int a = c >> 1, isu = c & 1; return (a >> 7) * 256 + isu * 128 + (a & 127); });
    P_TICK(3);
    cv_run(T, NE * 16 * 16, [&](int it, const float*& W, int& K, int& ncols, int& ldw, bf16_t*& WT, int& k0, int& n0) {
        const int e = it >> 8, r = it & 255;
        const int g4 = r >> 2, sub = r & 3, kt = (g4 >> 3) * 2 + (sub >> 1), nt = (g4 & 7) * 2 + (sub & 1);
        W = p.w_down + (size_t)e * DM * DM; K = DM; ncols = DM; ldw = DM; WT = btdn + (size_t)e * DM * DM; k0 = kt * 64; n0 = nt * 64; }, ident);
    P_TICK(4);
    cv_run(T, 2 * 33, [&](int it, const float*& W, int& K, int& ncols, int& ldw, bf16_t*& WT, int& k0, int& n0) {
        const int kv = it / 33, r = it % 33;
        ncols = 64; ldw = 64; n0 = 0;
        if (r < 32) { W = kv ? p.w1v : p.w1k; K = 2048; WT = w1t + (size_t)kv * 64 * 2048; k0 = r * 64; }
        else        { W = kv ? p.w2v : p.w2k; K = 64;   WT = w2t + (size_t)kv * 64 * 64;   k0 = 0; } }, ident);
    __syncthreads();
    if (blockIdx.x >= gridDim.x - 64 && tid < 128) {
        const int k = (blockIdx.x - (gridDim.x - 64)) * 16 + (tid >> 3), e4 = tid & 7;
        const float4 v = ((const float4*)p.w_router)[k * 8 + e4];
        const float vv[4] = {v.x, v.y, v.z, v.w};
        bf16_t* rwt = (bf16_t*)(wsb + WS_RWT);
#pragma unroll
        for (int j = 0; j < 4; ++j) {
            const unsigned hi = pk_bf16(vv[j], 0.f) & 0xffffu;
            const unsigned lo = pk_bf16(vv[j] - __uint_as_float(hi << 16), 0.f) & 0xffffu;
            rwt[(size_t)(e4 * 4 + j) * 1024 + k] = (bf16_t)hi;
            rwt[(size_t)(32 + e4 * 4 + j) * 1024 + k] = (bf16_t)lo;
        }
    }
    if (blockIdx.x < 64) {
        const int o = tid & 127, part = tid >> 7, kv = o >> 6, n = o & 63;
        const float* pe = (kv ? p.pe_v : p.pe_k) + blockIdx.x * 32 + part * 8;
        const float* w1 = (kv ? p.w1v : p.w1k) + (size_t)(blockIdx.x * 32 + part * 8) * 64 + n;
        float pv[8], wv[8];
#pragma unroll
        for (int j = 0; j < 8; ++j) { pv[j] = pe[j]; wv[j] = w1[j * 64]; }
        float s = 0.f;
#pragma unroll
        for (int j = 0; j < 8; ++j) s += pv[j] * wv[j];
        T[part * 128 + o] = s;
        __syncthreads();
        if (tid < 128) ((float*)(wsb + WS_C1P))[blockIdx.x * 128 + tid] = T[tid] + T[128 + tid] + T[256 + tid] + T[384 + tid];
    }
    __syncthreads();
    P_TICK(5);
}

__device__ __forceinline__ void f_cmp(const Params& p, unsigned char* shm) {
    unsigned char* wsb = (unsigned char*)p.ws;
    const bf16_t* pt = (const bf16_t*)(wsb + WS_PT);
    const bf16_t* w1t = (const bf16_t*)(wsb + WS_W1T);
    const bf16_t* w2t = (const bf16_t*)(wsb + WS_W2T);
    const int tid = threadIdx.x, lane = tid & 63, w = __builtin_amdgcn_readfirstlane(tid >> 6), fr = lane & 15, fq = lane >> 4;
    LAS float* part = (LAS float*)shm;
    LAS unsigned char* h1buf = (LAS unsigned char*)shm + 65536;
    LAS float* c1 = (LAS float*)((LAS unsigned char*)shm + 65536 + 32 * 144);
    if (tid < 128) {
        const float* c1p = (const float*)(wsb + WS_C1P);
        float s = 0.f;
#pragma unroll 16
        for (int b = 0; b < 64; ++b) s += c1p[b * 128 + tid];
        c1[tid] = s;
    }
    __syncthreads();
    for (int it = blockIdx.x; it < 256; it += gridDim.x) {
        const int rg = it & 15, g = (it >> 4) & 1, b = (it >> 5) & 3, kv = it >> 7;
        const int hg = (kv ? HG_VC : HG_KC) + g;
        const bf16_t* arow = pt + ((size_t)hg * NTOK + (size_t)b * SEQ + 16 * (32 * rg + fr)) * 64 + 8 * fq + 256 * w;
        const bf16_t* brow = w1t + ((size_t)kv * 64 + fr) * 2048 + 8 * fq + 256 * w;
        f32x4 acc[2][4];
#pragma unroll
        for (int mt = 0; mt < 2; ++mt)
#pragma unroll
            for (int nt = 0; nt < 4; ++nt) acc[mt][nt] = (f32x4){0.f, 0.f, 0.f, 0.f};
#pragma unroll
        for (int kk = 0; kk < 8; ++kk) {
            const bf16x8 a0 = *(const bf16x8*)(arow + 32 * kk);
            const bf16x8 a1 = *(const bf16x8*)(arow + (size_t)16 * 16 * 64 + 32 * kk);
#pragma unroll
            for (int nt = 0; nt < 4; ++nt) {
                const bf16x8 bb = *(const bf16x8*)(brow + (size_t)nt * 16 * 2048 + 32 * kk);
                acc[0][nt] = __builtin_amdgcn_mfma_f32_16x16x32_bf16(a0, bb, acc[0][nt], 0, 0, 0);
                acc[1][nt] = __builtin_amdgcn_mfma_f32_16x16x32_bf16(a1, bb, acc[1][nt], 0, 0, 0);
            }
        }
        __syncthreads();
#pragma unroll
        for (int mt = 0; mt < 2; ++mt)
#pragma unroll
            for (int nt = 0; nt < 4; ++nt)
#pragma unroll
                for (int reg = 0; reg < 4; ++reg) part[w * 2048 + (16 * mt + 4 * fq + reg) * 64 + nt * 16 + fr] = acc[mt][nt][reg];
        __syncthreads();
        {
#pragma unroll
            for (int q = 0; q < 4; ++q) {
                const int o = tid + 512 * q, row = o >> 6, col = o & 63;
                float s = c1[kv * 64 + col];
#pragma unroll
                for (int ww = 0; ww < 8; ++ww) s += part[ww * 2048 + o];
                *(LAS unsigned short*)(h1buf + row * 144 + col * 2) = (unsigned short)(pk_bf16(gelu_tanh(s), 0.f) & 0xffffu);
            }
        }
        __syncthreads();
        if (w < 2) {
            f32x4 acc2[4];
#pragma unroll
            for (int nt = 0; nt < 4; ++nt) acc2[nt] = (f32x4){0.f, 0.f, 0.f, 0.f};
#pragma unroll
            for (int k2 = 0; k2 < 2; ++k2) {
                const bf16x8 a2 = *(LAS const bf16x8*)(h1buf + (16 * w + fr) * 144 + (32 * k2 + 8 * fq) * 2);
#pragma unroll
                for (int nt = 0; nt < 4; ++nt) {
                    const bf16x8 b2 = *(const bf16x8*)(w2t + ((size_t)kv * 64 + nt * 16 + fr) * 64 + 32 * k2 + 8 * fq);
                    acc2[nt] = __builtin_amdgcn_mfma_f32_16x16x32_bf16(a2, b2, acc2[nt], 0, 0, 0);
                }
            }
            bf16_t* dst = (bf16_t*)(wsb + (kv ? WS_VCMP : WS_KCMP)) + (size_t)((b * 2 + g) * NCMPP + 32 * rg + 16 * w) * 64;
#pragma unroll
            for (int nt = 0; nt < 4; ++nt)
#pragma unroll
                for (int reg = 0; reg < 4; ++reg)
                    dst[(size_t)(4 * fq + reg) * 64 + nt * 16 + fr] = (bf16_t)(pk_bf16(acc2[nt][reg], 0.f) & 0xffffu);
        }
    }
    __syncthreads();
}

__device__ __forceinline__ void f_inproj(const Params& p, unsigned char* shm) {
    unsigned char* wsb = (unsigned char*)p.ws;
    const bf16_t* xn = (const bf16_t*)(wsb + WS_XN);
    const bf16_t* btin = (const bf16_t*)(wsb + WS_BTIN);
    bf16_t* pt = (bf16_t*)(wsb + WS_PT);
    float* gates = (float*)(wsb + WS_GATES);
    float* kmean = (float*)(wsb + WS_KMEAN);
    const int tid = threadIdx.x, wid = __builtin_amdgcn_readfirstlane(tid >> 6), lane = tid & 63, wr = wid >> 2, wc = wid & 3;
    constexpr int NTN = NIN_PAD / 256;
    gemm256_stream((LAS unsigned char*)shm,
        [&](int i, const char*& A, const char*& B, unsigned (&va)[2][2], const GPiece& pc) __attribute__((always_inline)) {
            const int it = xcd_unit(blockIdx.x + i * gridDim.x, (NTOK / 256) * NTN);
            if (it < 0) return false;
            const int pm = (it / (8 * NTN)) * 8 + (it % (8 * NTN)) % 8, pn = (it % (8 * NTN)) / 8;
            A = (const char*)xn;
            B = (const char*)(btin + (size_t)pn * 256 * DM);
#pragma unroll
            for (int h = 0; h < 2; ++h)
#pragma unroll
                for (int j = 0; j < 2; ++j) va[h][j] = (unsigned)((pm * 256 + h * 128 + pc.R[j]) * DM + pc.C[j]) * 2u;
            return true;
        },
        [&](int i, f32x4 (&acc)[2][2][4][2]) __attribute__((always_inline)) {
        PROBE_SKIP_EPI;
        const int it = xcd_unit(blockIdx.x + i * gridDim.x, (NTOK / 256) * NTN);
        const int pm = (it / (8 * NTN)) * 8 + (it % (8 * NTN)) % 8, pn = (it % (8 * NTN)) / 8;
        int le = lane;
        asm volatile("" : "+v"(le));
        const int er = le & 15, eq = le >> 4;
        if (pn < 11) {
#pragma unroll
            for (int bj = 0; bj < 2; ++bj) {
                const int hg = pn * 4 + bj * 2 + (wc >> 1);
                const float sc = (hg < 8 || (hg >= 24 && hg < 32)) ? QSCALE : 1.0f;
                bf16_t* base = pt + ((size_t)hg * NTOK + pm * 256 + wr * 64) * 64 + (wc & 1) * 32 + 8 * eq;
#pragma unroll
                for (int ai = 0; ai < 2; ++ai)
#pragma unroll
                    for (int m = 0; m < 4; ++m) {
                        const f32x4 a0 = acc[ai][bj][m][0], a1 = acc[ai][bj][m][1];
                        u32x4 ov;
                        ov.x = pk_bf16(a0[0] * sc, a0[1] * sc);
                        ov.y = pk_bf16(a0[2] * sc, a0[3] * sc);
                        ov.z = pk_bf16(a1[0] * sc, a1[1] * sc);
                        ov.w = pk_bf16(a1[2] * sc, a1[3] * sc);
                        *(u32x4*)(base + (size_t)(ai * 128 + m * 16 + er) * 64) = ov;
                    }
                if (hg >= HG_MK && hg < HG_MK + 8) {
                    const int b = (pm * 256) / SEQ, nblk = ((pm * 256) % SEQ) >> 8, h = hg - HG_MK;
                    float* kb = kmean + (size_t)((b * 8 + h) * 32 + nblk) * 64 + (wc & 1) * 32 + 8 * eq;
#pragma unroll
                    for (int n = 0; n < 2; ++n) {
                        f32x4 s = acc[0][bj][0][n];
#pragma unroll
                        for (int m = 1; m < 4; ++m) s += acc[0][bj][m][n];
#pragma unroll
                        for (int m = 0; m < 4; ++m) s += acc[1][bj][m][n];
#pragma unroll
                        for (int o = 1; o < 16; o <<= 1) {
                            s[0] += __shfl_xor(s[0], o);
                            s[1] += __shfl_xor(s[1], o);
                            s[2] += __shfl_xor(s[2], o);
                            s[3] += __shfl_xor(s[3], o);
                        }
                        if (er == 0) {
                            float* d = kb + 4 * n;
                            unsafeAtomicAdd(d + 0, s[0]);
                            unsafeAtomicAdd(d + 1, s[1]);
                            unsafeAtomicAdd(d + 2, s[2]);
                            unsafeAtomicAdd(d + 3, s[3]);
                        }
                    }
                }
            }
        } else if (wc == 0) {
#pragma unroll
            for (int n = 0; n < 2; ++n) {
                const int gc = 8 * eq + 4 * n;
                if (gc < 24) {
#pragma unroll
                    for (int ai = 0; ai < 2; ++ai)
#pragma unroll
                        for (int m = 0; m < 4; ++m) {
                            const f32x4 a = acc[ai][0][m][n];
                            const int row = pm * 256 + ai * 128 + wr * 64 + m * 16 + er;
                            f32x4 sg;
                            sg[0] = __builtin_amdgcn_rcpf(1.0f + __expf(-a[0]));
                            sg[1] = __builtin_amdgcn_rcpf(1.0f + __expf(-a[1]));
                            sg[2] = __builtin_amdgcn_rcpf(1.0f + __expf(-a[2]));
                            sg[3] = __builtin_amdgcn_rcpf(1.0f + __expf(-a[3]));
                            *(f32x4*)(gates + (size_t)row * 24 + gc) = sg;
                        }
                }
            }
        }
    });
    __syncthreads();
}

__device__ __forceinline__ void f_outproj(const Params& p, unsigned char* shm) {
    unsigned char* wsb = (unsigned char*)p.ws;
    const bf16_t* mixb = (const bf16_t*)(wsb + WS_MIXB);
    const bf16_t* btout = (const bf16_t*)(wsb + WS_BTOUT);
    const int tid = threadIdx.x, wid = __builtin_amdgcn_readfirstlane(tid >> 6), lane = tid & 63, wr = wid >> 2, wc = wid & 3;
    gemm256_stream((LAS unsigned char*)shm,
        [&](int i, const char*& A, const char*& B, unsigned (&va)[2][2], const GPiece& pc) __attribute__((always_inline)) {
            const int it = xcd_unit(blockIdx.x + i * gridDim.x, (NTOK / 256) * 4);
            if (it < 0) return false;
            const int pm = (it >> 5) * 8 + (it & 7), pn = (it & 31) >> 3;
            A = (const char*)mixb;
            B = (const char*)(btout + (size_t)pn * 256 * DM);
#pragma unroll
            for (int h = 0; h < 2; ++h)
#pragma unroll
                for (int j = 0; j < 2; ++j) va[h][j] = (unsigned)((pm * 256 + h * 128 + pc.R[j]) * DM + pc.C[j]) * 2u;
            return true;
        },
        [&](int i, f32x4 (&acc)[2][2][4][2]) __attribute__((always_inline)) {
        PROBE_SKIP_EPI;
        const int it = xcd_unit(blockIdx.x + i * gridDim.x, (NTOK / 256) * 4);
        const int pm = (it >> 5) * 8 + (it & 7), pn = (it & 31) >> 3;
        int le = lane;
        asm volatile("" : "+v"(le));
        const int er = le & 15, eq = le >> 4;
        bf16_t* x1b = (bf16_t*)(wsb + WS_X1B);
        const size_t cb = (size_t)(pm * 256 + wr * 64 + er) * DM + pn * 256 + wc * 32 + 8 * eq;
#define OP_OFF(g, q) (cb + (size_t)(((g) >> 1) * 128 + (((g) & 1) * 2 + ((q) >> 1)) * 16) * DM + ((q) & 1) * 128)
#define OP_LOAD(X, g) _Pragma("unroll") for (int q = 0; q < 4; ++q) { X[2 * q] = *(const f32x4*)(p.x + OP_OFF(g, q)); X[2 * q + 1] = *(const f32x4*)(p.x + OP_OFF(g, q) + 4); }
#define OP_STORE(X, g) _Pragma("unroll") for (int q = 0; q < 4; ++q) {                                                  \
            const f32x4 a0 = X[2 * q] + acc[(g) >> 1][q & 1][((g) & 1) * 2 + (q >> 1)][0], a1 = X[2 * q + 1] + acc[(g) >> 1][q & 1][((g) & 1) * 2 + (q >> 1)][1]; \
            u32x4 ov;                                                                                                  \
            ov.x = pk_bf16(a0[0], a0[1]); ov.y = pk_bf16(a0[2], a0[3]); ov.z = pk_bf16(a1[0], a1[1]); ov.w = pk_bf16(a1[2], a1[3]); \
            *(u32x4*)(x1b + OP_OFF(g, q)) = ov; }
        f32x4 xa[8], xb[8];
        OP_LOAD(xa, 0)
        OP_LOAD(xb, 1)
        OP_STORE(xa, 0)
        OP_LOAD(xa, 2)
        OP_STORE(xb, 1)
        OP_LOAD(xb, 3)
        OP_STORE(xa, 2)
        OP_STORE(xb, 3)
#undef OP_OFF
#undef OP_LOAD
#undef OP_STORE
    });
    __syncthreads();
}

__device__ __forceinline__ float wave_max_fast(float x) {
    x = fmaxf(x, lane_xor1(x));
    x = fmaxf(x, lane_xor2(x));
    x = fmaxf(x, DPP_F(x, 0x141));
    x = fmaxf(x, DPP_F(x, 0x140));
    { float a = x, b = x; lane_swap16(a, b); x = fmaxf(a, b); }
    { float a = x, b = x; lane_swap32(a, b); x = fmaxf(a, b); }
    return x;
}
__device__ __forceinline__ void f_router(const Params& p, unsigned char* shm) {
    const int tid = threadIdx.x, lane = tid & 63, w = tid >> 6;
    unsigned char* wsb = (unsigned char*)p.ws;
    float* Wl = (float*)shm;
    int* hist = (int*)(shm + 147456);
    bf16_t* hb = (bf16_t*)(wsb + WS_H);
    int* sele = (int*)(wsb + WS_SELE);
    float* selw = (float*)(wsb + WS_SELW);
    int* selr = (int*)(wsb + WS_SELR);
    int* bcnt = (int*)(wsb + WS_BCNT);
    __syncthreads();
    for (int idx = tid; idx < 8192; idx += 512) {
        const int k = idx >> 3, e4 = idx & 7;
        const float4 v = ((const float4*)p.w_router)[idx];
        const int rho = ((k >> 8) * 4 + (k & 3)) * 64 + ((k >> 2) & 63);
        *(float4*)(Wl + rho * 36 + e4 * 4) = v;
    }
    const float bias = p.b_router[lane >> 1];
    float4* gl4 = (float4*)(shm + 147456 + 256);
    if (tid < 256) gl4[tid] = ((const float4*)p.ffn_g)[tid];
    for (int c = blockIdx.x; c < NTOK / 128; c += gridDim.x) {
        __syncthreads();
        if (tid < 32) hist[tid] = 0;
        __syncthreads();
        const bf16_t* x1b = (const bf16_t*)(wsb + WS_X1B);
        u32x2 vn[2][4];
#pragma unroll
        for (int q = 0; q < 2; ++q) {
            const u32x2* xr = (const u32x2*)(x1b + (size_t)(c * 128 + w * 16 + q) * DM);
#pragma unroll
            for (int j = 0; j < 4; ++j) vn[q][j] = xr[lane + 64 * j];
        }
        for (int rr = 0; rr < 16; rr += 2) {
            const int row0 = c * 128 + w * 16 + rr;
            float4 v[2][4];
#pragma unroll
            for (int q = 0; q < 2; ++q)
#pragma unroll
                for (int j = 0; j < 4; ++j) v[q][j] = make_float4(bf_lo(vn[q][j].x), bf_hi(vn[q][j].x), bf_lo(vn[q][j].y), bf_hi(vn[q][j].y));
            if (rr + 2 < 16) {
#pragma unroll
                for (int q = 0; q < 2; ++q) {
                    const u32x2* xr = (const u32x2*)(x1b + (size_t)(row0 + 2 + q) * DM);
#pragma unroll
                    for (int j = 0; j < 4; ++j) vn[q][j] = xr[lane + 64 * j];
                }
            }
            float4 gv[4];
#pragma unroll
            for (int j = 0; j < 4; ++j) gv[j] = gl4[lane + 64 * j];
#pragma unroll
            for (int q = 0; q < 2; ++q) {
                float ss = 0.f;
#pragma unroll
                for (int j = 0; j < 4; ++j) ss += dot4(v[q][j], v[q][j]);
                ss = wave_sum(ss);
                const float r = 1.0f / sqrtf(ss * (1.0f / DM) + 1e-5f);
                u32x2* o = (u32x2*)(hb + (size_t)(row0 + q) * DM);
#pragma unroll
                for (int j = 0; j < 4; ++j) {
                    v[q][j] = make_float4(v[q][j].x * r * gv[j].x, v[q][j].y * r * gv[j].y, v[q][j].z * r * gv[j].z, v[q][j].w * r * gv[j].w);
                    u32x2 ov;
                    ov.x = pk_bf16(v[q][j].x, v[q][j].y);
                    ov.y = pk_bf16(v[q][j].z, v[q][j].w);
                    o[lane + 64 * j] = ov;
                }
            }
            f32x2 lg[32];
#pragma unroll
            for (int e = 0; e < 32; ++e) lg[e] = (f32x2){0.f, 0.f};
#pragma unroll
            for (int j = 0; j < 4; ++j) {
                const f32x2 hh[4] = {{v[0][j].x, v[1][j].x}, {v[0][j].y, v[1][j].y}, {v[0][j].z, v[1][j].z}, {v[0][j].w, v[1][j].w}};
#pragma unroll
                for (int cc = 0; cc < 4; ++cc) {
                    const float4* wr = (const float4*)(Wl + ((j * 4 + cc) * 64 + lane) * 36);
#pragma unroll
                    for (int e4 = 0; e4 < 8; ++e4) {
                        const float4 wv = wr[e4];
                        lg[e4 * 4 + 0] = __builtin_elementwise_fma(hh[cc], (f32x2){wv.x, wv.x}, lg[e4 * 4 + 0]);
                        lg[e4 * 4 + 1] = __builtin_elementwise_fma(hh[cc], (f32x2){wv.y, wv.y}, lg[e4 * 4 + 1]);
                        lg[e4 * 4 + 2] = __builtin_elementwise_fma(hh[cc], (f32x2){wv.z, wv.z}, lg[e4 * 4 + 2]);
                        lg[e4 * 4 + 3] = __builtin_elementwise_fma(hh[cc], (f32x2){wv.w, wv.w}, lg[e4 * 4 + 3]);
                    }
                    asm volatile("" ::: "memory");
                }
            }
#define RS_SWAP(Q, N, SWAP)                                                                                            \
            {                                                                                                          \
                _Pragma("unroll") for (int i_ = 0; i_ < (N); ++i_) {                                                     \
                    float a_ = lg[i_][Q], b_ = lg[(N) + i_][Q];                                                        \
                    SWAP(a_, b_);                                                                                      \
                    lg[i_][Q] = a_ + b_;                                                                               \
                }                                                                                                      \
            }
#define RS_DPP(Q, N, XOR, BIT)                                                                                         \
            {                                                                                                          \
                const bool up_ = (lane >> (BIT)) & 1;                                                                  \
                _Pragma("unroll") for (int i_ = 0; i_ < (N); ++i_) {                                                     \
                    const float t0_ = lg[i_][Q] + XOR(lg[i_][Q]), t1_ = lg[(N) + i_][Q] + XOR(lg[(N) + i_][Q]);        \
                    lg[i_][Q] = up_ ? t1_ : t0_;                                                                       \
                }                                                                                                      \
            }
#define ROW_TAIL(Q)                                                                                                    \
            {                                                                                                          \
                const int row = row0 + (Q);                                                                            \
                RS_SWAP(Q, 16, lane_swap32)                                                                            \
                RS_SWAP(Q, 8, lane_swap16)                                                                             \
                RS_DPP(Q, 4, lane_xor8, 3)                                                                             \
                RS_DPP(Q, 2, lane_xor4, 2)                                                                             \
                RS_DPP(Q, 1, lane_xor2, 1)                                                                             \
                float val = lg[0][Q] + lane_xor1(lg[0][Q]) + bias;     \
                float tv0, tv1, tv2, tv3;                                                                              \
                int ti0, ti1, ti2, ti3;                                                                                \
                TOP_STEP(tv0, ti0) TOP_STEP(tv1, ti1) TOP_STEP(tv2, ti2) TOP_STEP(tv3, ti3)                            \
                const float e1 = __expf(tv1 - tv0), e2 = __expf(tv2 - tv0), e3 = __expf(tv3 - tv0);                    \
                const float inv = 1.0f / (1.0f + e1 + e2 + e3);                                                        \
                if (lane == 0) {                                                                                       \
                    *(int4*)(sele + row * 4) = make_int4(ti0, ti1, ti2, ti3);                                          \
                    *(float4*)(selw + row * 4) = make_float4(inv, e1 * inv, e2 * inv, e3 * inv);                       \
                    int4 rk;                                                                                           \
                    rk.x = atomicAdd(&hist[ti0], 1);                                                                   \
                    rk.y = atomicAdd(&hist[ti1], 1);                                                                   \
                    rk.z = atomicAdd(&hist[ti2], 1);                                                                   \
                    rk.w = atomicAdd(&hist[ti3], 1);                                                                   \
                    *(int4*)(selr + row * 4) = rk;                                                                     \
                }                                                                                                      \
            }
#define TOP_STEP(TV, TI)                                                                                               \
                {                                                                                                      \
                    const float mx = wave_max_fast(val);                                                               \
                    const unsigned long long bal = __ballot(val == mx);                                                \
                    const int ln = __ffsll((long long)bal) - 1;       \
                    TV = mx;                                                                                           \
                    TI = ln >> 1;                                                                                      \
                    if ((lane >> 1) == (ln >> 1)) val = -INFINITY;                                                     \
                }
            ROW_TAIL(0)
            ROW_TAIL(1)
#undef ROW_TAIL
#undef TOP_STEP
#undef RS_SWAP
#undef RS_DPP
        }
        __syncthreads();
        if (tid < 32) bcnt[c * 32 + tid] = hist[tid];
    }
    __syncthreads();
}

__device__ __forceinline__ float row16_max(float x) {
    x = fmaxf(x, lane_xor1(x)); x = fmaxf(x, lane_xor2(x)); x = fmaxf(x, DPP_F(x, 0x141)); x = fmaxf(x, DPP_F(x, 0x140)); return x;
}
__device__ __forceinline__ int row16_min_i(int x) {
    x = min(x, __builtin_amdgcn_mov_dpp(x, 0xB1, 0xF, 0xF, true)); x = min(x, __builtin_amdgcn_mov_dpp(x, 0x4E, 0xF, 0xF, true));
    x = min(x, __builtin_amdgcn_mov_dpp(x, 0x141, 0xF, 0xF, true)); x = min(x, __builtin_amdgcn_mov_dpp(x, 0x140, 0xF, 0xF, true)); return x;
}
__device__ __forceinline__ void f_router_mfma(const Params& p, unsigned char* shm) {
    const int tid = threadIdx.x, lane = tid & 63, w = __builtin_amdgcn_readfirstlane(tid >> 6), fr = lane & 15, fq = lane >> 4;
    unsigned char* wsb = (unsigned char*)p.ws;
    LAS unsigned char* lds = (LAS unsigned char*)shm;
    constexpr int WP = 2064;
    constexpr int R_WHI = 0, R_WLO = 32 * WP, R_G = 2 * 32 * WP, R_RS = R_G + 4096, R_HIST = R_RS + 8 * 64;
    static_assert(R_HIST + 128 <= FAST_LDS_BYTES - 16, "router LDS map");
    LAS float* gl = (LAS float*)(lds + R_G);
    LAS float* rs = (LAS float*)(lds + R_RS) + w * 16;
    LAS int* hist = (LAS int*)(lds + R_HIST);
    bf16_t* hb = (bf16_t*)(wsb + WS_H);
    const bf16_t* x1b = (const bf16_t*)(wsb + WS_X1B);
    int* sele = (int*)(wsb + WS_SELE);
    float* selw = (float*)(wsb + WS_SELW);
    int* selr = (int*)(wsb + WS_SELR);
    int* bcnt = (int*)(wsb + WS_BCNT);
    __syncthreads();
    {
        const u32x4* src = (const u32x4*)(wsb + WS_RWT);
#pragma unroll 4
        for (int q = tid; q < 8192; q += 512) *(LAS u32x4*)(lds + (q >> 7) * WP + (q & 127) * 16) = src[q];
    }
    if (tid < 256) {
        const float4 g = ((const float4*)p.ffn_g)[tid];
        *(LAS f32x4*)(gl + tid * 4) = (f32x4){g.x, g.y, g.z, g.w};
    }
    const float bias0 = p.b_router[fr], bias1 = p.b_router[16 + fr];
    for (int c = blockIdx.x; c < NTOK / 128; c += gridDim.x) {
        __syncthreads();
        if (tid < 32) hist[tid] = 0;
        __syncthreads();
        const int row = c * 128 + w * 16 + fr;
        const bf16_t* xrow = x1b + (size_t)row * DM + 8 * fq;
        f32x4 acc0 = {0.f, 0.f, 0.f, 0.f}, acc1 = {0.f, 0.f, 0.f, 0.f};
        float ss = 0.f;
        LAS const unsigned char* bh0 = lds + R_WHI + fr * WP + fq * 16;
        u32x4 xr[2][8];
#pragma unroll
        for (int q = 0; q < 8; ++q) xr[0][q] = *(const u32x4*)(xrow + 32 * q);
#pragma unroll
        for (int kk = 0; kk < 32; ++kk) {
            if ((kk & 7) == 0 && kk + 8 < 32) {
#pragma unroll
                for (int q = 0; q < 8; ++q) xr[((kk >> 3) + 1) & 1][q] = *(const u32x4*)(xrow + 32 * (kk + 8 + q));
            }
            const f32x4 g0 = *(LAS const f32x4*)(gl + 32 * kk + 8 * fq), g1 = *(LAS const f32x4*)(gl + 32 * kk + 8 * fq + 4);
            const u32x4 xv = xr[(kk >> 3) & 1][kk & 7];
            float a[8] = {bf_lo(xv.x), bf_hi(xv.x), bf_lo(xv.y), bf_hi(xv.y), bf_lo(xv.z), bf_hi(xv.z), bf_lo(xv.w), bf_hi(xv.w)};
#pragma unroll
            for (int j = 0; j < 8; ++j) ss = fmaf(a[j], a[j], ss);
            a[0] *= g0[0]; a[1] *= g0[1]; a[2] *= g0[2]; a[3] *= g0[3]; a[4] *= g1[0]; a[5] *= g1[1]; a[6] *= g1[2]; a[7] *= g1[3];
            u32x4 hi, lo;
            hi.x = pk_bf16(a[0], a[1]); hi.y = pk_bf16(a[2], a[3]); hi.z = pk_bf16(a[4], a[5]); hi.w = pk_bf16(a[6], a[7]);
            lo.x = pk_bf16(a[0] - bf_lo(hi.x), a[1] - bf_hi(hi.x)); lo.y = pk_bf16(a[2] - bf_lo(hi.y), a[3] - bf_hi(hi.y));
            lo.z = pk_bf16(a[4] - bf_lo(hi.z), a[5] - bf_hi(hi.z)); lo.w = pk_bf16(a[6] - bf_lo(hi.w), a[7] - bf_hi(hi.w));
            const bf16x8 ah = __builtin_bit_cast(bf16x8, hi), al = __builtin_bit_cast(bf16x8, lo);
            const bf16x8 wh0 = *(LAS const bf16x8*)(bh0 + kk * 64), wh1 = *(LAS const bf16x8*)(bh0 + 16 * WP + kk * 64);
            const bf16x8 wl0 = *(LAS const bf16x8*)(bh0 + R_WLO + kk * 64), wl1 = *(LAS const bf16x8*)(bh0 + R_WLO + 16 * WP + kk * 64);
            acc0 = __builtin_amdgcn_mfma_f32_16x16x32_bf16(ah, wh0, acc0, 0, 0, 0);
            acc1 = __builtin_amdgcn_mfma_f32_16x16x32_bf16(ah, wh1, acc1, 0, 0, 0);
            acc0 = __builtin_amdgcn_mfma_f32_16x16x32_bf16(ah, wl0, acc0, 0, 0, 0);
            acc1 = __builtin_amdgcn_mfma_f32_16x16x32_bf16(ah, wl1, acc1, 0, 0, 0);
            acc0 = __builtin_amdgcn_mfma_f32_16x16x32_bf16(al, wh0, acc0, 0, 0, 0);
            acc1 = __builtin_amdgcn_mfma_f32_16x16x32_bf16(al, wh1, acc1, 0, 0, 0);
            acc0 = __builtin_amdgcn_mfma_f32_16x16x32_bf16(al, wl0, acc0, 0, 0, 0);
            acc1 = __builtin_amdgcn_mfma_f32_16x16x32_bf16(al, wl1, acc1, 0, 0, 0);
            asm volatile("" ::: "memory");
        }
        { float a_ = ss, b_ = ss; lane_swap16(a_, b_); ss = a_ + b_; }
        { float a_ = ss, b_ = ss; lane_swap32(a_, b_); ss = a_ + b_; }
        const float r = 1.0f / sqrtf(ss * (1.0f / DM) + 1e-5f);
        if (fq == 0) rs[fr] = r;
        {
            bf16_t* hrow = hb + (size_t)row * DM + 8 * fq;
#pragma unroll
            for (int q = 0; q < 8; ++q) xr[0][q] = *(const u32x4*)(xrow + 32 * q);
#pragma unroll
            for (int kk = 0; kk < 32; ++kk) {
                if ((kk & 7) == 0 && kk + 8 < 32) {
#pragma unroll
                    for (int q = 0; q < 8; ++q) xr[((kk >> 3) + 1) & 1][q] = *(const u32x4*)(xrow + 32 * (kk + 8 + q));
                }
                const f32x4 g0 = *(LAS const f32x4*)(gl + 32 * kk + 8 * fq), g1 = *(LAS const f32x4*)(gl + 32 * kk + 8 * fq + 4);
                const u32x4 xv = xr[(kk >> 3) & 1][kk & 7];
                u32x4 ov;
                ov.x = pk_bf16(bf_lo(xv.x) * r * g0[0], bf_hi(xv.x) * r * g0[1]);
                ov.y = pk_bf16(bf_lo(xv.y) * r * g0[2], bf_hi(xv.y) * r * g0[3]);
                ov.z = pk_bf16(bf_lo(xv.z) * r * g1[0], bf_hi(xv.z) * r * g1[1]);
                ov.w = pk_bf16(bf_lo(xv.w) * r * g1[2], bf_hi(xv.w) * r * g1[3]);
                *(u32x4*)(hrow + 32 * kk) = ov;
                asm volatile("" ::: "memory");
            }
        }
        asm volatile("s_waitcnt lgkmcnt(0)" ::: "memory");
#pragma unroll
        for (int reg = 0; reg < 4; ++reg) {
            const float rr = rs[4 * fq + reg];
            float v0 = fmaf(rr, acc0[reg], bias0), v1 = fmaf(rr, acc1[reg], bias1);
            float tv[4];
            int ti[4];
#pragma unroll
            for (int s = 0; s < 4; ++s) {
                const float mx = row16_max(fmaxf(v0, v1));
                const int e = row16_min_i(v0 == mx ? fr : (v1 == mx ? 16 + fr : 64));
                tv[s] = mx;
                ti[s] = e;
                if (fr == e) v0 = -INFINITY;
                if (16 + fr == e) v1 = -INFINITY;
            }
            const float e1 = __expf(tv[1] - tv[0]), e2 = __expf(tv[2] - tv[0]), e3 = __expf(tv[3] - tv[0]);
            const float inv = 1.0f / (1.0f + e1 + e2 + e3);
            if (fr == 0) {
                const int orow = c * 128 + w * 16 + 4 * fq + reg;
                *(int4*)(sele + orow * 4) = make_int4(ti[0], ti[1], ti[2], ti[3]);
                *(float4*)(selw + orow * 4) = make_float4(inv, e1 * inv, e2 * inv, e3 * inv);
                int4 rk;
                rk.x = atomicAdd((int*)(hist + ti[0]), 1);
                rk.y = atomicAdd((int*)(hist + ti[1]), 1);
                rk.z = atomicAdd((int*)(hist + ti[2]), 1);
                rk.w = atomicAdd((int*)(hist + ti[3]), 1);
                *(int4*)(selr + orow * 4) = rk;
            }
        }
        __syncthreads();
        if (tid < 32) bcnt[c * 32 + tid] = hist[tid];
    }
    __syncthreads();
}

__device__ __forceinline__ void f_fill(const Params& p, unsigned char* shm) {
    const int tid = threadIdx.x;
    unsigned char* wsb = (unsigned char*)p.ws;
    const int* sele = (const int*)(wsb + WS_SELE);
    const float* selw = (const float*)(wsb + WS_SELW);
    const int* selr = (const int*)(wsb + WS_SELR);
    int* selp = (int*)(wsb + WS_SELP);
    const int* bcnt = (const int*)(wsb + WS_BCNT);
    int* gcnt = (int*)(wsb + WS_GCNT);
    int* rtok = (int*)(wsb + WS_RTOK);
    float* rw = (float*)(wsb + WS_RW);
    int* pa = (int*)shm;
    int* pb = pa + 512;
    int* tot = pb + 512;
    int* base = tot + 32;
    int* pstart = base + 32;
    for (int c = blockIdx.x; c < NTOK / 128; c += gridDim.x) {
        __syncthreads();
        {
            const int e = tid & 31, part = tid >> 5;
            int sa = 0, sb = 0;
            for (int cc = part * 16; cc < part * 16 + 16; ++cc) {
                const int v = bcnt[cc * 32 + e];
                sa += v;
                sb += (cc < c) ? v : 0;
            }
            pa[part * 32 + e] = sa;
            pb[part * 32 + e] = sb;
        }
        __syncthreads();
        if (tid < 32) {
            int sa = 0, sb = 0;
            for (int q = 0; q < 16; ++q) { sa += pa[q * 32 + tid]; sb += pb[q * 32 + tid]; }
            tot[tid] = sa;
            base[tid] = sb;
        }
        __syncthreads();
        if (tid == 0) {
            int a = 0;
            for (int e = 0; e < NE; ++e) { pstart[e] = a; a += ((tot[e] + 255) >> 8) << 8; }
            pstart[NE] = a;
        }
        __syncthreads();
        {
            const int i = c * 512 + tid;
            const int e = sele[i];
            const int pos = pstart[e] + base[e] + selr[i];
            rtok[pos] = i >> 2;
            rw[pos] = selw[i];
            selp[i] = pos;
        }
        if (c == 0) {
            if (tid < 32) gcnt[tid] = tot[tid];
            for (int e = 0; e < NE; ++e) {
                const int r0 = pstart[e] + tot[e], r1 = pstart[e + 1];
                for (int r = r0 + tid; r < r1; r += 512) { rtok[r] = 0; rw[r] = 0.f; }
            }
        }
    }
    __syncthreads();
}

__device__ __forceinline__ void f_build_tiles(const Params& p, int* tb) {
    const int* gcnt = (const int*)((unsigned char*)p.ws + WS_GCNT);
    __syncthreads();
    if (threadIdx.x == 0) {
        int a = 0, t = 0;
        for (int e = 0; e < NE; ++e) {
            tb[e] = a;
            tb[40 + e] = t;
            const int nt = (gcnt[e] + 255) >> 8;
            a += nt << 8;
            t += nt;
        }
        tb[32] = a;
        tb[40 + 32] = t;
    }
    __syncthreads();
}

#ifndef UP_STAGGER_TICKS
#define UP_STAGGER_TICKS 0
#endif
#ifndef DOWN_STAGGER_TICKS
#define DOWN_STAGGER_TICKS 0
#endif
__device__ __forceinline__ void stagger_start(int total, int ticks) {
    const int rem = total % (int)gridDim.x, b = (int)blockIdx.x;
    if (rem == 0 || b < rem) return;
    const long long d = (long long)ticks * (b - rem + 1) / ((int)gridDim.x - rem);
    const long long t0 = wall_clock64();
    while (wall_clock64() - t0 < d) __builtin_amdgcn_s_sleep(16);
}
__device__ __forceinline__ void f_up(const Params& p, unsigned char* shm) {
    unsigned char* wsb = (unsigned char*)p.ws;
    int* tb = (int*)(shm + GEMM_LDS_BYTES);
    f_build_tiles(p, tb);
    const int T = tb[40 + 32];
    const bf16_t* hb = (const bf16_t*)(wsb + WS_H);
    const bf16_t* btup = (const bf16_t*)(wsb + WS_BTUP);
    bf16_t* act = (bf16_t*)(wsb + WS_ACT);
    const int* rtok = (const int*)(wsb + WS_RTOK);
    const int tid = threadIdx.x, wid = __builtin_amdgcn_readfirstlane(tid >> 6), lane = tid & 63, wr = wid >> 2, wc = wid & 3;
    LAS unsigned short* rtl = (LAS unsigned short*)((LAS unsigned char*)shm + GEMM_LDS_BYTES + 512);
    LAS float* bil = (LAS float*)(rtl + 17 * 256);
    constexpr int RTL_UNITS = 17;
    {
        int e = 0;
        for (int i = 0; i < RTL_UNITS; ++i) {
            const int it = xcd_unit(blockIdx.x + i * gridDim.x, T * 8);
            if (it < 0) break;
            const int vt = it >> 3, pn = it & 7;
            while (tb[40 + e + 1] <= vt) ++e;
            const int rowbase = tb[e] + (vt - tb[40 + e]) * 256;
            if (tid < 256) rtl[i * 256 + tid] = (unsigned short)rtok[rowbase + tid];
            else bil[i * 256 + tid - 256] = p.b_up[(size_t)e * DFF2 + pn * 256 + tid - 256];
        }
    }
    __syncthreads();
    int eu = 0, ee = 0;
    gemm256_stream((LAS unsigned char*)shm,
        [&](int i, const char*& A, const char*& B, unsigned (&va)[2][2], const GPiece& pc) __attribute__((always_inline)) {
            const int it = xcd_unit(blockIdx.x + i * gridDim.x, T * 8);
            if (it < 0) return false;
            const int vt = it >> 3, pn = it & 7;
            int e = eu;
            while (tb[40 + e + 1] <= vt) ++e;
            eu = e;
            const int rowbase = tb[e] + (vt - tb[40 + e]) * 256;
            A = (const char*)hb;
            B = (const char*)(btup + ((size_t)e * DFF2 + pn * 256) * DM);
#pragma unroll
            for (int h = 0; h < 2; ++h)
#pragma unroll
                for (int j = 0; j < 2; ++j) {
                    const int tk = i < RTL_UNITS ? (int)rtl[i * 256 + h * 128 + pc.R[j]] : rtok[rowbase + h * 128 + pc.R[j]];
                    va[h][j] = (unsigned)(tk * DM + pc.C[j]) * 2u;
                }
            return true;
        },
        [&](int i, f32x4 (&acc)[2][2][4][2]) __attribute__((always_inline)) {
        PROBE_SKIP_EPI;
        const int it = xcd_unit(blockIdx.x + i * gridDim.x, T * 8);
        const int vt = it >> 3, pn = it & 7;
        int e = ee;
        while (tb[40 + e + 1] <= vt) ++e;
        ee = e;
        const int rowbase = tb[e] + (vt - tb[40 + e]) * 256;
        int le = lane;
        asm volatile("" : "+v"(le));
        const int er = le & 15, eq = le >> 4;
        const int a0 = pn * 128 + wc * 32 + 8 * eq;
        float bg[8], bu[8];
        {
            float4 q0, q1, q2, q3;
            if (i < RTL_UNITS) {
                const LAS float* bl = bil + i * 256 + wc * 64 + 16 * eq;
                const f32x4 t0 = *(const LAS f32x4*)bl, t1 = *(const LAS f32x4*)(bl + 4), t2 = *(const LAS f32x4*)(bl + 8), t3 = *(const LAS f32x4*)(bl + 12);
                q0 = make_float4(t0[0], t0[1], t0[2], t0[3]); q1 = make_float4(t1[0], t1[1], t1[2], t1[3]);
                q2 = make_float4(t2[0], t2[1], t2[2], t2[3]); q3 = make_float4(t3[0], t3[1], t3[2], t3[3]);
            } else {
                const float* bias = p.b_up + (size_t)e * DFF2 + 2 * a0;
                q0 = *(const float4*)bias; q1 = *(const float4*)(bias + 4); q2 = *(const float4*)(bias + 8); q3 = *(const float4*)(bias + 12);
            }
            bg[0] = q0.x; bu[0] = q0.y; bg[1] = q0.z; bu[1] = q0.w; bg[2] = q1.x; bu[2] = q1.y; bg[3] = q1.z; bu[3] = q1.w;
            bg[4] = q2.x; bu[4] = q2.y; bg[5] = q2.z; bu[5] = q2.w; bg[6] = q3.x; bu[6] = q3.y; bg[7] = q3.z; bu[7] = q3.w;
        }
#pragma unroll
        for (int ai = 0; ai < 2; ++ai)
#pragma unroll
            for (int mm = 0; mm < 4; ++mm) {
                const int row = rowbase + ai * 128 + wr * 64 + mm * 16 + er;
                const f32x4 g0 = acc[ai][0][mm][0], g1 = acc[ai][0][mm][1], u0 = acc[ai][1][mm][0], u1 = acc[ai][1][mm][1];
                u32x4 ov;
                ov.x = pk_bf16(swiglu(g0[0] + bg[0], u0[0] + bu[0]), swiglu(g0[1] + bg[1], u0[1] + bu[1]));
                ov.y = pk_bf16(swiglu(g0[2] + bg[2], u0[2] + bu[2]), swiglu(g0[3] + bg[3], u0[3] + bu[3]));
                ov.z = pk_bf16(swiglu(g1[0] + bg[4], u1[0] + bu[4]), swiglu(g1[1] + bg[5], u1[1] + bu[5]));
                ov.w = pk_bf16(swiglu(g1[2] + bg[6], u1[2] + bu[6]), swiglu(g1[3] + bg[7], u1[3] + bu[7]));
                *(u32x4*)(act + (size_t)row * DM + a0) = ov;
            }
    });
    __syncthreads();
}

__device__ __forceinline__ void f_down(const Params& p, unsigned char* shm) {
    unsigned char* wsb = (unsigned char*)p.ws;
    int* tb = (int*)(shm + GEMM_LDS_BYTES);
    f_build_tiles(p, tb);
    const int T = tb[40 + 32];
    const bf16_t* act = (const bf16_t*)(wsb + WS_ACT);
    const bf16_t* btdn = (const bf16_t*)(wsb + WS_BTDN);
    bf16_t* yb = (bf16_t*)(wsb + WS_Y);
    const float* rw = (const float*)(wsb + WS_RW);
    const int tid = threadIdx.x, wid = __builtin_amdgcn_readfirstlane(tid >> 6), lane = tid & 63, wr = wid >> 2, wc = wid & 3;
    LAS float* rwl = (LAS float*)((LAS unsigned char*)shm + GEMM_LDS_BYTES + 512);
    LAS float* bil = rwl + 9 * 256;
    constexpr int EPL_UNITS = 9;
    {
        int e = 0;
        for (int i = 0; i < EPL_UNITS; ++i) {
            const int it = xcd_unit(blockIdx.x + i * gridDim.x, T * 4);
            if (it < 0) break;
            const int vt = it >> 2, pn = it & 3;
            while (tb[40 + e + 1] <= vt) ++e;
            const int rowbase = tb[e] + (vt - tb[40 + e]) * 256;
            if (tid < 256) rwl[i * 256 + tid] = rw[rowbase + tid];
            else bil[i * 256 + tid - 256] = p.b_down[(size_t)e * DM + pn * 256 + tid - 256];
        }
    }
    __syncthreads();
    int eu = 0, ee = 0;
    gemm256_stream((LAS unsigned char*)shm,
        [&](int i, const char*& A, const char*& B, unsigned (&va)[2][2], const GPiece& pc) __attribute__((always_inline)) {
            const int it = xcd_unit(blockIdx.x + i * gridDim.x, T * 4);
            if (it < 0) return false;
            const int vt = it >> 2, pn = it & 3;
            int e = eu;
            while (tb[40 + e + 1] <= vt) ++e;
            eu = e;
            const int rowbase = tb[e] + (vt - tb[40 + e]) * 256;
            A = (const char*)(act + (size_t)rowbase * DM);
            B = (const char*)(btdn + ((size_t)e * DM + pn * 256) * DM);
#pragma unroll
            for (int h = 0; h < 2; ++h)
#pragma unroll
                for (int j = 0; j < 2; ++j) va[h][j] = (unsigned)((h * 128 + pc.R[j]) * DM + pc.C[j]) * 2u;
            return true;
        },
        [&](int i, f32x4 (&acc)[2][2][4][2]) __attribute__((always_inline)) {
        PROBE_SKIP_EPI;
        const int it = xcd_unit(blockIdx.x + i * gridDim.x, T * 4);
        const int vt = it >> 2, pn = it & 3;
        int e = ee;
        while (tb[40 + e + 1] <= vt) ++e;
        ee = e;
        const int rowbase = tb[e] + (vt - tb[40 + e]) * 256;
        int le = lane;
        asm volatile("" : "+v"(le));
        const int er = le & 15, eq = le >> 4;
        const float* bias = p.b_down + (size_t)e * DM;
        float wgt[2][4];
#pragma unroll
        for (int ai = 0; ai < 2; ++ai)
#pragma unroll
            for (int mm = 0; mm < 4; ++mm) {
                const int rl = ai * 128 + wr * 64 + mm * 16 + er;
                wgt[ai][mm] = i < EPL_UNITS ? rwl[i * 256 + rl] : rw[rowbase + rl];
            }
        float4 bb[2][2];
#pragma unroll
        for (int bj = 0; bj < 2; ++bj) {
            const int cl = bj * 128 + wc * 32 + 8 * eq;
            if (i < EPL_UNITS) {
                const f32x4 t0 = *(const LAS f32x4*)(bil + i * 256 + cl), t1 = *(const LAS f32x4*)(bil + i * 256 + cl + 4);
                bb[bj][0] = make_float4(t0[0], t0[1], t0[2], t0[3]); bb[bj][1] = make_float4(t1[0], t1[1], t1[2], t1[3]);
            }
            else { bb[bj][0] = *(const float4*)(bias + pn * 256 + cl); bb[bj][1] = *(const float4*)(bias + pn * 256 + cl + 4); }
        }
#pragma unroll
        for (int bj = 0; bj < 2; ++bj) {
            const int col = pn * 256 + bj * 128 + wc * 32 + 8 * eq;
            const float4 b0 = bb[bj][0], b1 = bb[bj][1];
#pragma unroll
            for (int ai = 0; ai < 2; ++ai)
#pragma unroll
                for (int mm = 0; mm < 4; ++mm) {
                    const int row = rowbase + ai * 128 + wr * 64 + mm * 16 + er;
                    const float w_ = wgt[ai][mm];
                    const f32x4 x0 = acc[ai][bj][mm][0], x1 = acc[ai][bj][mm][1];
                    u32x4 ov;
                    ov.x = pk_bf16((x0[0] + b0.x) * w_, (x0[1] + b0.y) * w_);
                    ov.y = pk_bf16((x0[2] + b0.z) * w_, (x0[3] + b0.w) * w_);
                    ov.z = pk_bf16((x1[0] + b1.x) * w_, (x1[1] + b1.y) * w_);
                    ov.w = pk_bf16((x1[2] + b1.z) * w_, (x1[3] + b1.w) * w_);
                    *(u32x4*)(yb + (size_t)row * DM + col) = ov;
                }
        }
    });
    __syncthreads();
}


__device__ __forceinline__ void f_final(const Params& p) {
    const int lane = threadIdx.x & 63, w = threadIdx.x >> 6;
    unsigned char* wsb = (unsigned char*)p.ws;
    const bf16_t* yb = (const bf16_t*)(wsb + WS_Y);
    const int* selp = (const int*)(wsb + WS_SELP);
    const float4* g4 = (const float4*)p.final_g;
    for (int row0 = blockIdx.x * 8 + w; row0 < NTOK / 2; row0 += gridDim.x * 8) {
        float4 v[2][4];
        u32x2 xv[2][4];
        u32x2 yv[2][4][4];
#pragma unroll
        for (int q = 0; q < 2; ++q) {
            const int row = row0 + q * (NTOK / 2);
            const u32x2* xr = (const u32x2*)((const bf16_t*)(wsb + WS_X1B) + (size_t)row * DM);
            const int4 sp = *(const int4*)(selp + row * 4);
            const int pos[4] = {sp.x, sp.y, sp.z, sp.w};
#pragma unroll
            for (int j = 0; j < 4; ++j) xv[q][j] = xr[lane + 64 * j];
#pragma unroll
            for (int k = 0; k < 4; ++k) {
                const u32x2* yr = (const u32x2*)(yb + (size_t)pos[k] * DM);
#pragma unroll
                for (int j = 0; j < 4; ++j) yv[q][k][j] = yr[lane + 64 * j];
            }
        }
#pragma unroll
        for (int q = 0; q < 2; ++q) {
            const int row = row0 + q * (NTOK / 2);
#pragma unroll
            for (int j = 0; j < 4; ++j) v[q][j] = make_float4(bf_lo(xv[q][j].x), bf_hi(xv[q][j].x), bf_lo(xv[q][j].y), bf_hi(xv[q][j].y));
#pragma unroll
            for (int k = 0; k < 4; ++k)
#pragma unroll
                for (int j = 0; j < 4; ++j) {
                    v[q][j].x += bf_lo(yv[q][k][j].x);
                    v[q][j].y += bf_hi(yv[q][k][j].x);
                    v[q][j].z += bf_lo(yv[q][k][j].y);
                    v[q][j].w += bf_hi(yv[q][k][j].y);
                }
            float ss = 0.f;
#pragma unroll
            for (int j = 0; j < 4; ++j) ss += dot4(v[q][j], v[q][j]);
            ss = wave_sum(ss);
            const float r = 1.0f / sqrtf(ss * (1.0f / DM) + 1e-5f);
            float4* xo = (float4*)(p.out + (size_t)row * DM);
#pragma unroll
            for (int j = 0; j < 4; ++j) {
                const float4 g = g4[lane + 64 * j];
                xo[lane + 64 * j] = make_float4(v[q][j].x * r * g.x, v[q][j].y * r * g.y, v[q][j].z * r * g.z, v[q][j].w * r * g.w);
            }
        }
    }
}
#define XB_TMO      128
#define XB_XCNT(j)  (256  + 64 * (j))
#define XB_XSUB(j)  (1280 + 64 * (j))
#define XB_XGEN(j)  (2304 + 64 * (j))
#define XB_TOP      3328
#define XB_TOPGEN   3392
#define XCD_BAR_WORDS 3456
#define XB_SPIN_CAP (1u << 18)

__device__ __forceinline__ unsigned xb_ld(unsigned* p)              { return __hip_atomic_load(p, __ATOMIC_RELAXED, __HIP_MEMORY_SCOPE_AGENT); }
__device__ __forceinline__ unsigned xb_add(unsigned* p, unsigned v) { return __hip_atomic_fetch_add(p, v, __ATOMIC_RELAXED, __HIP_MEMORY_SCOPE_AGENT); }
__device__ __forceinline__ unsigned xb_xcc_id() { return (unsigned)__builtin_amdgcn_s_getreg((3 << 11) | 20) & 0xFu; }
#define XB_SPIN(cond, bar) do { unsigned _sp = 0; while (cond) { __builtin_amdgcn_s_sleep(1); \
    if ((++_sp & 255u) == 0u) { if (xb_ld(&(bar)[XB_TMO])) break; if (_sp > XB_SPIN_CAP) { atomicAdd(&(bar)[XB_TMO], 1u); break; } } } } while (0)

struct XcdBarrier {
    unsigned* bar; unsigned x;
    volatile LAS unsigned* st;
};

__device__ __forceinline__ XcdBarrier xcd_barrier_post(unsigned* bar, volatile LAS unsigned* st) {
    XcdBarrier b; b.bar = bar; b.x = xb_xcc_id(); b.st = st;
    if (threadIdx.x == 0) (void)xb_add(&bar[XB_XCNT(b.x)], 1u);
    return b;
}
__device__ __forceinline__ void xcd_barrier_complete(unsigned* bar, unsigned x, unsigned& nloc, unsigned& nx) {
    const unsigned G = gridDim.x * gridDim.y * gridDim.z;
    unsigned sum, cnt, mine, sp = 0u;
    for (;;) {
        sum = 0u; cnt = 0u; mine = 0u;
#pragma unroll
        for (unsigned j = 0; j < 16; ++j) { const unsigned c = xb_ld(&bar[XB_XCNT(j)]); sum += c; cnt += (c > 0u) ? 1u : 0u; mine = (j == x) ? c : mine; }
        if (sum == G) break;
        __builtin_amdgcn_s_sleep(1);
        if ((++sp & 255u) == 0u) { if (xb_ld(&bar[XB_TMO])) break; if (sp > XB_SPIN_CAP) { atomicAdd(&bar[XB_TMO], 1u); break; } }
    }
    nloc = mine > 0u ? mine : 1u; nx = cnt > 0u ? cnt : 1u;
}

__device__ __forceinline__ void xcd_barrier(const XcdBarrier& b) {
    asm volatile("s_waitcnt vmcnt(0)" ::: "memory");
    __syncthreads();
    if (threadIdx.x == 0) {
        unsigned* bar = b.bar;
        __builtin_amdgcn_s_waitcnt(0);
        unsigned nloc = b.st[0], nx = b.st[1];
        if (nloc == 0u) { xcd_barrier_complete(bar, b.x, nloc, nx); b.st[0] = nloc; b.st[1] = nx; }
        const unsigned old = xb_add(&bar[XB_XSUB(b.x)], 1u);
        const unsigned gen = old / nloc;
        if (old + 1u == (gen + 1u) * nloc) {
            __builtin_amdgcn_fence(__ATOMIC_RELEASE, "agent");
            asm volatile("s_waitcnt vmcnt(0)" ::: "memory");
            const unsigned og = xb_add(&bar[XB_TOP], 1u);
            const unsigned tg = og / nx;
            if (og + 1u == (tg + 1u) * nx) xb_add(&bar[XB_TOPGEN], 1u);
            else XB_SPIN(xb_ld(&bar[XB_TOPGEN]) == tg, bar);
            __builtin_amdgcn_fence(__ATOMIC_ACQUIRE, "agent");
            xb_add(&bar[XB_XGEN(b.x)], 1u);
            asm volatile("s_waitcnt vmcnt(0)" ::: "memory");
        } else {
            XB_SPIN(xb_ld(&bar[XB_XGEN(b.x)]) == gen, bar);
            __builtin_amdgcn_fence(__ATOMIC_ACQUIRE, "agent");
            asm volatile("s_waitcnt vmcnt(0)" ::: "memory");
        }
    }
    __syncthreads();
}


constexpr int NFPHASE = 11;
__global__ void __launch_bounds__(512) fast_kernel(Params p) {
    extern __shared__ __attribute__((aligned(16))) unsigned char shm[];
    cg::grid_group grid = cg::this_grid();
    const int lo = p.ph_lo, hi = p.ph_hi;
    if (lo < -1) grid.sync();
    XcdBarrier bar;
    if (hi - lo > 1) {
        volatile LAS unsigned* st = (volatile LAS unsigned*)((LAS unsigned char*)shm + (FAST_LDS_BYTES - 16));
        if (threadIdx.x < 4) st[threadIdx.x] = 0u;
        __syncthreads();
        bar = xcd_barrier_post((unsigned*)((unsigned char*)p.ws + WS_BAR), st);
    }
#define F_IN(k) ((lo <= (k) && (k) < hi) || (lo >= 100 && lo % 100 == (k)))
#define F_SYNC(k) do { if (F_IN(k) && F_IN((k) + 1)) xcd_barrier(bar); } while (0)
#ifdef PROBE_TIME_PHASE
    long long tq0 = 0, tq1 = 0;
#ifdef PROBE_TIME_SUB
    if (threadIdx.x == 0) { probe_ts[0] = 0; probe_ts[1] = 0; probe_ts[2] = 0; probe_ts[3] = 99; }
    __syncthreads();
#endif
#define F_TICK(k) do { if ((k) == PROBE_TIME_PHASE) tq0 = wall_clock64(); if ((k) == PROBE_TIME_PHASE + 1) tq1 = wall_clock64(); } while (0)
#ifdef PROBE_WAIT
#define F_PRE(k) do { if ((k) == PROBE_TIME_PHASE) { __syncthreads(); tq0 = wall_clock64(); } } while (0)
#else
#define F_PRE(k) do { } while (0)
#endif
#else
#define F_TICK(k) do { } while (0)
#define F_PRE(k) do { } while (0)
#endif
    F_TICK(0);
    if (F_IN(0)) f_prologue(p, shm);
    F_PRE(0); F_SYNC(0); F_TICK(1);
    if (F_IN(1)) f_inproj(p, shm);
    F_PRE(1); F_SYNC(1); F_TICK(2);
#ifdef PROBE_P2
    if (F_IN(2)) { if (PROBE_P2 == 0) tq0 = wall_clock64(); f_cmp(p, shm); if (PROBE_P2 == 0) tq1 = wall_clock64(); if (PROBE_P2 == 1) tq0 = wall_clock64(); f_moba_gate(p, shm); if (PROBE_P2 == 1) tq1 = wall_clock64(); }
#else
    if (F_IN(2)) { f_cmp(p, shm); f_moba_gate(p, shm); }
#endif
    F_PRE(2); F_SYNC(2); F_TICK(3);
    if (F_IN(3)) f_attn(p, shm);
    F_PRE(3); F_SYNC(3); F_TICK(4);
    if (F_IN(4)) f_moba_merge(p);
    F_PRE(4); F_SYNC(4); F_TICK(5);
    if (F_IN(5)) f_outproj(p, shm);
    F_PRE(5); F_SYNC(5); F_TICK(6);
    if (F_IN(6)) f_router_mfma(p, shm);
    F_PRE(6); F_SYNC(6); F_TICK(7);
    if (F_IN(7)) f_fill(p, shm);
    F_PRE(7); F_SYNC(7); F_TICK(8);
    if (F_IN(8)) f_up(p, shm);
    F_PRE(8); F_SYNC(8); F_TICK(9);
    if (F_IN(9)) f_down(p, shm);
    F_PRE(9); F_SYNC(9); F_TICK(10);
    if (F_IN(10)) f_final(p);
#ifdef PROBE_TIME_PHASE
    if (PROBE_TIME_PHASE == 10) { __syncthreads(); tq1 = wall_clock64(); }
#ifdef PROBE_TIME_SUB
    __syncthreads();
    tq0 = probe_ts[0]; tq1 = probe_ts[1];
#endif
#ifndef PROBE_BLOCK
#define PROBE_BLOCK 0
#endif
    if (blockIdx.x == PROBE_BLOCK) {
        const long long d = (tq1 - tq0) * PROBE_TIME_MULT, t0 = wall_clock64();
        while (wall_clock64() - t0 < d) __builtin_amdgcn_s_sleep(16);
    }
#endif
}

#ifndef PROBE_KIND
#define PROBE_KIND -1
#endif
#if PROBE_KIND >= 0
__global__ void __launch_bounds__(512) probe_kernel(Params p) {
    extern __shared__ __attribute__((aligned(16))) unsigned char shm[];
#if PROBE_KIND >= 100
    f_probe_gather<PROBE_KIND - 100>(p, shm);
#else
    f_probe_nsa<PROBE_KIND>(p, shm);
#endif
}
#endif

#ifndef MULTI_LAUNCH
#define MULTI_LAUNCH 0
#endif

extern "C" void kernel_launch(void* const* d_in, const int* in_sizes, int n_in, void* d_out, int out_size, void* d_ws,
                              size_t ws_size, hipStream_t stream) {
    static int grid = 0;
    if (!grid) {
        int dev = 0, cus = 0, per_cu = 0;
        (void)hipGetDevice(&dev);
        (void)hipDeviceGetAttribute(&cus, hipDeviceAttributeMultiprocessorCount, dev);
        (void)hipFuncSetAttribute((const void*)fast_kernel, hipFuncAttributeMaxDynamicSharedMemorySize, FAST_LDS_BYTES);
        (void)hipOccupancyMaxActiveBlocksPerMultiprocessor(&per_cu, fast_kernel, 512, FAST_LDS_BYTES);
        if (per_cu < 1) fprintf(stderr, "kernel_launch: occupancy query reports %d blocks per CU\n", per_cu);
        grid = cus;
        if (ws_size < WS_END) fprintf(stderr, "kernel_launch: workspace too small: %zu < %zu\n", ws_size, (size_t)WS_END);
    }
    Params p{};
    p.x = (const float*)d_in[0];
    p.attn_g = (const float*)d_in[1];
    p.w_in = (const float*)d_in[2];
    p.pe_k = (const float*)d_in[3];
    p.pe_v = (const float*)d_in[4];
    p.w1k = (const float*)d_in[5];
    p.w2k = (const float*)d_in[6];
    p.w1v = (const float*)d_in[7];
    p.w2v = (const float*)d_in[8];
    p.w_out = (const float*)d_in[9];
    p.ffn_g = (const float*)d_in[10];
    p.w_router = (const float*)d_in[11];
    p.b_router = (const float*)d_in[12];
    p.w_up = (const float*)d_in[13];
    p.b_up = (const float*)d_in[14];
    p.w_down = (const float*)d_in[15];
    p.b_down = (const float*)d_in[16];
    p.final_g = (const float*)d_in[17];
    p.out = (float*)d_out;
    p.ws = (float*)d_ws;
#if MULTI_LAUNCH
#ifndef PROBE_DUP_MASK
#define PROBE_DUP_MASK 0
#endif
    for (int ph = 0; ph < NFPHASE; ++ph) {
        const int reps = ((PROBE_DUP_MASK >> ph) & 1) ? 3 : 1;
        for (int r = 0; r < reps; ++r) {
            p.ph_lo = ph;
            p.ph_hi = ph + 1;
            hipLaunchKernelGGL(fast_kernel, dim3(grid), dim3(512), FAST_LDS_BYTES, stream, p);
        }
#ifdef PROBE_NOEPI_PHASE
#ifndef PROBE_NOEPI_MODE
#define PROBE_NOEPI_MODE 1
#endif
        if (ph == PROBE_NOEPI_PHASE) {
            for (int r = 0; r < 2; ++r) {
                p.ph_lo = 100 * PROBE_NOEPI_MODE + ph;
                p.ph_hi = p.ph_lo + 1;
                hipLaunchKernelGGL(fast_kernel, dim3(grid), dim3(512), FAST_LDS_BYTES, stream, p);
            }
        }
#endif
#if PROBE_KIND >= 0
        if (ph == 3) {
            static bool pset = false;
            if (!pset) { (void)hipFuncSetAttribute((const void*)probe_kernel, hipFuncAttributeMaxDynamicSharedMemorySize, FAST_LDS_BYTES); pset = true; }
            hipLaunchKernelGGL(probe_kernel, dim3(grid), dim3(512), FAST_LDS_BYTES, stream, p);
        }
#endif
    }
#else
    p.ph_lo = 0;
    p.ph_hi = NFPHASE;
    (void)hipMemsetAsync((unsigned char*)d_ws + WS_BAR, 0, 16384, stream);
    void* args[] = {&p};
    hipError_t e = hipLaunchCooperativeKernel((void*)fast_kernel, dim3(grid), dim3(512), args, FAST_LDS_BYTES, stream);
    if (e != hipSuccess) fprintf(stderr, "cooperative launch failed: %s (grid %d)\n", hipGetErrorString(e), grid);
#endif
}
```
